# Optimizing an MI355X kernel written in HIP

```python
import math
import jax, jax.numpy as jnp
from jax import lax
import numpy as np

D_MODEL = 2048
BATCH = 4
SEQ = 2048
DEPTH = 1

HEAD_DIM = 128
MIX_WIDTH = D_MODEL
A_HEADS = MIX_WIDTH // (2 * HEAD_DIM)
B_HEADS = MIX_WIDTH // (2 * HEAD_DIM)
A_WIDTH = A_HEADS * HEAD_DIM
B_WIDTH = B_HEADS * HEAD_DIM
DIFF_DIM = HEAD_DIM // 2
IN_WIDTH = 3 * A_WIDTH + 3 * B_WIDTH
DILATED_CONFIGS = ((128, 1), (512, 4), (2048, 16))
ROPE_THETA = 500000.0
ROPE_FRACTION = 4
D_FF = ((-(-8 * D_MODEL // 3) + 255) // 256) * 256
Q_BLOCK = 128
RMS_EPS = 1e-6
SUBLN_EPS = 1e-5
NEG_INF = -1e30

kernel_name = 'hybrid_dilated_diff_attn_encoder_block'


def rmsnorm(x, g, eps=RMS_EPS):
    xf = x.astype(jnp.float32)
    y = xf * lax.rsqrt(jnp.mean(xf * xf, axis=-1, keepdims=True) + eps)
    return (y * g.astype(jnp.float32)).astype(x.dtype)


def rope_tables(seq, rot_dim):
    inv_freq = ROPE_THETA ** (-jnp.arange(0, rot_dim, 2, dtype=jnp.float32) / rot_dim)
    ang = jnp.arange(seq, dtype=jnp.float32)[:, None] * inv_freq[None, :]
    return jnp.cos(ang), jnp.sin(ang)


def rope(x, cos, sin):
    r2 = cos.shape[-1]
    shape = (x.shape[1],) + (1,) * (x.ndim - 3) + (r2,)
    c, s = cos.reshape(shape), sin.reshape(shape)
    x1, x2 = x[..., :r2], x[..., r2:2 * r2]
    return jnp.concatenate([x1 * c - x2 * s, x2 * c + x1 * s, x[..., 2 * r2:]], axis=-1).astype(x.dtype)


def dilated_branch(q, k, v, dil, half):
    B, S, H, Dh = q.shape
    L = S // dil
    nb = -(-L // half)
    Lp = nb * half

    def by_residue(a):
        return a.reshape(B, L, dil, H, Dh).transpose(0, 2, 3, 1, 4)

    qs = jnp.pad(by_residue(q), ((0, 0), (0, 0), (0, 0), (0, Lp - L), (0, 0))).reshape(B, dil, H, nb, half, Dh)
    kpad = ((0, 0), (0, 0), (0, 0), (half, Lp - L + half), (0, 0))
    kp = jnp.pad(by_residue(k), kpad).reshape(B, dil, H, nb + 2, half, Dh)
    vp = jnp.pad(by_residue(v), kpad).reshape(B, dil, H, nb + 2, half, Dh)

    def band(a):
        return jnp.concatenate([a[:, :, :, :-2], a[:, :, :, 1:-1], a[:, :, :, 2:]], axis=4)

    kb, vb = band(kp), band(vp)
    s = jnp.einsum('brhnqe,brhnke->brhnqk', qs, kb, preferred_element_type=jnp.float32) * (Dh ** -0.5)
    blk = jnp.arange(nb)[:, None, None]
    qa = jnp.arange(half)[None, :, None]
    kj = jnp.arange(3 * half)[None, None, :]
    kpos = blk * half - half + kj
    dist = kj - half - qa
    mask = (jnp.abs(dist) <= half) & (kpos >= 0) & (kpos < L)
    s = jnp.where(mask, s, NEG_INF)
    m = jnp.max(s, axis=-1, keepdims=True)
    p = jnp.exp(s - m)
    den = jnp.sum(p, axis=-1)
    o = jnp.einsum('brhnqk,brhnke->brhnqe', p, vb.astype(jnp.float32)) / den[..., None]
    lse = m[..., 0] + jnp.log(den)
    o = o.reshape(B, dil, H, Lp, Dh)[:, :, :, :L].transpose(0, 3, 1, 2, 4).reshape(B, S, H, Dh)
    lse = lse.reshape(B, dil, H, Lp)[:, :, :, :L].transpose(0, 3, 1, 2).reshape(B, S, H)
    return o, lse


def dilated_attention(q, k, v):
    outs, lses = [], []
    for window, dil in DILATED_CONFIGS:
        o, lse = dilated_branch(q, k, v, dil, window // (2 * dil))
        outs.append(o)
        lses.append(lse)
    w = jax.nn.softmax(jnp.stack(lses, axis=0), axis=0)
    return jnp.einsum('gbsh,gbshe->bshe', w, jnp.stack(outs, axis=0))


def diff_attention(q, k, v, lam):
    B, S, H, _, d = q.shape
    nqb = S // Q_BLOCK
    qb = q.reshape(B, nqb, Q_BLOCK, H, 2, d).transpose(1, 0, 3, 4, 2, 5)
    kt = k.transpose(0, 2, 3, 1, 4)
    vt = v.transpose(0, 2, 1, 3)

    def one_block(qblk):
        s = jnp.einsum('bhcqe,bhcke->bhcqk', qblk, kt, preferred_element_type=jnp.float32) * (d ** -0.5)
        p = jax.nn.softmax(s, axis=-1)
        a = p[:, :, 0] - lam * p[:, :, 1]
        return jnp.einsum('bhqk,bhke->bhqe', a, vt.astype(jnp.float32))

    o = lax.map(one_block, qb)
    return o.transpose(1, 0, 3, 2, 4).reshape(B, S, H, 2 * d)


def setup_inputs(seed: int = 0) -> dict:
    key = jax.random.key(seed)
    ks = jax.random.split(key, 11)
    f32 = jnp.float32

    def dense(k, shape):
        return jax.random.normal(k, shape, f32) * (shape[-2] ** -0.5)

    def gain(k, shape):
        return 1.0 + 0.02 * jax.random.normal(k, shape, f32)

    return {
        'x': jax.random.normal(ks[0], (BATCH, SEQ, D_MODEL), f32),
        'norm_attn': gain(ks[1], (DEPTH, D_MODEL)),
        'w_in': dense(ks[2], (DEPTH, D_MODEL, IN_WIDTH)),
        'lambda_qk': 0.1 * jax.random.normal(ks[3], (DEPTH, 4, DIFF_DIM), f32),
        'subln': gain(ks[4], (DEPTH, 2 * DIFF_DIM)),
        'w_out': dense(ks[5], (DEPTH, MIX_WIDTH, D_MODEL)),
        'norm_ffn': gain(ks[6], (DEPTH, D_MODEL)),
        'w_gate': dense(ks[7], (DEPTH, D_MODEL, D_FF)),
        'w_up': dense(ks[8], (DEPTH, D_MODEL, D_FF)),
        'w_down': dense(ks[9], (DEPTH, D_FF, D_MODEL)),
        'norm_final': gain(ks[10], (D_MODEL,)),
    }


def reference(x, norm_attn, w_in, lambda_qk, subln, w_out, norm_ffn, w_gate, w_up, w_down, norm_final):
    B, S, _ = x.shape
    cos_a, sin_a = rope_tables(S, HEAD_DIM // ROPE_FRACTION)
    cos_b, sin_b = rope_tables(S, DIFF_DIM // ROPE_FRACTION)
    splits = [A_WIDTH, 2 * A_WIDTH, 3 * A_WIDTH, 3 * A_WIDTH + B_WIDTH, 3 * A_WIDTH + 2 * B_WIDTH]
    for l in range(DEPTH):
        h = rmsnorm(x, norm_attn[l])
        proj = h @ w_in[l]
        qa, ka, va, qb, kb, vb = jnp.split(proj, splits, axis=-1)
        qa = rope(qa.reshape(B, S, A_HEADS, HEAD_DIM), cos_a, sin_a)
        ka = rope(ka.reshape(B, S, A_HEADS, HEAD_DIM), cos_a, sin_a)
        va = va.reshape(B, S, A_HEADS, HEAD_DIM)
        ya = dilated_attention(qa, ka, va).astype(x.dtype).reshape(B, S, A_WIDTH)
        lam_init = 0.8 - 0.6 * math.exp(-0.3 * l)
        lq = lambda_qk[l].astype(jnp.float32)
        lam = jnp.exp(jnp.sum(lq[0] * lq[1])) - jnp.exp(jnp.sum(lq[2] * lq[3])) + lam_init
        qb = rope(qb.reshape(B, S, B_HEADS, 2, DIFF_DIM), cos_b, sin_b)
        kb = rope(kb.reshape(B, S, B_HEADS, 2, DIFF_DIM), cos_b, sin_b)
        vb = vb.reshape(B, S, B_HEADS, 2 * DIFF_DIM)
        yb = diff_attention(qb, kb, vb, lam)
        yb = (rmsnorm(yb, subln[l], SUBLN_EPS) * (1.0 - lam_init)).astype(x.dtype).reshape(B, S, B_WIDTH)
        x = x + jnp.concatenate([ya, yb], axis=-1) @ w_out[l]
        h = rmsnorm(x, norm_ffn[l])
        x = x + (jax.nn.silu(h @ w_gate[l]) * (h @ w_up[l])) @ w_down[l]
    return rmsnorm(x, norm_final)
```

```cpp
#include <hip/hip_runtime.h>
#include <hip/hip_cooperative_groups.h>
#include <hip/hip_bf16.h>
#include <cstdio>
#include <cstdint>
#include <cmath>
namespace cg = cooperative_groups;
__device__ __forceinline__ int mk_lane() { int l; asm volatile("v_mbcnt_lo_u32_b32 %0, -1, 0\n\tv_mbcnt_hi_u32_b32 %0, -1, %0" : "=v"(l)); return l & 63; }
namespace pg8 {
#define PG8_LAS __attribute__((address_space(3)))
typedef unsigned short bf16_t;
typedef short bf16x8 __attribute__((ext_vector_type(8)));
typedef float f32x4 __attribute__((ext_vector_type(4)));
typedef unsigned u32x4 __attribute__((ext_vector_type(4)));
constexpr int BM = 256, BK = 64, HALF = 128, HTB = HALF * BK * 2  , STAGE_BYTES = 8 * HTB, NXCD = 8, WGM = 8;

__host__ __device__ __forceinline__ int lds_byte(int r, int c) { const int st = (r >> 4) * 2 + (c >> 5), rr = r & 15, cc = c & 31, ob = rr * 64 + cc * 2; return st * 1024 + (ob ^ (((ob >> 9) & 1) << 5)); }
__host__ __device__ __forceinline__ void stage_rc(int b, int& R, int& C) { const int st = b / 1024, sb = b % 1024, swz = sb ^ (((sb >> 9) & 1) << 5); R = (st >> 1) * 16 + swz / 64; C = (st & 1) * 32 + (swz % 64) / 2; }
__host__ __device__ __forceinline__ int perm32(int rho) { const int n = rho >> 4, i = rho & 15; return 8 * (i >> 2) + 4 * n + (i & 3); }

struct Unit { int pm, pn, first, khalf, koff, nt, ul; };
struct Gemm { const bf16_t* A; const bf16_t* Bt; int M, N, K; };

struct StaticOrder {
    int nM, nN, nwg, G, c, dup, split_from, kh_bytes, kh_nt;
    __host__ __device__ void init(int M, int N, int G_, int c_) { nM = M / BM; nN = N / BM; nwg = nM * nN; G = G_; c = c_; dup = 1; split_from = -1; kh_bytes = 0; kh_nt = 0; }
    __host__ __device__ bool next(int i, Unit& u) const {
        long L = (long)(i / dup) * G + c; u.khalf = 0; u.koff = 0; u.nt = 0; u.ul = 0;
        if (split_from >= 0 && (long)(i / dup) * G >= split_from) {
            if ((long)(i / dup) * G > split_from) return false;
            u.ul = c >> 1; L = split_from + u.ul; u.khalf = 1 + (c & 1); u.koff = (c & 1) ? kh_bytes : 0; u.nt = kh_nt; }
        if (L >= nwg) return false;
        int wgid = (int)L; { const int q = nwg / NXCD, r = nwg % NXCD, xcd = wgid % NXCD, off = wgid / NXCD; wgid = (xcd < r ? xcd * (q + 1) : r * (q + 1) + (xcd - r) * q) + off; }
        const int nig = WGM * nN, gid = wgid / nig, fm = gid * WGM, gsz = (nM - fm) < WGM ? (nM - fm) : WGM;
        u.pm = fm + ((wgid % nig) % gsz); u.pn = (wgid % nig) / gsz; u.first = (i % dup) == 0; return true;
    }
    __device__ __forceinline__ void a_ready(const Unit&) const {}
    __device__ __forceinline__ void done(const Unit&) const {}
};

__device__ __forceinline__ unsigned cvt_pk_bf16(float lo, float hi) { unsigned r; asm volatile("v_cvt_pk_bf16_f32 %0, %1, %2" : "=v"(r) : "v"(lo), "v"(hi)); return r; }
typedef float f32x2 __attribute__((ext_vector_type(2)));
__device__ __forceinline__ float invf_a(int f) {
    constexpr float T[16] = {1.0f, 0.4403666f, 0.19392274f, 0.0853971f, 0.03760603f, 0.01656044f, 0.0072926646f, 0.003211446f,
                             0.0014142136f, 0.00062277244f, 0.0002742482f, 0.000120769735f, 5.3182957e-05f, 2.342e-05f, 1.0313385e-05f, 4.5416705e-06f};
    return T[f];
}
__device__ __forceinline__ void sincos_rev(float ang, float& s, float& c) {
    const float rev = ang * 0.15915494309189535f; const float fr = rev - __builtin_floorf(rev);
    s = __builtin_amdgcn_sinf(fr); c = __builtin_amdgcn_cosf(fr);
}
struct EpiQKV {
    static constexpr bool PERM = true, AFTER_DRAIN = false;
    bf16_t* O; int ldc;
    __device__ __forceinline__ void operator()(const f32x4 (&acc)[2][2][4][2], const Unit& u, int wr, int wc, int fr, int fq) const {
        const int row0 = u.pm * BM + wr * 64 + fr;
        const int sec = u.pn >> 2;
        const int col0 = u.pn * BM + wc * 32 + 8 * fq;
        const bool ropeA = (sec <= 1) && (wc == 0);
        const bool ropeB = (sec == 3 || sec == 4) && ((wc & 1) == 0);
#pragma unroll
        for (int ai = 0; ai < 2; ++ai)
#pragma unroll
            for (int m = 0; m < 4; ++m) {
                const int row = row0 + ai * HALF + m * 16;
                const float pos = (float)(row & 2047);
                bf16_t* rowp = O + (size_t)row * ldc + col0;
                float cs[8], sn[8];
                if (ropeA) {
                    const int fb = 8 * (fq & 1);
#pragma unroll
                    for (int i = 0; i < 8; ++i) { float f0 = invf_a(i), f1 = invf_a(8 + i); sincos_rev(pos * (fb ? f1 : f0), sn[i], cs[i]); }
                    const float sg = (fq >= 2) ? 1.f : -1.f;
#pragma unroll
                    for (int i = 0; i < 8; ++i) sn[i] *= sg;
                } else if (ropeB) {
#pragma unroll
                    for (int i = 0; i < 8; ++i) sincos_rev(pos * invf_a(2 * i), sn[i], cs[i]);
                    const float sg = (fq == 1) ? 1.f : -1.f;
#pragma unroll
                    for (int i = 0; i < 8; ++i) sn[i] *= sg;
                }
#pragma unroll
                for (int bj = 0; bj < 2; ++bj) {
                    f32x4 v0 = acc[ai][bj][m][0], v1 = acc[ai][bj][m][1];
                    if (ropeA) {
                        f32x4 p0, p1;
#pragma unroll
                        for (int i = 0; i < 4; ++i) { p0[i] = __shfl_xor(v0[i], 32); p1[i] = __shfl_xor(v1[i], 32); }
#pragma unroll
                        for (int i = 0; i < 4; ++i) { v0[i] = v0[i] * cs[i] + p0[i] * sn[i]; v1[i] = v1[i] * cs[4 + i] + p1[i] * sn[4 + i]; }
                    } else if (ropeB) {
                        f32x4 p0, p1;
#pragma unroll
                        for (int i = 0; i < 4; ++i) { p0[i] = __shfl_xor(v0[i], 16); p1[i] = __shfl_xor(v1[i], 16); }
                        if (fq < 2) {
#pragma unroll
                            for (int i = 0; i < 4; ++i) { v0[i] = v0[i] * cs[i] + p0[i] * sn[i]; v1[i] = v1[i] * cs[4 + i] + p1[i] * sn[4 + i]; }
                        }
                    }
                    u32x4 w; w.x = cvt_pk_bf16(v0[0], v0[1]); w.y = cvt_pk_bf16(v0[2], v0[3]); w.z = cvt_pk_bf16(v1[0], v1[1]); w.w = cvt_pk_bf16(v1[2], v1[3]);
                    *(u32x4*)(rowp + bj * HALF) = w;
                }
            }
    }
};
struct EpiOut {
    static constexpr bool PERM = false, AFTER_DRAIN = false;
    const float* base; bf16_t* xg; const float* g; float* ss; int ldc;
    __device__ __forceinline__ void operator()(const f32x4 (&acc)[2][2][4][2], const Unit& u, int wr, int wc, int fr, int fq) const {
        typedef unsigned u32x2v __attribute__((ext_vector_type(2)));
        const int col0 = u.pn * BM + wc * 32 + 4 * fq;
        f32x4 gv[2][2];
#pragma unroll
        for (int bj = 0; bj < 2; ++bj)
#pragma unroll
            for (int n = 0; n < 2; ++n) gv[bj][n] = *(const f32x4*)(g + col0 + bj * HALF + n * 16);
#pragma unroll
        for (int ai = 0; ai < 2; ++ai)
#pragma unroll
            for (int m = 0; m < 4; ++m) {
                const int row = u.pm * BM + ai * HALF + wr * 64 + m * 16 + fr; const size_t off = (size_t)row * ldc + col0; float s = 0.f;
#pragma unroll
                for (int bj = 0; bj < 2; ++bj)
#pragma unroll
                    for (int n = 0; n < 2; ++n) {
                        const f32x4 x1 = *(const f32x4*)(base + off + bj * HALF + n * 16) + acc[ai][bj][m][n];
                        s += (x1[0] * x1[0] + x1[1] * x1[1]) + (x1[2] * x1[2] + x1[3] * x1[3]);
                        const f32x4 y = x1 * gv[bj][n]; u32x2v w; w.x = cvt_pk_bf16(y[0], y[1]); w.y = cvt_pk_bf16(y[2], y[3]);
                        *(u32x2v*)(xg + off + bj * HALF + n * 16) = w;
                    }
                s += __shfl_xor(s, 16); s += __shfl_xor(s, 32);
                if (fq == 0 && u.first) atomicAdd(ss + row, s);
            }
    }
};
struct EpiGateUp {
    static constexpr bool PERM = true, AFTER_DRAIN = false;
    bf16_t* H; int ldh; const float* ss; float inv_n, eps; f32x4* part; unsigned* flag;
    __device__ __forceinline__ void operator()(const f32x4 (&acc)[2][2][4][2], const Unit& u, int wr, int wc, int fr, int fq) const {
        const int tid = (wr * 4 + wc) * 64 + fq * 16 + fr;
        f32x4* pp = part + (size_t)u.ul * (32 * 512) + tid;
        if (u.khalf == 1) {
#pragma unroll
            for (int ai = 0; ai < 2; ++ai)
#pragma unroll
                for (int bj = 0; bj < 2; ++bj)
#pragma unroll
                    for (int m = 0; m < 4; ++m)
#pragma unroll
                        for (int n = 0; n < 2; ++n) pp[(size_t)(((ai * 2 + bj) * 4 + m) * 2 + n) * 512] = acc[ai][bj][m][n];
            asm volatile("s_waitcnt vmcnt(0)" ::: "memory"); __builtin_amdgcn_s_barrier(); asm volatile("" ::: "memory");
            if (tid == 0) { __builtin_amdgcn_fence(__ATOMIC_RELEASE, "agent"); asm volatile("s_waitcnt vmcnt(0)" ::: "memory");
                __hip_atomic_store(flag + 16 * u.ul, 1u, __ATOMIC_RELAXED, __HIP_MEMORY_SCOPE_AGENT); }
            return;
        }
        if (u.khalf == 2) {
            if (tid < 64) { unsigned sp = 0;
                while ((unsigned)__builtin_amdgcn_readfirstlane(__hip_atomic_load(flag + 16 * u.ul, __ATOMIC_RELAXED, __HIP_MEMORY_SCOPE_AGENT)) == 0u) { __builtin_amdgcn_s_sleep(2); if (++sp > (1u << 22)) break; }
                __builtin_amdgcn_fence(__ATOMIC_ACQUIRE, "agent"); asm volatile("s_waitcnt vmcnt(0)" ::: "memory"); }
            asm volatile("s_waitcnt vmcnt(0) lgkmcnt(0)" ::: "memory"); __builtin_amdgcn_s_barrier(); asm volatile("" ::: "memory");
        }
        const int col0 = u.pn * HALF + wc * 32 + 8 * fq;
#pragma unroll
        for (int ai = 0; ai < 2; ++ai)
#pragma unroll
            for (int m = 0; m < 4; ++m) {
                const int row = u.pm * BM + ai * HALF + wr * 64 + m * 16 + fr;
                const float rstd = 1.0f / sqrtf(ss[row] * inv_n + eps);
                f32x4 gq[2], uq[2];
#pragma unroll
                for (int n = 0; n < 2; ++n) { gq[n] = acc[ai][0][m][n]; uq[n] = acc[ai][1][m][n]; }
                if (u.khalf == 2) {
#pragma unroll
                    for (int n = 0; n < 2; ++n) { gq[n] += pp[(size_t)(((ai * 2 + 0) * 4 + m) * 2 + n) * 512]; uq[n] += pp[(size_t)(((ai * 2 + 1) * 4 + m) * 2 + n) * 512]; }
                }
                float hv[8];
#pragma unroll
                for (int n = 0; n < 2; ++n)
#pragma unroll
                    for (int i = 0; i < 4; ++i) { const float gg = gq[n][i] * rstd, uu = uq[n][i] * rstd;
                        hv[4 * n + i] = gg * __builtin_amdgcn_rcpf(1.0f + __builtin_amdgcn_exp2f(-1.4426950408889634f * gg)) * uu; }
                u32x4 w; w.x = cvt_pk_bf16(hv[0], hv[1]); w.y = cvt_pk_bf16(hv[2], hv[3]); w.z = cvt_pk_bf16(hv[4], hv[5]); w.w = cvt_pk_bf16(hv[6], hv[7]);
                *(u32x4*)(H + (size_t)row * ldh + col0) = w;
            }
    }
};
struct EpiDown {
    static constexpr bool PERM = false, AFTER_DRAIN = false;
    const bf16_t* base; float* out; float* ss; int ldc;
    __device__ __forceinline__ void operator()(const f32x4 (&acc)[2][2][4][2], const Unit& u, int wr, int wc, int fr, int fq) const {
        typedef unsigned u32x2v __attribute__((ext_vector_type(2)));
        const int col0 = u.pn * BM + wc * 32 + 4 * fq;
#pragma unroll
        for (int ai = 0; ai < 2; ++ai)
#pragma unroll
            for (int m = 0; m < 4; ++m) {
                const int row = u.pm * BM + ai * HALF + wr * 64 + m * 16 + fr; const size_t off = (size_t)row * ldc + col0; float s = 0.f;
#pragma unroll
                for (int bj = 0; bj < 2; ++bj)
#pragma unroll
                    for (int n = 0; n < 2; ++n) {
                        const u32x2v rb = *(const u32x2v*)(base + off + bj * HALF + n * 16);
                        f32x4 x2 = acc[ai][bj][m][n];
                        x2[0] += __uint_as_float(rb.x << 16); x2[1] += __uint_as_float(rb.x & 0xffff0000u); x2[2] += __uint_as_float(rb.y << 16); x2[3] += __uint_as_float(rb.y & 0xffff0000u);
                        *(f32x4*)(out + off + bj * HALF + n * 16) = x2;
                        s += (x2[0] * x2[0] + x2[1] * x2[1]) + (x2[2] * x2[2] + x2[3] * x2[3]);
                    }
                s += __shfl_xor(s, 16); s += __shfl_xor(s, 32);
                if (fq == 0 && u.first) atomicAdd(ss + row, s);
            }
    }
};
struct EpiDownNorm {
    static constexpr bool PERM = false, AFTER_DRAIN = true;
    const bf16_t* base; const float* gres; float* out; const float* g; float* ss; unsigned* cnt; int ldc; float inv_n, eps;
    __device__ __forceinline__ void fused(f32x4 (&acc)[2][2][4][2], const Unit& u, int wr, int wc, int fr, int fq, PG8_LAS unsigned char* lds, int wid, int lane) const {
        typedef unsigned u32x2v __attribute__((ext_vector_type(2)));
        const int col0 = u.pn * BM + wc * 32 + 4 * fq;
        f32x4 rg[2][2];
#pragma unroll
        for (int bj = 0; bj < 2; ++bj)
#pragma unroll
            for (int n = 0; n < 2; ++n) { const f32x4 t = *(const f32x4*)(gres + col0 + bj * HALF + n * 16); rg[bj][n] = (f32x4){1.0f / t[0], 1.0f / t[1], 1.0f / t[2], 1.0f / t[3]}; }
#pragma unroll
        for (int ai = 0; ai < 2; ++ai)
#pragma unroll
            for (int m = 0; m < 4; ++m) {
                const int row = u.pm * BM + ai * HALF + wr * 64 + m * 16 + fr; const size_t off = (size_t)row * ldc + col0; float s = 0.f;
#pragma unroll
                for (int bj = 0; bj < 2; ++bj)
#pragma unroll
                    for (int n = 0; n < 2; ++n) {
                        const u32x2v rb = *(const u32x2v*)(base + off + bj * HALF + n * 16);
                        f32x4 x2 = acc[ai][bj][m][n];
                        x2[0] += __uint_as_float(rb.x << 16) * rg[bj][n][0]; x2[1] += __uint_as_float(rb.x & 0xffff0000u) * rg[bj][n][1]; x2[2] += __uint_as_float(rb.y << 16) * rg[bj][n][2]; x2[3] += __uint_as_float(rb.y & 0xffff0000u) * rg[bj][n][3];
                        acc[ai][bj][m][n] = x2;
                        s += (x2[0] * x2[0] + x2[1] * x2[1]) + (x2[2] * x2[2] + x2[3] * x2[3]);
                    }
                s += __shfl_xor(s, 16); s += __shfl_xor(s, 32);
                if (fq == 0) atomicAdd(ss + row, s);
            }
        asm volatile("s_waitcnt vmcnt(0)" ::: "memory");
        __builtin_amdgcn_s_barrier(); asm volatile("" ::: "memory");
        if (wid == 0) {
            unsigned* c = cnt + 64 * u.pm;
            if (lane == 0) __hip_atomic_fetch_add(c, 1u, __ATOMIC_RELAXED, __HIP_MEMORY_SCOPE_AGENT);
            unsigned sp = 0;
            while ((unsigned)__builtin_amdgcn_readfirstlane(__hip_atomic_load(c, __ATOMIC_RELAXED, __HIP_MEMORY_SCOPE_AGENT)) < 8u) { __builtin_amdgcn_s_sleep(2); if (++sp > (1u << 22)) break; }
            __builtin_amdgcn_fence(__ATOMIC_ACQUIRE, "agent");
        }
        asm volatile("s_waitcnt vmcnt(0) lgkmcnt(0)" ::: "memory"); __builtin_amdgcn_s_barrier(); asm volatile("" ::: "memory");
        f32x4 gv[2][2];
#pragma unroll
        for (int bj = 0; bj < 2; ++bj)
#pragma unroll
            for (int n = 0; n < 2; ++n) gv[bj][n] = *(const f32x4*)(g + col0 + bj * HALF + n * 16);
#pragma unroll
        for (int ai = 0; ai < 2; ++ai)
#pragma unroll
            for (int m = 0; m < 4; ++m) {
                const int row = u.pm * BM + ai * HALF + wr * 64 + m * 16 + fr; const size_t off = (size_t)row * ldc + col0;
                const float rstd = 1.0f / sqrtf(__hip_atomic_load(ss + row, __ATOMIC_RELAXED, __HIP_MEMORY_SCOPE_AGENT) * inv_n + eps);
#pragma unroll
                for (int bj = 0; bj < 2; ++bj)
#pragma unroll
                    for (int n = 0; n < 2; ++n) *(f32x4*)(out + off + bj * HALF + n * 16) = acc[ai][bj][m][n] * rstd * gv[bj][n];
            }
    }
};
template <class Epi, class Sched, bool ALIGN_EPI = false, bool SP2 = false>
__device__ __forceinline__ void gemm_phase(PG8_LAS unsigned char* lds, const Gemm g, const Sched& S, const Epi& E, const int wave_in) {
    const int wid = wave_in, lane = mk_lane(), tid = wid * 64 + lane, wr = wid >> 2, wc = wid & 3, fr = lane & 15, fq = lane >> 4;
    const int K = g.K, nt = K / BK;
    unsigned voffA[2], voffB[2];
#pragma unroll
    for (int i = 0; i < 2; ++i) { int R, C; stage_rc(tid * 16 + i * 8192, R, C); const int Rb = Epi::PERM ? ((R & ~31) + perm32(R & 31)) : R;
        voffA[i] = (unsigned)(R * K + C) * 2u; voffB[i] = (unsigned)(Rb * K + C) * 2u; }
    const size_t kstep = (size_t)(BK * 2);
    const size_t hstep = (size_t)HALF * K * 2;
    const size_t tstep = 2 * hstep;
    const unsigned ldsw = (unsigned)wid * 1024u;
    const int aoff = lds_byte(wr * 64 + fr, fq * 8), boff = lds_byte(wc * 32 + fr, fq * 8);
#define PG8_SA(b, h) (((b) * 2 + (h)) * HTB)
#define PG8_SB(b, h) ((4 + (b) * 2 + (h)) * HTB)
#define PG8_STAGE(bufoff, gbase, voff) do { _Pragma("unroll") for (int _i = 0; _i < 2; ++_i) \
        __builtin_amdgcn_global_load_lds((const unsigned*)((const char*)(gbase) + (voff)[_i]), (PG8_LAS unsigned*)(lds + (bufoff) + ldsw + _i * 8192), 16, 0, 0); } while (0)
#define PG8_LDA(dst, b, h) do { _Pragma("unroll") for (int m = 0; m < 4; ++m) _Pragma("unroll") for (int k = 0; k < 2; ++k) dst[m][k] = *(const PG8_LAS bf16x8*)(lds + PG8_SA(b, h) + aoff + m * 2048 + k * 1024); } while (0)
#define PG8_LDB(dst, b, h) do { _Pragma("unroll") for (int n = 0; n < 2; ++n) _Pragma("unroll") for (int k = 0; k < 2; ++k) dst[n][k] = *(const PG8_LAS bf16x8*)(lds + PG8_SB(b, h) + boff + n * 2048 + k * 1024); } while (0)
#define PG8_MMA(ai, bj, At, Bt) do { __builtin_amdgcn_s_setprio(1); _Pragma("unroll") for (int m = 0; m < 4; ++m) _Pragma("unroll") for (int n = 0; n < 2; ++n) _Pragma("unroll") for (int k = 0; k < 2; ++k) \
        acc[ai][bj][m][n] = __builtin_amdgcn_mfma_f32_16x16x32_bf16(Bt[n][k], At[m][k], acc[ai][bj][m][n], 0, 0, 0); __builtin_amdgcn_s_setprio(0); } while (0)
#define PG8_WAIT_V(n) asm volatile("s_waitcnt vmcnt(" #n ")" ::: "memory")
#define PG8_WAIT_L(n) asm volatile("s_waitcnt lgkmcnt(" #n ")" ::: "memory")
#define PG8_BAR __builtin_amdgcn_s_barrier()
#define PG8_SCHED __builtin_amdgcn_sched_barrier(0)
    Unit cur, nxt; int ui = 0;
    if (!S.next(0, cur)) return;
    f32x4 acc[2][2][4][2];
#pragma unroll
    for (int a = 0; a < 2; ++a)
#pragma unroll
        for (int b = 0; b < 2; ++b)
#pragma unroll
            for (int m = 0; m < 4; ++m)
#pragma unroll
                for (int n = 0; n < 2; ++n) acc[a][b][m][n] = (f32x4){0.f, 0.f, 0.f, 0.f};
    bf16x8 At[4][2], B0[2][2], B1[2][2];
    const char* cA = (const char*)g.A + (size_t)cur.pm * tstep + cur.koff; const char* cB = (const char*)g.Bt + (size_t)cur.pn * tstep + cur.koff; int ntc = cur.nt ? cur.nt : nt;
    S.a_ready(cur);
    if constexpr (SP2) {
        PG8_STAGE(PG8_SB(0, 0), cB, voffB); PG8_STAGE(PG8_SB(0, 1), cB + hstep, voffB); PG8_STAGE(PG8_SA(0, 0), cA, voffA); PG8_STAGE(PG8_SA(0, 1), cA + hstep, voffA);
        if (wr == 1) PG8_BAR;
        PG8_WAIT_V(2); PG8_BAR;
        PG8_STAGE(PG8_SB(1, 0), cB + kstep, voffB); PG8_STAGE(PG8_SA(1, 0), cA + kstep, voffA); PG8_STAGE(PG8_SB(1, 1), cB + hstep + kstep, voffB);
        PG8_WAIT_V(6); PG8_BAR;
    } else {
        PG8_STAGE(PG8_SB(0, 0), cB, voffB); PG8_STAGE(PG8_SA(0, 0), cA, voffA); PG8_STAGE(PG8_SB(0, 1), cB + hstep, voffB); PG8_STAGE(PG8_SA(0, 1), cA + hstep, voffA);
        if (wr == 1) PG8_BAR;
        PG8_WAIT_V(4); PG8_BAR;
        PG8_STAGE(PG8_SB(1, 0), cB + kstep, voffB); PG8_STAGE(PG8_SA(1, 0), cA + kstep, voffA); PG8_STAGE(PG8_SB(1, 1), cB + hstep + kstep, voffB);
        PG8_WAIT_V(6); PG8_BAR;
    }
    for (;;) {
        const bool has_next = S.next(ui + 1, nxt);
        const char* nA = has_next ? (const char*)g.A + (size_t)nxt.pm * tstep + nxt.koff : cA; const char* nB = has_next ? (const char*)g.Bt + (size_t)nxt.pn * tstep + nxt.koff : cB;
        for (int t = 0; t < ntc; t += 2) {
            const bool last = (t == ntc - 2);
            const char* a1 = cA + (size_t)(t + 1) * kstep;
            const char* a2 = last ? nA : cA + (size_t)(t + 2) * kstep; const char* b2 = last ? nB : cB + (size_t)(t + 2) * kstep;
            const char* a3 = a2 + kstep; const char* b3 = b2 + kstep;
            if (last && has_next) S.a_ready(nxt);
            if constexpr (SP2) {
            PG8_LDB(B0, 0, 0); PG8_LDB(B1, 0, 1); PG8_SCHED; PG8_LDA(At, 0, 0); PG8_STAGE(PG8_SA(1, 1), a1 + hstep, voffA);
            PG8_WAIT_V(8); PG8_WAIT_L(0); PG8_BAR; PG8_MMA(0, 0, At, B0); PG8_MMA(0, 1, At, B1); PG8_BAR; PG8_SCHED;
            PG8_LDA(At, 0, 1); PG8_STAGE(PG8_SB(0, 0), b2, voffB); PG8_STAGE(PG8_SB(0, 1), b2 + hstep, voffB); PG8_STAGE(PG8_SA(0, 0), a2, voffA);
            PG8_WAIT_V(8); PG8_WAIT_L(0); PG8_BAR; PG8_MMA(1, 0, At, B0); PG8_MMA(1, 1, At, B1); PG8_BAR; PG8_SCHED;
            PG8_LDB(B0, 1, 0); PG8_LDB(B1, 1, 1); PG8_SCHED; PG8_LDA(At, 1, 0); PG8_STAGE(PG8_SA(0, 1), a2 + hstep, voffA);
            PG8_WAIT_V(8); PG8_WAIT_L(0); PG8_BAR; PG8_MMA(0, 0, At, B0); PG8_MMA(0, 1, At, B1); PG8_BAR; PG8_SCHED;
            PG8_LDA(At, 1, 1); PG8_STAGE(PG8_SB(1, 0), b3, voffB); PG8_STAGE(PG8_SB(1, 1), b3 + hstep, voffB); PG8_STAGE(PG8_SA(1, 0), a3, voffA);
            PG8_WAIT_V(8); PG8_WAIT_L(0); PG8_BAR; PG8_MMA(1, 0, At, B0); PG8_MMA(1, 1, At, B1); PG8_BAR; PG8_SCHED;
            } else {
            PG8_LDB(B0, 0, 0); PG8_SCHED; PG8_LDA(At, 0, 0); PG8_STAGE(PG8_SA(1, 1), a1 + hstep, voffA);
            PG8_WAIT_L(8); PG8_BAR; PG8_WAIT_L(0); PG8_MMA(0, 0, At, B0); PG8_BAR; PG8_SCHED;
            PG8_LDB(B1, 0, 1); PG8_STAGE(PG8_SB(0, 0), b2, voffB);
            PG8_BAR; PG8_WAIT_L(0); PG8_MMA(0, 1, At, B1); PG8_BAR;
            PG8_LDA(At, 0, 1); PG8_STAGE(PG8_SA(0, 0), a2, voffA);
            PG8_BAR; PG8_WAIT_L(0); PG8_MMA(1, 0, At, B0); PG8_BAR; PG8_SCHED;
            PG8_STAGE(PG8_SB(0, 1), b2 + hstep, voffB);
            PG8_WAIT_V(6); PG8_BAR; PG8_MMA(1, 1, At, B1); PG8_BAR;
            PG8_LDB(B0, 1, 0); PG8_SCHED; PG8_LDA(At, 1, 0); PG8_STAGE(PG8_SA(0, 1), a2 + hstep, voffA);
            PG8_WAIT_L(8); PG8_BAR; PG8_WAIT_L(0); PG8_MMA(0, 0, At, B0); PG8_BAR; PG8_SCHED;
            PG8_LDB(B1, 1, 1); PG8_STAGE(PG8_SB(1, 0), b3, voffB);
            PG8_BAR; PG8_WAIT_L(0); PG8_MMA(0, 1, At, B1); PG8_BAR;
            PG8_LDA(At, 1, 1); PG8_STAGE(PG8_SA(1, 0), a3, voffA);
            PG8_BAR; PG8_WAIT_L(0); PG8_MMA(1, 0, At, B0); PG8_BAR; PG8_SCHED;
            PG8_STAGE(PG8_SB(1, 1), b3 + hstep, voffB);
            PG8_WAIT_V(6); PG8_BAR; PG8_MMA(1, 1, At, B1); PG8_BAR;
            }
        }
        if constexpr (ALIGN_EPI) { if (wr == 0) PG8_BAR; }
        if constexpr (!Epi::AFTER_DRAIN) { E(acc, cur, wr, wc, fr, fq); S.done(cur); }
        if (!has_next) break;
#pragma unroll
        for (int a = 0; a < 2; ++a)
#pragma unroll
            for (int b = 0; b < 2; ++b)
#pragma unroll
                for (int m = 0; m < 4; ++m)
#pragma unroll
                    for (int n = 0; n < 2; ++n) acc[a][b][m][n] = (f32x4){0.f, 0.f, 0.f, 0.f};
        cur = nxt; cA = nA; cB = nB; ++ui; ntc = cur.nt ? cur.nt : nt;
        if constexpr (ALIGN_EPI) { if (wr == 1) PG8_BAR; }
    }
    PG8_WAIT_V(0);
    if constexpr (!ALIGN_EPI) { if (wr == 0) PG8_BAR; }
    PG8_BAR;
    if constexpr (Epi::AFTER_DRAIN) { E.fused(acc, cur, wr, wc, fr, fq, lds, wid, lane); S.done(cur); }
#undef PG8_SA
#undef PG8_SB
#undef PG8_STAGE
#undef PG8_LDA
#undef PG8_LDB
#undef PG8_MMA
#undef PG8_WAIT_V
#undef PG8_WAIT_L
#undef PG8_BAR
#undef PG8_SCHED
}
}
namespace att {
using bf16 = __hip_bfloat16;
using bf16x8 = __attribute__((ext_vector_type(8))) short;
using s16x4  = __attribute__((ext_vector_type(4))) short;
using f32x16 = __attribute__((ext_vector_type(16))) float;
using u32x4  = __attribute__((ext_vector_type(4))) unsigned;
constexpr int D = 128, NW = 8, QBLK = 32, KVBLK = 64;
constexpr int LDR = 6144;
constexpr size_t SHM_V = KVBLK * D * 2, SHM_K = KVBLK * D * 2, SHM_ATTN = 2 * SHM_V + 2 * SHM_K + NW * 64 * 4;
#define KSWZ(row, colB) ((row) * 256 + ((colB) ^ (((row) & 7) << 4)))
#define SBAR() __builtin_amdgcn_sched_barrier(0)
__device__ __forceinline__ int crow(int r, int hi) { return (r & 3) + 8 * (r >> 2) + 4 * hi; }
__device__ __forceinline__ unsigned cvtpk(float lo, float hi) { unsigned r; asm volatile("v_cvt_pk_bf16_f32 %0, %1, %2" : "=v"(r) : "v"(lo), "v"(hi)); return r; }
__device__ __forceinline__ unsigned short f2bf1(float x) { return (unsigned short)(cvtpk(x, x) & 0xffffu); }
#define PK4(P, BASE, OUT) do { unsigned a0 = cvtpk(P[BASE + 0], P[BASE + 1]), a1 = cvtpk(P[BASE + 2], P[BASE + 3]);   \
    unsigned b0 = cvtpk(P[BASE + 4], P[BASE + 5]), b1 = cvtpk(P[BASE + 6], P[BASE + 7]);                              \
    auto r0 = __builtin_amdgcn_permlane32_swap(a0, b0, false, false); auto r1 = __builtin_amdgcn_permlane32_swap(a1, b1, false, false); \
    u32x4 w = {r0[0], r1[0], r0[1], r1[1]}; OUT = *reinterpret_cast<bf16x8*>(&w); } while (0)

template <int SCALE_E6>
struct SM {
    static constexpr float SCALE = SCALE_E6 == 125000 ? 0.125f : 0.088388347648318440f;
    static constexpr float THR = 8.f;
    static __device__ __forceinline__ void partialSM(f32x16& p0, f32x16& p1, float& m_reg, float& mn, float& alpha) {
        constexpr float C = SCALE * 1.4426950408889634f;
        float pmax = p0[0];
#pragma unroll
        for (int r = 1; r < 16; ++r) pmax = fmaxf(pmax, p0[r]);
#pragma unroll
        for (int r = 0; r < 16; ++r) pmax = fmaxf(pmax, p1[r]);
        { auto rr = __builtin_amdgcn_permlane32_swap(__float_as_uint(pmax), __float_as_uint(pmax), false, false);
          pmax = fmaxf(__uint_as_float(rr[0]), __uint_as_float(rr[1])); }
        if (__builtin_expect(__all(pmax - m_reg <= THR / SCALE), 1)) { mn = m_reg; alpha = 1.f; }
        else { mn = fmaxf(m_reg, pmax); alpha = __builtin_amdgcn_exp2f((m_reg - mn) * C); m_reg = mn; }
        float mnC = -mn * C;
#pragma unroll
        for (int r = 0; r < 16; ++r) p0[r] = fmaf(p0[r], C, mnC);
#pragma unroll
        for (int r = 0; r < 16; ++r) p1[r] = fmaf(p1[r], C, mnC);
#pragma unroll
        for (int r = 0; r < 16; ++r) p0[r] = __builtin_amdgcn_exp2f(p0[r]);
    }
};
__device__ __forceinline__ void finishSM(f32x16& p0, f32x16& p1, float alpha, float& l_reg, bf16x8& pa0, bf16x8& pa1, bf16x8& pa2, bf16x8& pa3) {
#pragma unroll
    for (int r = 0; r < 16; ++r) p1[r] = __builtin_amdgcn_exp2f(p1[r]);
    float ps = 0;
#pragma unroll
    for (int r = 0; r < 16; ++r) ps += p0[r];
#pragma unroll
    for (int r = 0; r < 16; ++r) ps += p1[r];
    { auto rr = __builtin_amdgcn_permlane32_swap(__float_as_uint(ps), __float_as_uint(ps), false, false);
      ps = __uint_as_float(rr[0]) + __uint_as_float(rr[1]); }
    l_reg = l_reg * alpha + ps;
    PK4(p0, 0, pa0); PK4(p0, 8, pa1); PK4(p1, 0, pa2); PK4(p1, 8, pa3);
}
template <int ND0>
__device__ __forceinline__ void qkt(f32x16& p0, f32x16& p1, const bf16* Ks, const bf16x8* qr, int dbase, int r32, int hi) {
    p0 = f32x16{}; p1 = f32x16{};
#pragma unroll
    for (int d0 = 0; d0 < ND0; ++d0) { int cb = ((dbase + d0) * 16 + hi * 8) * 2;
        bf16x8 b0 = *reinterpret_cast<const bf16x8*>((const char*)Ks + KSWZ(r32, cb));
        bf16x8 b1 = *reinterpret_cast<const bf16x8*>((const char*)Ks + KSWZ(32 + r32, cb));
        p0 = __builtin_amdgcn_mfma_f32_32x32x16_bf16(b0, qr[d0], p0, 0, 0, 0);
        p1 = __builtin_amdgcn_mfma_f32_32x32x16_bf16(b1, qr[d0], p1, 0, 0, 0); }
}
__device__ __forceinline__ int v_st(int k, int c) { const int kk = (k & ~0xC) | ((k & 4) << 1) | ((k & 8) >> 1); return ((kk >> 3) * 4 + (c >> 5)) * 512 + ((kk & 7) * 32 + (c & 31)) * 2; }
__device__ __forceinline__ int v_rd_base(int lane) { return ((lane & 3) << 3) | (((lane >> 2) & 3) << 6) | (((lane >> 4) & 1) << 5) | (((lane >> 5) & 1) << 8); }
constexpr int v_rd_off(int d0, int ks, int half) { return d0 * 512 + ks * 4096 + half * 2048; }
template <int OFF> __device__ __forceinline__ s16x4 tr_read(int vb) {
    s16x4 r; asm volatile("ds_read_b64_tr_b16 %0, %1 offset:%2" : "=&v"(r) : "v"(vb), "i"(OFF) : "memory"); return r;
}
#define PKV(L, H) (bf16x8){L[0], L[1], L[2], L[3], H[0], H[1], H[2], H[3]}
template <int D0> __device__ __forceinline__ void pv_one(f32x16& od, int vb, bf16x8 pa0, bf16x8 pa1, bf16x8 pa2, bf16x8 pa3) {
    const s16x4 l0 = tr_read<v_rd_off(D0, 0, 0)>(vb), h0 = tr_read<v_rd_off(D0, 0, 1)>(vb), l1 = tr_read<v_rd_off(D0, 1, 0)>(vb), h1 = tr_read<v_rd_off(D0, 1, 1)>(vb);
    const s16x4 l2 = tr_read<v_rd_off(D0, 2, 0)>(vb), h2 = tr_read<v_rd_off(D0, 2, 1)>(vb), l3 = tr_read<v_rd_off(D0, 3, 0)>(vb), h3 = tr_read<v_rd_off(D0, 3, 1)>(vb);
    asm volatile("s_waitcnt lgkmcnt(0)" ::: "memory"); SBAR();
    od = __builtin_amdgcn_mfma_f32_32x32x16_bf16(pa0, PKV(l0, h0), od, 0, 0, 0);
    od = __builtin_amdgcn_mfma_f32_32x32x16_bf16(pa1, PKV(l1, h1), od, 0, 0, 0);
    od = __builtin_amdgcn_mfma_f32_32x32x16_bf16(pa2, PKV(l2, h2), od, 0, 0, 0);
    od = __builtin_amdgcn_mfma_f32_32x32x16_bf16(pa3, PKV(l3, h3), od, 0, 0, 0);
}
__device__ __forceinline__ void pv_d0(f32x16* o, int vb, bf16x8 pa0, bf16x8 pa1, bf16x8 pa2, bf16x8 pa3) {
    pv_one<0>(o[0], vb, pa0, pa1, pa2, pa3); pv_one<1>(o[1], vb, pa0, pa1, pa2, pa3); pv_one<2>(o[2], vb, pa0, pa1, pa2, pa3); pv_one<3>(o[3], vb, pa0, pa1, pa2, pa3);
}
template <int D0> __device__ __forceinline__ void pv_one32(f32x16& od, int vb, bf16x8 pa0, bf16x8 pa1) {
    const s16x4 l0 = tr_read<v_rd_off(D0, 0, 0)>(vb), h0 = tr_read<v_rd_off(D0, 0, 1)>(vb), l1 = tr_read<v_rd_off(D0, 1, 0)>(vb), h1 = tr_read<v_rd_off(D0, 1, 1)>(vb);
    asm volatile("s_waitcnt lgkmcnt(0)" ::: "memory"); SBAR();
    od = __builtin_amdgcn_mfma_f32_32x32x16_bf16(pa0, PKV(l0, h0), od, 0, 0, 0);
    od = __builtin_amdgcn_mfma_f32_32x32x16_bf16(pa1, PKV(l1, h1), od, 0, 0, 0);
}

typedef float f32x4c __attribute__((ext_vector_type(4)));
struct ConvJob {
    const float *w_gate, *w_up, *w_down, *w_out, *g_ffn; unsigned short *WGU, *WDN, *WOUT;
    int next, end, stride;
};
struct ConvItem { const float* W; unsigned short* dst; int N, K, k0, n0, drow; };
constexpr int CV_GU = 32 * 88, CV_DN = 88 * 32, CV_OUT = 32 * 32, CV_TOTAL = 2 * CV_GU + CV_DN + CV_OUT;
__device__ __forceinline__ ConvItem conv_item(const float* Jw_gate, const float* Jw_up, const float* Jw_down, const float* Jw_out, unsigned short* JWGU, unsigned short* JWDN, unsigned short* JWOUT, int q) {
    ConvItem it;
    const bool gu = q < 2 * CV_GU, dn = !gu && q < 2 * CV_GU + CV_DN; const int up = (q >= CV_GU) ? 1 : 0;
    const int rg = q - up * CV_GU, kbg = rg / 88, nbg = rg - kbg * 88;
    const int rd = gu ? 0 : (dn ? q - 2 * CV_GU : q - 2 * CV_GU - CV_DN), kbd = rd >> 5, nbd = rd & 31;
    it.W = gu ? (up ? Jw_up : Jw_gate) : (dn ? Jw_down : Jw_out);
    it.dst = gu ? JWGU : (dn ? JWDN : JWOUT);
    it.N = gu ? 5632 : 2048; it.K = dn ? 5632 : 2048;
    it.k0 = 64 * (gu ? kbg : kbd); it.n0 = 64 * (gu ? nbg : nbd);
    it.drow = gu ? 256 * (it.n0 >> 7) + 128 * up + (it.n0 & 127) : it.n0;
    return it;
}
__device__ __forceinline__ void attn_dense_body(const bf16* __restrict__ Qb, const bf16* __restrict__ Kh, const bf16* __restrict__ Vh,
                                                unsigned short* __restrict__ Ob, int ldo, int dbase, int seq, char* lds, const int wave_in, ConvJob& cj) {
    using S8 = SM<125000>;
    const int wid = wave_in, lane = mk_lane(), tid = wid * 64 + lane, r32 = lane & 31, hi = lane >> 5;
    bf16* V_lds = (bf16*)lds; bf16* K_lds = (bf16*)(lds + 2 * SHM_V);
    float* ws = (float*)(lds + 2 * SHM_V + 2 * SHM_K) + wid * 64; float* li_l = ws; float* al_l = ws + 32;
    float m_reg = -1e30f, l_reg = 0; f32x16 o[4] = {}; bf16x8 qr[4];
    const bf16* Qw = Qb + (long)(wid * QBLK + r32) * LDR + dbase * 16 + hi * 8;
#pragma unroll
    for (int d0 = 0; d0 < 4; ++d0) qr[d0] = *reinterpret_cast<const bf16x8*>(Qw + d0 * 16);
    const int sr = tid >> 4, sc = (tid & 15) * 8, vst0 = v_st(sr, sc), vst1 = v_st(32 + sr, sc);
    const int vb0 = (int)(uintptr_t)V_lds + v_rd_base(lane);
    struct { bf16x8 vs0, vs1, ks0; } sr_[2];
    const int krow = tid >> 3, kcol = dbase * 16 + (tid & 7) * 8, kst0 = KSWZ(krow, kcol * 2);
#define SLOAD(i, k0) do { sr_[i].vs0 = *reinterpret_cast<const bf16x8*>(&Vh[(long)((k0) + sr) * LDR + sc]); sr_[i].vs1 = *reinterpret_cast<const bf16x8*>(&Vh[(long)((k0) + 32 + sr) * LDR + sc]); \
    sr_[i].ks0 = *reinterpret_cast<const bf16x8*>(&Kh[(long)((k0) + krow) * LDR + kcol]); } while (0)
#define SWRITE(b, i) do { *(bf16x8*)((char*)V_lds + (b) * SHM_V + vst0) = sr_[i].vs0;          \
    *(bf16x8*)((char*)V_lds + (b) * SHM_V + vst1) = sr_[i].vs1;                              \
    *(bf16x8*)((char*)K_lds + (b) * SHM_K + kst0) = sr_[i].ks0; } while (0)
#define SWAIT() do {} while (0)
#define RESC(a) do { if (__any((a) < 1.f)) { if (hi == 0) al_l[r32] = (a); asm volatile("s_waitcnt lgkmcnt(0)" ::: "memory"); \
    _Pragma("unroll") for (int d = 0; d < 4; ++d) _Pragma("unroll") for (int r = 0; r < 16; ++r) o[d][r] *= al_l[crow(r, hi)]; } } while (0)
    f32x16 pA0, pA1, pB0, pB1; float mnA, mnB, alA, alB; bf16x8 pa0, pa1, pa2, pa3; const int NT = seq / KVBLK;
    const float* const jwg = cj.w_gate; const float* const jwu = cj.w_up; const float* const jwd = cj.w_down; const float* const jwo = cj.w_out;
    unsigned short* const jGU = cj.WGU; unsigned short* const jDN = cj.WDN; unsigned short* const jOUT = cj.WOUT; const int jnext = cj.next, jend = cj.end, jstride = cj.stride;
    float* cscr = (float*)(lds + SHM_ATTN); f32x4c cv0, cv1; int slot = 0;
#define CV_Q(k) (min(jnext + (k) * jstride, jend))
#define CV_LOAD(q) do { const ConvItem it_ = conv_item(jwg, jwu, jwd, jwo, jGU, jDN, jOUT, (q)); const float* s_ = it_.W + (size_t)(it_.k0 + (tid >> 3)) * it_.N + it_.n0 + 8 * (tid & 7); \
    cv0 = *(const f32x4c*)s_; cv1 = *(const f32x4c*)(s_ + 4); } while (0)
#define CV_WRITE() do { f32x4c* d_ = (f32x4c*)(cscr + (tid >> 3) * 64 + 8 * ((tid & 7) ^ ((tid >> 6) & 7))); d_[0] = cv0; d_[1] = cv1; } while (0)
#define CV_STORE(q) do { const ConvItem it_ = conv_item(jwg, jwu, jwd, jwo, jGU, jDN, jOUT, (q)); const int n_ = tid >> 3, c_ = tid & 7; const float* s_ = cscr + (8 * c_) * 64 + (n_ ^ (8 * c_)); \
    u32x4 o_; o_.x = cvtpk(s_[0], s_[64]); o_.y = cvtpk(s_[128], s_[192]); o_.z = cvtpk(s_[256], s_[320]); o_.w = cvtpk(s_[384], s_[448]); \
    *(u32x4*)(it_.dst + (size_t)(it_.drow + n_) * it_.K + it_.k0 + 8 * c_) = o_; } while (0)
#define CV_CONSUME() do { CV_WRITE(); const int qn_ = CV_Q(slot + 1); CV_LOAD(qn_); } while (0)
#define CV_FINISH() do { const int qc_ = CV_Q(slot); CV_STORE(qc_); ++slot; } while (0)
    { const int q0_ = CV_Q(0); CV_LOAD(q0_); }
    constexpr int SE = 0, SO = 1;
    SLOAD(SE, 0); asm volatile("s_waitcnt vmcnt(0)" ::: "memory"); SWRITE(0, SE); __syncthreads();
    qkt<4>(pA0, pA1, K_lds, qr, dbase, r32, hi); S8::partialSM(pA0, pA1, m_reg, mnA, alA);
    SLOAD(SO, KVBLK); if (2 < NT) SLOAD(SE, 2 * KVBLK);
    SWAIT(); SWRITE(1, SO); __syncthreads();
    for (int j = 1; j + 1 < NT; j += 2) {
        SBAR(); qkt<4>(pB0, pB1, (bf16*)((char*)K_lds + SHM_K), qr, dbase, r32, hi);
        finishSM(pA0, pA1, alA, l_reg, pa0, pa1, pa2, pa3); SBAR();
        SLOAD(SO, (j + 2) * KVBLK); SBAR();
        pv_d0(o, vb0, pa0, pa1, pa2, pa3); S8::partialSM(pB0, pB1, m_reg, mnB, alB);
        __syncthreads(); SWAIT(); SWRITE(0, SE);
        CV_CONSUME();
        RESC(alB); __syncthreads();
        CV_FINISH();
        SBAR(); qkt<4>(pA0, pA1, K_lds, qr, dbase, r32, hi);
        finishSM(pB0, pB1, alB, l_reg, pa0, pa1, pa2, pa3); SBAR();
        SLOAD(SE, min(j + 3, NT - 1) * KVBLK); SBAR();
        pv_d0(o, vb0 + (int)SHM_V, pa0, pa1, pa2, pa3); S8::partialSM(pA0, pA1, m_reg, mnA, alA);
        __syncthreads(); SWAIT(); SWRITE(1, SO);
        CV_CONSUME();
        RESC(alA); __syncthreads();
        CV_FINISH();
    }
    cj.next = min(jnext + slot * jstride, jend + jstride);
    SBAR(); qkt<4>(pB0, pB1, (bf16*)((char*)K_lds + SHM_K), qr, dbase, r32, hi);
    finishSM(pA0, pA1, alA, l_reg, pa0, pa1, pa2, pa3); SBAR();
    pv_d0(o, vb0, pa0, pa1, pa2, pa3); S8::partialSM(pB0, pB1, m_reg, mnB, alB);
    __syncthreads(); RESC(alB);
    finishSM(pB0, pB1, alB, l_reg, pa0, pa1, pa2, pa3); SBAR();
    pv_d0(o, vb0 + (int)SHM_V, pa0, pa1, pa2, pa3);
    if (hi == 0) li_l[r32] = l_reg; asm volatile("s_waitcnt lgkmcnt(0)" ::: "memory");
    float rli[16];
#pragma unroll
    for (int r = 0; r < 16; ++r) rli[r] = __builtin_amdgcn_rcpf(li_l[crow(r, hi)]);
    unsigned short* Ow = Ob + (long)(wid * QBLK) * ldo;
#pragma unroll
    for (int r = 0; r < 16; ++r) { int orow = crow(r, hi);
#pragma unroll
        for (int d0 = 0; d0 < 4; ++d0) Ow[(long)orow * ldo + d0 * 32 + r32] = f2bf1(o[d0][r] * rli[r]); }
#undef CV_LOAD
#undef CV_Q
#undef CV_STORE
#undef CV_WRITE
#undef CV_CONSUME
#undef CV_FINISH
#undef SLOAD
#undef SWRITE
#undef SWAIT
#undef RESC
}

__device__ __forceinline__ void swa_wave_unit(const bf16* __restrict__ base, long rstride, int qc, int kc, int vc, int t0, int L,
                                              unsigned short* __restrict__ Ob, long ostride, float* __restrict__ Lb, long lstride, char* lds_w, float* scr) {
    constexpr float SCALE = 0.088388347648318440f, C = SCALE * 1.4426950408889634f;
    const int lane = mk_lane(), r32 = lane & 31, hi = lane >> 5;
    bf16* K_lds = (bf16*)lds_w; char* V_lds = lds_w + 8192;
    bf16x8 qr[8];
    { const bf16* Qw = base + (long)(t0 + r32) * rstride + qc + hi * 8;
#pragma unroll
      for (int d0 = 0; d0 < 8; ++d0) qr[d0] = *reinterpret_cast<const bf16x8*>(Qw + d0 * 16); }
    const int srow = lane >> 4, scol = (lane & 15) * 8;
    const bf16* kbase = base + (long)srow * rstride + kc + scol; const bf16* vbase = base + (long)srow * rstride + vc + scol;
    bf16x8 st[2][8];
#define TILE_K0(i) (t0 - 64 + 32 * (i))
#define TILE_OK(i) (TILE_K0(i) >= 0 && TILE_K0(i) < L)
#define TILE_KC(i) (min(max(TILE_K0(i), 0), L - 32))
#define LD_TILE(buf, pbase, i) do { const bf16* p_ = (pbase) + (long)TILE_KC(i) * rstride; _Pragma("unroll") for (int j = 0; j < 8; ++j) st[buf][j] = *reinterpret_cast<const bf16x8*>(p_ + (long)(4 * j) * rstride); } while (0)
    f32x16 s[5];
    LD_TILE(0, kbase, 0);
#pragma unroll
    for (int i = 0; i < 5; ++i) {
        if (i < 4) LD_TILE((i + 1) & 1, kbase, i + 1); else LD_TILE((i + 1) & 1, vbase, 0);
#pragma unroll
        for (int j = 0; j < 8; ++j) *(bf16x8*)((char*)K_lds + KSWZ(4 * j + srow, scol * 2)) = st[i & 1][j];
        f32x16 p = f32x16{};
#pragma unroll
        for (int d0 = 0; d0 < 8; ++d0) { const int cb = (d0 * 16 + hi * 8) * 2;
            const bf16x8 b0 = *reinterpret_cast<const bf16x8*>((const char*)K_lds + KSWZ(r32, cb));
            p = __builtin_amdgcn_mfma_f32_32x32x16_bf16(b0, qr[d0], p, 0, 0, 0); }
        const bool ok = TILE_OK(i);
#pragma unroll
        for (int r = 0; r < 16; ++r) {
            bool keep = ok;
            if (i == 0) keep = keep && (crow(r, hi) >= r32);
            if (i == 4) keep = keep && (crow(r, hi) <= r32);
            s[i][r] = keep ? p[r] : -1e30f;
        }
    }
    float m = -1e30f;
#pragma unroll
    for (int i = 0; i < 5; ++i)
#pragma unroll
        for (int r = 0; r < 16; ++r) m = fmaxf(m, s[i][r]);
    { auto rr = __builtin_amdgcn_permlane32_swap(__float_as_uint(m), __float_as_uint(m), false, false);
      m = fmaxf(__uint_as_float(rr[0]), __uint_as_float(rr[1])); }
    const float mC = -m * C; float l = 0.f;
#pragma unroll
    for (int i = 0; i < 5; ++i)
#pragma unroll
        for (int r = 0; r < 16; ++r) { s[i][r] = __builtin_amdgcn_exp2f(fmaf(s[i][r], C, mC)); l += s[i][r]; }
    { auto rr = __builtin_amdgcn_permlane32_swap(__float_as_uint(l), __float_as_uint(l), false, false);
      l = __uint_as_float(rr[0]) + __uint_as_float(rr[1]); }
    bf16x8 pa[5][2];
#pragma unroll
    for (int i = 0; i < 5; ++i) { PK4(s[i], 0, pa[i][0]); PK4(s[i], 8, pa[i][1]); }
    f32x16 o[4] = {};
    const int vb = (int)(uintptr_t)V_lds + v_rd_base(lane);
#pragma unroll
    for (int i = 0; i < 5; ++i) {
        if (i < 4) LD_TILE(i & 1, vbase, i + 1);
#pragma unroll
        for (int j = 0; j < 8; ++j) *(bf16x8*)(V_lds + v_st(4 * j + srow, scol)) = st[(i + 1) & 1][j];
        asm volatile("s_waitcnt lgkmcnt(0)" ::: "memory");
        pv_one32<0>(o[0], vb, pa[i][0], pa[i][1]); pv_one32<1>(o[1], vb, pa[i][0], pa[i][1]); pv_one32<2>(o[2], vb, pa[i][0], pa[i][1]); pv_one32<3>(o[3], vb, pa[i][0], pa[i][1]);
    }
#undef TILE_K0
#undef TILE_OK
#undef TILE_KC
#undef LD_TILE
    if (hi == 0) { scr[r32] = l; Lb[(long)(t0 + r32) * lstride] = m * SCALE + __logf(l); }
    asm volatile("s_waitcnt lgkmcnt(0)" ::: "memory");
    float rli[16];
#pragma unroll
    for (int r = 0; r < 16; ++r) rli[r] = __builtin_amdgcn_rcpf(scr[crow(r, hi)]);
#pragma unroll
    for (int r = 0; r < 16; ++r) { const long orow = (long)(t0 + crow(r, hi)) * ostride;
#pragma unroll
        for (int d0 = 0; d0 < 4; ++d0) Ob[orow + d0 * 32 + r32] = f2bf1(o[d0][r] * rli[r]); }
    asm volatile("s_waitcnt lgkmcnt(0)" ::: "memory");
}
__device__ __forceinline__ void swa_wg_unit(const bf16* __restrict__ QKVb, int gbr, int uidx, unsigned short* __restrict__ OAg, float* __restrict__ LSEg, char* lds, float* scr, const int wid) {
    constexpr float SCALE = 0.088388347648318440f, C = SCALE * 1.4426950408889634f;
    const int lane = mk_lane(), tid = wid * 64 + lane, r32 = lane & 31, hi = lane >> 5;
    const int dsh = 2 * gbr, dil = 1 << dsh, L = 2048 >> dsh, nblk = L >> 5; const bool big = nblk >= 8;
    const int upers = big ? (nblk >> 3) : 1; const int sub0 = big ? uidx / upers : 2 * uidx; const int qt0 = big ? (uidx % upers) * 8 : 0;
    const long rstride = (long)dil * LDR;
#define SUB_BASE(sub) (QKVb + ((size_t)((sub) >> (3 + dsh)) * 2048 + (((sub) >> 3) & (dil - 1))) * LDR + ((sub) & 7) * 128)
    const int srow = tid >> 4, scol = (tid & 15) * 8;
    bf16x8 kst[12], vst[12];
#pragma unroll
    for (int sl = 0; sl < 12; ++sl) {
        const int sub_s = big ? sub0 : sub0 + ((sl >> 2) & 1); const int kt_s = big ? min(max(qt0 - 2 + sl, 0), nblk - 1) : (sl & 3);
        const bf16* p_ = SUB_BASE(sub_s) + (long)(kt_s * 32 + srow) * rstride + scol;
        kst[sl] = *reinterpret_cast<const bf16x8*>(p_ + 1024);
    }
    const int sub_w = big ? sub0 : sub0 + (wid >> 2); const int qt = big ? qt0 + wid : (wid & 3); const int t0 = qt * 32;
    const bf16* base_w = SUB_BASE(sub_w);
    bf16x8 qr[8];
    { const bf16* Qw = base_w + (long)(t0 + r32) * rstride + hi * 8;
#pragma unroll
      for (int d0 = 0; d0 < 8; ++d0) qr[d0] = *reinterpret_cast<const bf16x8*>(Qw + d0 * 16); }
#pragma unroll
    for (int sl = 0; sl < 12; ++sl) *(bf16x8*)(lds + sl * 8192 + KSWZ(srow, scol * 2)) = kst[sl];
#pragma unroll
    for (int sl = 0; sl < 12; ++sl) {
        const int sub_s = big ? sub0 : sub0 + ((sl >> 2) & 1); const int kt_s = big ? min(max(qt0 - 2 + sl, 0), nblk - 1) : (sl & 3);
        const bf16* p_ = SUB_BASE(sub_s) + (long)(kt_s * 32 + srow) * rstride + scol;
        vst[sl] = *reinterpret_cast<const bf16x8*>(p_ + 2048);
    }
    __syncthreads();
    f32x16 s[5];
#pragma unroll
    for (int i = 0; i < 5; ++i) {
        const int kt = qt - 2 + i; const bool ok = kt >= 0 && kt < nblk;
        const int slot = big ? wid + i : 4 * (wid >> 2) + min(max(kt, 0), 3);
        const char* Ks = lds + slot * 8192;
        f32x16 p = f32x16{};
#pragma unroll
        for (int d0 = 0; d0 < 8; ++d0) { const int cb = (d0 * 16 + hi * 8) * 2;
            const bf16x8 b0 = *reinterpret_cast<const bf16x8*>(Ks + KSWZ(r32, cb));
            p = __builtin_amdgcn_mfma_f32_32x32x16_bf16(b0, qr[d0], p, 0, 0, 0); }
#pragma unroll
        for (int r = 0; r < 16; ++r) {
            bool keep = ok;
            if (i == 0) keep = keep && (crow(r, hi) >= r32);
            if (i == 4) keep = keep && (crow(r, hi) <= r32);
            s[i][r] = keep ? p[r] : -1e30f;
        }
    }
    float m = -1e30f;
#pragma unroll
    for (int i = 0; i < 5; ++i)
#pragma unroll
        for (int r = 0; r < 16; ++r) m = fmaxf(m, s[i][r]);
    { auto rr = __builtin_amdgcn_permlane32_swap(__float_as_uint(m), __float_as_uint(m), false, false);
      m = fmaxf(__uint_as_float(rr[0]), __uint_as_float(rr[1])); }
    const float mC = -m * C; float l = 0.f;
#pragma unroll
    for (int i = 0; i < 5; ++i)
#pragma unroll
        for (int r = 0; r < 16; ++r) { s[i][r] = __builtin_amdgcn_exp2f(fmaf(s[i][r], C, mC)); l += s[i][r]; }
    { auto rr = __builtin_amdgcn_permlane32_swap(__float_as_uint(l), __float_as_uint(l), false, false);
      l = __uint_as_float(rr[0]) + __uint_as_float(rr[1]); }
    bf16x8 pa[5][2];
#pragma unroll
    for (int i = 0; i < 5; ++i) { PK4(s[i], 0, pa[i][0]); PK4(s[i], 8, pa[i][1]); }
    __syncthreads();
#pragma unroll
    for (int sl = 0; sl < 12; ++sl) *(bf16x8*)(lds + sl * 8192 + v_st(srow, scol)) = vst[sl];
    __syncthreads();
    f32x16 o[4] = {};
#pragma unroll
    for (int i = 0; i < 5; ++i) {
        const int kt = qt - 2 + i;
        const int slot = big ? wid + i : 4 * (wid >> 2) + min(max(kt, 0), 3);
        const int vb = (int)(uintptr_t)(lds + slot * 8192) + v_rd_base(lane);
        pv_one32<0>(o[0], vb, pa[i][0], pa[i][1]); pv_one32<1>(o[1], vb, pa[i][0], pa[i][1]); pv_one32<2>(o[2], vb, pa[i][0], pa[i][1]); pv_one32<3>(o[3], vb, pa[i][0], pa[i][1]);
    }
    const size_t tok0 = ((size_t)(sub_w >> (3 + dsh)) * 2048 + ((sub_w >> 3) & (dil - 1))); const int hh = sub_w & 7;
    if (hi == 0) { scr[r32] = l; LSEg[(tok0 + (size_t)(t0 + r32) * dil) * 8 + hh] = m * SCALE + __logf(l); }
    asm volatile("s_waitcnt lgkmcnt(0)" ::: "memory");
    float rli[16];
#pragma unroll
    for (int r = 0; r < 16; ++r) rli[r] = __builtin_amdgcn_rcpf(scr[crow(r, hi)]);
#pragma unroll
    for (int r = 0; r < 16; ++r) { unsigned short* orow = OAg + (tok0 + (size_t)(t0 + crow(r, hi)) * dil) * 1024 + hh * 128;
#pragma unroll
        for (int d0 = 0; d0 < 4; ++d0) orow[d0 * 32 + r32] = f2bf1(o[d0][r] * rli[r]); }
    asm volatile("s_waitcnt lgkmcnt(0)" ::: "memory");
    __syncthreads();
#undef SUB_BASE
}
#undef SBAR
}
#ifndef MK_DUP_PHASE
#define MK_DUP_PHASE -1
#endif
#define NREP(k) (1 + (MK_DUP_PHASE == (k) ? 1 : 0))
#ifndef MK_ONE_LAUNCH
#define MK_ONE_LAUNCH 1
#endif
constexpr int NWAVES = 8;
constexpr int BATCH = 4, SEQ = 2048, DM = 2048, M = BATCH * SEQ, NIN = 6144, DFF = 5632, NGU = 2 * DFF, NHEAD = 8, HD = 128;
constexpr float RMS_EPS = 1e-6f, SUBLN_EPS = 1e-5f, LAM_INIT = 0.2f;
constexpr size_t MiB = 1u << 20;
constexpr size_t WS_SS1 = 0, WS_SS2 = 64 * 1024, WS_LSE = 1 * MiB;
constexpr size_t WS_QKV = 2 * MiB;
constexpr size_t WS_Y = 2 * MiB;
constexpr size_t WS_H = 34 * MiB;
constexpr size_t WS_WIN = 98 * MiB, WS_XN = 122 * MiB;
constexpr size_t WS_OA = 98 * MiB;
constexpr size_t WS_WOUT = 154 * MiB;
constexpr size_t WS_OB = 162 * MiB, WS_XG = 162 * MiB;
constexpr size_t WS_WGU = 194 * MiB, WS_WDN = 238 * MiB, WS_END = 260 * MiB;
static_assert(WS_H + (size_t)M * DFF * 2 <= WS_XG && WS_OA + (size_t)3 * M * 1024 * 2 <= WS_WOUT && WS_WDN + (size_t)DM * DFF * 2 <= WS_END && WS_WGU + (size_t)NGU * DM * 2 <= WS_WDN && WS_QKV + (size_t)M * NIN * 2 <= WS_WIN, "d_ws map");
constexpr int RING_BYTES = 131072, LDS_BYTES = 147456, MISC_OFF = 139264;
constexpr size_t WS_BAR = 128 * 1024, WS_CNT = 144 * 1024, WS_FLAG = 152 * 1024, BAR_BYTES = 32 * 1024;

#define GAS __attribute__((address_space(1)))
#define LAS __attribute__((address_space(3)))
typedef unsigned short bf16;
typedef unsigned v4u __attribute__((ext_vector_type(4)));
typedef float f32x4 __attribute__((ext_vector_type(4)));
#define LDS_WAIT() asm volatile("s_waitcnt lgkmcnt(0)" ::: "memory")
__device__ __forceinline__ unsigned f2bf(float f) { unsigned u = __builtin_bit_cast(unsigned, f); return (u + 0x7fffu + ((u >> 16) & 1u)) >> 16; }
__device__ __forceinline__ unsigned pk2(float lo, float hi) { return f2bf(lo) | (f2bf(hi) << 16); }
__device__ __forceinline__ float bflo(unsigned w) { return __uint_as_float(w << 16); }
__device__ __forceinline__ float bfhi(unsigned w) { return __uint_as_float(w & 0xffff0000u); }
__device__ __forceinline__ float wave_sum(float v) {
#pragma unroll
    for (int o = 1; o < 64; o <<= 1) v += __shfl_xor(v, o);
    return v;
}
__device__ __forceinline__ void transpose_item(const float* W, int K, int N, bf16* WT, int k0, int n0, int dst_row0, LAS float* scr, int lane, const float* ks = nullptr) {
    float wv[32];
#pragma unroll
    for (int i = 0; i < 32; ++i) { const int kk = 2 * i + (lane >> 5); wv[i] = W[(size_t)(k0 + kk) * N + n0 + (lane & 31)]; }
#pragma unroll
    for (int i = 0; i < 32; ++i) { const int kk = 2 * i + (lane >> 5); scr[kk * 33 + (lane & 31)] = wv[i]; }
    LDS_WAIT(); asm volatile("" ::: "memory");
    const int c = lane & 7;
    f32x4 g0 = {1.f, 1.f, 1.f, 1.f}, g1 = {1.f, 1.f, 1.f, 1.f};
    if (ks) { g0 = *(const f32x4*)(ks + k0 + 8 * c); g1 = *(const f32x4*)(ks + k0 + 8 * c + 4); }
#pragma unroll
    for (int j = 0; j < 4; ++j) { const int n = (lane >> 3) + 8 * j; const LAS float* s = scr + (8 * c) * 33 + n;
        v4u o; o.x = pk2(s[0 * 33] * g0.x, s[1 * 33] * g0.y); o.y = pk2(s[2 * 33] * g0.z, s[3 * 33] * g0.w); o.z = pk2(s[4 * 33] * g1.x, s[5 * 33] * g1.y); o.w = pk2(s[6 * 33] * g1.z, s[7 * 33] * g1.w);
        *(GAS v4u*)(WT + (size_t)(dst_row0 + n) * K + k0 + 8 * c) = o; }
    LDS_WAIT(); asm volatile("" ::: "memory");
}

#define XB_TMO      128
#define XB_XCNT(j)  (256  + 64 * (j))
#define XB_XSUB(j)  (1280 + 64 * (j))
#define XB_XGEN(j)  (2304 + 64 * (j))
#define XB_TOP      3328
#define XB_TOPGEN   3392
#define XCD_BAR_WORDS 3456
#define XB_SPIN_CAP (1u << 18)

__device__ __forceinline__ unsigned xb_ld(unsigned* p)              { return __hip_atomic_load(p, __ATOMIC_RELAXED, __HIP_MEMORY_SCOPE_AGENT); }
__device__ __forceinline__ unsigned xb_add(unsigned* p, unsigned v) { return __hip_atomic_fetch_add(p, v, __ATOMIC_RELAXED, __HIP_MEMORY_SCOPE_AGENT); }
__device__ __forceinline__ unsigned xb_xcc_id() { return (unsigned)__builtin_amdgcn_s_getreg((3 << 11) | 20) & 0xFu; }
#define XB_SPIN(cond, bar) do { unsigned _sp = 0; while (cond) { __builtin_amdgcn_s_sleep(1); \
    if ((++_sp & 255u) == 0u) { if (xb_ld(&(bar)[XB_TMO])) break; if (_sp > XB_SPIN_CAP) { atomicAdd(&(bar)[XB_TMO], 1u); break; } } } } while (0)

struct XcdBarrier {
    unsigned* bar; unsigned x;
    volatile LAS unsigned* st;
};

__device__ __forceinline__ XcdBarrier xcd_barrier_post(unsigned* bar, volatile LAS unsigned* st, const int wave_in) {
    XcdBarrier b; b.bar = bar; b.x = xb_xcc_id(); b.st = st;
    if (wave_in == 0 && mk_lane() == 0) (void)xb_add(&bar[XB_XCNT(b.x)], 1u);
    return b;
}
__device__ __forceinline__ void xcd_barrier_complete(unsigned* bar, unsigned x, unsigned& nloc, unsigned& nx) {
    const unsigned G = gridDim.x * gridDim.y * gridDim.z;
    unsigned sum, cnt, mine, sp = 0u;
    for (;;) {
        sum = 0u; cnt = 0u; mine = 0u;
#pragma unroll
        for (unsigned j = 0; j < 16; ++j) { const unsigned c = xb_ld(&bar[XB_XCNT(j)]); sum += c; cnt += (c > 0u) ? 1u : 0u; mine = (j == x) ? c : mine; }
        if (sum == G) break;
        __builtin_amdgcn_s_sleep(1);
        if ((++sp & 255u) == 0u) { if (xb_ld(&bar[XB_TMO])) break; if (sp > XB_SPIN_CAP) { atomicAdd(&bar[XB_TMO], 1u); break; } }
    }
    nloc = mine > 0u ? mine : 1u; nx = cnt > 0u ? cnt : 1u;
}

__device__ __forceinline__ void xcd_barrier(const XcdBarrier& b, const int wave_in) {
    asm volatile("s_waitcnt vmcnt(0)" ::: "memory");
    __syncthreads();
    if (wave_in == 0 && mk_lane() == 0) {
        unsigned* bar = b.bar;
        __builtin_amdgcn_s_waitcnt(0);
        unsigned nloc = b.st[0], nx = b.st[1];
        if (nloc == 0u) { xcd_barrier_complete(bar, b.x, nloc, nx); b.st[0] = nloc; b.st[1] = nx; }
        const unsigned old = xb_add(&bar[XB_XSUB(b.x)], 1u);
        const unsigned gen = old / nloc;
        if (old + 1u == (gen + 1u) * nloc) {
            __builtin_amdgcn_fence(__ATOMIC_RELEASE, "agent");
            asm volatile("s_waitcnt vmcnt(0)" ::: "memory");
            const unsigned og = xb_add(&bar[XB_TOP], 1u);
            const unsigned tg = og / nx;
            if (og + 1u == (tg + 1u) * nx) xb_add(&bar[XB_TOPGEN], 1u);
            else XB_SPIN(xb_ld(&bar[XB_TOPGEN]) == tg, bar);
            __builtin_amdgcn_fence(__ATOMIC_ACQUIRE, "agent");
            xb_add(&bar[XB_XGEN(b.x)], 1u);
            asm volatile("s_waitcnt vmcnt(0)" ::: "memory");
        } else {
            XB_SPIN(xb_ld(&bar[XB_XGEN(b.x)]) == gen, bar);
            __builtin_amdgcn_fence(__ATOMIC_ACQUIRE, "agent");
            asm volatile("s_waitcnt vmcnt(0)" ::: "memory");
        }
    }
    __syncthreads();
}
struct Args { const float* in[11]; float* out; unsigned char* ws; int ph_lo, ph_hi; };
constexpr int NPHASE = 7;

__global__ void __launch_bounds__(NWAVES * 64, 2) mk_fwd(Args args) {
    extern __shared__ __attribute__((aligned(16))) unsigned char lds[];
    LAS unsigned char* ldsl = (LAS unsigned char*)lds;
    const int wave = __builtin_amdgcn_readfirstlane((int)threadIdx.x >> 6);
    const int G = gridDim.x, bx = blockIdx.x;
    const int vcu = (G % 8 == 0) ? (bx % 8) * (G / 8) + bx / 8 : bx;
    const int gw = vcu * NWAVES + wave, NGW = G * NWAVES;
    unsigned char* ws = args.ws;
    const float* x = args.in[0]; const float* g_attn = args.in[1]; const float* w_in = args.in[2]; const float* lambda_qk = args.in[3]; const float* subln = args.in[4];
    const float* w_out = args.in[5]; const float* g_ffn = args.in[6]; const float* w_gate = args.in[7]; const float* w_up = args.in[8]; const float* w_down = args.in[9];
    const float* g_final = args.in[10];
    float* out = args.out;
    float* SS1 = (float*)(ws + WS_SS1); float* SS2 = (float*)(ws + WS_SS2); float* LSE = (float*)(ws + WS_LSE);
    bf16* QKV = (bf16*)(ws + WS_QKV); bf16* WGU = (bf16*)(ws + WS_WGU); bf16* WDN = (bf16*)(ws + WS_WDN); bf16* HB = (bf16*)(ws + WS_H);
    bf16* WIN = (bf16*)(ws + WS_WIN); bf16* XN = (bf16*)(ws + WS_XN); bf16* OA = (bf16*)(ws + WS_OA); bf16* WOUT = (bf16*)(ws + WS_WOUT);
    bf16* OB = (bf16*)(ws + WS_OB); bf16* XG = (bf16*)(ws + WS_XG); bf16* Y = (bf16*)(ws + WS_Y);
    const int lo = args.ph_lo, hi_ph = args.ph_hi;
#define IN(k) (lo <= (k) && (k) < hi_ph)
    if (wave == 0) { const int l0 = mk_lane(); if (l0 < 32) ((LAS unsigned*)(ldsl + MISC_OFF))[l0] = 0u; }
    __syncthreads();
    XcdBarrier bar; bar.bar = (unsigned*)(ws + WS_BAR); bar.x = 0; bar.st = nullptr;
    if (hi_ph - lo > 1) bar = xcd_barrier_post((unsigned*)(ws + WS_BAR), (volatile LAS unsigned*)(ldsl + MISC_OFF), wave);
    if (lo < -1000) cg::this_grid().sync();
#define SEAM(k) do { if (IN(k) && IN((k) + 1)) { for (int rb = 0; rb < (MK_DUP_PHASE == 30 ? 3 : 1); ++rb) xcd_barrier(bar, wave); } } while (0)

    if (IN(0)) for (int rep = 0; rep < NREP(0); ++rep) { const int lane = mk_lane(), tid = wave * 64 + lane;
        LAS float* scr = (LAS float*)(ldsl + wave * 16384);
        constexpr int I_IN = (DM / 64) * (NIN / 32), I_OUT = (DM / 64) * (DM / 32);
        for (int it = gw; it < I_IN; it += NGW) {
            if (it < I_IN) { const int nblk = NIN / 32, kb = it / nblk, nb = it % nblk; transpose_item(w_in, DM, NIN, WIN, 64 * kb, 32 * nb, 32 * nb, scr, lane); }
            else { const int r = it - I_IN; const int nblk = DM / 32, kb = r / nblk, nb = r % nblk; transpose_item(w_out, DM, DM, WOUT, 64 * kb, 32 * nb, 32 * nb, scr, lane); }
        }
        for (int m = gw; m < M; m += NGW) {
            const GAS f32x4* xr = (const GAS f32x4*)(x + (size_t)m * DM) + lane;
            f32x4 v[8]; float s = 0.f;
#pragma unroll
            for (int j = 0; j < 8; ++j) { v[j] = xr[64 * j]; s += (v[j].x * v[j].x + v[j].y * v[j].y) + (v[j].z * v[j].z + v[j].w * v[j].w); }
            const float rstd = 1.0f / sqrtf(wave_sum(s) * (1.f / DM) + RMS_EPS);
            GAS unsigned long long* o8 = (GAS unsigned long long*)(XN + (size_t)m * DM) + lane;
#pragma unroll
            for (int j = 0; j < 8; ++j) { const f32x4 gg = *((const GAS f32x4*)g_attn + lane + 64 * j);
                o8[64 * j] = (unsigned long long)pk2(v[j].x * rstd * gg.x, v[j].y * rstd * gg.y) | ((unsigned long long)pk2(v[j].z * rstd * gg.z, v[j].w * rstd * gg.w) << 32); }
        }
        for (int i = bx * (NWAVES * 64) + tid; i < M; i += G * NWAVES * 64) { SS1[i] = 0.f; SS2[i] = 0.f; }
    }
    SEAM(0);
    if (IN(1)) {
        pg8::Gemm g{XN, WIN, M, NIN, DM}; pg8::StaticOrder S; S.init(M, NIN, G, bx); S.dup = NREP(1);
        pg8::EpiQKV E{QKV, NIN};
        pg8::gemm_phase<pg8::EpiQKV, pg8::StaticOrder, true, true>(ldsl, g, S, E, wave);
    }
    SEAM(1);
    if (IN(2)) { const int lane = mk_lane();
        att::ConvJob cj{w_gate, w_up, w_down, w_out, g_ffn, WGU, WDN, WOUT, vcu, vcu + G * ((att::CV_TOTAL - 1 - vcu) / G), G};
        for (int uu = vcu; uu < BATCH * NHEAD * 2 * (SEQ / 256) * NREP(20); uu += G) { const int u = uu & 511;
            const int qb = u & 7, c = (u >> 3) & 1, h = (u >> 4) & 7, b = u >> 7;
            const att::bf16* rowb = (const att::bf16*)QKV + (size_t)b * SEQ * NIN;
            att::attn_dense_body(rowb + (size_t)qb * 256 * NIN + 3072 + h * HD, rowb + 4096 + h * HD, rowb + 5120 + h * HD,
                                 OB + (size_t)c * M * 1024 + ((size_t)b * SEQ + qb * 256) * 1024 + h * HD, 1024, 4 * c, SEQ, (char*)lds, wave, cj);
        }
        __syncthreads();
        {
            char* lds_w = (char*)lds + wave * 16384; float* scr = (float*)((char*)lds + RING_BYTES) + wave * 64;
            LAS float* tscr = (LAS float*)(ldsl + wave * 16384);
            constexpr int I_G = (DM / 64) * (DFF / 32), I_D = (DFF / 64) * (DM / 32);
#define CONV_ITEMS() do { for (int it = gw; it < 2 * I_G + I_D; it += NGW) { \
                if (it < 2 * I_G) { const int up = it >= I_G; const int r = it - up * I_G; const int nblk = DFF / 32, kb = r / nblk, nb = r % nblk, n0 = 32 * nb; \
                    transpose_item(up ? w_up : w_gate, DM, DFF, WGU, 64 * kb, n0, 256 * (n0 >> 7) + 128 * up + (n0 & 127), tscr, lane, g_ffn); } \
                else { const int r = it - 2 * I_G; const int nblk = DM / 32, kb = r / nblk, nb = r % nblk; transpose_item(w_down, DFF, DM, WDN, 64 * kb, 32 * nb, 32 * nb, tscr, lane); } } } while (0)
            for (int uu = vcu; uu < 768 * NREP(21); uu += G) { const int u = uu % 768;
                const int gbr = u >> 8, uidx = u & 255;
                att::swa_wg_unit((const att::bf16*)QKV, gbr, uidx, OA + (size_t)gbr * M * 1024, LSE + (size_t)gbr * M * 8, (char*)lds, scr, wave);
            }
#undef CONV_ITEMS
        }
        __syncthreads();
    }
    SEAM(2);
    if (IN(3)) for (int rep = 0; rep < NREP(3); ++rep) { const int lane = mk_lane();
        float lam;
        { const float a = lambda_qk[lane] * lambda_qk[64 + lane], b2 = lambda_qk[128 + lane] * lambda_qk[192 + lane];
          lam = __expf(wave_sum(a)) - __expf(wave_sum(b2)) + LAM_INIT; }
        for (int m = gw; m < M; m += NGW) {
#pragma unroll
            for (int j = 0; j < 2; ++j) {
                const int ch = j * 64 + lane, col = ch * 8, h = ch >> 4;
                const float l0 = LSE[(size_t)m * 8 + h], l1 = LSE[(size_t)(M + m) * 8 + h], l2 = LSE[(size_t)(2 * M + m) * 8 + h];
                const float mx = fmaxf(l0, fmaxf(l1, l2)); float w0 = __expf(l0 - mx), w1 = __expf(l1 - mx), w2 = __expf(l2 - mx);
                const float inv = 1.0f / (w0 + w1 + w2); w0 *= inv; w1 *= inv; w2 *= inv;
                const v4u a0 = *(const GAS v4u*)(OA + (size_t)m * 1024 + col), a1 = *(const GAS v4u*)(OA + ((size_t)M + m) * 1024 + col), a2 = *(const GAS v4u*)(OA + ((size_t)2 * M + m) * 1024 + col);
                v4u ya;
#pragma unroll
                for (int i = 0; i < 4; ++i) ya[i] = pk2(w0 * bflo(a0[i]) + w1 * bflo(a1[i]) + w2 * bflo(a2[i]), w0 * bfhi(a0[i]) + w1 * bfhi(a1[i]) + w2 * bfhi(a2[i]));
                *(GAS v4u*)(Y + (size_t)m * DM + col) = ya;
                const v4u b0 = *(const GAS v4u*)(OB + (size_t)m * 1024 + col), b1 = *(const GAS v4u*)(OB + ((size_t)M + m) * 1024 + col);
                float d[8]; float ssq = 0.f;
#pragma unroll
                for (int i = 0; i < 4; ++i) { d[2 * i] = bflo(b0[i]) - lam * bflo(b1[i]); d[2 * i + 1] = bfhi(b0[i]) - lam * bfhi(b1[i]); ssq += d[2 * i] * d[2 * i] + d[2 * i + 1] * d[2 * i + 1]; }
                ssq += __shfl_xor(ssq, 1); ssq += __shfl_xor(ssq, 2); ssq += __shfl_xor(ssq, 4); ssq += __shfl_xor(ssq, 8);
                const float rs = (1.0f - LAM_INIT) / sqrtf(ssq * (1.f / HD) + SUBLN_EPS);
                const f32x4 s0 = *(const GAS f32x4*)(subln + (col & 127)), s1 = *(const GAS f32x4*)(subln + (col & 127) + 4);
                v4u yb; yb.x = pk2(d[0] * rs * s0.x, d[1] * rs * s0.y); yb.y = pk2(d[2] * rs * s0.z, d[3] * rs * s0.w); yb.z = pk2(d[4] * rs * s1.x, d[5] * rs * s1.y); yb.w = pk2(d[6] * rs * s1.z, d[7] * rs * s1.w);
                *(GAS v4u*)(Y + (size_t)m * DM + 1024 + col) = yb;
            }
        }
    }
    SEAM(3);
    if (IN(4)) {
        pg8::Gemm g{Y, WOUT, M, DM, DM}; pg8::StaticOrder S; S.init(M, DM, G, bx); S.dup = NREP(4);
        pg8::EpiOut E{x, XG, g_ffn, SS1, DM};
        pg8::gemm_phase<pg8::EpiOut, pg8::StaticOrder, true, true>(ldsl, g, S, E, wave);
    }
    SEAM(4);
    if (IN(5)) {
        pg8::Gemm g{XG, WGU, M, NGU, DM}; pg8::StaticOrder S; S.init(M, NGU, G, bx); S.dup = NREP(5);
        S.split_from = -1  ; S.kh_bytes = (DM / 2) * 2; S.kh_nt = DM / 128;
        pg8::EpiGateUp E{HB, DFF, SS1, 1.0f / DM, RMS_EPS, (pg8::f32x4*)(ws + WS_Y), (unsigned*)(ws + WS_FLAG)};
        pg8::gemm_phase<pg8::EpiGateUp, pg8::StaticOrder, true, true>(ldsl, g, S, E, wave);
    }
    SEAM(5);
    if (IN(6)) {
        pg8::Gemm g{HB, WDN, M, DM, DFF}; pg8::StaticOrder S; S.init(M, DM, G, bx);
        pg8::EpiDownNorm E{XG, g_ffn, out, g_final, SS2, (unsigned*)(ws + WS_CNT), DM, 1.0f / DM, RMS_EPS};
        pg8::gemm_phase<pg8::EpiDownNorm, pg8::StaticOrder, false, true>(ldsl, g, S, E, wave);
    }
#undef IN
#undef SEAM
}

extern "C" void kernel_launch(void* const* d_in, const int* in_sizes, int n_in, void* d_out, int out_size, void* d_ws, size_t ws_size, hipStream_t stream) {
    static int grid = 0;
    if (grid == 0) {
        if (n_in != 11 || in_sizes[0] != M * DM || out_size != M * DM || ws_size < WS_END) { fprintf(stderr, "kernel_launch: shape/workspace mismatch (n_in %d, in0 %d, out %d, ws %zu)\n", n_in, n_in > 0 ? in_sizes[0] : -1, out_size, ws_size); grid = -1; return; }
        int dev = 0, cus = 0, per_cu = 0;
        if (hipGetDevice(&dev) != hipSuccess || hipDeviceGetAttribute(&cus, hipDeviceAttributeMultiprocessorCount, dev) != hipSuccess) { grid = -1; return; }
        if (hipFuncSetAttribute((const void*)mk_fwd, hipFuncAttributeMaxDynamicSharedMemorySize, LDS_BYTES) != hipSuccess) { fprintf(stderr, "kernel_launch: hipFuncSetAttribute failed\n"); grid = -1; return; }
        if (hipOccupancyMaxActiveBlocksPerMultiprocessor(&per_cu, (const void*)mk_fwd, NWAVES * 64, LDS_BYTES) != hipSuccess || per_cu < 1) { fprintf(stderr, "kernel_launch: occupancy query says %d\n", per_cu); per_cu = 1; }
        (void)hipGetLastError();
        grid = cus;
        if (grid != 256) { fprintf(stderr, "kernel_launch: this kernel needs a 256-CU device (got %d)\n", cus); grid = -1; return; }
    }
    if (grid < 0) return;
    Args a{};
    for (int i = 0; i < 11; ++i) a.in[i] = (const float*)d_in[i];
    a.out = (float*)d_out; a.ws = (unsigned char*)d_ws;
#if MK_ONE_LAUNCH
    if (hipMemsetAsync((char*)d_ws + WS_BAR, 0, BAR_BYTES, stream) != hipSuccess) { fprintf(stderr, "kernel_launch: memset failed\n"); return; }
    a.ph_lo = 0; a.ph_hi = NPHASE;
    void* kargs[] = {&a};
    hipError_t e = hipLaunchCooperativeKernel((const void*)mk_fwd, dim3(grid), dim3(NWAVES * 64), kargs, LDS_BYTES, stream);
    if (e != hipSuccess) fprintf(stderr, "kernel_launch: cooperative launch failed: %s (grid %d)\n", hipGetErrorString(e), grid);
#else
    for (int p = 0; p < NPHASE; ++p) {
        a.ph_lo = p; a.ph_hi = p + 1;
        hipLaunchKernelGGL(mk_fwd, dim3(grid), dim3(NWAVES * 64), LDS_BYTES, stream, a);
    }
#endif
}
```

```cpp
#include <hip/hip_runtime.h>
#include <hip/hip_cooperative_groups.h>
#include <hip/hip_bf16.h>
#include <cstdio>
#include <cstdint>
#include <cmath>
namespace cg = cooperative_groups;
__device__ __forceinline__ int mk_lane() { int l; asm volatile("v_mbcnt_lo_u32_b32 %0, -1, 0\n\tv_mbcnt_hi_u32_b32 %0, -1, %0" : "=v"(l)); return l & 63; }
namespace pg8 {
#define PG8_LAS __attribute__((address_space(3)))
typedef unsigned short bf16_t;
typedef short bf16x8 __attribute__((ext_vector_type(8)));
typedef float f32x4 __attribute__((ext_vector_type(4)));
typedef unsigned u32x4 __attribute__((ext_vector_type(4)));
constexpr int BM = 256, BK = 64, HALF = 128, HTB = HALF * BK * 2  , STAGE_BYTES = 8 * HTB, NXCD = 8, WGM = 8;

__host__ __device__ __forceinline__ int lds_byte(int r, int c) { const int st = (r >> 4) * 2 + (c >> 5), rr = r & 15, cc = c & 31, ob = rr * 64 + cc * 2; return st * 1024 + (ob ^ (((ob >> 9) & 1) << 5)); }
__host__ __device__ __forceinline__ void stage_rc(int b, int& R, int& C) { const int st = b / 1024, sb = b % 1024, swz = sb ^ (((sb >> 9) & 1) << 5); R = (st >> 1) * 16 + swz / 64; C = (st & 1) * 32 + (swz % 64) / 2; }
__host__ __device__ __forceinline__ int perm32(int rho) { const int n = rho >> 4, i = rho & 15; return 8 * (i >> 2) + 4 * n + (i & 3); }

struct Unit { int pm, pn, first, khalf, koff, nt, ul; };
struct Gemm { const bf16_t* A; const bf16_t* Bt; int M, N, K; };

struct StaticOrder {
    int nM, nN, nwg, G, c, dup, split_from, kh_bytes, kh_nt;
    __host__ __device__ void init(int M, int N, int G_, int c_) { nM = M / BM; nN = N / BM; nwg = nM * nN; G = G_; c = c_; dup = 1; split_from = -1; kh_bytes = 0; kh_nt = 0; }
    __host__ __device__ bool next(int i, Unit& u) const {
        long L = (long)(i / dup) * G + c; u.khalf = 0; u.koff = 0; u.nt = 0; u.ul = 0;
        if (split_from >= 0 && (long)(i / dup) * G >= split_from) {
            if ((long)(i / dup) * G > split_from) return false;
            u.ul = c >> 1; L = split_from + u.ul; u.khalf = 1 + (c & 1); u.koff = (c & 1) ? kh_bytes : 0; u.nt = kh_nt; }
        if (L >= nwg) return false;
        int wgid = (int)L; { const int q = nwg / NXCD, r = nwg % NXCD, xcd = wgid % NXCD, off = wgid / NXCD; wgid = (xcd < r ? xcd * (q + 1) : r * (q + 1) + (xcd - r) * q) + off; }
        const int nig = WGM * nN, gid = wgid / nig, fm = gid * WGM, gsz = (nM - fm) < WGM ? (nM - fm) : WGM;
        u.pm = fm + ((wgid % nig) % gsz); u.pn = (wgid % nig) / gsz; u.first = (i % dup) == 0; return true;
    }
    __device__ __forceinline__ void a_ready(const Unit&) const {}
    __device__ __forceinline__ void done(const Unit&) const {}
};

__device__ __forceinline__ unsigned cvt_pk_bf16(float lo, float hi) { unsigned r; asm volatile("v_cvt_pk_bf16_f32 %0, %1, %2" : "=v"(r) : "v"(lo), "v"(hi)); return r; }
typedef float f32x2 __attribute__((ext_vector_type(2)));
__device__ __forceinline__ float invf_a(int f) {
    constexpr float T[16] = {1.0f, 0.4403666f, 0.19392274f, 0.0853971f, 0.03760603f, 0.01656044f, 0.0072926646f, 0.003211446f,
                             0.0014142136f, 0.00062277244f, 0.0002742482f, 0.000120769735f, 5.3182957e-05f, 2.342e-05f, 1.0313385e-05f, 4.5416705e-06f};
    return T[f];
}
__device__ __forceinline__ void sincos_rev(float ang, float& s, float& c) {
    const float rev = ang * 0.15915494309189535f; const float fr = rev - __builtin_floorf(rev);
    s = __builtin_amdgcn_sinf(fr); c = __builtin_amdgcn_cosf(fr);
}
struct EpiQKV {
    static constexpr bool PERM = true, AFTER_DRAIN = false;
    bf16_t* O; int ldc;
    __device__ __forceinline__ void operator()(const f32x4 (&acc)[2][2][4][2], const Unit& u, int wr, int wc, int fr, int fq) const {
        const int row0 = u.pm * BM + wr * 64 + fr;
        const int sec = u.pn >> 2;
        const int col0 = u.pn * BM + wc * 32 + 8 * fq;
        const bool ropeA = (sec <= 1) && (wc == 0);
        const bool ropeB = (sec == 3 || sec == 4) && ((wc & 1) == 0);
#pragma unroll
        for (int ai = 0; ai < 2; ++ai)
#pragma unroll
            for (int m = 0; m < 4; ++m) {
                const int row = row0 + ai * HALF + m * 16;
                const float pos = (float)(row & 2047);
                bf16_t* rowp = O + (size_t)row * ldc + col0;
                float cs[8], sn[8];
                if (ropeA) {
                    const int fb = 8 * (fq & 1);
#pragma unroll
                    for (int i = 0; i < 8; ++i) { float f0 = invf_a(i), f1 = invf_a(8 + i); sincos_rev(pos * (fb ? f1 : f0), sn[i], cs[i]); }
                    const float sg = (fq >= 2) ? 1.f : -1.f;
#pragma unroll
                    for (int i = 0; i < 8; ++i) sn[i] *= sg;
                } else if (ropeB) {
#pragma unroll
                    for (int i = 0; i < 8; ++i) sincos_rev(pos * invf_a(2 * i), sn[i], cs[i]);
                    const float sg = (fq == 1) ? 1.f : -1.f;
#pragma unroll
                    for (int i = 0; i < 8; ++i) sn[i] *= sg;
                }
#pragma unroll
                for (int bj = 0; bj < 2; ++bj) {
                    f32x4 v0 = acc[ai][bj][m][0], v1 = acc[ai][bj][m][1];
                    if (ropeA) {
                        f32x4 p0, p1;
#pragma unroll
                        for (int i = 0; i < 4; ++i) { p0[i] = __shfl_xor(v0[i], 32); p1[i] = __shfl_xor(v1[i], 32); }
#pragma unroll
                        for (int i = 0; i < 4; ++i) { v0[i] = v0[i] * cs[i] + p0[i] * sn[i]; v1[i] = v1[i] * cs[4 + i] + p1[i] * sn[4 + i]; }
                    } else if (ropeB) {
                        f32x4 p0, p1;
#pragma unroll
                        for (int i = 0; i < 4; ++i) { p0[i] = __shfl_xor(v0[i], 16); p1[i] = __shfl_xor(v1[i], 16); }
                        if (fq < 2) {
#pragma unroll
                            for (int i = 0; i < 4; ++i) { v0[i] = v0[i] * cs[i] + p0[i] * sn[i]; v1[i] = v1[i] * cs[4 + i] + p1[i] * sn[4 + i]; }
                        }
                    }
                    u32x4 w; w.x = cvt_pk_bf16(v0[0], v0[1]); w.y = cvt_pk_bf16(v0[2], v0[3]); w.z = cvt_pk_bf16(v1[0], v1[1]); w.w = cvt_pk_bf16(v1[2], v1[3]);
                    *(u32x4*)(rowp + bj * HALF) = w;
                }
            }
    }
};
struct EpiOut {
    static constexpr bool PERM = false, AFTER_DRAIN = false;
    const float* base; bf16_t* xg; const float* g; float* ss; int ldc;
    __device__ __forceinline__ void operator()(const f32x4 (&acc)[2][2][4][2], const Unit& u, int wr, int wc, int fr, int fq) const {
        typedef unsigned u32x2v __attribute__((ext_vector_type(2)));
        const int col0 = u.pn * BM + wc * 32 + 4 * fq;
        f32x4 gv[2][2];
#pragma unroll
        for (int bj = 0; bj < 2; ++bj)
#pragma unroll
            for (int n = 0; n < 2; ++n) gv[bj][n] = *(const f32x4*)(g + col0 + bj * HALF + n * 16);
#pragma unroll
        for (int ai = 0; ai < 2; ++ai)
#pragma unroll
            for (int m = 0; m < 4; ++m) {
                const int row = u.pm * BM + ai * HALF + wr * 64 + m * 16 + fr; const size_t off = (size_t)row * ldc + col0; float s = 0.f;
#pragma unroll
                for (int bj = 0; bj < 2; ++bj)
#pragma unroll
                    for (int n = 0; n < 2; ++n) {
                        const f32x4 x1 = *(const f32x4*)(base + off + bj * HALF + n * 16) + acc[ai][bj][m][n];
                        s += (x1[0] * x1[0] + x1[1] * x1[1]) + (x1[2] * x1[2] + x1[3] * x1[3]);
                        const f32x4 y = x1 * gv[bj][n]; u32x2v w; w.x = cvt_pk_bf16(y[0], y[1]); w.y = cvt_pk_bf16(y[2], y[3]);
                        *(u32x2v*)(xg + off + bj * HALF + n * 16) = w;
                    }
                s += __shfl_xor(s, 16); s += __shfl_xor(s, 32);
                if (fq == 0 && u.first) atomicAdd(ss + row, s);
            }
    }
};
struct EpiGateUp {
    static constexpr bool PERM = true, AFTER_DRAIN = false;
    bf16_t* H; int ldh; const float* ss; float inv_n, eps; f32x4* part; unsigned* flag;
    __device__ __forceinline__ void operator()(const f32x4 (&acc)[2][2][4][2], const Unit& u, int wr, int wc, int fr, int fq) const {
        const int tid = (wr * 4 + wc) * 64 + fq * 16 + fr;
        f32x4* pp = part + (size_t)u.ul * (32 * 512) + tid;
        if (u.khalf == 1) {
#pragma unroll
            for (int ai = 0; ai < 2; ++ai)
#pragma unroll
                for (int bj = 0; bj < 2; ++bj)
#pragma unroll
                    for (int m = 0; m < 4; ++m)
#pragma unroll
                        for (int n = 0; n < 2; ++n) pp[(size_t)(((ai * 2 + bj) * 4 + m) * 2 + n) * 512] = acc[ai][bj][m][n];
            asm volatile("s_waitcnt vmcnt(0)" ::: "memory"); __builtin_amdgcn_s_barrier(); asm volatile("" ::: "memory");
            if (tid == 0) { __builtin_amdgcn_fence(__ATOMIC_RELEASE, "agent"); asm volatile("s_waitcnt vmcnt(0)" ::: "memory");
                __hip_atomic_store(flag + 16 * u.ul, 1u, __ATOMIC_RELAXED, __HIP_MEMORY_SCOPE_AGENT); }
            return;
        }
        if (u.khalf == 2) {
            if (tid < 64) { unsigned sp = 0;
                while ((unsigned)__builtin_amdgcn_readfirstlane(__hip_atomic_load(flag + 16 * u.ul, __ATOMIC_RELAXED, __HIP_MEMORY_SCOPE_AGENT)) == 0u) { __builtin_amdgcn_s_sleep(2); if (++sp > (1u << 22)) break; }
                __builtin_amdgcn_fence(__ATOMIC_ACQUIRE, "agent"); asm volatile("s_waitcnt vmcnt(0)" ::: "memory"); }
            asm volatile("s_waitcnt vmcnt(0) lgkmcnt(0)" ::: "memory"); __builtin_amdgcn_s_barrier(); asm volatile("" ::: "memory");
        }
        const int col0 = u.pn * HALF + wc * 32 + 8 * fq;
#pragma unroll
        for (int ai = 0; ai < 2; ++ai)
#pragma unroll
            for (int m = 0; m < 4; ++m) {
                const int row = u.pm * BM + ai * HALF + wr * 64 + m * 16 + fr;
                const float rstd = 1.0f / sqrtf(ss[row] * inv_n + eps);
                f32x4 gq[2], uq[2];
#pragma unroll
                for (int n = 0; n < 2; ++n) { gq[n] = acc[ai][0][m][n]; uq[n] = acc[ai][1][m][n]; }
                if (u.khalf == 2) {
#pragma unroll
                    for (int n = 0; n < 2; ++n) { gq[n] += pp[(size_t)(((ai * 2 + 0) * 4 + m) * 2 + n) * 512]; uq[n] += pp[(size_t)(((ai * 2 + 1) * 4 + m) * 2 + n) * 512]; }
                }
                float hv[8];
#pragma unroll
                for (int n = 0; n < 2; ++n)
#pragma unroll
                    for (int i = 0; i < 4; ++i) { const float gg = gq[n][i] * rstd, uu = uq[n][i] * rstd;
                        hv[4 * n + i] = gg * __builtin_amdgcn_rcpf(1.0f + __builtin_amdgcn_exp2f(-1.4426950408889634f * gg)) * uu; }
                u32x4 w; w.x = cvt_pk_bf16(hv[0], hv[1]); w.y = cvt_pk_bf16(hv[2], hv[3]); w.z = cvt_pk_bf16(hv[4], hv[5]); w.w = cvt_pk_bf16(hv[6], hv[7]);
                *(u32x4*)(H + (size_t)row * ldh + col0) = w;
            }
    }
};
struct EpiDown {
    static constexpr bool PERM = false, AFTER_DRAIN = false;
    const bf16_t* base; float* out; float* ss; int ldc;
    __device__ __forceinline__ void operator()(const f32x4 (&acc)[2][2][4][2], const Unit& u, int wr, int wc, int fr, int fq) const {
        typedef unsigned u32x2v __attribute__((ext_vector_type(2)));
        const int col0 = u.pn * BM + wc * 32 + 4 * fq;
#pragma unroll
        for (int ai = 0; ai < 2; ++ai)
#pragma unroll
            for (int m = 0; m < 4; ++m) {
                const int row = u.pm * BM + ai * HALF + wr * 64 + m * 16 + fr; const size_t off = (size_t)row * ldc + col0; float s = 0.f;
#pragma unroll
                for (int bj = 0; bj < 2; ++bj)
#pragma unroll
                    for (int n = 0; n < 2; ++n) {
                        const u32x2v rb = *(const u32x2v*)(base + off + bj * HALF + n * 16);
                        f32x4 x2 = acc[ai][bj][m][n];
                        x2[0] += __uint_as_float(rb.x << 16); x2[1] += __uint_as_float(rb.x & 0xffff0000u); x2[2] += __uint_as_float(rb.y << 16); x2[3] += __uint_as_float(rb.y & 0xffff0000u);
                        *(f32x4*)(out + off + bj * HALF + n * 16) = x2;
                        s += (x2[0] * x2[0] + x2[1] * x2[1]) + (x2[2] * x2[2] + x2[3] * x2[3]);
                    }
                s += __shfl_xor(s, 16); s += __shfl_xor(s, 32);
                if (fq == 0 && u.first) atomicAdd(ss + row, s);
            }
    }
};
struct EpiDownNorm {
    static constexpr bool PERM = false, AFTER_DRAIN = true;
    const bf16_t* base; const float* gres; float* out; const float* g; float* ss; unsigned* cnt; int ldc; float inv_n, eps;
    __device__ __forceinline__ void fused(f32x4 (&acc)[2][2][4][2], const Unit& u, int wr, int wc, int fr, int fq, PG8_LAS unsigned char* lds, int wid, int lane) const {
        typedef unsigned u32x2v __attribute__((ext_vector_type(2)));
        const int col0 = u.pn * BM + wc * 32 + 4 * fq;
        f32x4 rg[2][2];
#pragma unroll
        for (int bj = 0; bj < 2; ++bj)
#pragma unroll
            for (int n = 0; n < 2; ++n) { const f32x4 t = *(const f32x4*)(gres + col0 + bj * HALF + n * 16); rg[bj][n] = (f32x4){1.0f / t[0], 1.0f / t[1], 1.0f / t[2], 1.0f / t[3]}; }
#pragma unroll
        for (int ai = 0; ai < 2; ++ai)
#pragma unroll
            for (int m = 0; m < 4; ++m) {
                const int row = u.pm * BM + ai * HALF + wr * 64 + m * 16 + fr; const size_t off = (size_t)row * ldc + col0; float s = 0.f;
#pragma unroll
                for (int bj = 0; bj < 2; ++bj)
#pragma unroll
                    for (int n = 0; n < 2; ++n) {
                        const u32x2v rb = *(const u32x2v*)(base + off + bj * HALF + n * 16);
                        f32x4 x2 = acc[ai][bj][m][n];
                        x2[0] += __uint_as_float(rb.x << 16) * rg[bj][n][0]; x2[1] += __uint_as_float(rb.x & 0xffff0000u) * rg[bj][n][1]; x2[2] += __uint_as_float(rb.y << 16) * rg[bj][n][2]; x2[3] += __uint_as_float(rb.y & 0xffff0000u) * rg[bj][n][3];
                        acc[ai][bj][m][n] = x2;
                        s += (x2[0] * x2[0] + x2[1] * x2[1]) + (x2[2] * x2[2] + x2[3] * x2[3]);
                    }
                s += __shfl_xor(s, 16); s += __shfl_xor(s, 32);
                if (fq == 0) atomicAdd(ss + row, s);
            }
        asm volatile("s_waitcnt vmcnt(0)" ::: "memory");
        __builtin_amdgcn_s_barrier(); asm volatile("" ::: "memory");
        if (wid == 0) {
            unsigned* c = cnt + 64 * u.pm;
            if (lane == 0) __hip_atomic_fetch_add(c, 1u, __ATOMIC_RELAXED, __HIP_MEMORY_SCOPE_AGENT);
            unsigned sp = 0;
            while ((unsigned)__builtin_amdgcn_readfirstlane(__hip_atomic_load(c, __ATOMIC_RELAXED, __HIP_MEMORY_SCOPE_AGENT)) < 8u) { __builtin_amdgcn_s_sleep(2); if (++sp > (1u << 22)) break; }
            __builtin_amdgcn_fence(__ATOMIC_ACQUIRE, "agent");
        }
        asm volatile("s_waitcnt vmcnt(0) lgkmcnt(0)" ::: "memory"); __builtin_amdgcn_s_barrier(); asm volatile("" ::: "memory");
        f32x4 gv[2][2];
#pragma unroll
        for (int bj = 0; bj < 2; ++bj)
#pragma unroll
            for (int n = 0; n < 2; ++n) gv[bj][n] = *(const f32x4*)(g + col0 + bj * HALF + n * 16);
#pragma unroll
        for (int ai = 0; ai < 2; ++ai)
#pragma unroll
            for (int m = 0; m < 4; ++m) {
                const int row = u.pm * BM + ai * HALF + wr * 64 + m * 16 + fr; const size_t off = (size_t)row * ldc + col0;
                const float rstd = 1.0f / sqrtf(__hip_atomic_load(ss + row, __ATOMIC_RELAXED, __HIP_MEMORY_SCOPE_AGENT) * inv_n + eps);
#pragma unroll
                for (int bj = 0; bj < 2; ++bj)
#pragma unroll
                    for (int n = 0; n < 2; ++n) *(f32x4*)(out + off + bj * HALF + n * 16) = acc[ai][bj][m][n] * rstd * gv[bj][n];
            }
    }
};
template <class Epi, class Sched, bool ALIGN_EPI = false, bool SP2 = false>
__device__ __forceinline__ void gemm_phase(PG8_LAS unsigned char* lds, const Gemm g, const Sched& S, const Epi& E, const int wave_in) {
    const int wid = wave_in, lane = mk_lane(), tid = wid * 64 + lane, wr = wid >> 2, wc = wid & 3, fr = lane & 15, fq = lane >> 4;
    const int K = g.K, nt = K / BK;
    unsigned voffA[2], voffB[2];
#pragma unroll
    for (int i = 0; i < 2; ++i) { int R, C; stage_rc(tid * 16 + i * 8192, R, C); const int Rb = Epi::PERM ? ((R & ~31) + perm32(R & 31)) : R;
        voffA[i] = (unsigned)(R * K + C) * 2u; voffB[i] = (unsigned)(Rb * K + C) * 2u; }
    const size_t kstep = (size_t)(BK * 2);
    const size_t hstep = (size_t)HALF * K * 2;
    const size_t tstep = 2 * hstep;
    const unsigned ldsw = (unsigned)wid * 1024u;
    const int aoff = lds_byte(wr * 64 + fr, fq * 8), boff = lds_byte(wc * 32 + fr, fq * 8);
#define PG8_SA(b, h) (((b) * 2 + (h)) * HTB)
#define PG8_SB(b, h) ((4 + (b) * 2 + (h)) * HTB)
#define PG8_STAGE(bufoff, gbase, voff) do { _Pragma("unroll") for (int _i = 0; _i < 2; ++_i) \
        __builtin_amdgcn_global_load_lds((const unsigned*)((const char*)(gbase) + (voff)[_i]), (PG8_LAS unsigned*)(lds + (bufoff) + ldsw + _i * 8192), 16, 0, 0); } while (0)
#define PG8_LDA(dst, b, h) do { _Pragma("unroll") for (int m = 0; m < 4; ++m) _Pragma("unroll") for (int k = 0; k < 2; ++k) dst[m][k] = *(const PG8_LAS bf16x8*)(lds + PG8_SA(b, h) + aoff + m * 2048 + k * 1024); } while (0)
#define PG8_LDB(dst, b, h) do { _Pragma("unroll") for (int n = 0; n < 2; ++n) _Pragma("unroll") for (int k = 0; k < 2; ++k) dst[n][k] = *(const PG8_LAS bf16x8*)(lds + PG8_SB(b, h) + boff + n * 2048 + k * 1024); } while (0)
#define PG8_MMA(ai, bj, At, Bt) do { __builtin_amdgcn_s_setprio(1); _Pragma("unroll") for (int m = 0; m < 4; ++m) _Pragma("unroll") for (int n = 0; n < 2; ++n) _Pragma("unroll") for (int k = 0; k < 2; ++k) \
        acc[ai][bj][m][n] = __builtin_amdgcn_mfma_f32_16x16x32_bf16(Bt[n][k], At[m][k], acc[ai][bj][m][n], 0, 0, 0); __builtin_amdgcn_s_setprio(0); } while (0)
#define PG8_WAIT_V(n) asm volatile("s_waitcnt vmcnt(" #n ")" ::: "memory")
#define PG8_WAIT_L(n) asm volatile("s_waitcnt lgkmcnt(" #n ")" ::: "memory")
#define PG8_BAR __builtin_amdgcn_s_barrier()
#define PG8_SCHED __builtin_amdgcn_sched_barrier(0)
    Unit cur, nxt; int ui = 0;
    if (!S.next(0, cur)) return;
    f32x4 acc[2][2][4][2];
#pragma unroll
    for (int a = 0; a < 2; ++a)
#pragma unroll
        for (int b = 0; b < 2; ++b)
#pragma unroll
            for (int m = 0; m < 4; ++m)
#pragma unroll
                for (int n = 0; n < 2; ++n) acc[a][b][m][n] = (f32x4){0.f, 0.f, 0.f, 0.f};
    bf16x8 At[4][2], B0[2][2], B1[2][2];
    const char* cA = (const char*)g.A + (size_t)cur.pm * tstep + cur.koff; const char* cB = (const char*)g.Bt + (size_t)cur.pn * tstep + cur.koff; int ntc = cur.nt ? cur.nt : nt;
    S.a_ready(cur);
    if constexpr (SP2) {
        PG8_STAGE(PG8_SB(0, 0), cB, voffB); PG8_STAGE(PG8_SB(0, 1), cB + hstep, voffB); PG8_STAGE(PG8_SA(0, 0), cA, voffA); PG8_STAGE(PG8_SA(0, 1), cA + hstep, voffA);
        if (wr == 1) PG8_BAR;
        PG8_WAIT_V(2); PG8_BAR;
        PG8_STAGE(PG8_SB(1, 0), cB + kstep, voffB); PG8_STAGE(PG8_SA(1, 0), cA + kstep, voffA); PG8_STAGE(PG8_SB(1, 1), cB + hstep + kstep, voffB);
        PG8_WAIT_V(6); PG8_BAR;
    } else {
        PG8_STAGE(PG8_SB(0, 0), cB, voffB); PG8_STAGE(PG8_SA(0, 0), cA, voffA); PG8_STAGE(PG8_SB(0, 1), cB + hstep, voffB); PG8_STAGE(PG8_SA(0, 1), cA + hstep, voffA);
        if (wr == 1) PG8_BAR;
        PG8_WAIT_V(4); PG8_BAR;
        PG8_STAGE(PG8_SB(1, 0), cB + kstep, voffB); PG8_STAGE(PG8_SA(1, 0), cA + kstep, voffA); PG8_STAGE(PG8_SB(1, 1), cB + hstep + kstep, voffB);
        PG8_WAIT_V(6); PG8_BAR;
    }
    for (;;) {
        const bool has_next = S.next(ui + 1, nxt);
        const char* nA = has_next ? (const char*)g.A + (size_t)nxt.pm * tstep + nxt.koff : cA; const char* nB = has_next ? (const char*)g.Bt + (size_t)nxt.pn * tstep + nxt.koff : cB;
        for (int t = 0; t < ntc; t += 2) {
            const bool last = (t == ntc - 2);
            const char* a1 = cA + (size_t)(t + 1) * kstep;
            const char* a2 = last ? nA : cA + (size_t)(t + 2) * kstep; const char* b2 = last ? nB : cB + (size_t)(t + 2) * kstep;
            const char* a3 = a2 + kstep; const char* b3 = b2 + kstep;
            if (last && has_next) S.a_ready(nxt);
            if constexpr (SP2) {
            PG8_LDB(B0, 0, 0); PG8_LDB(B1, 0, 1); PG8_SCHED; PG8_LDA(At, 0, 0); PG8_STAGE(PG8_SA(1, 1), a1 + hstep, voffA);
            PG8_WAIT_V(8); PG8_WAIT_L(0); PG8_BAR; PG8_MMA(0, 0, At, B0); PG8_MMA(0, 1, At, B1); PG8_BAR; PG8_SCHED;
            PG8_LDA(At, 0, 1); PG8_STAGE(PG8_SB(0, 0), b2, voffB); PG8_STAGE(PG8_SB(0, 1), b2 + hstep, voffB); PG8_STAGE(PG8_SA(0, 0), a2, voffA);
            PG8_WAIT_V(8); PG8_WAIT_L(0); PG8_BAR; PG8_MMA(1, 0, At, B0); PG8_MMA(1, 1, At, B1); PG8_BAR; PG8_SCHED;
            PG8_LDB(B0, 1, 0); PG8_LDB(B1, 1, 1); PG8_SCHED; PG8_LDA(At, 1, 0); PG8_STAGE(PG8_SA(0, 1), a2 + hstep, voffA);
            PG8_WAIT_V(8); PG8_WAIT_L(0); PG8_BAR; PG8_MMA(0, 0, At, B0); PG8_MMA(0, 1, At, B1); PG8_BAR; PG8_SCHED;
            PG8_LDA(At, 1, 1); PG8_STAGE(PG8_SB(1, 0), b3, voffB); PG8_STAGE(PG8_SB(1, 1), b3 + hstep, voffB); PG8_STAGE(PG8_SA(1, 0), a3, voffA);
            PG8_WAIT_V(8); PG8_WAIT_L(0); PG8_BAR; PG8_MMA(1, 0, At, B0); PG8_MMA(1, 1, At, B1); PG8_BAR; PG8_SCHED;
            } else {
            PG8_LDB(B0, 0, 0); PG8_SCHED; PG8_LDA(At, 0, 0); PG8_STAGE(PG8_SA(1, 1), a1 + hstep, voffA);
            PG8_WAIT_L(8); PG8_BAR; PG8_WAIT_L(0); PG8_MMA(0, 0, At, B0); PG8_BAR; PG8_SCHED;
            PG8_LDB(B1, 0, 1); PG8_STAGE(PG8_SB(0, 0), b2, voffB);
            PG8_BAR; PG8_WAIT_L(0); PG8_MMA(0, 1, At, B1); PG8_BAR;
            PG8_LDA(At, 0, 1); PG8_STAGE(PG8_SA(0, 0), a2, voffA);
            PG8_BAR; PG8_WAIT_L(0); PG8_MMA(1, 0, At, B0); PG8_BAR; PG8_SCHED;
            PG8_STAGE(PG8_SB(0, 1), b2 + hstep, voffB);
            PG8_WAIT_V(6); PG8_BAR; PG8_MMA(1, 1, At, B1); PG8_BAR;
            PG8_LDB(B0, 1, 0); PG8_SCHED; PG8_LDA(At, 1, 0); PG8_STAGE(PG8_SA(0, 1), a2 + hstep, voffA);
            PG8_WAIT_L(8); PG8_BAR; PG8_WAIT_L(0); PG8_MMA(0, 0, At, B0); PG8_BAR; PG8_SCHED;
            PG8_LDB(B1, 1, 1); PG8_STAGE(PG8_SB(1, 0), b3, voffB);
            PG8_BAR; PG8_WAIT_L(0); PG8_MMA(0, 1, At, B1); PG8_BAR;
            PG8_LDA(At, 1, 1); PG8_STAGE(PG8_SA(1, 0), a3, voffA);
            PG8_BAR; PG8_WAIT_L(0); PG8_MMA(1, 0, At, B0); PG8_BAR; PG8_SCHED;
            PG8_STAGE(PG8_SB(1, 1), b3 + hstep, voffB);
            PG8_WAIT_V(6); PG8_BAR; PG8_MMA(1, 1, At, B1); PG8_BAR;
            }
        }
        if constexpr (ALIGN_EPI) { if (wr == 0) PG8_BAR; }
        if constexpr (!Epi::AFTER_DRAIN) { E(acc, cur, wr, wc, fr, fq); S.done(cur); }
        if (!has_next) break;
#pragma unroll
        for (int a = 0; a < 2; ++a)
#pragma unroll
            for (int b = 0; b < 2; ++b)
#pragma unroll
                for (int m = 0; m < 4; ++m)
#pragma unroll
                    for (int n = 0; n < 2; ++n) acc[a][b][m][n] = (f32x4){0.f, 0.f, 0.f, 0.f};
        cur = nxt; cA = nA; cB = nB; ++ui; ntc = cur.nt ? cur.nt : nt;
        if constexpr (ALIGN_EPI) { if (wr == 1) PG8_BAR; }
    }
    PG8_WAIT_V(0);
    if constexpr (!ALIGN_EPI) { if (wr == 0) PG8_BAR; }
    PG8_BAR;
    if constexpr (Epi::AFTER_DRAIN) { E.fused(acc, cur, wr, wc, fr, fq, lds, wid, lane); S.done(cur); }
#undef PG8_SA
#undef PG8_SB
#undef PG8_STAGE
#undef PG8_LDA
#undef PG8_LDB
#undef PG8_MMA
#undef PG8_WAIT_V
#undef PG8_WAIT_L
#undef PG8_BAR
#undef PG8_SCHED
}
}
namespace att {
using bf16 = __hip_bfloat16;
using bf16x8 = __attribute__((ext_vector_type(8))) short;
using s16x4  = __attribute__((ext_vector_type(4))) short;
using f32x16 = __attribute__((ext_vector_type(16))) float;
using u32x4  = __attribute__((ext_vector_type(4))) unsigned;
constexpr int D = 128, NW = 8, QBLK = 32, KVBLK = 64;
constexpr int LDR = 6144;
constexpr size_t SHM_V = KVBLK * D * 2, SHM_K = KVBLK * D * 2, SHM_ATTN = 2 * SHM_V + 2 * SHM_K + NW * 64 * 4;
#define KSWZ(row, colB) ((row) * 256 + ((colB) ^ (((row) & 7) << 4)))
#define SBAR() __builtin_amdgcn_sched_barrier(0)
__device__ __forceinline__ int crow(int r, int hi) { return (r & 3) + 8 * (r >> 2) + 4 * hi; }
__device__ __forceinline__ unsigned cvtpk(float lo, float hi) { unsigned r; asm volatile("v_cvt_pk_bf16_f32 %0, %1, %2" : "=v"(r) : "v"(lo), "v"(hi)); return r; }
__device__ __forceinline__ unsigned short f2bf1(float x) { return (unsigned short)(cvtpk(x, x) & 0xffffu); }
#define PK4(P, BASE, OUT) do { unsigned a0 = cvtpk(P[BASE + 0], P[BASE + 1]), a1 = cvtpk(P[BASE + 2], P[BASE + 3]);   \
    unsigned b0 = cvtpk(P[BASE + 4], P[BASE + 5]), b1 = cvtpk(P[BASE + 6], P[BASE + 7]);                              \
    auto r0 = __builtin_amdgcn_permlane32_swap(a0, b0, false, false); auto r1 = __builtin_amdgcn_permlane32_swap(a1, b1, false, false); \
    u32x4 w = {r0[0], r1[0], r0[1], r1[1]}; OUT = *reinterpret_cast<bf16x8*>(&w); } while (0)

template <int SCALE_E6>
struct SM {
    static constexpr float SCALE = SCALE_E6 == 125000 ? 0.125f : 0.088388347648318440f;
    static constexpr float THR = 8.f;
    static __device__ __forceinline__ void partialSM(f32x16& p0, f32x16& p1, float& m_reg, float& mn, float& alpha) {
        constexpr float C = SCALE * 1.4426950408889634f;
        float pmax = p0[0];
#pragma unroll
        for (int r = 1; r < 16; ++r) pmax = fmaxf(pmax, p0[r]);
#pragma unroll
        for (int r = 0; r < 16; ++r) pmax = fmaxf(pmax, p1[r]);
        { auto rr = __builtin_amdgcn_permlane32_swap(__float_as_uint(pmax), __float_as_uint(pmax), false, false);
          pmax = fmaxf(__uint_as_float(rr[0]), __uint_as_float(rr[1])); }
        if (__builtin_expect(__all(pmax - m_reg <= THR / SCALE), 1)) { mn = m_reg; alpha = 1.f; }
        else { mn = fmaxf(m_reg, pmax); alpha = __builtin_amdgcn_exp2f((m_reg - mn) * C); m_reg = mn; }
        float mnC = -mn * C;
#pragma unroll
        for (int r = 0; r < 16; ++r) p0[r] = fmaf(p0[r], C, mnC);
#pragma unroll
        for (int r = 0; r < 16; ++r) p1[r] = fmaf(p1[r], C, mnC);
#pragma unroll
        for (int r = 0; r < 16; ++r) p0[r] = __builtin_amdgcn_exp2f(p0[r]);
    }
};
__device__ __forceinline__ void finishSM(f32x16& p0, f32x16& p1, float alpha, float& l_reg, bf16x8& pa0, bf16x8& pa1, bf16x8& pa2, bf16x8& pa3) {
#pragma unroll
    for (int r = 0; r < 16; ++r) p1[r] = __builtin_amdgcn_exp2f(p1[r]);
    float ps = 0;
#pragma unroll
    for (int r = 0; r < 16; ++r) ps += p0[r];
#pragma unroll
    for (int r = 0; r < 16; ++r) ps += p1[r];
    { auto rr = __builtin_amdgcn_permlane32_swap(__float_as_uint(ps), __float_as_uint(ps), false, false);
      ps = __uint_as_float(rr[0]) + __uint_as_float(rr[1]); }
    l_reg = l_reg * alpha + ps;
    PK4(p0, 0, pa0); PK4(p0, 8, pa1); PK4(p1, 0, pa2); PK4(p1, 8, pa3);
}
template <int ND0>
__device__ __forceinline__ void qkt(f32x16& p0, f32x16& p1, const bf16* Ks, const bf16x8* qr, int dbase, int r32, int hi) {
    p0 = f32x16{}; p1 = f32x16{};
#pragma unroll
    for (int d0 = 0; d0 < ND0; ++d0) { int cb = ((dbase + d0) * 16 + hi * 8) * 2;
        bf16x8 b0 = *reinterpret_cast<const bf16x8*>((const char*)Ks + KSWZ(r32, cb));
        bf16x8 b1 = *reinterpret_cast<const bf16x8*>((const char*)Ks + KSWZ(32 + r32, cb));
        p0 = __builtin_amdgcn_mfma_f32_32x32x16_bf16(b0, qr[d0], p0, 0, 0, 0);
        p1 = __builtin_amdgcn_mfma_f32_32x32x16_bf16(b1, qr[d0], p1, 0, 0, 0); }
}
__device__ __forceinline__ int v_st(int k, int c) { const int kk = (k & ~0xC) | ((k & 4) << 1) | ((k & 8) >> 1); return ((kk >> 3) * 4 + (c >> 5)) * 512 + ((kk & 7) * 32 + (c & 31)) * 2; }
__device__ __forceinline__ int v_rd_base(int lane) { return ((lane & 3) << 3) | (((lane >> 2) & 3) << 6) | (((lane >> 4) & 1) << 5) | (((lane >> 5) & 1) << 8); }
constexpr int v_rd_off(int d0, int ks, int half) { return d0 * 512 + ks * 4096 + half * 2048; }
template <int OFF> __device__ __forceinline__ s16x4 tr_read(int vb) {
    s16x4 r; asm volatile("ds_read_b64_tr_b16 %0, %1 offset:%2" : "=&v"(r) : "v"(vb), "i"(OFF) : "memory"); return r;
}
#define PKV(L, H) (bf16x8){L[0], L[1], L[2], L[3], H[0], H[1], H[2], H[3]}
template <int D0> __device__ __forceinline__ void pv_one(f32x16& od, int vb, bf16x8 pa0, bf16x8 pa1, bf16x8 pa2, bf16x8 pa3) {
    const s16x4 l0 = tr_read<v_rd_off(D0, 0, 0)>(vb), h0 = tr_read<v_rd_off(D0, 0, 1)>(vb), l1 = tr_read<v_rd_off(D0, 1, 0)>(vb), h1 = tr_read<v_rd_off(D0, 1, 1)>(vb);
    const s16x4 l2 = tr_read<v_rd_off(D0, 2, 0)>(vb), h2 = tr_read<v_rd_off(D0, 2, 1)>(vb), l3 = tr_read<v_rd_off(D0, 3, 0)>(vb), h3 = tr_read<v_rd_off(D0, 3, 1)>(vb);
    asm volatile("s_waitcnt lgkmcnt(0)" ::: "memory"); SBAR();
    od = __builtin_amdgcn_mfma_f32_32x32x16_bf16(pa0, PKV(l0, h0), od, 0, 0, 0);
    od = __builtin_amdgcn_mfma_f32_32x32x16_bf16(pa1, PKV(l1, h1), od, 0, 0, 0);
    od = __builtin_amdgcn_mfma_f32_32x32x16_bf16(pa2, PKV(l2, h2), od, 0, 0, 0);
    od = __builtin_amdgcn_mfma_f32_32x32x16_bf16(pa3, PKV(l3, h3), od, 0, 0, 0);
}
__device__ __forceinline__ void pv_d0(f32x16* o, int vb, bf16x8 pa0, bf16x8 pa1, bf16x8 pa2, bf16x8 pa3) {
    pv_one<0>(o[0], vb, pa0, pa1, pa2, pa3); pv_one<1>(o[1], vb, pa0, pa1, pa2, pa3); pv_one<2>(o[2], vb, pa0, pa1, pa2, pa3); pv_one<3>(o[3], vb, pa0, pa1, pa2, pa3);
}
template <int D0> __device__ __forceinline__ void pv_one32(f32x16& od, int vb, bf16x8 pa0, bf16x8 pa1) {
    const s16x4 l0 = tr_read<v_rd_off(D0, 0, 0)>(vb), h0 = tr_read<v_rd_off(D0, 0, 1)>(vb), l1 = tr_read<v_rd_off(D0, 1, 0)>(vb), h1 = tr_read<v_rd_off(D0, 1, 1)>(vb);
    asm volatile("s_waitcnt lgkmcnt(0)" ::: "memory"); SBAR();
    od = __builtin_amdgcn_mfma_f32_32x32x16_bf16(pa0, PKV(l0, h0), od, 0, 0, 0);
    od = __builtin_amdgcn_mfma_f32_32x32x16_bf16(pa1, PKV(l1, h1), od, 0, 0, 0);
}

typedef float f32x4c __attribute__((ext_vector_type(4)));
struct ConvJob {
    const float *w_gate, *w_up, *w_down, *w_out, *g_ffn; unsigned short *WGU, *WDN, *WOUT;
    int next, end, stride;
};
struct ConvItem { const float* W; unsigned short* dst; int N, K, k0, n0, drow; };
constexpr int CV_GU = 32 * 88, CV_DN = 88 * 32, CV_OUT = 32 * 32, CV_TOTAL = 2 * CV_GU + CV_DN + CV_OUT;
__device__ __forceinline__ ConvItem conv_item(const float* Jw_gate, const float* Jw_up, const float* Jw_down, const float* Jw_out, unsigned short* JWGU, unsigned short* JWDN, unsigned short* JWOUT, int q) {
    ConvItem it;
    const bool gu = q < 2 * CV_GU, dn = !gu && q < 2 * CV_GU + CV_DN; const int up = (q >= CV_GU) ? 1 : 0;
    const int rg = q - up * CV_GU, kbg = rg / 88, nbg = rg - kbg * 88;
    const int rd = gu ? 0 : (dn ? q - 2 * CV_GU : q - 2 * CV_GU - CV_DN), kbd = rd >> 5, nbd = rd & 31;
    it.W = gu ? (up ? Jw_up : Jw_gate) : (dn ? Jw_down : Jw_out);
    it.dst = gu ? JWGU : (dn ? JWDN : JWOUT);
    it.N = gu ? 5632 : 2048; it.K = dn ? 5632 : 2048;
    it.k0 = 64 * (gu ? kbg : kbd); it.n0 = 64 * (gu ? nbg : nbd);
    it.drow = gu ? 256 * (it.n0 >> 7) + 128 * up + (it.n0 & 127) : it.n0;
    return it;
}
__device__ __forceinline__ void attn_dense_body(const bf16* __restrict__ Qb, const bf16* __restrict__ Kh, const bf16* __restrict__ Vh,
                                                unsigned short* __restrict__ Ob, int ldo, int dbase, int seq, char* lds, const int wave_in, ConvJob& cj) {
    using S8 = SM<125000>;
    const int wid = wave_in, lane = mk_lane(), tid = wid * 64 + lane, r32 = lane & 31, hi = lane >> 5;
    bf16* V_lds = (bf16*)lds; bf16* K_lds = (bf16*)(lds + 2 * SHM_V);
    float* ws = (float*)(lds + 2 * SHM_V + 2 * SHM_K) + wid * 64; float* li_l = ws; float* al_l = ws + 32;
    float m_reg = -1e30f, l_reg = 0; f32x16 o[4] = {}; bf16x8 qr[4];
    const bf16* Qw = Qb + (long)(wid * QBLK + r32) * LDR + dbase * 16 + hi * 8;
#pragma unroll
    for (int d0 = 0; d0 < 4; ++d0) qr[d0] = *reinterpret_cast<const bf16x8*>(Qw + d0 * 16);
    const int sr = tid >> 4, sc = (tid & 15) * 8, vst0 = v_st(sr, sc), vst1 = v_st(32 + sr, sc);
    const int vb0 = (int)(uintptr_t)V_lds + v_rd_base(lane);
    struct { bf16x8 vs0, vs1, ks0; } sr_[2];
    const int krow = tid >> 3, kcol = dbase * 16 + (tid & 7) * 8, kst0 = KSWZ(krow, kcol * 2);
#define SLOAD(i, k0) do { sr_[i].vs0 = *reinterpret_cast<const bf16x8*>(&Vh[(long)((k0) + sr) * LDR + sc]); sr_[i].vs1 = *reinterpret_cast<const bf16x8*>(&Vh[(long)((k0) + 32 + sr) * LDR + sc]); \
    sr_[i].ks0 = *reinterpret_cast<const bf16x8*>(&Kh[(long)((k0) + krow) * LDR + kcol]); } while (0)
#define SWRITE(b, i) do { *(bf16x8*)((char*)V_lds + (b) * SHM_V + vst0) = sr_[i].vs0;          \
    *(bf16x8*)((char*)V_lds + (b) * SHM_V + vst1) = sr_[i].vs1;                              \
    *(bf16x8*)((char*)K_lds + (b) * SHM_K + kst0) = sr_[i].ks0; } while (0)
#define SWAIT() do {} while (0)
#define RESC(a) do { if (__any((a) < 1.f)) { if (hi == 0) al_l[r32] = (a); asm volatile("s_waitcnt lgkmcnt(0)" ::: "memory"); \
    _Pragma("unroll") for (int d = 0; d < 4; ++d) _Pragma("unroll") for (int r = 0; r < 16; ++r) o[d][r] *= al_l[crow(r, hi)]; } } while (0)
    f32x16 pA0, pA1, pB0, pB1; float mnA, mnB, alA, alB; bf16x8 pa0, pa1, pa2, pa3; const int NT = seq / KVBLK;
    const float* const jwg = cj.w_gate; const float* const jwu = cj.w_up; const float* const jwd = cj.w_down; const float* const jwo = cj.w_out;
    unsigned short* const jGU = cj.WGU; unsigned short* const jDN = cj.WDN; unsigned short* const jOUT = cj.WOUT; const int jnext = cj.next, jend = cj.end, jstride = cj.stride;
    float* cscr = (float*)(lds + SHM_ATTN); f32x4c cv0, cv1; int slot = 0;
#define CV_Q(k) (min(jnext + (k) * jstride, jend))
#define CV_LOAD(q) do { const ConvItem it_ = conv_item(jwg, jwu, jwd, jwo, jGU, jDN, jOUT, (q)); const float* s_ = it_.W + (size_t)(it_.k0 + (tid >> 3)) * it_.N + it_.n0 + 8 * (tid & 7); \
    cv0 = *(const f32x4c*)s_; cv1 = *(const f32x4c*)(s_ + 4); } while (0)
#define CV_WRITE() do { f32x4c* d_ = (f32x4c*)(cscr + (tid >> 3) * 64 + 8 * ((tid & 7) ^ ((tid >> 6) & 7))); d_[0] = cv0; d_[1] = cv1; } while (0)
#define CV_STORE(q) do { const ConvItem it_ = conv_item(jwg, jwu, jwd, jwo, jGU, jDN, jOUT, (q)); const int n_ = tid >> 3, c_ = tid & 7; const float* s_ = cscr + (8 * c_) * 64 + (n_ ^ (8 * c_)); \
    u32x4 o_; o_.x = cvtpk(s_[0], s_[64]); o_.y = cvtpk(s_[128], s_[192]); o_.z = cvtpk(s_[256], s_[320]); o_.w = cvtpk(s_[384], s_[448]); \
    *(u32x4*)(it_.dst + (size_t)(it_.drow + n_) * it_.K + it_.k0 + 8 * c_) = o_; } while (0)
#define CV_CONSUME() do { CV_WRITE(); const int qn_ = CV_Q(slot + 1); CV_LOAD(qn_); } while (0)
#define CV_FINISH() do { const int qc_ = CV_Q(slot); CV_STORE(qc_); ++slot; } while (0)
    { const int q0_ = CV_Q(0); CV_LOAD(q0_); }
    constexpr int SE = 0, SO = 1;
    SLOAD(SE, 0); asm volatile("s_waitcnt vmcnt(0)" ::: "memory"); SWRITE(0, SE); __syncthreads();
    qkt<4>(pA0, pA1, K_lds, qr, dbase, r32, hi); S8::partialSM(pA0, pA1, m_reg, mnA, alA);
    SLOAD(SO, KVBLK); if (2 < NT) SLOAD(SE, 2 * KVBLK);
    SWAIT(); SWRITE(1, SO); __syncthreads();
    for (int j = 1; j + 1 < NT; j += 2) {
        SBAR(); qkt<4>(pB0, pB1, (bf16*)((char*)K_lds + SHM_K), qr, dbase, r32, hi);
        finishSM(pA0, pA1, alA, l_reg, pa0, pa1, pa2, pa3); SBAR();
        SLOAD(SO, (j + 2) * KVBLK); SBAR();
        pv_d0(o, vb0, pa0, pa1, pa2, pa3); S8::partialSM(pB0, pB1, m_reg, mnB, alB);
        __syncthreads(); SWAIT(); SWRITE(0, SE);
        CV_CONSUME();
        RESC(alB); __syncthreads();
        CV_FINISH();
        SBAR(); qkt<4>(pA0, pA1, K_lds, qr, dbase, r32, hi);
        finishSM(pB0, pB1, alB, l_reg, pa0, pa1, pa2, pa3); SBAR();
        SLOAD(SE, min(j + 3, NT - 1) * KVBLK); SBAR();
        pv_d0(o, vb0 + (int)SHM_V, pa0, pa1, pa2, pa3); S8::partialSM(pA0, pA1, m_reg, mnA, alA);
        __syncthreads(); SWAIT(); SWRITE(1, SO);
        CV_CONSUME();
        RESC(alA); __syncthreads();
        CV_FINISH();
    }
    cj.next = min(jnext + slot * jstride, jend + jstride);
    SBAR(); qkt<4>(pB0, pB1, (bf16*)((char*)K_lds + SHM_K), qr, dbase, r32, hi);
    finishSM(pA0, pA1, alA, l_reg, pa0, pa1, pa2, pa3); SBAR();
    pv_d0(o, vb0, pa0, pa1, pa2, pa3); S8::partialSM(pB0, pB1, m_reg, mnB, alB);
    __syncthreads(); RESC(alB);
    finishSM(pB0, pB1, alB, l_reg, pa0, pa1, pa2, pa3); SBAR();
    pv_d0(o, vb0 + (int)SHM_V, pa0, pa1, pa2, pa3);
    if (hi == 0) li_l[r32] = l_reg; asm volatile("s_waitcnt lgkmcnt(0)" ::: "memory");
    float rli[16];
#pragma unroll
    for (int r = 0; r < 16; ++r) rli[r] = __builtin_amdgcn_rcpf(li_l[crow(r, hi)]);
    unsigned short* Ow = Ob + (long)(wid * QBLK) * ldo;
#pragma unroll
    for (int r = 0; r < 16; ++r) { int orow = crow(r, hi);
#pragma unroll
        for (int d0 = 0; d0 < 4; ++d0) Ow[(long)orow * ldo + d0 * 32 + r32] = f2bf1(o[d0][r] * rli[r]); }
#undef CV_LOAD
#undef CV_Q
#undef CV_STORE
#undef CV_WRITE
#undef CV_CONSUME
#undef CV_FINISH
#undef SLOAD
#undef SWRITE
#undef SWAIT
#undef RESC
}

__device__ __forceinline__ void swa_wave_unit(const bf16* __restrict__ base, long rstride, int qc, int kc, int vc, int t0, int L,
                                              unsigned short* __restrict__ Ob, long ostride, float* __restrict__ Lb, long lstride, char* lds_w, float* scr) {
    constexpr float SCALE = 0.088388347648318440f, C = SCALE * 1.4426950408889634f;
    const int lane = mk_lane(), r32 = lane & 31, hi = lane >> 5;
    bf16* K_lds = (bf16*)lds_w; char* V_lds = lds_w + 8192;
    bf16x8 qr[8];
    { const bf16* Qw = base + (long)(t0 + r32) * rstride + qc + hi * 8;
#pragma unroll
      for (int d0 = 0; d0 < 8; ++d0) qr[d0] = *reinterpret_cast<const bf16x8*>(Qw + d0 * 16); }
    const int srow = lane >> 4, scol = (lane & 15) * 8;
    const bf16* kbase = base + (long)srow * rstride + kc + scol; const bf16* vbase = base + (long)srow * rstride + vc + scol;
    bf16x8 st[2][8];
#define TILE_K0(i) (t0 - 64 + 32 * (i))
#define TILE_OK(i) (TILE_K0(i) >= 0 && TILE_K0(i) < L)
#define TILE_KC(i) (min(max(TILE_K0(i), 0), L - 32))
#define LD_TILE(buf, pbase, i) do { const bf16* p_ = (pbase) + (long)TILE_KC(i) * rstride; _Pragma("unroll") for (int j = 0; j < 8; ++j) st[buf][j] = *reinterpret_cast<const bf16x8*>(p_ + (long)(4 * j) * rstride); } while (0)
    f32x16 s[5];
    LD_TILE(0, kbase, 0);
#pragma unroll
    for (int i = 0; i < 5; ++i) {
        if (i < 4) LD_TILE((i + 1) & 1, kbase, i + 1); else LD_TILE((i + 1) & 1, vbase, 0);
#pragma unroll
        for (int j = 0; j < 8; ++j) *(bf16x8*)((char*)K_lds + KSWZ(4 * j + srow, scol * 2)) = st[i & 1][j];
        f32x16 p = f32x16{};
#pragma unroll
        for (int d0 = 0; d0 < 8; ++d0) { const int cb = (d0 * 16 + hi * 8) * 2;
            const bf16x8 b0 = *reinterpret_cast<const bf16x8*>((const char*)K_lds + KSWZ(r32, cb));
            p = __builtin_amdgcn_mfma_f32_32x32x16_bf16(b0, qr[d0], p, 0, 0, 0); }
        const bool ok = TILE_OK(i);
#pragma unroll
        for (int r = 0; r < 16; ++r) {
            bool keep = ok;
            if (i == 0) keep = keep && (crow(r, hi) >= r32);
            if (i == 4) keep = keep && (crow(r, hi) <= r32);
            s[i][r] = keep ? p[r] : -1e30f;
        }
    }
    float m = -1e30f;
#pragma unroll
    for (int i = 0; i < 5; ++i)
#pragma unroll
        for (int r = 0; r < 16; ++r) m = fmaxf(m, s[i][r]);
    { auto rr = __builtin_amdgcn_permlane32_swap(__float_as_uint(m), __float_as_uint(m), false, false);
      m = fmaxf(__uint_as_float(rr[0]), __uint_as_float(rr[1])); }
    const float mC = -m * C; float l = 0.f;
#pragma unroll
    for (int i = 0; i < 5; ++i)
#pragma unroll
        for (int r = 0; r < 16; ++r) { s[i][r] = __builtin_amdgcn_exp2f(fmaf(s[i][r], C, mC)); l += s[i][r]; }
    { auto rr = __builtin_amdgcn_permlane32_swap(__float_as_uint(l), __float_as_uint(l), false, false);
      l = __uint_as_float(rr[0]) + __uint_as_float(rr[1]); }
    bf16x8 pa[5][2];
#pragma unroll
    for (int i = 0; i < 5; ++i) { PK4(s[i], 0, pa[i][0]); PK4(s[i], 8, pa[i][1]); }
    f32x16 o[4] = {};
    const int vb = (int)(uintptr_t)V_lds + v_rd_base(lane);
#pragma unroll
    for (int i = 0; i < 5; ++i) {
        if (i < 4) LD_TILE(i & 1, vbase, i + 1);
#pragma unroll
        for (int j = 0; j < 8; ++j) *(bf16x8*)(V_lds + v_st(4 * j + srow, scol)) = st[(i + 1) & 1][j];
        asm volatile("s_waitcnt lgkmcnt(0)" ::: "memory");
        pv_one32<0>(o[0], vb, pa[i][0], pa[i][1]); pv_one32<1>(o[1], vb, pa[i][0], pa[i][1]); pv_one32<2>(o[2], vb, pa[i][0], pa[i][1]); pv_one32<3>(o[3], vb, pa[i][0], pa[i][1]);
    }
#undef TILE_K0
#undef TILE_OK
#undef TILE_KC
#undef LD_TILE
    if (hi == 0) { scr[r32] = l; Lb[(long)(t0 + r32) * lstride] = m * SCALE + __logf(l); }
    asm volatile("s_waitcnt lgkmcnt(0)" ::: "memory");
    float rli[16];
#pragma unroll
    for (int r = 0; r < 16; ++r) rli[r] = __builtin_amdgcn_rcpf(scr[crow(r, hi)]);
#pragma unroll
    for (int r = 0; r < 16; ++r) { const long orow = (long)(t0 + crow(r, hi)) * ostride;
#pragma unroll
        for (int d0 = 0; d0 < 4; ++d0) Ob[orow + d0 * 32 + r32] = f2bf1(o[d0][r] * rli[r]); }
    asm volatile("s_waitcnt lgkmcnt(0)" ::: "memory");
}
__device__ __forceinline__ void swa_wg_unit(const bf16* __restrict__ QKVb, int gbr, int uidx, unsigned short* __restrict__ OAg, float* __restrict__ LSEg, char* lds, float* scr, const int wid) {
    constexpr float SCALE = 0.088388347648318440f, C = SCALE * 1.4426950408889634f;
    const int lane = mk_lane(), tid = wid * 64 + lane, r32 = lane & 31, hi = lane >> 5;
    const int dsh = 2 * gbr, dil = 1 << dsh, L = 2048 >> dsh, nblk = L >> 5; const bool big = nblk >= 8;
    const int upers = big ? (nblk >> 3) : 1; const int sub0 = big ? uidx / upers : 2 * uidx; const int qt0 = big ? (uidx % upers) * 8 : 0;
    const long rstride = (long)dil * LDR;
#define SUB_BASE(sub) (QKVb + ((size_t)((sub) >> (3 + dsh)) * 2048 + (((sub) >> 3) & (dil - 1))) * LDR + ((sub) & 7) * 128)
    const int srow = tid >> 4, scol = (tid & 15) * 8;
    bf16x8 kst[12], vst[12];
#pragma unroll
    for (int sl = 0; sl < 12; ++sl) {
        const int sub_s = big ? sub0 : sub0 + ((sl >> 2) & 1); const int kt_s = big ? min(max(qt0 - 2 + sl, 0), nblk - 1) : (sl & 3);
        const bf16* p_ = SUB_BASE(sub_s) + (long)(kt_s * 32 + srow) * rstride + scol;
        kst[sl] = *reinterpret_cast<const bf16x8*>(p_ + 1024);
    }
    const int sub_w = big ? sub0 : sub0 + (wid >> 2); const int qt = big ? qt0 + wid : (wid & 3); const int t0 = qt * 32;
    const bf16* base_w = SUB_BASE(sub_w);
    bf16x8 qr[8];
    { const bf16* Qw = base_w + (long)(t0 + r32) * rstride + hi * 8;
#pragma unroll
      for (int d0 = 0; d0 < 8; ++d0) qr[d0] = *reinterpret_cast<const bf16x8*>(Qw + d0 * 16); }
#pragma unroll
    for (int sl = 0; sl < 12; ++sl) *(bf16x8*)(lds + sl * 8192 + KSWZ(srow, scol * 2)) = kst[sl];
#pragma unroll
    for (int sl = 0; sl < 12; ++sl) {
        const int sub_s = big ? sub0 : sub0 + ((sl >> 2) & 1); const int kt_s = big ? min(max(qt0 - 2 + sl, 0), nblk - 1) : (sl & 3);
        const bf16* p_ = SUB_BASE(sub_s) + (long)(kt_s * 32 + srow) * rstride + scol;
        vst[sl] = *reinterpret_cast<const bf16x8*>(p_ + 2048);
    }
    __syncthreads();
    f32x16 s[5];
#pragma unroll
    for (int i = 0; i < 5; ++i) {
        const int kt = qt - 2 + i; const bool ok = kt >= 0 && kt < nblk;
        const int slot = big ? wid + i : 4 * (wid >> 2) + min(max(kt, 0), 3);
        const char* Ks = lds + slot * 8192;
        f32x16 p = f32x16{};
#pragma unroll
        for (int d0 = 0; d0 < 8; ++d0) { const int cb = (d0 * 16 + hi * 8) * 2;
            const bf16x8 b0 = *reinterpret_cast<const bf16x8*>(Ks + KSWZ(r32, cb));
            p = __builtin_amdgcn_mfma_f32_32x32x16_bf16(b0, qr[d0], p, 0, 0, 0); }
#pragma unroll
        for (int r = 0; r < 16; ++r) {
            bool keep = ok;
            if (i == 0) keep = keep && (crow(r, hi) >= r32);
            if (i == 4) keep = keep && (crow(r, hi) <= r32);
            s[i][r] = keep ? p[r] : -1e30f;
        }
    }
    float m = -1e30f;
#pragma unroll
    for (int i = 0; i < 5; ++i)
#pragma unroll
        for (int r = 0; r < 16; ++r) m = fmaxf(m, s[i][r]);
    { auto rr = __builtin_amdgcn_permlane32_swap(__float_as_uint(m), __float_as_uint(m), false, false);
      m = fmaxf(__uint_as_float(rr[0]), __uint_as_float(rr[1])); }
    const float mC = -m * C; float l = 0.f;
#pragma unroll
    for (int i = 0; i < 5; ++i)
#pragma unroll
        for (int r = 0; r < 16; ++r) { s[i][r] = __builtin_amdgcn_exp2f(fmaf(s[i][r], C, mC)); l += s[i][r]; }
    { auto rr = __builtin_amdgcn_permlane32_swap(__float_as_uint(l), __float_as_uint(l), false, false);
      l = __uint_as_float(rr[0]) + __uint_as_float(rr[1]); }
    bf16x8 pa[5][2];
#pragma unroll
    for (int i = 0; i < 5; ++i) { PK4(s[i], 0, pa[i][0]); PK4(s[i], 8, pa[i][1]); }
    __syncthreads();
#pragma unroll
    for (int sl = 0; sl < 12; ++sl) *(bf16x8*)(lds + sl * 8192 + v_st(srow, scol)) = vst[sl];
    __syncthreads();
    f32x16 o[4] = {};
#pragma unroll
    for (int i = 0; i < 5; ++i) {
        const int kt = qt - 2 + i;
        const int slot = big ? wid + i : 4 * (wid >> 2) + min(max(kt, 0), 3);
        const int vb = (int)(uintptr_t)(lds + slot * 8192) + v_rd_base(lane);
        pv_one32<0>(o[0], vb, pa[i][0], pa[i][1]); pv_one32<1>(o[1], vb, pa[i][0], pa[i][1]); pv_one32<2>(o[2], vb, pa[i][0], pa[i][1]); pv_one32<3>(o[3], vb, pa[i][0], pa[i][1]);
    }
    const size_t tok0 = ((size_t)(sub_w >> (3 + dsh)) * 2048 + ((sub_w >> 3) & (dil - 1))); const int hh = sub_w & 7;
    if (hi == 0) { scr[r32] = l; LSEg[(tok0 + (size_t)(t0 + r32) * dil) * 8 + hh] = m * SCALE + __logf(l); }
    asm volatile("s_waitcnt lgkmcnt(0)" ::: "memory");
    float rli[16];
#pragma unroll
    for (int r = 0; r < 16; ++r) rli[r] = __builtin_amdgcn_rcpf(scr[crow(r, hi)]);
#pragma unroll
    for (int r = 0; r < 16; ++r) { unsigned short* orow = OAg + (tok0 + (size_t)(t0 + crow(r, hi)) * dil) * 1024 + hh * 128;
#pragma unroll
        for (int d0 = 0; d0 < 4; ++d0) orow[d0 * 32 + r32] = f2bf1(o[d0][r] * rli[r]); }
    asm volatile("s_waitcnt lgkmcnt(0)" ::: "memory");
    __syncthreads();
#undef SUB_BASE
}
#undef SBAR
}
#ifndef MK_DUP_PHASE
#define MK_DUP_PHASE -1
#endif
#define NREP(k) (1 + (MK_DUP_PHASE == (k) ? 1 : 0))
#ifndef MK_ONE_LAUNCH
#define MK_ONE_LAUNCH 1
#endif
constexpr int NWAVES = 8;
constexpr int BATCH = 4, SEQ = 2048, DM = 2048, M = BATCH * SEQ, NIN = 6144, DFF = 5632, NGU = 2 * DFF, NHEAD = 8, HD = 128;
constexpr float RMS_EPS = 1e-6f, SUBLN_EPS = 1e-5f, LAM_INIT = 0.2f;
constexpr size_t MiB = 1u << 20;
constexpr size_t WS_SS1 = 0, WS_SS2 = 64 * 1024, WS_LSE = 1 * MiB;
constexpr size_t WS_QKV = 2 * MiB;
constexpr size_t WS_Y = 2 * MiB;
constexpr size_t WS_H = 34 * MiB;
constexpr size_t WS_WIN = 98 * MiB, WS_XN = 122 * MiB;
constexpr size_t WS_OA = 98 * MiB;
constexpr size_t WS_WOUT = 154 * MiB;
constexpr size_t WS_OB = 162 * MiB, WS_XG = 162 * MiB;
constexpr size_t WS_WGU = 194 * MiB, WS_WDN = 238 * MiB, WS_END = 260 * MiB;
static_assert(WS_H + (size_t)M * DFF * 2 <= WS_XG && WS_OA + (size_t)3 * M * 1024 * 2 <= WS_WOUT && WS_WDN + (size_t)DM * DFF * 2 <= WS_END && WS_WGU + (size_t)NGU * DM * 2 <= WS_WDN && WS_QKV + (size_t)M * NIN * 2 <= WS_WIN, "d_ws map");
constexpr int RING_BYTES = 131072, LDS_BYTES = 147456, MISC_OFF = 139264;
constexpr size_t WS_BAR = 128 * 1024, WS_CNT = 144 * 1024, WS_FLAG = 152 * 1024, BAR_BYTES = 32 * 1024;

#define GAS __attribute__((address_space(1)))
#define LAS __attribute__((address_space(3)))
typedef unsigned short bf16;
typedef unsigned v4u __attribute__((ext_vector_type(4)));
typedef float f32x4 __attribute__((ext_vector_type(4)));
#define LDS_WAIT() asm volatile("s_waitcnt lgkmcnt(0)" ::: "memory")
__device__ __forceinline__ unsigned f2bf(float f) { unsigned u = __builtin_bit_cast(unsigned, f); return (u + 0x7fffu + ((u >> 16) & 1u)) >> 16; }
__device__ __forceinline__ unsigned pk2(float lo, float hi) { return f2bf(lo) | (f2bf(hi) << 16); }
__device__ __forceinline__ float bflo(unsigned w) { return __uint_as_float(w << 16); }
__device__ __forceinline__ float bfhi(unsigned w) { return __uint_as_float(w & 0xffff0000u); }
__device__ __forceinline__ float wave_sum(float v) {
#pragma unroll
    for (int o = 1; o < 64; o <<= 1) v += __shfl_xor(v, o);
    return v;
}
__device__ __forceinline__ void transpose_item(const float* W, int K, int N, bf16* WT, int k0, int n0, int dst_row0, LAS float* scr, int lane, const float* ks = nullptr) {
    float wv[32];
#pragma unroll
    for (int i = 0; i < 32; ++i) { const int kk = 2 * i + (lane >> 5); wv[i] = W[(size_t)(k0 + kk) * N + n0 + (lane & 31)]; }
#pragma unroll
    for (int i = 0; i < 32; ++i) { const int kk = 2 * i + (lane >> 5); scr[kk * 33 + (lane & 31)] = wv[i]; }
    LDS_WAIT(); asm volatile("" ::: "memory");
    const int c = lane & 7;
    f32x4 g0 = {1.f, 1.f, 1.f, 1.f}, g1 = {1.f, 1.f, 1.f, 1.f};
    if (ks) { g0 = *(const f32x4*)(ks + k0 + 8 * c); g1 = *(const f32x4*)(ks + k0 + 8 * c + 4); }
#pragma unroll
    for (int j = 0; j < 4; ++j) { const int n = (lane >> 3) + 8 * j; const LAS float* s = scr + (8 * c) * 33 + n;
        v4u o; o.x = pk2(s[0 * 33] * g0.x, s[1 * 33] * g0.y); o.y = pk2(s[2 * 33] * g0.z, s[3 * 33] * g0.w); o.z = pk2(s[4 * 33] * g1.x, s[5 * 33] * g1.y); o.w = pk2(s[6 * 33] * g1.z, s[7 * 33] * g1.w);
        *(GAS v4u*)(WT + (size_t)(dst_row0 + n) * K + k0 + 8 * c) = o; }
    LDS_WAIT(); asm volatile("" ::: "memory");
}

#define XB_TMO      128
#define XB_XCNT(j)  (256  + 64 * (j))
#define XB_XSUB(j)  (1280 + 64 * (j))
#define XB_XGEN(j)  (2304 + 64 * (j))
#define XB_TOP      3328
#define XB_TOPGEN   3392
#define XCD_BAR_WORDS 3456
#define XB_SPIN_CAP (1u << 18)

__device__ __forceinline__ unsigned xb_ld(unsigned* p)              { return __hip_atomic_load(p, __ATOMIC_RELAXED, __HIP_MEMORY_SCOPE_AGENT); }
__device__ __forceinline__ unsigned xb_add(unsigned* p, unsigned v) { return __hip_atomic_fetch_add(p, v, __ATOMIC_RELAXED, __HIP_MEMORY_SCOPE_AGENT); }
__device__ __forceinline__ unsigned xb_xcc_id() { return (unsigned)__builtin_amdgcn_s_getreg((3 << 11) | 20) & 0xFu; }
#define XB_SPIN(cond, bar) do { unsigned _sp = 0; while (cond) { __builtin_amdgcn_s_sleep(1); \
    if ((++_sp & 255u) == 0u) { if (xb_ld(&(bar)[XB_TMO])) break; if (_sp > XB_SPIN_CAP) { atomicAdd(&(bar)[XB_TMO], 1u); break; } } } } while (0)

struct XcdBarrier {
    unsigned* bar; unsigned x;
    volatile LAS unsigned* st;
};

__device__ __forceinline__ XcdBarrier xcd_barrier_post(unsigned* bar, volatile LAS unsigned* st, const int wave_in) {
    XcdBarrier b; b.bar = bar; b.x = xb_xcc_id(); b.st = st;
    if (wave_in == 0 && mk_lane() == 0) (void)xb_add(&bar[XB_XCNT(b.x)], 1u);
    return b;
}
__device__ __forceinline__ void xcd_barrier_complete(unsigned* bar, unsigned x, unsigned& nloc, unsigned& nx) {
    const unsigned G = gridDim.x * gridDim.y * gridDim.z;
    unsigned sum, cnt, mine, sp = 0u;
    for (;;) {
        sum = 0u; cnt = 0u; mine = 0u;
#pragma unroll
        for (unsigned j = 0; j < 16; ++j) { const unsigned c = xb_ld(&bar[XB_XCNT(j)]); sum += c; cnt += (c > 0u) ? 1u : 0u; mine = (j == x) ? c : mine; }
        if (sum == G) break;
        __builtin_amdgcn_s_sleep(1);
        if ((++sp & 255u) == 0u) { if (xb_ld(&bar[XB_TMO])) break; if (sp > XB_SPIN_CAP) { atomicAdd(&bar[XB_TMO], 1u); break; } }
    }
    nloc = mine > 0u ? mine : 1u; nx = cnt > 0u ? cnt : 1u;
}

__device__ __forceinline__ void xcd_barrier(const XcdBarrier& b, const int wave_in) {
    asm volatile("s_waitcnt vmcnt(0)" ::: "memory");
    __syncthreads();
    if (wave_in == 0 && mk_lane() == 0) {
        unsigned* bar = b.bar;
        __builtin_amdgcn_s_waitcnt(0);
        unsigned nloc = b.st[0], nx = b.st[1];
        if (nloc == 0u) { xcd_barrier_complete(bar, b.x, nloc, nx); b.st[0] = nloc; b.st[1] = nx; }
        const unsigned old = xb_add(&bar[XB_XSUB(b.x)], 1u);
        const unsigned gen = old / nloc;
        if (old + 1u == (gen + 1u) * nloc) {
            __builtin_amdgcn_fence(__ATOMIC_RELEASE, "agent");
            asm volatile("s_waitcnt vmcnt(0)" ::: "memory");
            const unsigned og = xb_add(&bar[XB_TOP], 1u);
            const unsigned tg = og / nx;
            if (og + 1u == (tg + 1u) * nx) xb_add(&bar[XB_TOPGEN], 1u);
            else XB_SPIN(xb_ld(&bar[XB_TOPGEN]) == tg, bar);
            __builtin_amdgcn_fence(__ATOMIC_ACQUIRE, "agent");
            xb_add(&bar[XB_XGEN(b.x)], 1u);
            asm volatile("s_waitcnt vmcnt(0)" ::: "memory");
        } else {
            XB_SPIN(xb_ld(&bar[XB_XGEN(b.x)]) == gen, bar);
            __builtin_amdgcn_fence(__ATOMIC_ACQUIRE, "agent");
            asm volatile("s_waitcnt vmcnt(0)" ::: "memory");
        }
    }
    __syncthreads();
}
struct Args { const float* in[11]; float* out; unsigned char* ws; int ph_lo, ph_hi; };
constexpr int NPHASE = 7;

__global__ void __launch_bounds__(NWAVES * 64, 2) mk_fwd(Args args) {
    extern __shared__ __attribute__((aligned(16))) unsigned char lds[];
    LAS unsigned char* ldsl = (LAS unsigned char*)lds;
    const int wave = __builtin_amdgcn_readfirstlane((int)threadIdx.x >> 6);
    const int G = gridDim.x, bx = blockIdx.x;
    const int vcu = (G % 8 == 0) ? (bx % 8) * (G / 8) + bx / 8 : bx;
    const int gw = vcu * NWAVES + wave, NGW = G * NWAVES;
    unsigned char* ws = args.ws;
    const float* x = args.in[0]; const float* g_attn = args.in[1]; const float* w_in = args.in[2]; const float* lambda_qk = args.in[3]; const float* subln = args.in[4];
    const float* w_out = args.in[5]; const float* g_ffn = args.in[6]; const float* w_gate = args.in[7]; const float* w_up = args.in[8]; const float* w_down = args.in[9];
    const float* g_final = args.in[10];
    float* out = args.out;
    float* SS1 = (float*)(ws + WS_SS1); float* SS2 = (float*)(ws + WS_SS2); float* LSE = (float*)(ws + WS_LSE);
    bf16* QKV = (bf16*)(ws + WS_QKV); bf16* WGU = (bf16*)(ws + WS_WGU); bf16* WDN = (bf16*)(ws + WS_WDN); bf16* HB = (bf16*)(ws + WS_H);
    bf16* WIN = (bf16*)(ws + WS_WIN); bf16* XN = (bf16*)(ws + WS_XN); bf16* OA = (bf16*)(ws + WS_OA); bf16* WOUT = (bf16*)(ws + WS_WOUT);
    bf16* OB = (bf16*)(ws + WS_OB); bf16* XG = (bf16*)(ws + WS_XG); bf16* Y = (bf16*)(ws + WS_Y);
    const int lo = args.ph_lo, hi_ph = args.ph_hi;
#define IN(k) (lo <= (k) && (k) < hi_ph)
    if (wave == 0) { const int l0 = mk_lane(); if (l0 < 32) ((LAS unsigned*)(ldsl + MISC_OFF))[l0] = 0u; }
    __syncthreads();
    XcdBarrier bar; bar.bar = (unsigned*)(ws + WS_BAR); bar.x = 0; bar.st = nullptr;
    if (hi_ph - lo > 1) bar = xcd_barrier_post((unsigned*)(ws + WS_BAR), (volatile LAS unsigned*)(ldsl + MISC_OFF), wave);
    if (lo < -1000) cg::this_grid().sync();
#define SEAM(k) do { if (IN(k) && IN((k) + 1)) { for (int rb = 0; rb < (MK_DUP_PHASE == 30 ? 3 : 1); ++rb) xcd_barrier(bar, wave); } } while (0)

    if (IN(0)) for (int rep = 0; rep < NREP(0); ++rep) { const int lane = mk_lane(), tid = wave * 64 + lane;
        LAS float* scr = (LAS float*)(ldsl + wave * 16384);
        constexpr int I_IN = (DM / 64) * (NIN / 32), I_OUT = (DM / 64) * (DM / 32);
        for (int it = gw; it < I_IN; it += NGW) {
            if (it < I_IN) { const int nblk = NIN / 32, kb = it / nblk, nb = it % nblk; transpose_item(w_in, DM, NIN, WIN, 64 * kb, 32 * nb, 32 * nb, scr, lane); }
            else { const int r = it - I_IN; const int nblk = DM / 32, kb = r / nblk, nb = r % nblk; transpose_item(w_out, DM, DM, WOUT, 64 * kb, 32 * nb, 32 * nb, scr, lane); }
        }
        for (int m = gw; m < M; m += NGW) {
            const GAS f32x4* xr = (const GAS f32x4*)(x + (size_t)m * DM) + lane;
            f32x4 v[8]; float s = 0.f;
#pragma unroll
            for (int j = 0; j < 8; ++j) { v[j] = xr[64 * j]; s += (v[j].x * v[j].x + v[j].y * v[j].y) + (v[j].z * v[j].z + v[j].w * v[j].w); }
            const float rstd = 1.0f / sqrtf(wave_sum(s) * (1.f / DM) + RMS_EPS);
            GAS unsigned long long* o8 = (GAS unsigned long long*)(XN + (size_t)m * DM) + lane;
#pragma unroll
            for (int j = 0; j < 8; ++j) { const f32x4 gg = *((const GAS f32x4*)g_attn + lane + 64 * j);
                o8[64 * j] = (unsigned long long)pk2(v[j].x * rstd * gg.x, v[j].y * rstd * gg.y) | ((unsigned long long)pk2(v[j].z * rstd * gg.z, v[j].w * rstd * gg.w) << 32); }
        }
        for (int i = bx * (NWAVES * 64) + tid; i < M; i += G * NWAVES * 64) { SS1[i] = 0.f; SS2[i] = 0.f; }
    }
    SEAM(0);
    if (IN(1)) {
        pg8::Gemm g{XN, WIN, M, NIN, DM}; pg8::StaticOrder S; S.init(M, NIN, G, bx); S.dup = NREP(1);
        pg8::EpiQKV E{QKV, NIN};
        pg8::gemm_phase<pg8::EpiQKV, pg8::StaticOrder, true, true>(ldsl, g, S, E, wave);
    }
    SEAM(1);
    if (IN(2)) { const int lane = mk_lane();
        att::ConvJob cj{w_gate, w_up, w_down, w_out, g_ffn, WGU, WDN, WOUT, vcu, vcu + G * ((att::CV_TOTAL - 1 - vcu) / G), G};
        for (int uu = vcu; uu < BATCH * NHEAD * 2 * (SEQ / 256) * NREP(20); uu += G) { const int u = uu & 511;
            const int qb = u & 7, c = u >> 8, h = (u >> 3) & 7, b = (u >> 6) & 3;
            const att::bf16* rowb = (const att::bf16*)QKV + (size_t)b * SEQ * NIN;
            att::attn_dense_body(rowb + (size_t)qb * 256 * NIN + 3072 + h * HD, rowb + 4096 + h * HD, rowb + 5120 + h * HD,
                                 OB + (size_t)c * M * 1024 + ((size_t)b * SEQ + qb * 256) * 1024 + h * HD, 1024, 4 * c, SEQ, (char*)lds, wave, cj);
        }
        __syncthreads();
        {
            char* lds_w = (char*)lds + wave * 16384; float* scr = (float*)((char*)lds + RING_BYTES) + wave * 64;
            LAS float* tscr = (LAS float*)(ldsl + wave * 16384);
            constexpr int I_G = (DM / 64) * (DFF / 32), I_D = (DFF / 64) * (DM / 32);
#define CONV_ITEMS() do { for (int it = gw; it < 2 * I_G + I_D; it += NGW) { \
                if (it < 2 * I_G) { const int up = it >= I_G; const int r = it - up * I_G; const int nblk = DFF / 32, kb = r / nblk, nb = r % nblk, n0 = 32 * nb; \
                    transpose_item(up ? w_up : w_gate, DM, DFF, WGU, 64 * kb, n0, 256 * (n0 >> 7) + 128 * up + (n0 & 127), tscr, lane, g_ffn); } \
                else { const int r = it - 2 * I_G; const int nblk = DM / 32, kb = r / nblk, nb = r % nblk; transpose_item(w_down, DFF, DM, WDN, 64 * kb, 32 * nb, 32 * nb, tscr, lane); } } } while (0)
            for (int uu = vcu; uu < 768 * NREP(21); uu += G) { const int u = uu % 768;
                const int gbr = u >> 8, uidx = u & 255;
                att::swa_wg_unit((const att::bf16*)QKV, gbr, uidx, OA + (size_t)gbr * M * 1024, LSE + (size_t)gbr * M * 8, (char*)lds, scr, wave);
            }
#undef CONV_ITEMS
        }
        __syncthreads();
    }
    SEAM(2);
    if (IN(3)) for (int rep = 0; rep < NREP(3); ++rep) { const int lane = mk_lane();
        float lam;
        { const float a = lambda_qk[lane] * lambda_qk[64 + lane], b2 = lambda_qk[128 + lane] * lambda_qk[192 + lane];
          lam = __expf(wave_sum(a)) - __expf(wave_sum(b2)) + LAM_INIT; }
        for (int m = gw; m < M; m += NGW) {
#pragma unroll
            for (int j = 0; j < 2; ++j) {
                const int ch = j * 64 + lane, col = ch * 8, h = ch >> 4;
                const float l0 = LSE[(size_t)m * 8 + h], l1 = LSE[(size_t)(M + m) * 8 + h], l2 = LSE[(size_t)(2 * M + m) * 8 + h];
                const float mx = fmaxf(l0, fmaxf(l1, l2)); float w0 = __expf(l0 - mx), w1 = __expf(l1 - mx), w2 = __expf(l2 - mx);
                const float inv = 1.0f / (w0 + w1 + w2); w0 *= inv; w1 *= inv; w2 *= inv;
                const v4u a0 = *(const GAS v4u*)(OA + (size_t)m * 1024 + col), a1 = *(const GAS v4u*)(OA + ((size_t)M + m) * 1024 + col), a2 = *(const GAS v4u*)(OA + ((size_t)2 * M + m) * 1024 + col);
                v4u ya;
#pragma unroll
                for (int i = 0; i < 4; ++i) ya[i] = pk2(w0 * bflo(a0[i]) + w1 * bflo(a1[i]) + w2 * bflo(a2[i]), w0 * bfhi(a0[i]) + w1 * bfhi(a1[i]) + w2 * bfhi(a2[i]));
                *(GAS v4u*)(Y + (size_t)m * DM + col) = ya;
                const v4u b0 = *(const GAS v4u*)(OB + (size_t)m * 1024 + col), b1 = *(const GAS v4u*)(OB + ((size_t)M + m) * 1024 + col);
                float d[8]; float ssq = 0.f;
#pragma unroll
                for (int i = 0; i < 4; ++i) { d[2 * i] = bflo(b0[i]) - lam * bflo(b1[i]); d[2 * i + 1] = bfhi(b0[i]) - lam * bfhi(b1[i]); ssq += d[2 * i] * d[2 * i] + d[2 * i + 1] * d[2 * i + 1]; }
                ssq += __shfl_xor(ssq, 1); ssq += __shfl_xor(ssq, 2); ssq += __shfl_xor(ssq, 4); ssq += __shfl_xor(ssq, 8);
                const float rs = (1.0f - LAM_INIT) / sqrtf(ssq * (1.f / HD) + SUBLN_EPS);
                const f32x4 s0 = *(const GAS f32x4*)(subln + (col & 127)), s1 = *(const GAS f32x4*)(subln + (col & 127) + 4);
                v4u yb; yb.x = pk2(d[0] * rs * s0.x, d[1] * rs * s0.y); yb.y = pk2(d[2] * rs * s0.z, d[3] * rs * s0.w); yb.z = pk2(d[4] * rs * s1.x, d[5] * rs * s1.y); yb.w = pk2(d[6] * rs * s1.z, d[7] * rs * s1.w);
                *(GAS v4u*)(Y + (size_t)m * DM + 1024 + col) = yb;
            }
        }
    }
    SEAM(3);
    if (IN(4)) {
        pg8::Gemm g{Y, WOUT, M, DM, DM}; pg8::StaticOrder S; S.init(M, DM, G, bx); S.dup = NREP(4);
        pg8::EpiOut E{x, XG, g_ffn, SS1, DM};
        pg8::gemm_phase<pg8::EpiOut, pg8::StaticOrder, true, true>(ldsl, g, S, E, wave);
    }
    SEAM(4);
    if (IN(5)) {
        pg8::Gemm g{XG, WGU, M, NGU, DM}; pg8::StaticOrder S; S.init(M, NGU, G, bx); S.dup = NREP(5);
        S.split_from = -1  ; S.kh_bytes = (DM / 2) * 2; S.kh_nt = DM / 128;
        pg8::EpiGateUp E{HB, DFF, SS1, 1.0f / DM, RMS_EPS, (pg8::f32x4*)(ws + WS_Y), (unsigned*)(ws + WS_FLAG)};
        pg8::gemm_phase<pg8::EpiGateUp, pg8::StaticOrder, true, true>(ldsl, g, S, E, wave);
    }
    SEAM(5);
    if (IN(6)) {
        pg8::Gemm g{HB, WDN, M, DM, DFF}; pg8::StaticOrder S; S.init(M, DM, G, bx);
        pg8::EpiDownNorm E{XG, g_ffn, out, g_final, SS2, (unsigned*)(ws + WS_CNT), DM, 1.0f / DM, RMS_EPS};
        pg8::gemm_phase<pg8::EpiDownNorm, pg8::StaticOrder, false, true>(ldsl, g, S, E, wave);
    }
#undef IN
#undef SEAM
}

extern "C" void kernel_launch(void* const* d_in, const int* in_sizes, int n_in, void* d_out, int out_size, void* d_ws, size_t ws_size, hipStream_t stream) {
    static int grid = 0;
    if (grid == 0) {
        if (n_in != 11 || in_sizes[0] != M * DM || out_size != M * DM || ws_size < WS_END) { fprintf(stderr, "kernel_launch: shape/workspace mismatch (n_in %d, in0 %d, out %d, ws %zu)\n", n_in, n_in > 0 ? in_sizes[0] : -1, out_size, ws_size); grid = -1; return; }
        int dev = 0, cus = 0, per_cu = 0;
        if (hipGetDevice(&dev) != hipSuccess || hipDeviceGetAttribute(&cus, hipDeviceAttributeMultiprocessorCount, dev) != hipSuccess) { grid = -1; return; }
        if (hipFuncSetAttribute((const void*)mk_fwd, hipFuncAttributeMaxDynamicSharedMemorySize, LDS_BYTES) != hipSuccess) { fprintf(stderr, "kernel_launch: hipFuncSetAttribute failed\n"); grid = -1; return; }
        if (hipOccupancyMaxActiveBlocksPerMultiprocessor(&per_cu, (const void*)mk_fwd, NWAVES * 64, LDS_BYTES) != hipSuccess || per_cu < 1) { fprintf(stderr, "kernel_launch: occupancy query says %d\n", per_cu); per_cu = 1; }
        (void)hipGetLastError();
        grid = cus;
        if (grid != 256) { fprintf(stderr, "kernel_launch: this kernel needs a 256-CU device (got %d)\n", cus); grid = -1; return; }
    }
    if (grid < 0) return;
    Args a{};
    for (int i = 0; i < 11; ++i) a.in[i] = (const float*)d_in[i];
    a.out = (float*)d_out; a.ws = (unsigned char*)d_ws;
#if MK_ONE_LAUNCH
    if (hipMemsetAsync((char*)d_ws + WS_BAR, 0, BAR_BYTES, stream) != hipSuccess) { fprintf(stderr, "kernel_launch: memset failed\n"); return; }
    a.ph_lo = 0; a.ph_hi = NPHASE;
    void* kargs[] = {&a};
    hipError_t e = hipLaunchCooperativeKernel((const void*)mk_fwd, dim3(grid), dim3(NWAVES * 64), kargs, LDS_BYTES, stream);
    if (e != hipSuccess) fprintf(stderr, "kernel_launch: cooperative launch failed: %s (grid %d)\n", hipGetErrorString(e), grid);
#else
    for (int p = 0; p < NPHASE; ++p) {
        a.ph_lo = p; a.ph_hi = p + 1;
        hipLaunchKernelGGL(mk_fwd, dim3(grid), dim3(NWAVES * 64), LDS_BYTES, stream, a);
    }
#endif
}
```

```cpp
#include <hip/hip_runtime.h>
#include <hip/hip_cooperative_groups.h>
#include <hip/hip_bf16.h>
#include <cstdio>
#include <cstdint>
#include <cmath>
namespace cg = cooperative_groups;
__device__ __forceinline__ int mk_lane() { int l; asm volatile("v_mbcnt_lo_u32_b32 %0, -1, 0\n\tv_mbcnt_hi_u32_b32 %0, -1, %0" : "=v"(l)); return l & 63; }
namespace pg8 {
#define PG8_LAS __attribute__((address_space(3)))
typedef unsigned short bf16_t;
typedef short bf16x8 __attribute__((ext_vector_type(8)));
typedef float f32x4 __attribute__((ext_vector_type(4)));
typedef unsigned u32x4 __attribute__((ext_vector_type(4)));
constexpr int BM = 256, BK = 64, HALF = 128, HTB = HALF * BK * 2  , STAGE_BYTES = 8 * HTB, NXCD = 8, WGM = 8;

__host__ __device__ __forceinline__ int lds_byte(int r, int c) { const int st = (r >> 4) * 2 + (c >> 5), rr = r & 15, cc = c & 31, ob = rr * 64 + cc * 2; return st * 1024 + (ob ^ (((ob >> 9) & 1) << 5)); }
__host__ __device__ __forceinline__ void stage_rc(int b, int& R, int& C) { const int st = b / 1024, sb = b % 1024, swz = sb ^ (((sb >> 9) & 1) << 5); R = (st >> 1) * 16 + swz / 64; C = (st & 1) * 32 + (swz % 64) / 2; }
__host__ __device__ __forceinline__ int perm32(int rho) { const int n = rho >> 4, i = rho & 15; return 8 * (i >> 2) + 4 * n + (i & 3); }

struct Unit { int pm, pn, first, khalf, koff, nt, ul; };
struct Gemm { const bf16_t* A; const bf16_t* Bt; int M, N, K; };

struct StaticOrder {
    int nM, nN, nwg, G, c, dup, split_from, kh_bytes, kh_nt;
    __host__ __device__ void init(int M, int N, int G_, int c_) { nM = M / BM; nN = N / BM; nwg = nM * nN; G = G_; c = c_; dup = 1; split_from = -1; kh_bytes = 0; kh_nt = 0; }
    __host__ __device__ bool next(int i, Unit& u) const {
        long L = (long)(i / dup) * G + c; u.khalf = 0; u.koff = 0; u.nt = 0; u.ul = 0;
        if (split_from >= 0 && (long)(i / dup) * G >= split_from) {
            if ((long)(i / dup) * G > split_from) return false;
            u.ul = c >> 1; L = split_from + u.ul; u.khalf = 1 + (c & 1); u.koff = (c & 1) ? kh_bytes : 0; u.nt = kh_nt; }
        if (L >= nwg) return false;
        int wgid = (int)L; { const int q = nwg / NXCD, r = nwg % NXCD, xcd = wgid % NXCD, off = wgid / NXCD; wgid = (xcd < r ? xcd * (q + 1) : r * (q + 1) + (xcd - r) * q) + off; }
        const int nig = WGM * nN, gid = wgid / nig, fm = gid * WGM, gsz = (nM - fm) < WGM ? (nM - fm) : WGM;
        u.pm = fm + ((wgid % nig) % gsz); u.pn = (wgid % nig) / gsz; u.first = (i % dup) == 0; return true;
    }
    __device__ __forceinline__ void a_ready(const Unit&) const {}
    __device__ __forceinline__ void done(const Unit&) const {}
};

__device__ __forceinline__ unsigned cvt_pk_bf16(float lo, float hi) { unsigned r; asm volatile("v_cvt_pk_bf16_f32 %0, %1, %2" : "=v"(r) : "v"(lo), "v"(hi)); return r; }
typedef float f32x2 __attribute__((ext_vector_type(2)));
__device__ __forceinline__ float invf_a(int f) {
    constexpr float T[16] = {1.0f, 0.4403666f, 0.19392274f, 0.0853971f, 0.03760603f, 0.01656044f, 0.0072926646f, 0.003211446f,
                             0.0014142136f, 0.00062277244f, 0.0002742482f, 0.000120769735f, 5.3182957e-05f, 2.342e-05f, 1.0313385e-05f, 4.5416705e-06f};
    return T[f];
}
__device__ __forceinline__ void sincos_rev(float ang, float& s, float& c) {
    const float rev = ang * 0.15915494309189535f; const float fr = rev - __builtin_floorf(rev);
    s = __builtin_amdgcn_sinf(fr); c = __builtin_amdgcn_cosf(fr);
}
struct EpiQKV {
    static constexpr bool PERM = true, AFTER_DRAIN = false;
    bf16_t* O; int ldc;
    __device__ __forceinline__ void operator()(const f32x4 (&acc)[2][2][4][2], const Unit& u, int wr, int wc, int fr, int fq) const {
        const int row0 = u.pm * BM + wr * 64 + fr;
        const int sec = u.pn >> 2;
        const int col0 = u.pn * BM + wc * 32 + 8 * fq;
        const bool ropeA = (sec <= 1) && (wc == 0);
        const bool ropeB = (sec == 3 || sec == 4) && ((wc & 1) == 0);
#pragma unroll
        for (int ai = 0; ai < 2; ++ai)
#pragma unroll
            for (int m = 0; m < 4; ++m) {
                const int row = row0 + ai * HALF + m * 16;
                const float pos = (float)(row & 2047);
                bf16_t* rowp = O + (size_t)row * ldc + col0;
                float cs[8], sn[8];
                if (ropeA) {
                    const int fb = 8 * (fq & 1);
#pragma unroll
                    for (int i = 0; i < 8; ++i) { float f0 = invf_a(i), f1 = invf_a(8 + i); sincos_rev(pos * (fb ? f1 : f0), sn[i], cs[i]); }
                    const float sg = (fq >= 2) ? 1.f : -1.f;
#pragma unroll
                    for (int i = 0; i < 8; ++i) sn[i] *= sg;
                } else if (ropeB) {
#pragma unroll
                    for (int i = 0; i < 8; ++i) sincos_rev(pos * invf_a(2 * i), sn[i], cs[i]);
                    const float sg = (fq == 1) ? 1.f : -1.f;
#pragma unroll
                    for (int i = 0; i < 8; ++i) sn[i] *= sg;
                }
#pragma unroll
                for (int bj = 0; bj < 2; ++bj) {
                    f32x4 v0 = acc[ai][bj][m][0], v1 = acc[ai][bj][m][1];
                    if (ropeA) {
                        f32x4 p0, p1;
#pragma unroll
                        for (int i = 0; i < 4; ++i) { p0[i] = __shfl_xor(v0[i], 32); p1[i] = __shfl_xor(v1[i], 32); }
#pragma unroll
                        for (int i = 0; i < 4; ++i) { v0[i] = v0[i] * cs[i] + p0[i] * sn[i]; v1[i] = v1[i] * cs[4 + i] + p1[i] * sn[4 + i]; }
                    } else if (ropeB) {
                        f32x4 p0, p1;
#pragma unroll
                        for (int i = 0; i < 4; ++i) { p0[i] = __shfl_xor(v0[i], 16); p1[i] = __shfl_xor(v1[i], 16); }
                        if (fq < 2) {
#pragma unroll
                            for (int i = 0; i < 4; ++i) { v0[i] = v0[i] * cs[i] + p0[i] * sn[i]; v1[i] = v1[i] * cs[4 + i] + p1[i] * sn[4 + i]; }
                        }
                    }
                    u32x4 w; w.x = cvt_pk_bf16(v0[0], v0[1]); w.y = cvt_pk_bf16(v0[2], v0[3]); w.z = cvt_pk_bf16(v1[0], v1[1]); w.w = cvt_pk_bf16(v1[2], v1[3]);
                    *(u32x4*)(rowp + bj * HALF) = w;
                }
            }
    }
};
struct EpiOut {
    static constexpr bool PERM = false, AFTER_DRAIN = false;
    const float* base; bf16_t* xg; const float* g; float* ss; int ldc;
    __device__ __forceinline__ void operator()(const f32x4 (&acc)[2][2][4][2], const Unit& u, int wr, int wc, int fr, int fq) const {
        typedef unsigned u32x2v __attribute__((ext_vector_type(2)));
        const int col0 = u.pn * BM + wc * 32 + 4 * fq;
        f32x4 gv[2][2];
#pragma unroll
        for (int bj = 0; bj < 2; ++bj)
#pragma unroll
            for (int n = 0; n < 2; ++n) gv[bj][n] = *(const f32x4*)(g + col0 + bj * HALF + n * 16);
#pragma unroll
        for (int ai = 0; ai < 2; ++ai)
#pragma unroll
            for (int m = 0; m < 4; ++m) {
                const int row = u.pm * BM + ai * HALF + wr * 64 + m * 16 + fr; const size_t off = (size_t)row * ldc + col0; float s = 0.f;
#pragma unroll
                for (int bj = 0; bj < 2; ++bj)
#pragma unroll
                    for (int n = 0; n < 2; ++n) {
                        const f32x4 x1 = *(const f32x4*)(base + off + bj * HALF + n * 16) + acc[ai][bj][m][n];
                        s += (x1[0] * x1[0] + x1[1] * x1[1]) + (x1[2] * x1[2] + x1[3] * x1[3]);
                        const f32x4 y = x1 * gv[bj][n]; u32x2v w; w.x = cvt_pk_bf16(y[0], y[1]); w.y = cvt_pk_bf16(y[2], y[3]);
                        *(u32x2v*)(xg + off + bj * HALF + n * 16) = w;
                    }
                s += __shfl_xor(s, 16); s += __shfl_xor(s, 32);
                if (fq == 0 && u.first) atomicAdd(ss + row, s);
            }
    }
};
struct EpiGateUp {
    static constexpr bool PERM = true, AFTER_DRAIN = false;
    bf16_t* H; int ldh; const float* ss; float inv_n, eps; f32x4* part; unsigned* flag;
    __device__ __forceinline__ void operator()(const f32x4 (&acc)[2][2][4][2], const Unit& u, int wr, int wc, int fr, int fq) const {
        const int tid = (wr * 4 + wc) * 64 + fq * 16 + fr;
        f32x4* pp = part + (size_t)u.ul * (32 * 512) + tid;
        if (u.khalf == 1) {
#pragma unroll
            for (int ai = 0; ai < 2; ++ai)
#pragma unroll
                for (int bj = 0; bj < 2; ++bj)
#pragma unroll
                    for (int m = 0; m < 4; ++m)
#pragma unroll
                        for (int n = 0; n < 2; ++n) pp[(size_t)(((ai * 2 + bj) * 4 + m) * 2 + n) * 512] = acc[ai][bj][m][n];
            asm volatile("s_waitcnt vmcnt(0)" ::: "memory"); __builtin_amdgcn_s_barrier(); asm volatile("" ::: "memory");
            if (tid == 0) { __builtin_amdgcn_fence(__ATOMIC_RELEASE, "agent"); asm volatile("s_waitcnt vmcnt(0)" ::: "memory");
                __hip_atomic_store(flag + 16 * u.ul, 1u, __ATOMIC_RELAXED, __HIP_MEMORY_SCOPE_AGENT); }
            return;
        }
        if (u.khalf == 2) {
            if (tid < 64) { unsigned sp = 0;
                while ((unsigned)__builtin_amdgcn_readfirstlane(__hip_atomic_load(flag + 16 * u.ul, __ATOMIC_RELAXED, __HIP_MEMORY_SCOPE_AGENT)) == 0u) { __builtin_amdgcn_s_sleep(2); if (++sp > (1u << 22)) break; }
                __builtin_amdgcn_fence(__ATOMIC_ACQUIRE, "agent"); asm volatile("s_waitcnt vmcnt(0)" ::: "memory"); }
            asm volatile("s_waitcnt vmcnt(0) lgkmcnt(0)" ::: "memory"); __builtin_amdgcn_s_barrier(); asm volatile("" ::: "memory");
        }
        const int col0 = u.pn * HALF + wc * 32 + 8 * fq;
#pragma unroll
        for (int ai = 0; ai < 2; ++ai)
#pragma unroll
            for (int m = 0; m < 4; ++m) {
                const int row = u.pm * BM + ai * HALF + wr * 64 + m * 16 + fr;
                const float rstd = 1.0f / sqrtf(ss[row] * inv_n + eps);
                f32x4 gq[2], uq[2];
#pragma unroll
                for (int n = 0; n < 2; ++n) { gq[n] = acc[ai][0][m][n]; uq[n] = acc[ai][1][m][n]; }
                if (u.khalf == 2) {
#pragma unroll
                    for (int n = 0; n < 2; ++n) { gq[n] += pp[(size_t)(((ai * 2 + 0) * 4 + m) * 2 + n) * 512]; uq[n] += pp[(size_t)(((ai * 2 + 1) * 4 + m) * 2 + n) * 512]; }
                }
                float hv[8];
#pragma unroll
                for (int n = 0; n < 2; ++n)
#pragma unroll
                    for (int i = 0; i < 4; ++i) { const float gg = gq[n][i] * rstd, uu = uq[n][i] * rstd;
                        hv[4 * n + i] = gg * __builtin_amdgcn_rcpf(1.0f + __builtin_amdgcn_exp2f(-1.4426950408889634f * gg)) * uu; }
                u32x4 w; w.x = cvt_pk_bf16(hv[0], hv[1]); w.y = cvt_pk_bf16(hv[2], hv[3]); w.z = cvt_pk_bf16(hv[4], hv[5]); w.w = cvt_pk_bf16(hv[6], hv[7]);
                *(u32x4*)(H + (size_t)row * ldh + col0) = w;
            }
    }
};
struct EpiDown {
    static constexpr bool PERM = false, AFTER_DRAIN = false;
    const bf16_t* base; float* out; float* ss; int ldc;
    __device__ __forceinline__ void operator()(const f32x4 (&acc)[2][2][4][2], const Unit& u, int wr, int wc, int fr, int fq) const {
        typedef unsigned u32x2v __attribute__((ext_vector_type(2)));
        const int col0 = u.pn * BM + wc * 32 + 4 * fq;
#pragma unroll
        for (int ai = 0; ai < 2; ++ai)
#pragma unroll
            for (int m = 0; m < 4; ++m) {
                const int row = u.pm * BM + ai * HALF + wr * 64 + m * 16 + fr; const size_t off = (size_t)row * ldc + col0; float s = 0.f;
#pragma unroll
                for (int bj = 0; bj < 2; ++bj)
#pragma unroll
                    for (int n = 0; n < 2; ++n) {
                        const u32x2v rb = *(const u32x2v*)(base + off + bj * HALF + n * 16);
                        f32x4 x2 = acc[ai][bj][m][n];
                        x2[0] += __uint_as_float(rb.x << 16); x2[1] += __uint_as_float(rb.x & 0xffff0000u); x2[2] += __uint_as_float(rb.y << 16); x2[3] += __uint_as_float(rb.y & 0xffff0000u);
                        *(f32x4*)(out + off + bj * HALF + n * 16) = x2;
                        s += (x2[0] * x2[0] + x2[1] * x2[1]) + (x2[2] * x2[2] + x2[3] * x2[3]);
                    }
                s += __shfl_xor(s, 16); s += __shfl_xor(s, 32);
                if (fq == 0 && u.first) atomicAdd(ss + row, s);
            }
    }
};
struct EpiDownNorm {
    static constexpr bool PERM = false, AFTER_DRAIN = true;
    const bf16_t* base; const float* gres; float* out; const float* g; float* ss; unsigned* cnt; int ldc; float inv_n, eps;
    __device__ __forceinline__ void fused(f32x4 (&acc)[2][2][4][2], const Unit& u, int wr, int wc, int fr, int fq, PG8_LAS unsigned char* lds, int wid, int lane) const {
        typedef unsigned u32x2v __attribute__((ext_vector_type(2)));
        const int col0 = u.pn * BM + wc * 32 + 4 * fq;
        f32x4 rg[2][2];
#pragma unroll
        for (int bj = 0; bj < 2; ++bj)
#pragma unroll
            for (int n = 0; n < 2; ++n) { const f32x4 t = *(const f32x4*)(gres + col0 + bj * HALF + n * 16); rg[bj][n] = (f32x4){1.0f / t[0], 1.0f / t[1], 1.0f / t[2], 1.0f / t[3]}; }
#pragma unroll
        for (int ai = 0; ai < 2; ++ai)
#pragma unroll
            for (int m = 0; m < 4; ++m) {
                const int row = u.pm * BM + ai * HALF + wr * 64 + m * 16 + fr; const size_t off = (size_t)row * ldc + col0; float s = 0.f;
#pragma unroll
                for (int bj = 0; bj < 2; ++bj)
#pragma unroll
                    for (int n = 0; n < 2; ++n) {
                        const u32x2v rb = *(const u32x2v*)(base + off + bj * HALF + n * 16);
                        f32x4 x2 = acc[ai][bj][m][n];
                        x2[0] += __uint_as_float(rb.x << 16) * rg[bj][n][0]; x2[1] += __uint_as_float(rb.x & 0xffff0000u) * rg[bj][n][1]; x2[2] += __uint_as_float(rb.y << 16) * rg[bj][n][2]; x2[3] += __uint_as_float(rb.y & 0xffff0000u) * rg[bj][n][3];
                        acc[ai][bj][m][n] = x2;
                        s += (x2[0] * x2[0] + x2[1] * x2[1]) + (x2[2] * x2[2] + x2[3] * x2[3]);
                    }
                s += __shfl_xor(s, 16); s += __shfl_xor(s, 32);
                if (fq == 0) atomicAdd(ss + row, s);
            }
        asm volatile("s_waitcnt vmcnt(0)" ::: "memory");
        __builtin_amdgcn_s_barrier(); asm volatile("" ::: "memory");
        if (wid == 0) {
            unsigned* c = cnt + 64 * u.pm;
            if (lane == 0) __hip_atomic_fetch_add(c, 1u, __ATOMIC_RELAXED, __HIP_MEMORY_SCOPE_AGENT);
            unsigned sp = 0;
            while ((unsigned)__builtin_amdgcn_readfirstlane(__hip_atomic_load(c, __ATOMIC_RELAXED, __HIP_MEMORY_SCOPE_AGENT)) < 8u) { __builtin_amdgcn_s_sleep(2); if (++sp > (1u << 22)) break; }
            __builtin_amdgcn_fence(__ATOMIC_ACQUIRE, "agent");
        }
        asm volatile("s_waitcnt vmcnt(0) lgkmcnt(0)" ::: "memory"); __builtin_amdgcn_s_barrier(); asm volatile("" ::: "memory");
        f32x4 gv[2][2];
#pragma unroll
        for (int bj = 0; bj < 2; ++bj)
#pragma unroll
            for (int n = 0; n < 2; ++n) gv[bj][n] = *(const f32x4*)(g + col0 + bj * HALF + n * 16);
#pragma unroll
        for (int ai = 0; ai < 2; ++ai)
#pragma unroll
            for (int m = 0; m < 4; ++m) {
                const int row = u.pm * BM + ai * HALF + wr * 64 + m * 16 + fr; const size_t off = (size_t)row * ldc + col0;
                const float rstd = 1.0f / sqrtf(__hip_atomic_load(ss + row, __ATOMIC_RELAXED, __HIP_MEMORY_SCOPE_AGENT) * inv_n + eps);
#pragma unroll
                for (int bj = 0; bj < 2; ++bj)
#pragma unroll
                    for (int n = 0; n < 2; ++n) *(f32x4*)(out + off + bj * HALF + n * 16) = acc[ai][bj][m][n] * rstd * gv[bj][n];
            }
    }
};
template <class Epi, class Sched, bool ALIGN_EPI = false, bool SP2 = false>
__device__ __forceinline__ void gemm_phase(PG8_LAS unsigned char* lds, const Gemm g, const Sched& S, const Epi& E, const int wave_in) {
    const int wid = wave_in, lane = mk_lane(), tid = wid * 64 + lane, wr = wid >> 2, wc = wid & 3, fr = lane & 15, fq = lane >> 4;
    const int K = g.K, nt = K / BK;
    unsigned voffA[2], voffB[2];
#pragma unroll
    for (int i = 0; i < 2; ++i) { int R, C; stage_rc(tid * 16 + i * 8192, R, C); const int Rb = Epi::PERM ? ((R & ~31) + perm32(R & 31)) : R;
        voffA[i] = (unsigned)(R * K + C) * 2u; voffB[i] = (unsigned)(Rb * K + C) * 2u; }
    const size_t kstep = (size_t)(BK * 2);
    const size_t hstep = (size_t)HALF * K * 2;
    const size_t tstep = 2 * hstep;
    const unsigned ldsw = (unsigned)wid * 1024u;
    const int aoff = lds_byte(wr * 64 + fr, fq * 8), boff = lds_byte(wc * 32 + fr, fq * 8);
#define PG8_SA(b, h) (((b) * 2 + (h)) * HTB)
#define PG8_SB(b, h) ((4 + (b) * 2 + (h)) * HTB)
#define PG8_STAGE(bufoff, gbase, voff) do { _Pragma("unroll") for (int _i = 0; _i < 2; ++_i) \
        __builtin_amdgcn_global_load_lds((const unsigned*)((const char*)(gbase) + (voff)[_i]), (PG8_LAS unsigned*)(lds + (bufoff) + ldsw + _i * 8192), 16, 0, 0); } while (0)
#define PG8_LDA(dst, b, h) do { _Pragma("unroll") for (int m = 0; m < 4; ++m) _Pragma("unroll") for (int k = 0; k < 2; ++k) dst[m][k] = *(const PG8_LAS bf16x8*)(lds + PG8_SA(b, h) + aoff + m * 2048 + k * 1024); } while (0)
#define PG8_LDB(dst, b, h) do { _Pragma("unroll") for (int n = 0; n < 2; ++n) _Pragma("unroll") for (int k = 0; k < 2; ++k) dst[n][k] = *(const PG8_LAS bf16x8*)(lds + PG8_SB(b, h) + boff + n * 2048 + k * 1024); } while (0)
#define PG8_MMA(ai, bj, At, Bt) do { __builtin_amdgcn_s_setprio(1); _Pragma("unroll") for (int m = 0; m < 4; ++m) _Pragma("unroll") for (int n = 0; n < 2; ++n) _Pragma("unroll") for (int k = 0; k < 2; ++k) \
        acc[ai][bj][m][n] = __builtin_amdgcn_mfma_f32_16x16x32_bf16(Bt[n][k], At[m][k], acc[ai][bj][m][n], 0, 0, 0); __builtin_amdgcn_s_setprio(0); } while (0)
#define PG8_WAIT_V(n) asm volatile("s_waitcnt vmcnt(" #n ")" ::: "memory")
#define PG8_WAIT_L(n) asm volatile("s_waitcnt lgkmcnt(" #n ")" ::: "memory")
#define PG8_BAR __builtin_amdgcn_s_barrier()
#define PG8_SCHED __builtin_amdgcn_sched_barrier(0)
    Unit cur, nxt; int ui = 0;
    if (!S.next(0, cur)) return;
    f32x4 acc[2][2][4][2];
#pragma unroll
    for (int a = 0; a < 2; ++a)
#pragma unroll
        for (int b = 0; b < 2; ++b)
#pragma unroll
            for (int m = 0; m < 4; ++m)
#pragma unroll
                for (int n = 0; n < 2; ++n) acc[a][b][m][n] = (f32x4){0.f, 0.f, 0.f, 0.f};
    bf16x8 At[4][2], B0[2][2], B1[2][2];
    const char* cA = (const char*)g.A + (size_t)cur.pm * tstep + cur.koff; const char* cB = (const char*)g.Bt + (size_t)cur.pn * tstep + cur.koff; int ntc = cur.nt ? cur.nt : nt;
    S.a_ready(cur);
    if constexpr (SP2) {
        PG8_STAGE(PG8_SB(0, 0), cB, voffB); PG8_STAGE(PG8_SB(0, 1), cB + hstep, voffB); PG8_STAGE(PG8_SA(0, 0), cA, voffA); PG8_STAGE(PG8_SA(0, 1), cA + hstep, voffA);
        if (wr == 1) PG8_BAR;
        PG8_WAIT_V(2); PG8_BAR;
        PG8_STAGE(PG8_SB(1, 0), cB + kstep, voffB); PG8_STAGE(PG8_SA(1, 0), cA + kstep, voffA); PG8_STAGE(PG8_SB(1, 1), cB + hstep + kstep, voffB);
        PG8_WAIT_V(6); PG8_BAR;
    } else {
        PG8_STAGE(PG8_SB(0, 0), cB, voffB); PG8_STAGE(PG8_SA(0, 0), cA, voffA); PG8_STAGE(PG8_SB(0, 1), cB + hstep, voffB); PG8_STAGE(PG8_SA(0, 1), cA + hstep, voffA);
        if (wr == 1) PG8_BAR;
        PG8_WAIT_V(4); PG8_BAR;
        PG8_STAGE(PG8_SB(1, 0), cB + kstep, voffB); PG8_STAGE(PG8_SA(1, 0), cA + kstep, voffA); PG8_STAGE(PG8_SB(1, 1), cB + hstep + kstep, voffB);
        PG8_WAIT_V(6); PG8_BAR;
    }
    for (;;) {
        const bool has_next = S.next(ui + 1, nxt);
        const char* nA = has_next ? (const char*)g.A + (size_t)nxt.pm * tstep + nxt.koff : cA; const char* nB = has_next ? (const char*)g.Bt + (size_t)nxt.pn * tstep + nxt.koff : cB;
        for (int t = 0; t < ntc; t += 2) {
            const bool last = (t == ntc - 2);
            const char* a1 = cA + (size_t)(t + 1) * kstep;
            const char* a2 = last ? nA : cA + (size_t)(t + 2) * kstep; const char* b2 = last ? nB : cB + (size_t)(t + 2) * kstep;
            const char* a3 = a2 + kstep; const char* b3 = b2 + kstep;
            if (last && has_next) S.a_ready(nxt);
            if constexpr (SP2) {
            PG8_LDB(B0, 0, 0); PG8_LDB(B1, 0, 1); PG8_SCHED; PG8_LDA(At, 0, 0); PG8_STAGE(PG8_SA(1, 1), a1 + hstep, voffA);
            PG8_WAIT_V(8); PG8_WAIT_L(0); PG8_BAR; PG8_MMA(0, 0, At, B0); PG8_MMA(0, 1, At, B1); PG8_BAR; PG8_SCHED;
            PG8_LDA(At, 0, 1); PG8_STAGE(PG8_SB(0, 0), b2, voffB); PG8_STAGE(PG8_SB(0, 1), b2 + hstep, voffB); PG8_STAGE(PG8_SA(0, 0), a2, voffA);
            PG8_WAIT_V(8); PG8_WAIT_L(0); PG8_BAR; PG8_MMA(1, 0, At, B0); PG8_MMA(1, 1, At, B1); PG8_BAR; PG8_SCHED;
            PG8_LDB(B0, 1, 0); PG8_LDB(B1, 1, 1); PG8_SCHED; PG8_LDA(At, 1, 0); PG8_STAGE(PG8_SA(0, 1), a2 + hstep, voffA);
            PG8_WAIT_V(8); PG8_WAIT_L(0); PG8_BAR; PG8_MMA(0, 0, At, B0); PG8_MMA(0, 1, At, B1); PG8_BAR; PG8_SCHED;
            PG8_LDA(At, 1, 1); PG8_STAGE(PG8_SB(1, 0), b3, voffB); PG8_STAGE(PG8_SB(1, 1), b3 + hstep, voffB); PG8_STAGE(PG8_SA(1, 0), a3, voffA);
            PG8_WAIT_V(8); PG8_WAIT_L(0); PG8_BAR; PG8_MMA(1, 0, At, B0); PG8_MMA(1, 1, At, B1); PG8_BAR; PG8_SCHED;
            } else {
            PG8_LDB(B0, 0, 0); PG8_SCHED; PG8_LDA(At, 0, 0); PG8_STAGE(PG8_SA(1, 1), a1 + hstep, voffA);
            PG8_WAIT_L(8); PG8_BAR; PG8_WAIT_L(0); PG8_MMA(0, 0, At, B0); PG8_BAR; PG8_SCHED;
            PG8_LDB(B1, 0, 1); PG8_STAGE(PG8_SB(0, 0), b2, voffB);
            PG8_BAR; PG8_WAIT_L(0); PG8_MMA(0, 1, At, B1); PG8_BAR;
            PG8_LDA(At, 0, 1); PG8_STAGE(PG8_SA(0, 0), a2, voffA);
            PG8_BAR; PG8_WAIT_L(0); PG8_MMA(1, 0, At, B0); PG8_BAR; PG8_SCHED;
            PG8_STAGE(PG8_SB(0, 1), b2 + hstep, voffB);
            PG8_WAIT_V(6); PG8_BAR; PG8_MMA(1, 1, At, B1); PG8_BAR;
            PG8_LDB(B0, 1, 0); PG8_SCHED; PG8_LDA(At, 1, 0); PG8_STAGE(PG8_SA(0, 1), a2 + hstep, voffA);
            PG8_WAIT_L(8); PG8_BAR; PG8_WAIT_L(0); PG8_MMA(0, 0, At, B0); PG8_BAR; PG8_SCHED;
            PG8_LDB(B1, 1, 1); PG8_STAGE(PG8_SB(1, 0), b3, voffB);
            PG8_BAR; PG8_WAIT_L(0); PG8_MMA(0, 1, At, B1); PG8_BAR;
            PG8_LDA(At, 1, 1); PG8_STAGE(PG8_SA(1, 0), a3, voffA);
            PG8_BAR; PG8_WAIT_L(0); PG8_MMA(1, 0, At, B0); PG8_BAR; PG8_SCHED;
            PG8_STAGE(PG8_SB(1, 1), b3 + hstep, voffB);
            PG8_WAIT_V(6); PG8_BAR; PG8_MMA(1, 1, At, B1); PG8_BAR;
            }
        }
        if constexpr (ALIGN_EPI) { if (wr == 0) PG8_BAR; }
        if constexpr (!Epi::AFTER_DRAIN) { E(acc, cur, wr, wc, fr, fq); S.done(cur); }
        if (!has_next) break;
#pragma unroll
        for (int a = 0; a < 2; ++a)
#pragma unroll
            for (int b = 0; b < 2; ++b)
#pragma unroll
                for (int m = 0; m < 4; ++m)
#pragma unroll
                    for (int n = 0; n < 2; ++n) acc[a][b][m][n] = (f32x4){0.f, 0.f, 0.f, 0.f};
        cur = nxt; cA = nA; cB = nB; ++ui; ntc = cur.nt ? cur.nt : nt;
        if constexpr (ALIGN_EPI) { if (wr == 1) PG8_BAR; }
    }
    PG8_WAIT_V(0);
    if constexpr (!ALIGN_EPI) { if (wr == 0) PG8_BAR; }
    PG8_BAR;
    if constexpr (Epi::AFTER_DRAIN) { E.fused(acc, cur, wr, wc, fr, fq, lds, wid, lane); S.done(cur); }
#undef PG8_SA
#undef PG8_SB
#undef PG8_STAGE
#undef PG8_LDA
#undef PG8_LDB
#undef PG8_MMA
#undef PG8_WAIT_V
#undef PG8_WAIT_L
#undef PG8_BAR
#undef PG8_SCHED
}
}
namespace att {
using bf16 = __hip_bfloat16;
using bf16x8 = __attribute__((ext_vector_type(8))) short;
using s16x4  = __attribute__((ext_vector_type(4))) short;
using f32x16 = __attribute__((ext_vector_type(16))) float;
using u32x4  = __attribute__((ext_vector_type(4))) unsigned;
constexpr int D = 128, NW = 8, QBLK = 32, KVBLK = 64;
constexpr int LDR = 6144;
constexpr size_t SHM_V = KVBLK * D * 2, SHM_K = KVBLK * D * 2, SHM_ATTN = 2 * SHM_V + 2 * SHM_K + NW * 64 * 4;
#define KSWZ(row, colB) ((row) * 256 + ((colB) ^ (((row) & 7) << 4)))
#define SBAR() __builtin_amdgcn_sched_barrier(0)
__device__ __forceinline__ int crow(int r, int hi) { return (r & 3) + 8 * (r >> 2) + 4 * hi; }
__device__ __forceinline__ unsigned cvtpk(float lo, float hi) { unsigned r; asm volatile("v_cvt_pk_bf16_f32 %0, %1, %2" : "=v"(r) : "v"(lo), "v"(hi)); return r; }
__device__ __forceinline__ unsigned short f2bf1(float x) { return (unsigned short)(cvtpk(x, x) & 0xffffu); }
#define PK4(P, BASE, OUT) do { unsigned a0 = cvtpk(P[BASE + 0], P[BASE + 1]), a1 = cvtpk(P[BASE + 2], P[BASE + 3]);   \
    unsigned b0 = cvtpk(P[BASE + 4], P[BASE + 5]), b1 = cvtpk(P[BASE + 6], P[BASE + 7]);                              \
    auto r0 = __builtin_amdgcn_permlane32_swap(a0, b0, false, false); auto r1 = __builtin_amdgcn_permlane32_swap(a1, b1, false, false); \
    u32x4 w = {r0[0], r1[0], r0[1], r1[1]}; OUT = *reinterpret_cast<bf16x8*>(&w); } while (0)

template <int SCALE_E6>
struct SM {
    static constexpr float SCALE = SCALE_E6 == 125000 ? 0.125f : 0.088388347648318440f;
    static constexpr float THR = 8.f;
    static __device__ __forceinline__ void partialSM(f32x16& p0, f32x16& p1, float& m_reg, float& mn, float& alpha) {
        constexpr float C = SCALE * 1.4426950408889634f;
        float pmax = p0[0];
#pragma unroll
        for (int r = 1; r < 16; ++r) pmax = fmaxf(pmax, p0[r]);
#pragma unroll
        for (int r = 0; r < 16; ++r) pmax = fmaxf(pmax, p1[r]);
        { auto rr = __builtin_amdgcn_permlane32_swap(__float_as_uint(pmax), __float_as_uint(pmax), false, false);
          pmax = fmaxf(__uint_as_float(rr[0]), __uint_as_float(rr[1])); }
        if (__builtin_expect(__all(pmax - m_reg <= THR / SCALE), 1)) { mn = m_reg; alpha = 1.f; }
        else { mn = fmaxf(m_reg, pmax); alpha = __builtin_amdgcn_exp2f((m_reg - mn) * C); m_reg = mn; }
        float mnC = -mn * C;
#pragma unroll
        for (int r = 0; r < 16; ++r) p0[r] = fmaf(p0[r], C, mnC);
#pragma unroll
        for (int r = 0; r < 16; ++r) p1[r] = fmaf(p1[r], C, mnC);
#pragma unroll
        for (int r = 0; r < 16; ++r) p0[r] = __builtin_amdgcn_exp2f(p0[r]);
    }
};
__device__ __forceinline__ void finishSM(f32x16& p0, f32x16& p1, float alpha, float& l_reg, bf16x8& pa0, bf16x8& pa1, bf16x8& pa2, bf16x8& pa3) {
#pragma unroll
    for (int r = 0; r < 16; ++r) p1[r] = __builtin_amdgcn_exp2f(p1[r]);
    float ps = 0;
#pragma unroll
    for (int r = 0; r < 16; ++r) ps += p0[r];
#pragma unroll
    for (int r = 0; r < 16; ++r) ps += p1[r];
    { auto rr = __builtin_amdgcn_permlane32_swap(__float_as_uint(ps), __float_as_uint(ps), false, false);
      ps = __uint_as_float(rr[0]) + __uint_as_float(rr[1]); }
    l_reg = l_reg * alpha + ps;
    PK4(p0, 0, pa0); PK4(p0, 8, pa1); PK4(p1, 0, pa2); PK4(p1, 8, pa3);
}
template <int ND0>
__device__ __forceinline__ void qkt(f32x16& p0, f32x16& p1, const bf16* Ks, const bf16x8* qr, int dbase, int r32, int hi) {
    p0 = f32x16{}; p1 = f32x16{};
#pragma unroll
    for (int d0 = 0; d0 < ND0; ++d0) { int cb = ((dbase + d0) * 16 + hi * 8) * 2;
        bf16x8 b0 = *reinterpret_cast<const bf16x8*>((const char*)Ks + KSWZ(r32, cb));
        bf16x8 b1 = *reinterpret_cast<const bf16x8*>((const char*)Ks + KSWZ(32 + r32, cb));
        p0 = __builtin_amdgcn_mfma_f32_32x32x16_bf16(b0, qr[d0], p0, 0, 0, 0);
        p1 = __builtin_amdgcn_mfma_f32_32x32x16_bf16(b1, qr[d0], p1, 0, 0, 0); }
}
__device__ __forceinline__ int v_st(int k, int c) { const int kk = (k & ~0xC) | ((k & 4) << 1) | ((k & 8) >> 1); return ((kk >> 3) * 4 + (c >> 5)) * 512 + ((kk & 7) * 32 + (c & 31)) * 2; }
__device__ __forceinline__ int v_rd_base(int lane) { return ((lane & 3) << 3) | (((lane >> 2) & 3) << 6) | (((lane >> 4) & 1) << 5) | (((lane >> 5) & 1) << 8); }
constexpr int v_rd_off(int d0, int ks, int half) { return d0 * 512 + ks * 4096 + half * 2048; }
template <int OFF> __device__ __forceinline__ s16x4 tr_read(int vb) {
    s16x4 r; asm volatile("ds_read_b64_tr_b16 %0, %1 offset:%2" : "=&v"(r) : "v"(vb), "i"(OFF) : "memory"); return r;
}
#define PKV(L, H) (bf16x8){L[0], L[1], L[2], L[3], H[0], H[1], H[2], H[3]}
template <int D0> __device__ __forceinline__ void pv_one(f32x16& od, int vb, bf16x8 pa0, bf16x8 pa1, bf16x8 pa2, bf16x8 pa3) {
    const s16x4 l0 = tr_read<v_rd_off(D0, 0, 0)>(vb), h0 = tr_read<v_rd_off(D0, 0, 1)>(vb), l1 = tr_read<v_rd_off(D0, 1, 0)>(vb), h1 = tr_read<v_rd_off(D0, 1, 1)>(vb);
    const s16x4 l2 = tr_read<v_rd_off(D0, 2, 0)>(vb), h2 = tr_read<v_rd_off(D0, 2, 1)>(vb), l3 = tr_read<v_rd_off(D0, 3, 0)>(vb), h3 = tr_read<v_rd_off(D0, 3, 1)>(vb);
    asm volatile("s_waitcnt lgkmcnt(0)" ::: "memory"); SBAR();
    od = __builtin_amdgcn_mfma_f32_32x32x16_bf16(pa0, PKV(l0, h0), od, 0, 0, 0);
    od = __builtin_amdgcn_mfma_f32_32x32x16_bf16(pa1, PKV(l1, h1), od, 0, 0, 0);
    od = __builtin_amdgcn_mfma_f32_32x32x16_bf16(pa2, PKV(l2, h2), od, 0, 0, 0);
    od = __builtin_amdgcn_mfma_f32_32x32x16_bf16(pa3, PKV(l3, h3), od, 0, 0, 0);
}
__device__ __forceinline__ void pv_d0(f32x16* o, int vb, bf16x8 pa0, bf16x8 pa1, bf16x8 pa2, bf16x8 pa3) {
    pv_one<0>(o[0], vb, pa0, pa1, pa2, pa3); pv_one<1>(o[1], vb, pa0, pa1, pa2, pa3); pv_one<2>(o[2], vb, pa0, pa1, pa2, pa3); pv_one<3>(o[3], vb, pa0, pa1, pa2, pa3);
}
template <int D0> __device__ __forceinline__ void pv_one32(f32x16& od, int vb, bf16x8 pa0, bf16x8 pa1) {
    const s16x4 l0 = tr_read<v_rd_off(D0, 0, 0)>(vb), h0 = tr_read<v_rd_off(D0, 0, 1)>(vb), l1 = tr_read<v_rd_off(D0, 1, 0)>(vb), h1 = tr_read<v_rd_off(D0, 1, 1)>(vb);
    asm volatile("s_waitcnt lgkmcnt(0)" ::: "memory"); SBAR();
    od = __builtin_amdgcn_mfma_f32_32x32x16_bf16(pa0, PKV(l0, h0), od, 0, 0, 0);
    od = __builtin_amdgcn_mfma_f32_32x32x16_bf16(pa1, PKV(l1, h1), od, 0, 0, 0);
}

typedef float f32x4c __attribute__((ext_vector_type(4)));
struct ConvJob {
    const float *w_gate, *w_up, *w_down, *w_out, *g_ffn; unsigned short *WGU, *WDN, *WOUT;
    int next, end, stride;
};
struct ConvItem { const float* W; unsigned short* dst; int N, K, k0, n0, drow; };
constexpr int CV_GU = 32 * 88, CV_DN = 88 * 32, CV_OUT = 32 * 32, CV_TOTAL = 2 * CV_GU + CV_DN + CV_OUT;
__device__ __forceinline__ ConvItem conv_item(const float* Jw_gate, const float* Jw_up, const float* Jw_down, const float* Jw_out, unsigned short* JWGU, unsigned short* JWDN, unsigned short* JWOUT, int q) {
    ConvItem it;
    const bool gu = q < 2 * CV_GU, dn = !gu && q < 2 * CV_GU + CV_DN; const int up = (q >= CV_GU) ? 1 : 0;
    const int rg = q - up * CV_GU, kbg = rg / 88, nbg = rg - kbg * 88;
    const int rd = gu ? 0 : (dn ? q - 2 * CV_GU : q - 2 * CV_GU - CV_DN), kbd = rd >> 5, nbd = rd & 31;
    it.W = gu ? (up ? Jw_up : Jw_gate) : (dn ? Jw_down : Jw_out);
    it.dst = gu ? JWGU : (dn ? JWDN : JWOUT);
    it.N = gu ? 5632 : 2048; it.K = dn ? 5632 : 2048;
    it.k0 = 64 * (gu ? kbg : kbd); it.n0 = 64 * (gu ? nbg : nbd);
    it.drow = gu ? 256 * (it.n0 >> 7) + 128 * up + (it.n0 & 127) : it.n0;
    return it;
}
__device__ __forceinline__ void attn_dense_body(const bf16* __restrict__ Qb, const bf16* __restrict__ Kh, const bf16* __restrict__ Vh,
                                                unsigned short* __restrict__ Ob, int ldo, int dbase, int seq, char* lds, const int wave_in, ConvJob& cj,
                                                const bool second, unsigned short* __restrict__ Yb, const float lam, const float* __restrict__ subln) {
    using S8 = SM<125000>;
    const int wid = wave_in, lane = mk_lane(), tid = wid * 64 + lane, r32 = lane & 31, hi = lane >> 5;
    bf16* V_lds = (bf16*)lds; bf16* K_lds = (bf16*)(lds + 2 * SHM_V);
    float* ws = (float*)(lds + 2 * SHM_V + 2 * SHM_K) + wid * 64; float* li_l = ws; float* al_l = ws + 32;
    float m_reg = -1e30f, l_reg = 0; f32x16 o[4] = {}; bf16x8 qr[4];
    const bf16* Qw = Qb + (long)(wid * QBLK + r32) * LDR + dbase * 16 + hi * 8;
#pragma unroll
    for (int d0 = 0; d0 < 4; ++d0) qr[d0] = *reinterpret_cast<const bf16x8*>(Qw + d0 * 16);
    const int sr = tid >> 4, sc = (tid & 15) * 8, vst0 = v_st(sr, sc), vst1 = v_st(32 + sr, sc);
    const int vb0 = (int)(uintptr_t)V_lds + v_rd_base(lane);
    struct { bf16x8 vs0, vs1, ks0; } sr_[2];
    const int krow = tid >> 3, kcol = dbase * 16 + (tid & 7) * 8, kst0 = KSWZ(krow, kcol * 2);
#define SLOAD(i, k0) do { sr_[i].vs0 = *reinterpret_cast<const bf16x8*>(&Vh[(long)((k0) + sr) * LDR + sc]); sr_[i].vs1 = *reinterpret_cast<const bf16x8*>(&Vh[(long)((k0) + 32 + sr) * LDR + sc]); \
    sr_[i].ks0 = *reinterpret_cast<const bf16x8*>(&Kh[(long)((k0) + krow) * LDR + kcol]); } while (0)
#define SWRITE(b, i) do { *(bf16x8*)((char*)V_lds + (b) * SHM_V + vst0) = sr_[i].vs0;          \
    *(bf16x8*)((char*)V_lds + (b) * SHM_V + vst1) = sr_[i].vs1;                              \
    *(bf16x8*)((char*)K_lds + (b) * SHM_K + kst0) = sr_[i].ks0; } while (0)
#define SWAIT() do {} while (0)
#define RESC(a) do { if (__any((a) < 1.f)) { if (hi == 0) al_l[r32] = (a); asm volatile("s_waitcnt lgkmcnt(0)" ::: "memory"); \
    _Pragma("unroll") for (int d = 0; d < 4; ++d) _Pragma("unroll") for (int r = 0; r < 16; ++r) o[d][r] *= al_l[crow(r, hi)]; } } while (0)
    f32x16 pA0, pA1, pB0, pB1; float mnA, mnB, alA, alB; bf16x8 pa0, pa1, pa2, pa3; const int NT = seq / KVBLK;
    const float* const jwg = cj.w_gate; const float* const jwu = cj.w_up; const float* const jwd = cj.w_down; const float* const jwo = cj.w_out;
    unsigned short* const jGU = cj.WGU; unsigned short* const jDN = cj.WDN; unsigned short* const jOUT = cj.WOUT; const int jnext = cj.next, jend = cj.end, jstride = cj.stride;
    float* cscr = (float*)(lds + SHM_ATTN); f32x4c cv0, cv1; int slot = 0;
#define CV_Q(k) (min(jnext + (k) * jstride, jend))
#define CV_LOAD(q) do { const ConvItem it_ = conv_item(jwg, jwu, jwd, jwo, jGU, jDN, jOUT, (q)); const float* s_ = it_.W + (size_t)(it_.k0 + (tid >> 3)) * it_.N + it_.n0 + 8 * (tid & 7); \
    cv0 = *(const f32x4c*)s_; cv1 = *(const f32x4c*)(s_ + 4); } while (0)
#define CV_WRITE() do { f32x4c* d_ = (f32x4c*)(cscr + (tid >> 3) * 64 + 8 * ((tid & 7) ^ ((tid >> 6) & 7))); d_[0] = cv0; d_[1] = cv1; } while (0)
#define CV_STORE(q) do { const ConvItem it_ = conv_item(jwg, jwu, jwd, jwo, jGU, jDN, jOUT, (q)); const int n_ = tid >> 3, c_ = tid & 7; const float* s_ = cscr + (8 * c_) * 64 + (n_ ^ (8 * c_)); \
    u32x4 o_; o_.x = cvtpk(s_[0], s_[64]); o_.y = cvtpk(s_[128], s_[192]); o_.z = cvtpk(s_[256], s_[320]); o_.w = cvtpk(s_[384], s_[448]); \
    *(u32x4*)(it_.dst + (size_t)(it_.drow + n_) * it_.K + it_.k0 + 8 * c_) = o_; } while (0)
#define CV_CONSUME() do { CV_WRITE(); const int qn_ = CV_Q(slot + 1); CV_LOAD(qn_); } while (0)
#define CV_FINISH() do { const int qc_ = CV_Q(slot); CV_STORE(qc_); ++slot; } while (0)
    { const int q0_ = CV_Q(0); CV_LOAD(q0_); }
    constexpr int SE = 0, SO = 1;
    SLOAD(SE, 0); asm volatile("s_waitcnt vmcnt(0)" ::: "memory"); SWRITE(0, SE); __syncthreads();
    qkt<4>(pA0, pA1, K_lds, qr, dbase, r32, hi); S8::partialSM(pA0, pA1, m_reg, mnA, alA);
    SLOAD(SO, KVBLK); if (2 < NT) SLOAD(SE, 2 * KVBLK);
    SWAIT(); SWRITE(1, SO); __syncthreads();
    for (int j = 1; j + 1 < NT; j += 2) {
        SBAR(); qkt<4>(pB0, pB1, (bf16*)((char*)K_lds + SHM_K), qr, dbase, r32, hi);
        finishSM(pA0, pA1, alA, l_reg, pa0, pa1, pa2, pa3); SBAR();
        SLOAD(SO, (j + 2) * KVBLK); SBAR();
        pv_d0(o, vb0, pa0, pa1, pa2, pa3); S8::partialSM(pB0, pB1, m_reg, mnB, alB);
        __syncthreads(); SWAIT(); SWRITE(0, SE);
        CV_CONSUME();
        RESC(alB); __syncthreads();
        CV_FINISH();
        SBAR(); qkt<4>(pA0, pA1, K_lds, qr, dbase, r32, hi);
        finishSM(pB0, pB1, alB, l_reg, pa0, pa1, pa2, pa3); SBAR();
        SLOAD(SE, min(j + 3, NT - 1) * KVBLK); SBAR();
        pv_d0(o, vb0 + (int)SHM_V, pa0, pa1, pa2, pa3); S8::partialSM(pA0, pA1, m_reg, mnA, alA);
        __syncthreads(); SWAIT(); SWRITE(1, SO);
        CV_CONSUME();
        RESC(alA); __syncthreads();
        CV_FINISH();
    }
    cj.next = min(jnext + slot * jstride, jend + jstride);
    SBAR(); qkt<4>(pB0, pB1, (bf16*)((char*)K_lds + SHM_K), qr, dbase, r32, hi);
    finishSM(pA0, pA1, alA, l_reg, pa0, pa1, pa2, pa3); SBAR();
    pv_d0(o, vb0, pa0, pa1, pa2, pa3); S8::partialSM(pB0, pB1, m_reg, mnB, alB);
    __syncthreads(); RESC(alB);
    finishSM(pB0, pB1, alB, l_reg, pa0, pa1, pa2, pa3); SBAR();
    pv_d0(o, vb0 + (int)SHM_V, pa0, pa1, pa2, pa3);
    if (hi == 0) li_l[r32] = l_reg; asm volatile("s_waitcnt lgkmcnt(0)" ::: "memory");
    float rli[16];
#pragma unroll
    for (int r = 0; r < 16; ++r) rli[r] = __builtin_amdgcn_rcpf(li_l[crow(r, hi)]);
    unsigned short* Ow = (unsigned short*)(lds + SHM_ATTN + 16384) + wid * 4096;
    if (!second) {
#pragma unroll
        for (int r = 0; r < 16; ++r) { int orow = crow(r, hi);
#pragma unroll
            for (int d0 = 0; d0 < 4; ++d0) Ow[orow * 128 + d0 * 32 + r32] = f2bf1(o[d0][r] * rli[r]); }
        asm volatile("s_waitcnt lgkmcnt(0)" ::: "memory");
    } else {
        float ssq[16];
#pragma unroll
        for (int r = 0; r < 16; ++r) { const int orow = crow(r, hi); ssq[r] = 0.f;
#pragma unroll
            for (int d0 = 0; d0 < 4; ++d0) { const float o0 = __uint_as_float((unsigned)Ow[orow * 128 + d0 * 32 + r32] << 16);
                const float d = o0 - lam * (o[d0][r] * rli[r]); o[d0][r] = d; ssq[r] += d * d; } }
#pragma unroll
        for (int r = 0; r < 16; ++r) { float v = ssq[r]; v += __shfl_xor(v, 1); v += __shfl_xor(v, 2); v += __shfl_xor(v, 4); v += __shfl_xor(v, 8); v += __shfl_xor(v, 16); ssq[r] = v; }
        float sl[4];
#pragma unroll
        for (int d0 = 0; d0 < 4; ++d0) sl[d0] = subln[d0 * 32 + r32] * 0.8f;
        unsigned short* Yw = Yb + (long)(wid * QBLK) * 2048;
#pragma unroll
        for (int r = 0; r < 16; ++r) { const int orow = crow(r, hi); const float rs = 1.0f / sqrtf(ssq[r] * (1.0f / 128.0f) + 1e-5f);
#pragma unroll
            for (int d0 = 0; d0 < 4; ++d0) Yw[(long)orow * 2048 + d0 * 32 + r32] = f2bf1(o[d0][r] * rs * sl[d0]); }
    }
#undef CV_LOAD
#undef CV_Q
#undef CV_STORE
#undef CV_WRITE
#undef CV_CONSUME
#undef CV_FINISH
#undef SLOAD
#undef SWRITE
#undef SWAIT
#undef RESC
}

__device__ __forceinline__ void swa_wave_unit(const bf16* __restrict__ base, long rstride, int qc, int kc, int vc, int t0, int L,
                                              unsigned short* __restrict__ Ob, long ostride, float* __restrict__ Lb, long lstride, char* lds_w, float* scr) {
    constexpr float SCALE = 0.088388347648318440f, C = SCALE * 1.4426950408889634f;
    const int lane = mk_lane(), r32 = lane & 31, hi = lane >> 5;
    bf16* K_lds = (bf16*)lds_w; char* V_lds = lds_w + 8192;
    bf16x8 qr[8];
    { const bf16* Qw = base + (long)(t0 + r32) * rstride + qc + hi * 8;
#pragma unroll
      for (int d0 = 0; d0 < 8; ++d0) qr[d0] = *reinterpret_cast<const bf16x8*>(Qw + d0 * 16); }
    const int srow = lane >> 4, scol = (lane & 15) * 8;
    const bf16* kbase = base + (long)srow * rstride + kc + scol; const bf16* vbase = base + (long)srow * rstride + vc + scol;
    bf16x8 st[2][8];
#define TILE_K0(i) (t0 - 64 + 32 * (i))
#define TILE_OK(i) (TILE_K0(i) >= 0 && TILE_K0(i) < L)
#define TILE_KC(i) (min(max(TILE_K0(i), 0), L - 32))
#define LD_TILE(buf, pbase, i) do { const bf16* p_ = (pbase) + (long)TILE_KC(i) * rstride; _Pragma("unroll") for (int j = 0; j < 8; ++j) st[buf][j] = *reinterpret_cast<const bf16x8*>(p_ + (long)(4 * j) * rstride); } while (0)
    f32x16 s[5];
    LD_TILE(0, kbase, 0);
#pragma unroll
    for (int i = 0; i < 5; ++i) {
        if (i < 4) LD_TILE((i + 1) & 1, kbase, i + 1); else LD_TILE((i + 1) & 1, vbase, 0);
#pragma unroll
        for (int j = 0; j < 8; ++j) *(bf16x8*)((char*)K_lds + KSWZ(4 * j + srow, scol * 2)) = st[i & 1][j];
        f32x16 p = f32x16{};
#pragma unroll
        for (int d0 = 0; d0 < 8; ++d0) { const int cb = (d0 * 16 + hi * 8) * 2;
            const bf16x8 b0 = *reinterpret_cast<const bf16x8*>((const char*)K_lds + KSWZ(r32, cb));
            p = __builtin_amdgcn_mfma_f32_32x32x16_bf16(b0, qr[d0], p, 0, 0, 0); }
        const bool ok = TILE_OK(i);
#pragma unroll
        for (int r = 0; r < 16; ++r) {
            bool keep = ok;
            if (i == 0) keep = keep && (crow(r, hi) >= r32);
            if (i == 4) keep = keep && (crow(r, hi) <= r32);
            s[i][r] = keep ? p[r] : -1e30f;
        }
    }
    float m = -1e30f;
#pragma unroll
    for (int i = 0; i < 5; ++i)
#pragma unroll
        for (int r = 0; r < 16; ++r) m = fmaxf(m, s[i][r]);
    { auto rr = __builtin_amdgcn_permlane32_swap(__float_as_uint(m), __float_as_uint(m), false, false);
      m = fmaxf(__uint_as_float(rr[0]), __uint_as_float(rr[1])); }
    const float mC = -m * C; float l = 0.f;
#pragma unroll
    for (int i = 0; i < 5; ++i)
#pragma unroll
        for (int r = 0; r < 16; ++r) { s[i][r] = __builtin_amdgcn_exp2f(fmaf(s[i][r], C, mC)); l += s[i][r]; }
    { auto rr = __builtin_amdgcn_permlane32_swap(__float_as_uint(l), __float_as_uint(l), false, false);
      l = __uint_as_float(rr[0]) + __uint_as_float(rr[1]); }
    bf16x8 pa[5][2];
#pragma unroll
    for (int i = 0; i < 5; ++i) { PK4(s[i], 0, pa[i][0]); PK4(s[i], 8, pa[i][1]); }
    f32x16 o[4] = {};
    const int vb = (int)(uintptr_t)V_lds + v_rd_base(lane);
#pragma unroll
    for (int i = 0; i < 5; ++i) {
        if (i < 4) LD_TILE(i & 1, vbase, i + 1);
#pragma unroll
        for (int j = 0; j < 8; ++j) *(bf16x8*)(V_lds + v_st(4 * j + srow, scol)) = st[(i + 1) & 1][j];
        asm volatile("s_waitcnt lgkmcnt(0)" ::: "memory");
        pv_one32<0>(o[0], vb, pa[i][0], pa[i][1]); pv_one32<1>(o[1], vb, pa[i][0], pa[i][1]); pv_one32<2>(o[2], vb, pa[i][0], pa[i][1]); pv_one32<3>(o[3], vb, pa[i][0], pa[i][1]);
    }
#undef TILE_K0
#undef TILE_OK
#undef TILE_KC
#undef LD_TILE
    if (hi == 0) { scr[r32] = l; Lb[(long)(t0 + r32) * lstride] = m * SCALE + __logf(l); }
    asm volatile("s_waitcnt lgkmcnt(0)" ::: "memory");
    float rli[16];
#pragma unroll
    for (int r = 0; r < 16; ++r) rli[r] = __builtin_amdgcn_rcpf(scr[crow(r, hi)]);
#pragma unroll
    for (int r = 0; r < 16; ++r) { const long orow = (long)(t0 + crow(r, hi)) * ostride;
#pragma unroll
        for (int d0 = 0; d0 < 4; ++d0) Ob[orow + d0 * 32 + r32] = f2bf1(o[d0][r] * rli[r]); }
    asm volatile("s_waitcnt lgkmcnt(0)" ::: "memory");
}
__device__ __forceinline__ void swa_wg_unit(const bf16* __restrict__ QKVb, int gbr, int sub0, int qt0, int sstep, unsigned short* __restrict__ OAg, float* __restrict__ LSEg, char* lds, float* scr, const int wid) {
    constexpr float SCALE = 0.088388347648318440f, C = SCALE * 1.4426950408889634f;
    const int lane = mk_lane(), tid = wid * 64 + lane, r32 = lane & 31, hi = lane >> 5;
    const int dsh = 2 * gbr, dil = 1 << dsh, L = 2048 >> dsh, nblk = L >> 5; const bool big = nblk >= 8;
    const long rstride = (long)dil * LDR;
#define SUB_BASE(sub) (QKVb + ((size_t)((sub) >> (3 + dsh)) * 2048 + (((sub) >> 3) & (dil - 1))) * LDR + ((sub) & 7) * 128)
    const int srow = tid >> 4, scol = (tid & 15) * 8;
    bf16x8 kst[12], vst[12];
#pragma unroll
    for (int sl = 0; sl < 12; ++sl) {
        const int sub_s = big ? sub0 : sub0 + ((sl >> 2) & 1) * sstep; const int kt_s = big ? min(max(qt0 - 2 + sl, 0), nblk - 1) : (sl & 3);
        const bf16* p_ = SUB_BASE(sub_s) + (long)(kt_s * 32 + srow) * rstride + scol;
        kst[sl] = *reinterpret_cast<const bf16x8*>(p_ + 1024);
    }
    const int sub_w = big ? sub0 : sub0 + (wid >> 2) * sstep; const int qt = big ? qt0 + wid : (wid & 3); const int t0 = qt * 32;
    const bf16* base_w = SUB_BASE(sub_w);
    bf16x8 qr[8];
    { const bf16* Qw = base_w + (long)(t0 + r32) * rstride + hi * 8;
#pragma unroll
      for (int d0 = 0; d0 < 8; ++d0) qr[d0] = *reinterpret_cast<const bf16x8*>(Qw + d0 * 16); }
#pragma unroll
    for (int sl = 0; sl < 12; ++sl) *(bf16x8*)(lds + sl * 8192 + KSWZ(srow, scol * 2)) = kst[sl];
#pragma unroll
    for (int sl = 0; sl < 12; ++sl) {
        const int sub_s = big ? sub0 : sub0 + ((sl >> 2) & 1) * sstep; const int kt_s = big ? min(max(qt0 - 2 + sl, 0), nblk - 1) : (sl & 3);
        const bf16* p_ = SUB_BASE(sub_s) + (long)(kt_s * 32 + srow) * rstride + scol;
        vst[sl] = *reinterpret_cast<const bf16x8*>(p_ + 2048);
    }
    __syncthreads();
    f32x16 s[5];
#pragma unroll
    for (int i = 0; i < 5; ++i) {
        const int kt = qt - 2 + i; const bool ok = kt >= 0 && kt < nblk;
        const int slot = big ? wid + i : 4 * (wid >> 2) + min(max(kt, 0), 3);
        const char* Ks = lds + slot * 8192;
        f32x16 p = f32x16{};
#pragma unroll
        for (int d0 = 0; d0 < 8; ++d0) { const int cb = (d0 * 16 + hi * 8) * 2;
            const bf16x8 b0 = *reinterpret_cast<const bf16x8*>(Ks + KSWZ(r32, cb));
            p = __builtin_amdgcn_mfma_f32_32x32x16_bf16(b0, qr[d0], p, 0, 0, 0); }
#pragma unroll
        for (int r = 0; r < 16; ++r) {
            bool keep = ok;
            if (i == 0) keep = keep && (crow(r, hi) >= r32);
            if (i == 4) keep = keep && (crow(r, hi) <= r32);
            s[i][r] = keep ? p[r] : -1e30f;
        }
    }
    float m = -1e30f;
#pragma unroll
    for (int i = 0; i < 5; ++i)
#pragma unroll
        for (int r = 0; r < 16; ++r) m = fmaxf(m, s[i][r]);
    { auto rr = __builtin_amdgcn_permlane32_swap(__float_as_uint(m), __float_as_uint(m), false, false);
      m = fmaxf(__uint_as_float(rr[0]), __uint_as_float(rr[1])); }
    const float mC = -m * C; float l = 0.f;
#pragma unroll
    for (int i = 0; i < 5; ++i)
#pragma unroll
        for (int r = 0; r < 16; ++r) { s[i][r] = __builtin_amdgcn_exp2f(fmaf(s[i][r], C, mC)); l += s[i][r]; }
    { auto rr = __builtin_amdgcn_permlane32_swap(__float_as_uint(l), __float_as_uint(l), false, false);
      l = __uint_as_float(rr[0]) + __uint_as_float(rr[1]); }
    bf16x8 pa[5][2];
#pragma unroll
    for (int i = 0; i < 5; ++i) { PK4(s[i], 0, pa[i][0]); PK4(s[i], 8, pa[i][1]); }
    __syncthreads();
#pragma unroll
    for (int sl = 0; sl < 12; ++sl) *(bf16x8*)(lds + sl * 8192 + v_st(srow, scol)) = vst[sl];
    __syncthreads();
    f32x16 o[4] = {};
#pragma unroll
    for (int i = 0; i < 5; ++i) {
        const int kt = qt - 2 + i;
        const int slot = big ? wid + i : 4 * (wid >> 2) + min(max(kt, 0), 3);
        const int vb = (int)(uintptr_t)(lds + slot * 8192) + v_rd_base(lane);
        pv_one32<0>(o[0], vb, pa[i][0], pa[i][1]); pv_one32<1>(o[1], vb, pa[i][0], pa[i][1]); pv_one32<2>(o[2], vb, pa[i][0], pa[i][1]); pv_one32<3>(o[3], vb, pa[i][0], pa[i][1]);
    }
    const size_t tok0 = ((size_t)(sub_w >> (3 + dsh)) * 2048 + ((sub_w >> 3) & (dil - 1))); const int hh = sub_w & 7;
    if (hi == 0) { scr[r32] = l; LSEg[(tok0 + (size_t)(t0 + r32) * dil) * 8 + hh] = m * SCALE + __logf(l); }
    asm volatile("s_waitcnt lgkmcnt(0)" ::: "memory");
    float rli[16];
#pragma unroll
    for (int r = 0; r < 16; ++r) rli[r] = __builtin_amdgcn_rcpf(scr[crow(r, hi)]);
#pragma unroll
    for (int r = 0; r < 16; ++r) { unsigned short* orow = OAg + (tok0 + (size_t)(t0 + crow(r, hi)) * dil) * 1024 + hh * 128;
#pragma unroll
        for (int d0 = 0; d0 < 4; ++d0) orow[d0 * 32 + r32] = f2bf1(o[d0][r] * rli[r]); }
    asm volatile("s_waitcnt lgkmcnt(0)" ::: "memory");
    __syncthreads();
#undef SUB_BASE
}
#undef SBAR
}
#ifndef MK_DUP_PHASE
#define MK_DUP_PHASE -1
#endif
#define NREP(k) (1 + (MK_DUP_PHASE == (k) ? 1 : 0))
#ifndef MK_ONE_LAUNCH
#define MK_ONE_LAUNCH 1
#endif
constexpr int NWAVES = 8;
constexpr int BATCH = 4, SEQ = 2048, DM = 2048, M = BATCH * SEQ, NIN = 6144, DFF = 5632, NGU = 2 * DFF, NHEAD = 8, HD = 128;
constexpr float RMS_EPS = 1e-6f, SUBLN_EPS = 1e-5f, LAM_INIT = 0.2f;
constexpr size_t MiB = 1u << 20;
constexpr size_t WS_SS1 = 0, WS_SS2 = 64 * 1024, WS_LSE = 1 * MiB;
constexpr size_t WS_QKV = 2 * MiB;
constexpr size_t WS_Y = 162 * MiB;
constexpr size_t WS_H = 34 * MiB;
constexpr size_t WS_WIN = 98 * MiB, WS_XN = 122 * MiB;
constexpr size_t WS_OA = 98 * MiB;
constexpr size_t WS_WOUT = 154 * MiB;
constexpr size_t WS_OB = 162 * MiB, WS_XG = 2 * MiB;
constexpr size_t WS_WGU = 194 * MiB, WS_WDN = 238 * MiB, WS_END = 260 * MiB;
static_assert(WS_H + (size_t)M * DFF * 2 <= WS_WOUT && WS_XG + (size_t)M * DM * 2 <= WS_H && WS_Y + (size_t)M * DM * 2 <= WS_WGU && WS_OA + (size_t)3 * M * 1024 * 2 <= WS_WOUT && WS_WDN + (size_t)DM * DFF * 2 <= WS_END && WS_WGU + (size_t)NGU * DM * 2 <= WS_WDN && WS_QKV + (size_t)M * NIN * 2 <= WS_WIN, "d_ws map");
constexpr int RING_BYTES = 131072, LDS_BYTES = 163840, MISC_OFF = 163584;
constexpr size_t WS_BAR = 128 * 1024, WS_CNT = 144 * 1024, WS_FLAG = 152 * 1024, WS_GRP = 160 * 1024, BAR_BYTES = 40 * 1024;

#define GAS __attribute__((address_space(1)))
#define LAS __attribute__((address_space(3)))
typedef unsigned short bf16;
typedef unsigned v4u __attribute__((ext_vector_type(4)));
typedef float f32x4 __attribute__((ext_vector_type(4)));
#define LDS_WAIT() asm volatile("s_waitcnt lgkmcnt(0)" ::: "memory")
__device__ __forceinline__ unsigned f2bf(float f) { unsigned u = __builtin_bit_cast(unsigned, f); return (u + 0x7fffu + ((u >> 16) & 1u)) >> 16; }
__device__ __forceinline__ unsigned pk2(float lo, float hi) { return f2bf(lo) | (f2bf(hi) << 16); }
__device__ __forceinline__ float bflo(unsigned w) { return __uint_as_float(w << 16); }
__device__ __forceinline__ float bfhi(unsigned w) { return __uint_as_float(w & 0xffff0000u); }
__device__ __forceinline__ float wave_sum(float v) {
#pragma unroll
    for (int o = 1; o < 64; o <<= 1) v += __shfl_xor(v, o);
    return v;
}
__device__ __forceinline__ void transpose_item(const float* W, int K, int N, bf16* WT, int k0, int n0, int dst_row0, LAS float* scr, int lane, const float* ks = nullptr) {
    float wv[32];
#pragma unroll
    for (int i = 0; i < 32; ++i) { const int kk = 2 * i + (lane >> 5); wv[i] = W[(size_t)(k0 + kk) * N + n0 + (lane & 31)]; }
#pragma unroll
    for (int i = 0; i < 32; ++i) { const int kk = 2 * i + (lane >> 5); scr[kk * 33 + (lane & 31)] = wv[i]; }
    LDS_WAIT(); asm volatile("" ::: "memory");
    const int c = lane & 7;
    f32x4 g0 = {1.f, 1.f, 1.f, 1.f}, g1 = {1.f, 1.f, 1.f, 1.f};
    if (ks) { g0 = *(const f32x4*)(ks + k0 + 8 * c); g1 = *(const f32x4*)(ks + k0 + 8 * c + 4); }
#pragma unroll
    for (int j = 0; j < 4; ++j) { const int n = (lane >> 3) + 8 * j; const LAS float* s = scr + (8 * c) * 33 + n;
        v4u o; o.x = pk2(s[0 * 33] * g0.x, s[1 * 33] * g0.y); o.y = pk2(s[2 * 33] * g0.z, s[3 * 33] * g0.w); o.z = pk2(s[4 * 33] * g1.x, s[5 * 33] * g1.y); o.w = pk2(s[6 * 33] * g1.z, s[7 * 33] * g1.w);
        *(GAS v4u*)(WT + (size_t)(dst_row0 + n) * K + k0 + 8 * c) = o; }
    LDS_WAIT(); asm volatile("" ::: "memory");
}

#define XB_TMO      128
#define XB_XCNT(j)  (256  + 64 * (j))
#define XB_XSUB(j)  (1280 + 64 * (j))
#define XB_XGEN(j)  (2304 + 64 * (j))
#define XB_TOP      3328
#define XB_TOPGEN   3392
#define XCD_BAR_WORDS 3456
#define XB_SPIN_CAP (1u << 18)

__device__ __forceinline__ unsigned xb_ld(unsigned* p)              { return __hip_atomic_load(p, __ATOMIC_RELAXED, __HIP_MEMORY_SCOPE_AGENT); }
__device__ __forceinline__ unsigned xb_add(unsigned* p, unsigned v) { return __hip_atomic_fetch_add(p, v, __ATOMIC_RELAXED, __HIP_MEMORY_SCOPE_AGENT); }
__device__ __forceinline__ unsigned xb_xcc_id() { return (unsigned)__builtin_amdgcn_s_getreg((3 << 11) | 20) & 0xFu; }
#define XB_SPIN(cond, bar) do { unsigned _sp = 0; while (cond) { __builtin_amdgcn_s_sleep(1); \
    if ((++_sp & 255u) == 0u) { if (xb_ld(&(bar)[XB_TMO])) break; if (_sp > XB_SPIN_CAP) { atomicAdd(&(bar)[XB_TMO], 1u); break; } } } } while (0)

struct XcdBarrier {
    unsigned* bar; unsigned x;
    volatile LAS unsigned* st;
};

__device__ __forceinline__ XcdBarrier xcd_barrier_post(unsigned* bar, volatile LAS unsigned* st, const int wave_in) {
    XcdBarrier b; b.bar = bar; b.x = xb_xcc_id(); b.st = st;
    if (wave_in == 0 && mk_lane() == 0) (void)xb_add(&bar[XB_XCNT(b.x)], 1u);
    return b;
}
__device__ __forceinline__ void xcd_barrier_complete(unsigned* bar, unsigned x, unsigned& nloc, unsigned& nx) {
    const unsigned G = gridDim.x * gridDim.y * gridDim.z;
    unsigned sum, cnt, mine, sp = 0u;
    for (;;) {
        sum = 0u; cnt = 0u; mine = 0u;
#pragma unroll
        for (unsigned j = 0; j < 16; ++j) { const unsigned c = xb_ld(&bar[XB_XCNT(j)]); sum += c; cnt += (c > 0u) ? 1u : 0u; mine = (j == x) ? c : mine; }
        if (sum == G) break;
        __builtin_amdgcn_s_sleep(1);
        if ((++sp & 255u) == 0u) { if (xb_ld(&bar[XB_TMO])) break; if (sp > XB_SPIN_CAP) { atomicAdd(&bar[XB_TMO], 1u); break; } }
    }
    nloc = mine > 0u ? mine : 1u; nx = cnt > 0u ? cnt : 1u;
}

__device__ __forceinline__ void xcd_barrier(const XcdBarrier& b, const int wave_in) {
    asm volatile("s_waitcnt vmcnt(0)" ::: "memory");
    __syncthreads();
    if (wave_in == 0 && mk_lane() == 0) {
        unsigned* bar = b.bar;
        __builtin_amdgcn_s_waitcnt(0);
        unsigned nloc = b.st[0], nx = b.st[1];
        if (nloc == 0u) { xcd_barrier_complete(bar, b.x, nloc, nx); b.st[0] = nloc; b.st[1] = nx; }
        const unsigned old = xb_add(&bar[XB_XSUB(b.x)], 1u);
        const unsigned gen = old / nloc;
        if (old + 1u == (gen + 1u) * nloc) {
            __builtin_amdgcn_fence(__ATOMIC_RELEASE, "agent");
            asm volatile("s_waitcnt vmcnt(0)" ::: "memory");
            const unsigned og = xb_add(&bar[XB_TOP], 1u);
            const unsigned tg = og / nx;
            if (og + 1u == (tg + 1u) * nx) xb_add(&bar[XB_TOPGEN], 1u);
            else XB_SPIN(xb_ld(&bar[XB_TOPGEN]) == tg, bar);
            __builtin_amdgcn_fence(__ATOMIC_ACQUIRE, "agent");
            xb_add(&bar[XB_XGEN(b.x)], 1u);
            asm volatile("s_waitcnt vmcnt(0)" ::: "memory");
        } else {
            XB_SPIN(xb_ld(&bar[XB_XGEN(b.x)]) == gen, bar);
            __builtin_amdgcn_fence(__ATOMIC_ACQUIRE, "agent");
            asm volatile("s_waitcnt vmcnt(0)" ::: "memory");
        }
    }
    __syncthreads();
}
struct Args { const float* in[11]; float* out; unsigned char* ws; int ph_lo, ph_hi; };
constexpr int NPHASE = 7;

__global__ void __launch_bounds__(NWAVES * 64, 2) mk_fwd(Args args) {
    extern __shared__ __attribute__((aligned(16))) unsigned char lds[];
    LAS unsigned char* ldsl = (LAS unsigned char*)lds;
    const int wave = __builtin_amdgcn_readfirstlane((int)threadIdx.x >> 6);
    const int G = gridDim.x, bx = blockIdx.x;
    const int vcu = (G % 8 == 0) ? (bx % 8) * (G / 8) + bx / 8 : bx;
    const int gw = vcu * NWAVES + wave, NGW = G * NWAVES;
    unsigned char* ws = args.ws;
    const float* x = args.in[0]; const float* g_attn = args.in[1]; const float* w_in = args.in[2]; const float* lambda_qk = args.in[3]; const float* subln = args.in[4];
    const float* w_out = args.in[5]; const float* g_ffn = args.in[6]; const float* w_gate = args.in[7]; const float* w_up = args.in[8]; const float* w_down = args.in[9];
    const float* g_final = args.in[10];
    float* out = args.out;
    float* SS1 = (float*)(ws + WS_SS1); float* SS2 = (float*)(ws + WS_SS2); float* LSE = (float*)(ws + WS_LSE);
    bf16* QKV = (bf16*)(ws + WS_QKV); bf16* WGU = (bf16*)(ws + WS_WGU); bf16* WDN = (bf16*)(ws + WS_WDN); bf16* HB = (bf16*)(ws + WS_H);
    bf16* WIN = (bf16*)(ws + WS_WIN); bf16* XN = (bf16*)(ws + WS_XN); bf16* OA = (bf16*)(ws + WS_OA); bf16* WOUT = (bf16*)(ws + WS_WOUT);
    bf16* OB = (bf16*)(ws + WS_OB); bf16* XG = (bf16*)(ws + WS_XG); bf16* Y = (bf16*)(ws + WS_Y);
    const int lo = args.ph_lo, hi_ph = args.ph_hi;
#define IN(k) (lo <= (k) && (k) < hi_ph)
    if (wave == 0) { const int l0 = mk_lane(); if (l0 < 32) ((LAS unsigned*)(ldsl + MISC_OFF))[l0] = 0u; }
    __syncthreads();
    XcdBarrier bar; bar.bar = (unsigned*)(ws + WS_BAR); bar.x = 0; bar.st = nullptr;
    if (hi_ph - lo > 1) bar = xcd_barrier_post((unsigned*)(ws + WS_BAR), (volatile LAS unsigned*)(ldsl + MISC_OFF), wave);
    if (lo < -1000) cg::this_grid().sync();
#define SEAM(k) do { if (IN(k) && IN((k) + 1)) { for (int rb = 0; rb < (MK_DUP_PHASE == 30 ? 3 : 1); ++rb) xcd_barrier(bar, wave); } } while (0)

    if (IN(0)) for (int rep = 0; rep < NREP(0); ++rep) { const int lane = mk_lane(), tid = wave * 64 + lane;
        LAS float* scr = (LAS float*)(ldsl + wave * 16384);
        constexpr int I_IN = (DM / 64) * (NIN / 32), I_OUT = (DM / 64) * (DM / 32);
        for (int it = gw; it < I_IN; it += NGW) {
            if (it < I_IN) { const int nblk = NIN / 32, kb = it / nblk, nb = it % nblk; transpose_item(w_in, DM, NIN, WIN, 64 * kb, 32 * nb, 32 * nb, scr, lane); }
            else { const int r = it - I_IN; const int nblk = DM / 32, kb = r / nblk, nb = r % nblk; transpose_item(w_out, DM, DM, WOUT, 64 * kb, 32 * nb, 32 * nb, scr, lane); }
        }
        for (int m = gw; m < M; m += NGW) {
            const GAS f32x4* xr = (const GAS f32x4*)(x + (size_t)m * DM) + lane;
            f32x4 v[8]; float s = 0.f;
#pragma unroll
            for (int j = 0; j < 8; ++j) { v[j] = xr[64 * j]; s += (v[j].x * v[j].x + v[j].y * v[j].y) + (v[j].z * v[j].z + v[j].w * v[j].w); }
            const float rstd = 1.0f / sqrtf(wave_sum(s) * (1.f / DM) + RMS_EPS);
            GAS unsigned long long* o8 = (GAS unsigned long long*)(XN + (size_t)m * DM) + lane;
#pragma unroll
            for (int j = 0; j < 8; ++j) { const f32x4 gg = *((const GAS f32x4*)g_attn + lane + 64 * j);
                o8[64 * j] = (unsigned long long)pk2(v[j].x * rstd * gg.x, v[j].y * rstd * gg.y) | ((unsigned long long)pk2(v[j].z * rstd * gg.z, v[j].w * rstd * gg.w) << 32); }
        }
        for (int i = bx * (NWAVES * 64) + tid; i < M; i += G * NWAVES * 64) { SS1[i] = 0.f; SS2[i] = 0.f; }
    }
    SEAM(0);
    if (IN(1)) {
        pg8::Gemm g{XN, WIN, M, NIN, DM}; pg8::StaticOrder S; S.init(M, NIN, G, bx); S.dup = NREP(1);
        pg8::EpiQKV E{QKV, NIN};
        pg8::gemm_phase<pg8::EpiQKV, pg8::StaticOrder, true, true>(ldsl, g, S, E, wave);
    }
    SEAM(1);
    if (IN(2)) { const int lane = mk_lane();
        float lam;
        { const float a = lambda_qk[lane] * lambda_qk[64 + lane], b2 = lambda_qk[128 + lane] * lambda_qk[192 + lane];
          lam = __expf(wave_sum(a)) - __expf(wave_sum(b2)) + LAM_INIT; }
        const int grp = vcu >> 3, k = vcu & 7, gb = grp >> 3, gh = grp & 7;
        const att::bf16* rowb = (const att::bf16*)QKV + (size_t)gb * SEQ * NIN;
        att::ConvJob cj{w_gate, w_up, w_down, w_out, g_ffn, WGU, WDN, WOUT, vcu, vcu + G * ((att::CV_TOTAL - 1 - vcu) / G), G};
        for (int i = 0; i < 2 * NREP(20); ++i) {
            const int c = i & 1;
            att::attn_dense_body(rowb + (size_t)k * 256 * NIN + 3072 + gh * HD, rowb + 4096 + gh * HD, rowb + 5120 + gh * HD, nullptr, 1024, 4 * c, SEQ, (char*)lds, wave, cj,
                                 c == 1, Y + ((size_t)gb * SEQ + k * 256) * DM + 1024 + gh * HD, lam, subln);
        }
        __syncthreads();
        { float* scr = (float*)((char*)lds + RING_BYTES) + wave * 64;
          for (int rep = 0; rep < NREP(21); ++rep) {
            att::swa_wg_unit((const att::bf16*)QKV, 0, gb * 8 + gh, 8 * k, 0, OA, LSE, (char*)lds, scr, wave);
            att::swa_wg_unit((const att::bf16*)QKV, 1, (gb * 4 + (k >> 1)) * 8 + gh, 8 * (k & 1), 0, OA + (size_t)M * 1024, LSE + (size_t)M * 8, (char*)lds, scr, wave);
            att::swa_wg_unit((const att::bf16*)QKV, 2, (gb * 16 + 2 * k) * 8 + gh, 0, 8, OA + (size_t)2 * M * 1024, LSE + (size_t)2 * M * 8, (char*)lds, scr, wave);
          } }
        asm volatile("s_waitcnt vmcnt(0)" ::: "memory"); __syncthreads();
        if (wave == 0 && lane == 0) {
            unsigned* gc = (unsigned*)(ws + WS_GRP) + 64 * grp;
            __builtin_amdgcn_fence(__ATOMIC_RELEASE, "agent"); asm volatile("s_waitcnt vmcnt(0)" ::: "memory");
            __hip_atomic_fetch_add(gc, 1u, __ATOMIC_RELAXED, __HIP_MEMORY_SCOPE_AGENT);
            unsigned sp = 0; while (__hip_atomic_load(gc, __ATOMIC_RELAXED, __HIP_MEMORY_SCOPE_AGENT) < 8u) { __builtin_amdgcn_s_sleep(2); if (++sp > (1u << 22)) break; }
            __builtin_amdgcn_fence(__ATOMIC_ACQUIRE, "agent"); asm volatile("s_waitcnt vmcnt(0)" ::: "memory");
        }
        __syncthreads();
        { const int col = (lane & 15) * 8;
#pragma unroll 2
          for (int it = 0; it < 8; ++it) {
            const size_t m = (size_t)gb * SEQ + k * 256 + wave * 32 + it * 4 + (lane >> 4);
            const float l0 = LSE[m * 8 + gh], l1 = LSE[((size_t)M + m) * 8 + gh], l2 = LSE[((size_t)2 * M + m) * 8 + gh];
            const float mx = fmaxf(l0, fmaxf(l1, l2)); float w0 = __expf(l0 - mx), w1 = __expf(l1 - mx), w2 = __expf(l2 - mx);
            const float inv = 1.0f / (w0 + w1 + w2); w0 *= inv; w1 *= inv; w2 *= inv;
            const v4u a0 = *(const GAS v4u*)(OA + m * 1024 + gh * HD + col), a1 = *(const GAS v4u*)(OA + ((size_t)M + m) * 1024 + gh * HD + col), a2 = *(const GAS v4u*)(OA + ((size_t)2 * M + m) * 1024 + gh * HD + col);
            v4u ya;
#pragma unroll
            for (int i = 0; i < 4; ++i) ya[i] = pk2(w0 * bflo(a0[i]) + w1 * bflo(a1[i]) + w2 * bflo(a2[i]), w0 * bfhi(a0[i]) + w1 * bfhi(a1[i]) + w2 * bfhi(a2[i]));
            *(GAS v4u*)(Y + m * DM + gh * HD + col) = ya;
          } }
        __syncthreads();
    }
    SEAM(2);
    if (IN(4)) {
        pg8::Gemm g{Y, WOUT, M, DM, DM}; pg8::StaticOrder S; S.init(M, DM, G, bx); S.dup = NREP(4);
        pg8::EpiOut E{x, XG, g_ffn, SS1, DM};
        pg8::gemm_phase<pg8::EpiOut, pg8::StaticOrder, true, true>(ldsl, g, S, E, wave);
    }
    SEAM(4);
    if (IN(5)) {
        pg8::Gemm g{XG, WGU, M, NGU, DM}; pg8::StaticOrder S; S.init(M, NGU, G, bx); S.dup = NREP(5);
        S.split_from = -1  ; S.kh_bytes = (DM / 2) * 2; S.kh_nt = DM / 128;
        pg8::EpiGateUp E{HB, DFF, SS1, 1.0f / DM, RMS_EPS, (pg8::f32x4*)(ws + WS_Y), (unsigned*)(ws + WS_FLAG)};
        pg8::gemm_phase<pg8::EpiGateUp, pg8::StaticOrder, true, true>(ldsl, g, S, E, wave);
    }
    SEAM(5);
    if (IN(6)) {
        pg8::Gemm g{HB, WDN, M, DM, DFF}; pg8::StaticOrder S; S.init(M, DM, G, bx);
        pg8::EpiDownNorm E{XG, g_ffn, out, g_final, SS2, (unsigned*)(ws + WS_CNT), DM, 1.0f / DM, RMS_EPS};
        pg8::gemm_phase<pg8::EpiDownNorm, pg8::StaticOrder, false, true>(ldsl, g, S, E, wave);
    }
#undef IN
#undef SEAM
}

extern "C" void kernel_launch(void* const* d_in, const int* in_sizes, int n_in, void* d_out, int out_size, void* d_ws, size_t ws_size, hipStream_t stream) {
    static int grid = 0;
    if (grid == 0) {
        if (n_in != 11 || in_sizes[0] != M * DM || out_size != M * DM || ws_size < WS_END) { fprintf(stderr, "kernel_launch: shape/workspace mismatch (n_in %d, in0 %d, out %d, ws %zu)\n", n_in, n_in > 0 ? in_sizes[0] : -1, out_size, ws_size); grid = -1; return; }
        int dev = 0, cus = 0, per_cu = 0;
        if (hipGetDevice(&dev) != hipSuccess || hipDeviceGetAttribute(&cus, hipDeviceAttributeMultiprocessorCount, dev) != hipSuccess) { grid = -1; return; }
        if (hipFuncSetAttribute((const void*)mk_fwd, hipFuncAttributeMaxDynamicSharedMemorySize, LDS_BYTES) != hipSuccess) { fprintf(stderr, "kernel_launch: hipFuncSetAttribute failed\n"); grid = -1; return; }
        if (hipOccupancyMaxActiveBlocksPerMultiprocessor(&per_cu, (const void*)mk_fwd, NWAVES * 64, LDS_BYTES) != hipSuccess || per_cu < 1) { fprintf(stderr, "kernel_launch: occupancy query says %d\n", per_cu); per_cu = 1; }
        (void)hipGetLastError();
        grid = cus;
        if (grid != 256) { fprintf(stderr, "kernel_launch: this kernel needs a 256-CU device (got %d)\n", cus); grid = -1; return; }
    }
    if (grid < 0) return;
    Args a{};
    for (int i = 0; i < 11; ++i) a.in[i] = (const float*)d_in[i];
    a.out = (float*)d_out; a.ws = (unsigned char*)d_ws;
#if MK_ONE_LAUNCH
    if (hipMemsetAsync((char*)d_ws + WS_BAR, 0, BAR_BYTES, stream) != hipSuccess) { fprintf(stderr, "kernel_launch: memset failed\n"); return; }
    a.ph_lo = 0; a.ph_hi = NPHASE;
    void* kargs[] = {&a};
    hipError_t e = hipLaunchCooperativeKernel((const void*)mk_fwd, dim3(grid), dim3(NWAVES * 64), kargs, LDS_BYTES, stream);
    if (e != hipSuccess) fprintf(stderr, "kernel_launch: cooperative launch failed: %s (grid %d)\n", hipGetErrorString(e), grid);
#else
    for (int p = 0; p < NPHASE; ++p) {
        a.ph_lo = p; a.ph_hi = p + 1;
        hipLaunchKernelGGL(mk_fwd, dim3(grid), dim3(NWAVES * 64), LDS_BYTES, stream, a);
    }
#endif
}
```

```cpp
#include <hip/hip_runtime.h>
#include <hip/hip_cooperative_groups.h>
#include <hip/hip_bf16.h>
#include <cstdio>
#include <cstdint>
#include <cmath>
namespace cg = cooperative_groups;
__device__ __forceinline__ int mk_lane() { int l; asm volatile("v_mbcnt_lo_u32_b32 %0, -1, 0\n\tv_mbcnt_hi_u32_b32 %0, -1, %0" : "=v"(l)); return l & 63; }
namespace pg8 {
#define PG8_LAS __attribute__((address_space(3)))
typedef unsigned short bf16_t;
typedef short bf16x8 __attribute__((ext_vector_type(8)));
typedef float f32x4 __attribute__((ext_vector_type(4)));
typedef unsigned u32x4 __attribute__((ext_vector_type(4)));
constexpr int BM = 256, BK = 64, HALF = 128, HTB = HALF * BK * 2  , STAGE_BYTES = 8 * HTB, NXCD = 8, WGM = 8;

__host__ __device__ __forceinline__ int lds_byte(int r, int c) { const int st = (r >> 4) * 2 + (c >> 5), rr = r & 15, cc = c & 31, ob = rr * 64 + cc * 2; return st * 1024 + (ob ^ (((ob >> 9) & 1) << 5)); }
__host__ __device__ __forceinline__ void stage_rc(int b, int& R, int& C) { const int st = b / 1024, sb = b % 1024, swz = sb ^ (((sb >> 9) & 1) << 5); R = (st >> 1) * 16 + swz / 64; C = (st & 1) * 32 + (swz % 64) / 2; }
__host__ __device__ __forceinline__ int perm32(int rho) { const int n = rho >> 4, i = rho & 15; return 8 * (i >> 2) + 4 * n + (i & 3); }

struct Unit { int pm, pn, first, khalf, koff, nt, ul; };
struct Gemm { const bf16_t* A; const bf16_t* Bt; int M, N, K; };

struct StaticOrder {
    int nM, nN, nwg, G, c, dup, split_from, kh_bytes, kh_nt;
    __host__ __device__ void init(int M, int N, int G_, int c_) { nM = M / BM; nN = N / BM; nwg = nM * nN; G = G_; c = c_; dup = 1; split_from = -1; kh_bytes = 0; kh_nt = 0; }
    __host__ __device__ bool next(int i, Unit& u) const {
        long L = (long)(i / dup) * G + c; u.khalf = 0; u.koff = 0; u.nt = 0; u.ul = 0;
        if (split_from >= 0 && (long)(i / dup) * G >= split_from) {
            if ((long)(i / dup) * G > split_from) return false;
            u.ul = c >> 1; L = split_from + u.ul; u.khalf = 1 + (c & 1); u.koff = (c & 1) ? kh_bytes : 0; u.nt = kh_nt; }
        if (L >= nwg) return false;
        int wgid = (int)L; { const int q = nwg / NXCD, r = nwg % NXCD, xcd = wgid % NXCD, off = wgid / NXCD; wgid = (xcd < r ? xcd * (q + 1) : r * (q + 1) + (xcd - r) * q) + off; }
        const int nig = WGM * nN, gid = wgid / nig, fm = gid * WGM, gsz = (nM - fm) < WGM ? (nM - fm) : WGM;
        u.pm = fm + ((wgid % nig) % gsz); u.pn = (wgid % nig) / gsz; u.first = (i % dup) == 0; return true;
    }
    __device__ __forceinline__ void a_ready(const Unit&) const {}
    __device__ __forceinline__ void done(const Unit&) const {}
};

__device__ __forceinline__ unsigned cvt_pk_bf16(float lo, float hi) { unsigned r; asm volatile("v_cvt_pk_bf16_f32 %0, %1, %2" : "=v"(r) : "v"(lo), "v"(hi)); return r; }
typedef float f32x2 __attribute__((ext_vector_type(2)));
__device__ __forceinline__ float invf_a(int f) {
    constexpr float T[16] = {1.0f, 0.4403666f, 0.19392274f, 0.0853971f, 0.03760603f, 0.01656044f, 0.0072926646f, 0.003211446f,
                             0.0014142136f, 0.00062277244f, 0.0002742482f, 0.000120769735f, 5.3182957e-05f, 2.342e-05f, 1.0313385e-05f, 4.5416705e-06f};
    return T[f];
}
__device__ __forceinline__ void sincos_rev(float ang, float& s, float& c) {
    const float rev = ang * 0.15915494309189535f; const float fr = rev - __builtin_floorf(rev);
    s = __builtin_amdgcn_sinf(fr); c = __builtin_amdgcn_cosf(fr);
}
struct EpiQKV {
    static constexpr bool PERM = true, AFTER_DRAIN = false;
    bf16_t* O; int ldc;
    __device__ __forceinline__ void operator()(const f32x4 (&acc)[2][2][4][2], const Unit& u, int wr, int wc, int fr, int fq) const {
        const int row0 = u.pm * BM + wr * 64 + fr;
        const int sec = u.pn >> 2;
        const int col0 = u.pn * BM + wc * 32 + 8 * fq;
        const bool ropeA = (sec <= 1) && (wc == 0);
        const bool ropeB = (sec == 3 || sec == 4) && ((wc & 1) == 0);
#pragma unroll
        for (int ai = 0; ai < 2; ++ai)
#pragma unroll
            for (int m = 0; m < 4; ++m) {
                const int row = row0 + ai * HALF + m * 16;
                const float pos = (float)(row & 2047);
                bf16_t* rowp = O + (size_t)row * ldc + col0;
                float cs[8], sn[8];
                if (ropeA) {
                    const int fb = 8 * (fq & 1);
#pragma unroll
                    for (int i = 0; i < 8; ++i) { float f0 = invf_a(i), f1 = invf_a(8 + i); sincos_rev(pos * (fb ? f1 : f0), sn[i], cs[i]); }
                    const float sg = (fq >= 2) ? 1.f : -1.f;
#pragma unroll
                    for (int i = 0; i < 8; ++i) sn[i] *= sg;
                } else if (ropeB) {
#pragma unroll
                    for (int i = 0; i < 8; ++i) sincos_rev(pos * invf_a(2 * i), sn[i], cs[i]);
                    const float sg = (fq == 1) ? 1.f : -1.f;
#pragma unroll
                    for (int i = 0; i < 8; ++i) sn[i] *= sg;
                }
#pragma unroll
                for (int bj = 0; bj < 2; ++bj) {
                    f32x4 v0 = acc[ai][bj][m][0], v1 = acc[ai][bj][m][1];
                    if (ropeA) {
                        f32x4 p0, p1;
#pragma unroll
                        for (int i = 0; i < 4; ++i) { p0[i] = __shfl_xor(v0[i], 32); p1[i] = __shfl_xor(v1[i], 32); }
#pragma unroll
                        for (int i = 0; i < 4; ++i) { v0[i] = v0[i] * cs[i] + p0[i] * sn[i]; v1[i] = v1[i] * cs[4 + i] + p1[i] * sn[4 + i]; }
                    } else if (ropeB) {
                        f32x4 p0, p1;
#pragma unroll
                        for (int i = 0; i < 4; ++i) { p0[i] = __shfl_xor(v0[i], 16); p1[i] = __shfl_xor(v1[i], 16); }
                        if (fq < 2) {
#pragma unroll
                            for (int i = 0; i < 4; ++i) { v0[i] = v0[i] * cs[i] + p0[i] * sn[i]; v1[i] = v1[i] * cs[4 + i] + p1[i] * sn[4 + i]; }
                        }
                    }
                    u32x4 w; w.x = cvt_pk_bf16(v0[0], v0[1]); w.y = cvt_pk_bf16(v0[2], v0[3]); w.z = cvt_pk_bf16(v1[0], v1[1]); w.w = cvt_pk_bf16(v1[2], v1[3]);
                    *(u32x4*)(rowp + bj * HALF) = w;
                }
            }
    }
};
struct EpiOut {
    static constexpr bool PERM = false, AFTER_DRAIN = false;
    const float* base; bf16_t* xg; const float* g; float* ss; int ldc;
    __device__ __forceinline__ void operator()(const f32x4 (&acc)[2][2][4][2], const Unit& u, int wr, int wc, int fr, int fq) const {
        typedef unsigned u32x2v __attribute__((ext_vector_type(2)));
        const int col0 = u.pn * BM + wc * 32 + 4 * fq;
        f32x4 gv[2][2];
#pragma unroll
        for (int bj = 0; bj < 2; ++bj)
#pragma unroll
            for (int n = 0; n < 2; ++n) gv[bj][n] = *(const f32x4*)(g + col0 + bj * HALF + n * 16);
#pragma unroll
        for (int ai = 0; ai < 2; ++ai)
#pragma unroll
            for (int m = 0; m < 4; ++m) {
                const int row = u.pm * BM + ai * HALF + wr * 64 + m * 16 + fr; const size_t off = (size_t)row * ldc + col0; float s = 0.f;
#pragma unroll
                for (int bj = 0; bj < 2; ++bj)
#pragma unroll
                    for (int n = 0; n < 2; ++n) {
                        const f32x4 x1 = *(const f32x4*)(base + off + bj * HALF + n * 16) + acc[ai][bj][m][n];
                        s += (x1[0] * x1[0] + x1[1] * x1[1]) + (x1[2] * x1[2] + x1[3] * x1[3]);
                        const f32x4 y = x1 * gv[bj][n]; u32x2v w; w.x = cvt_pk_bf16(y[0], y[1]); w.y = cvt_pk_bf16(y[2], y[3]);
                        *(u32x2v*)(xg + off + bj * HALF + n * 16) = w;
                    }
                s += __shfl_xor(s, 16); s += __shfl_xor(s, 32);
                if (fq == 0 && u.first) atomicAdd(ss + row, s);
            }
    }
};
struct EpiGateUp {
    static constexpr bool PERM = true, AFTER_DRAIN = false;
    bf16_t* H; int ldh; const float* ss; float inv_n, eps; f32x4* part; unsigned* flag;
    __device__ __forceinline__ void operator()(const f32x4 (&acc)[2][2][4][2], const Unit& u, int wr, int wc, int fr, int fq) const {
        const int tid = (wr * 4 + wc) * 64 + fq * 16 + fr;
        f32x4* pp = part + (size_t)u.ul * (32 * 512) + tid;
        if (u.khalf == 1) {
#pragma unroll
            for (int ai = 0; ai < 2; ++ai)
#pragma unroll
                for (int bj = 0; bj < 2; ++bj)
#pragma unroll
                    for (int m = 0; m < 4; ++m)
#pragma unroll
                        for (int n = 0; n < 2; ++n) pp[(size_t)(((ai * 2 + bj) * 4 + m) * 2 + n) * 512] = acc[ai][bj][m][n];
            asm volatile("s_waitcnt vmcnt(0)" ::: "memory"); __builtin_amdgcn_s_barrier(); asm volatile("" ::: "memory");
            if (tid == 0) { __builtin_amdgcn_fence(__ATOMIC_RELEASE, "agent"); asm volatile("s_waitcnt vmcnt(0)" ::: "memory");
                __hip_atomic_store(flag + 16 * u.ul, 1u, __ATOMIC_RELAXED, __HIP_MEMORY_SCOPE_AGENT); }
            return;
        }
        if (u.khalf == 2) {
            if (tid < 64) { unsigned sp = 0;
                while ((unsigned)__builtin_amdgcn_readfirstlane(__hip_atomic_load(flag + 16 * u.ul, __ATOMIC_RELAXED, __HIP_MEMORY_SCOPE_AGENT)) == 0u) { __builtin_amdgcn_s_sleep(2); if (++sp > (1u << 22)) break; }
                __builtin_amdgcn_fence(__ATOMIC_ACQUIRE, "agent"); asm volatile("s_waitcnt vmcnt(0)" ::: "memory"); }
            asm volatile("s_waitcnt vmcnt(0) lgkmcnt(0)" ::: "memory"); __builtin_amdgcn_s_barrier(); asm volatile("" ::: "memory");
        }
        const int col0 = u.pn * HALF + wc * 32 + 8 * fq;
#pragma unroll
        for (int ai = 0; ai < 2; ++ai)
#pragma unroll
            for (int m = 0; m < 4; ++m) {
                const int row = u.pm * BM + ai * HALF + wr * 64 + m * 16 + fr;
                const float rstd = 1.0f / sqrtf(ss[row] * inv_n + eps);
                f32x4 gq[2], uq[2];
#pragma unroll
                for (int n = 0; n < 2; ++n) { gq[n] = acc[ai][0][m][n]; uq[n] = acc[ai][1][m][n]; }
                if (u.khalf == 2) {
#pragma unroll
                    for (int n = 0; n < 2; ++n) { gq[n] += pp[(size_t)(((ai * 2 + 0) * 4 + m) * 2 + n) * 512]; uq[n] += pp[(size_t)(((ai * 2 + 1) * 4 + m) * 2 + n) * 512]; }
                }
                float hv[8];
#pragma unroll
                for (int n = 0; n < 2; ++n)
#pragma unroll
                    for (int i = 0; i < 4; ++i) { const float gg = gq[n][i] * rstd, uu = uq[n][i] * rstd;
                        hv[4 * n + i] = gg * __builtin_amdgcn_rcpf(1.0f + __builtin_amdgcn_exp2f(-1.4426950408889634f * gg)) * uu; }
                u32x4 w; w.x = cvt_pk_bf16(hv[0], hv[1]); w.y = cvt_pk_bf16(hv[2], hv[3]); w.z = cvt_pk_bf16(hv[4], hv[5]); w.w = cvt_pk_bf16(hv[6], hv[7]);
                *(u32x4*)(H + (size_t)row * ldh + col0) = w;
            }
    }
};
struct EpiDown {
    static constexpr bool PERM = false, AFTER_DRAIN = false;
    const bf16_t* base; float* out; float* ss; int ldc;
    __device__ __forceinline__ void operator()(const f32x4 (&acc)[2][2][4][2], const Unit& u, int wr, int wc, int fr, int fq) const {
        typedef unsigned u32x2v __attribute__((ext_vector_type(2)));
        const int col0 = u.pn * BM + wc * 32 + 4 * fq;
#pragma unroll
        for (int ai = 0; ai < 2; ++ai)
#pragma unroll
            for (int m = 0; m < 4; ++m) {
                const int row = u.pm * BM + ai * HALF + wr * 64 + m * 16 + fr; const size_t off = (size_t)row * ldc + col0; float s = 0.f;
#pragma unroll
                for (int bj = 0; bj < 2; ++bj)
#pragma unroll
                    for (int n = 0; n < 2; ++n) {
                        const u32x2v rb = *(const u32x2v*)(base + off + bj * HALF + n * 16);
                        f32x4 x2 = acc[ai][bj][m][n];
                        x2[0] += __uint_as_float(rb.x << 16); x2[1] += __uint_as_float(rb.x & 0xffff0000u); x2[2] += __uint_as_float(rb.y << 16); x2[3] += __uint_as_float(rb.y & 0xffff0000u);
                        *(f32x4*)(out + off + bj * HALF + n * 16) = x2;
                        s += (x2[0] * x2[0] + x2[1] * x2[1]) + (x2[2] * x2[2] + x2[3] * x2[3]);
                    }
                s += __shfl_xor(s, 16); s += __shfl_xor(s, 32);
                if (fq == 0 && u.first) atomicAdd(ss + row, s);
            }
    }
};
struct EpiDownNorm {
    static constexpr bool PERM = false, AFTER_DRAIN = true;
    const bf16_t* base; const float* gres; float* out; const float* g; float* ss; unsigned* cnt; int ldc; float inv_n, eps;
    __device__ __forceinline__ void fused(f32x4 (&acc)[2][2][4][2], const Unit& u, int wr, int wc, int fr, int fq, PG8_LAS unsigned char* lds, int wid, int lane) const {
        typedef unsigned u32x2v __attribute__((ext_vector_type(2)));
        const int col0 = u.pn * BM + wc * 32 + 4 * fq;
        f32x4 rg[2][2];
#pragma unroll
        for (int bj = 0; bj < 2; ++bj)
#pragma unroll
            for (int n = 0; n < 2; ++n) { const f32x4 t = *(const f32x4*)(gres + col0 + bj * HALF + n * 16); rg[bj][n] = (f32x4){1.0f / t[0], 1.0f / t[1], 1.0f / t[2], 1.0f / t[3]}; }
#pragma unroll
        for (int ai = 0; ai < 2; ++ai)
#pragma unroll
            for (int m = 0; m < 4; ++m) {
                const int row = u.pm * BM + ai * HALF + wr * 64 + m * 16 + fr; const size_t off = (size_t)row * ldc + col0; float s = 0.f;
#pragma unroll
                for (int bj = 0; bj < 2; ++bj)
#pragma unroll
                    for (int n = 0; n < 2; ++n) {
                        const u32x2v rb = *(const u32x2v*)(base + off + bj * HALF + n * 16);
                        f32x4 x2 = acc[ai][bj][m][n];
                        x2[0] += __uint_as_float(rb.x << 16) * rg[bj][n][0]; x2[1] += __uint_as_float(rb.x & 0xffff0000u) * rg[bj][n][1]; x2[2] += __uint_as_float(rb.y << 16) * rg[bj][n][2]; x2[3] += __uint_as_float(rb.y & 0xffff0000u) * rg[bj][n][3];
                        acc[ai][bj][m][n] = x2;
                        s += (x2[0] * x2[0] + x2[1] * x2[1]) + (x2[2] * x2[2] + x2[3] * x2[3]);
                    }
                s += __shfl_xor(s, 16); s += __shfl_xor(s, 32);
                if (fq == 0) atomicAdd(ss + row, s);
            }
        asm volatile("s_waitcnt vmcnt(0)" ::: "memory");
        __builtin_amdgcn_s_barrier(); asm volatile("" ::: "memory");
        if (wid == 0) {
            unsigned* c = cnt + 64 * u.pm;
            if (lane == 0) __hip_atomic_fetch_add(c, 1u, __ATOMIC_RELAXED, __HIP_MEMORY_SCOPE_AGENT);
            unsigned sp = 0;
            while ((unsigned)__builtin_amdgcn_readfirstlane(__hip_atomic_load(c, __ATOMIC_RELAXED, __HIP_MEMORY_SCOPE_AGENT)) < 8u) { __builtin_amdgcn_s_sleep(2); if (++sp > (1u << 22)) break; }
            __builtin_amdgcn_fence(__ATOMIC_ACQUIRE, "agent");
        }
        asm volatile("s_waitcnt vmcnt(0) lgkmcnt(0)" ::: "memory"); __builtin_amdgcn_s_barrier(); asm volatile("" ::: "memory");
        f32x4 gv[2][2];
#pragma unroll
        for (int bj = 0; bj < 2; ++bj)
#pragma unroll
            for (int n = 0; n < 2; ++n) gv[bj][n] = *(const f32x4*)(g + col0 + bj * HALF + n * 16);
#pragma unroll
        for (int ai = 0; ai < 2; ++ai)
#pragma unroll
            for (int m = 0; m < 4; ++m) {
                const int row = u.pm * BM + ai * HALF + wr * 64 + m * 16 + fr; const size_t off = (size_t)row * ldc + col0;
                const float rstd = 1.0f / sqrtf(__hip_atomic_load(ss + row, __ATOMIC_RELAXED, __HIP_MEMORY_SCOPE_AGENT) * inv_n + eps);
#pragma unroll
                for (int bj = 0; bj < 2; ++bj)
#pragma unroll
                    for (int n = 0; n < 2; ++n) *(f32x4*)(out + off + bj * HALF + n * 16) = acc[ai][bj][m][n] * rstd * gv[bj][n];
            }
    }
};
template <class Epi, class Sched, bool ALIGN_EPI = false, bool SP2 = false>
__device__ __forceinline__ void gemm_phase(PG8_LAS unsigned char* lds, const Gemm g, const Sched& S, const Epi& E, const int wave_in) {
    const int wid = wave_in, lane = mk_lane(), tid = wid * 64 + lane, wr = wid >> 2, wc = wid & 3, fr = lane & 15, fq = lane >> 4;
    const int K = g.K, nt = K / BK;
    unsigned voffA[2], voffB[2];
#pragma unroll
    for (int i = 0; i < 2; ++i) { int R, C; stage_rc(tid * 16 + i * 8192, R, C); const int Rb = Epi::PERM ? ((R & ~31) + perm32(R & 31)) : R;
        voffA[i] = (unsigned)(R * K + C) * 2u; voffB[i] = (unsigned)(Rb * K + C) * 2u; }
    const size_t kstep = (size_t)(BK * 2);
    const size_t hstep = (size_t)HALF * K * 2;
    const size_t tstep = 2 * hstep;
    const unsigned ldsw = (unsigned)wid * 1024u;
    const int aoff = lds_byte(wr * 64 + fr, fq * 8), boff = lds_byte(wc * 32 + fr, fq * 8);
#define PG8_SA(b, h) (((b) * 2 + (h)) * HTB)
#define PG8_SB(b, h) ((4 + (b) * 2 + (h)) * HTB)
#define PG8_STAGE(bufoff, gbase, voff) do { _Pragma("unroll") for (int _i = 0; _i < 2; ++_i) \
        __builtin_amdgcn_global_load_lds((const unsigned*)((const char*)(gbase) + (voff)[_i]), (PG8_LAS unsigned*)(lds + (bufoff) + ldsw + _i * 8192), 16, 0, 0); } while (0)
#define PG8_LDA(dst, b, h) do { _Pragma("unroll") for (int m = 0; m < 4; ++m) _Pragma("unroll") for (int k = 0; k < 2; ++k) dst[m][k] = *(const PG8_LAS bf16x8*)(lds + PG8_SA(b, h) + aoff + m * 2048 + k * 1024); } while (0)
#define PG8_LDB(dst, b, h) do { _Pragma("unroll") for (int n = 0; n < 2; ++n) _Pragma("unroll") for (int k = 0; k < 2; ++k) dst[n][k] = *(const PG8_LAS bf16x8*)(lds + PG8_SB(b, h) + boff + n * 2048 + k * 1024); } while (0)
#define PG8_MMA(ai, bj, At, Bt) do { __builtin_amdgcn_s_setprio(1); _Pragma("unroll") for (int m = 0; m < 4; ++m) _Pragma("unroll") for (int n = 0; n < 2; ++n) _Pragma("unroll") for (int k = 0; k < 2; ++k) \
        acc[ai][bj][m][n] = __builtin_amdgcn_mfma_f32_16x16x32_bf16(Bt[n][k], At[m][k], acc[ai][bj][m][n], 0, 0, 0); __builtin_amdgcn_s_setprio(0); } while (0)
#define PG8_WAIT_V(n) asm volatile("s_waitcnt vmcnt(" #n ")" ::: "memory")
#define PG8_WAIT_L(n) asm volatile("s_waitcnt lgkmcnt(" #n ")" ::: "memory")
#define PG8_BAR __builtin_amdgcn_s_barrier()
#define PG8_SCHED __builtin_amdgcn_sched_barrier(0)
    Unit cur, nxt; int ui = 0;
    if (!S.next(0, cur)) return;
    f32x4 acc[2][2][4][2];
#pragma unroll
    for (int a = 0; a < 2; ++a)
#pragma unroll
        for (int b = 0; b < 2; ++b)
#pragma unroll
            for (int m = 0; m < 4; ++m)
#pragma unroll
                for (int n = 0; n < 2; ++n) acc[a][b][m][n] = (f32x4){0.f, 0.f, 0.f, 0.f};
    bf16x8 At[4][2], B0[2][2], B1[2][2];
    const char* cA = (const char*)g.A + (size_t)cur.pm * tstep + cur.koff; const char* cB = (const char*)g.Bt + (size_t)cur.pn * tstep + cur.koff; int ntc = cur.nt ? cur.nt : nt;
    S.a_ready(cur);
    if constexpr (SP2) {
        PG8_STAGE(PG8_SB(0, 0), cB, voffB); PG8_STAGE(PG8_SB(0, 1), cB + hstep, voffB); PG8_STAGE(PG8_SA(0, 0), cA, voffA); PG8_STAGE(PG8_SA(0, 1), cA + hstep, voffA);
        if (wr == 1) PG8_BAR;
        PG8_WAIT_V(2); PG8_BAR;
        PG8_STAGE(PG8_SB(1, 0), cB + kstep, voffB); PG8_STAGE(PG8_SA(1, 0), cA + kstep, voffA); PG8_STAGE(PG8_SB(1, 1), cB + hstep + kstep, voffB);
        PG8_WAIT_V(6); PG8_BAR;
    } else {
        PG8_STAGE(PG8_SB(0, 0), cB, voffB); PG8_STAGE(PG8_SA(0, 0), cA, voffA); PG8_STAGE(PG8_SB(0, 1), cB + hstep, voffB); PG8_STAGE(PG8_SA(0, 1), cA + hstep, voffA);
        if (wr == 1) PG8_BAR;
        PG8_WAIT_V(4); PG8_BAR;
        PG8_STAGE(PG8_SB(1, 0), cB + kstep, voffB); PG8_STAGE(PG8_SA(1, 0), cA + kstep, voffA); PG8_STAGE(PG8_SB(1, 1), cB + hstep + kstep, voffB);
        PG8_WAIT_V(6); PG8_BAR;
    }
    for (;;) {
        const bool has_next = S.next(ui + 1, nxt);
        const char* nA = has_next ? (const char*)g.A + (size_t)nxt.pm * tstep + nxt.koff : cA; const char* nB = has_next ? (const char*)g.Bt + (size_t)nxt.pn * tstep + nxt.koff : cB;
        for (int t = 0; t < ntc; t += 2) {
            const bool last = (t == ntc - 2);
            const char* a1 = cA + (size_t)(t + 1) * kstep;
            const char* a2 = last ? nA : cA + (size_t)(t + 2) * kstep; const char* b2 = last ? nB : cB + (size_t)(t + 2) * kstep;
            const char* a3 = a2 + kstep; const char* b3 = b2 + kstep;
            if (last && has_next) S.a_ready(nxt);
            if constexpr (SP2) {
            PG8_LDB(B0, 0, 0); PG8_LDB(B1, 0, 1); PG8_SCHED; PG8_LDA(At, 0, 0); PG8_STAGE(PG8_SA(1, 1), a1 + hstep, voffA);
            PG8_WAIT_V(8); PG8_WAIT_L(0); PG8_BAR; PG8_MMA(0, 0, At, B0); PG8_MMA(0, 1, At, B1); PG8_BAR; PG8_SCHED;
            PG8_LDA(At, 0, 1); PG8_STAGE(PG8_SB(0, 0), b2, voffB); PG8_STAGE(PG8_SB(0, 1), b2 + hstep, voffB); PG8_STAGE(PG8_SA(0, 0), a2, voffA);
            PG8_WAIT_V(8); PG8_WAIT_L(0); PG8_BAR; PG8_MMA(1, 0, At, B0); PG8_MMA(1, 1, At, B1); PG8_BAR; PG8_SCHED;
            PG8_LDB(B0, 1, 0); PG8_LDB(B1, 1, 1); PG8_SCHED; PG8_LDA(At, 1, 0); PG8_STAGE(PG8_SA(0, 1), a2 + hstep, voffA);
            PG8_WAIT_V(8); PG8_WAIT_L(0); PG8_BAR; PG8_MMA(0, 0, At, B0); PG8_MMA(0, 1, At, B1); PG8_BAR; PG8_SCHED;
            PG8_LDA(At, 1, 1); PG8_STAGE(PG8_SB(1, 0), b3, voffB); PG8_STAGE(PG8_SB(1, 1), b3 + hstep, voffB); PG8_STAGE(PG8_SA(1, 0), a3, voffA);
            PG8_WAIT_V(8); PG8_WAIT_L(0); PG8_BAR; PG8_MMA(1, 0, At, B0); PG8_MMA(1, 1, At, B1); PG8_BAR; PG8_SCHED;
            } else {
            PG8_LDB(B0, 0, 0); PG8_SCHED; PG8_LDA(At, 0, 0); PG8_STAGE(PG8_SA(1, 1), a1 + hstep, voffA);
            PG8_WAIT_L(8); PG8_BAR; PG8_WAIT_L(0); PG8_MMA(0, 0, At, B0); PG8_BAR; PG8_SCHED;
            PG8_LDB(B1, 0, 1); PG8_STAGE(PG8_SB(0, 0), b2, voffB);
            PG8_BAR; PG8_WAIT_L(0); PG8_MMA(0, 1, At, B1); PG8_BAR;
            PG8_LDA(At, 0, 1); PG8_STAGE(PG8_SA(0, 0), a2, voffA);
            PG8_BAR; PG8_WAIT_L(0); PG8_MMA(1, 0, At, B0); PG8_BAR; PG8_SCHED;
            PG8_STAGE(PG8_SB(0, 1), b2 + hstep, voffB);
            PG8_WAIT_V(6); PG8_BAR; PG8_MMA(1, 1, At, B1); PG8_BAR;
            PG8_LDB(B0, 1, 0); PG8_SCHED; PG8_LDA(At, 1, 0); PG8_STAGE(PG8_SA(0, 1), a2 + hstep, voffA);
            PG8_WAIT_L(8); PG8_BAR; PG8_WAIT_L(0); PG8_MMA(0, 0, At, B0); PG8_BAR; PG8_SCHED;
            PG8_LDB(B1, 1, 1); PG8_STAGE(PG8_SB(1, 0), b3, voffB);
            PG8_BAR; PG8_WAIT_L(0); PG8_MMA(0, 1, At, B1); PG8_BAR;
            PG8_LDA(At, 1, 1); PG8_STAGE(PG8_SA(1, 0), a3, voffA);
            PG8_BAR; PG8_WAIT_L(0); PG8_MMA(1, 0, At, B0); PG8_BAR; PG8_SCHED;
            PG8_STAGE(PG8_SB(1, 1), b3 + hstep, voffB);
            PG8_WAIT_V(6); PG8_BAR; PG8_MMA(1, 1, At, B1); PG8_BAR;
            }
        }
        if constexpr (ALIGN_EPI) { if (wr == 0) PG8_BAR; }
        if constexpr (!Epi::AFTER_DRAIN) { E(acc, cur, wr, wc, fr, fq); S.done(cur); }
        if (!has_next) break;
#pragma unroll
        for (int a = 0; a < 2; ++a)
#pragma unroll
            for (int b = 0; b < 2; ++b)
#pragma unroll
                for (int m = 0; m < 4; ++m)
#pragma unroll
                    for (int n = 0; n < 2; ++n) acc[a][b][m][n] = (f32x4){0.f, 0.f, 0.f, 0.f};
        cur = nxt; cA = nA; cB = nB; ++ui; ntc = cur.nt ? cur.nt : nt;
        if constexpr (ALIGN_EPI) { if (wr == 1) PG8_BAR; }
    }
    PG8_WAIT_V(0);
    if constexpr (!ALIGN_EPI) { if (wr == 0) PG8_BAR; }
    PG8_BAR;
    if constexpr (Epi::AFTER_DRAIN) { E.fused(acc, cur, wr, wc, fr, fq, lds, wid, lane); S.done(cur); }
#undef PG8_SA
#undef PG8_SB
#undef PG8_STAGE
#undef PG8_LDA
#undef PG8_LDB
#undef PG8_MMA
#undef PG8_WAIT_V
#undef PG8_WAIT_L
#undef PG8_BAR
#undef PG8_SCHED
}
}
namespace att {
using bf16 = __hip_bfloat16;
using bf16x8 = __attribute__((ext_vector_type(8))) short;
using s16x4  = __attribute__((ext_vector_type(4))) short;
using f32x16 = __attribute__((ext_vector_type(16))) float;
using u32x4  = __attribute__((ext_vector_type(4))) unsigned;
constexpr int D = 128, NW = 8, QBLK = 32, KVBLK = 64;
constexpr int LDR = 6144;
constexpr size_t SHM_V = KVBLK * D * 2, SHM_K = KVBLK * D * 2, SHM_ATTN = 2 * SHM_V + 2 * SHM_K + NW * 64 * 4;
#define KSWZ(row, colB) ((row) * 256 + ((colB) ^ (((row) & 7) << 4)))
#define SBAR() __builtin_amdgcn_sched_barrier(0)
__device__ __forceinline__ int crow(int r, int hi) { return (r & 3) + 8 * (r >> 2) + 4 * hi; }
__device__ __forceinline__ unsigned cvtpk(float lo, float hi) { unsigned r; asm volatile("v_cvt_pk_bf16_f32 %0, %1, %2" : "=v"(r) : "v"(lo), "v"(hi)); return r; }
__device__ __forceinline__ unsigned short f2bf1(float x) { return (unsigned short)(cvtpk(x, x) & 0xffffu); }
#define PK4(P, BASE, OUT) do { unsigned a0 = cvtpk(P[BASE + 0], P[BASE + 1]), a1 = cvtpk(P[BASE + 2], P[BASE + 3]);   \
    unsigned b0 = cvtpk(P[BASE + 4], P[BASE + 5]), b1 = cvtpk(P[BASE + 6], P[BASE + 7]);                              \
    auto r0 = __builtin_amdgcn_permlane32_swap(a0, b0, false, false); auto r1 = __builtin_amdgcn_permlane32_swap(a1, b1, false, false); \
    u32x4 w = {r0[0], r1[0], r0[1], r1[1]}; OUT = *reinterpret_cast<bf16x8*>(&w); } while (0)

template <int SCALE_E6>
struct SM {
    static constexpr float SCALE = SCALE_E6 == 125000 ? 0.125f : 0.088388347648318440f;
    static constexpr float THR = 8.f;
    static __device__ __forceinline__ void partialSM(f32x16& p0, f32x16& p1, float& m_reg, float& mn, float& alpha) {
        constexpr float C = SCALE * 1.4426950408889634f;
        float pmax = p0[0];
#pragma unroll
        for (int r = 1; r < 16; ++r) pmax = fmaxf(pmax, p0[r]);
#pragma unroll
        for (int r = 0; r < 16; ++r) pmax = fmaxf(pmax, p1[r]);
        { auto rr = __builtin_amdgcn_permlane32_swap(__float_as_uint(pmax), __float_as_uint(pmax), false, false);
          pmax = fmaxf(__uint_as_float(rr[0]), __uint_as_float(rr[1])); }
        if (__builtin_expect(__all(pmax - m_reg <= THR / SCALE), 1)) { mn = m_reg; alpha = 1.f; }
        else { mn = fmaxf(m_reg, pmax); alpha = __builtin_amdgcn_exp2f((m_reg - mn) * C); m_reg = mn; }
        float mnC = -mn * C;
#pragma unroll
        for (int r = 0; r < 16; ++r) p0[r] = fmaf(p0[r], C, mnC);
#pragma unroll
        for (int r = 0; r < 16; ++r) p1[r] = fmaf(p1[r], C, mnC);
#pragma unroll
        for (int r = 0; r < 16; ++r) p0[r] = __builtin_amdgcn_exp2f(p0[r]);
    }
};
__device__ __forceinline__ void finishSM(f32x16& p0, f32x16& p1, float alpha, float& l_reg, bf16x8& pa0, bf16x8& pa1, bf16x8& pa2, bf16x8& pa3) {
#pragma unroll
    for (int r = 0; r < 16; ++r) p1[r] = __builtin_amdgcn_exp2f(p1[r]);
    float ps = 0;
#pragma unroll
    for (int r = 0; r < 16; ++r) ps += p0[r];
#pragma unroll
    for (int r = 0; r < 16; ++r) ps += p1[r];
    { auto rr = __builtin_amdgcn_permlane32_swap(__float_as_uint(ps), __float_as_uint(ps), false, false);
      ps = __uint_as_float(rr[0]) + __uint_as_float(rr[1]); }
    l_reg = l_reg * alpha + ps;
    PK4(p0, 0, pa0); PK4(p0, 8, pa1); PK4(p1, 0, pa2); PK4(p1, 8, pa3);
}
template <int ND0>
__device__ __forceinline__ void qkt(f32x16& p0, f32x16& p1, const bf16* Ks, const bf16x8* qr, int dbase, int r32, int hi) {
    p0 = f32x16{}; p1 = f32x16{};
#pragma unroll
    for (int d0 = 0; d0 < ND0; ++d0) { int cb = ((dbase + d0) * 16 + hi * 8) * 2;
        bf16x8 b0 = *reinterpret_cast<const bf16x8*>((const char*)Ks + KSWZ(r32, cb));
        bf16x8 b1 = *reinterpret_cast<const bf16x8*>((const char*)Ks + KSWZ(32 + r32, cb));
        p0 = __builtin_amdgcn_mfma_f32_32x32x16_bf16(b0, qr[d0], p0, 0, 0, 0);
        p1 = __builtin_amdgcn_mfma_f32_32x32x16_bf16(b1, qr[d0], p1, 0, 0, 0); }
}
__device__ __forceinline__ int v_st(int k, int c) { const int kk = (k & ~0xC) | ((k & 4) << 1) | ((k & 8) >> 1); return ((kk >> 3) * 4 + (c >> 5)) * 512 + ((kk & 7) * 32 + (c & 31)) * 2; }
__device__ __forceinline__ int v_rd_base(int lane) { return ((lane & 3) << 3) | (((lane >> 2) & 3) << 6) | (((lane >> 4) & 1) << 5) | (((lane >> 5) & 1) << 8); }
constexpr int v_rd_off(int d0, int ks, int half) { return d0 * 512 + ks * 4096 + half * 2048; }
template <int OFF> __device__ __forceinline__ s16x4 tr_read(int vb) {
    s16x4 r; asm volatile("ds_read_b64_tr_b16 %0, %1 offset:%2" : "=&v"(r) : "v"(vb), "i"(OFF) : "memory"); return r;
}
#define PKV(L, H) (bf16x8){L[0], L[1], L[2], L[3], H[0], H[1], H[2], H[3]}
template <int D0> __device__ __forceinline__ void pv_one(f32x16& od, int vb, bf16x8 pa0, bf16x8 pa1, bf16x8 pa2, bf16x8 pa3) {
    const s16x4 l0 = tr_read<v_rd_off(D0, 0, 0)>(vb), h0 = tr_read<v_rd_off(D0, 0, 1)>(vb), l1 = tr_read<v_rd_off(D0, 1, 0)>(vb), h1 = tr_read<v_rd_off(D0, 1, 1)>(vb);
    const s16x4 l2 = tr_read<v_rd_off(D0, 2, 0)>(vb), h2 = tr_read<v_rd_off(D0, 2, 1)>(vb), l3 = tr_read<v_rd_off(D0, 3, 0)>(vb), h3 = tr_read<v_rd_off(D0, 3, 1)>(vb);
    asm volatile("s_waitcnt lgkmcnt(0)" ::: "memory"); SBAR();
    od = __builtin_amdgcn_mfma_f32_32x32x16_bf16(pa0, PKV(l0, h0), od, 0, 0, 0);
    od = __builtin_amdgcn_mfma_f32_32x32x16_bf16(pa1, PKV(l1, h1), od, 0, 0, 0);
    od = __builtin_amdgcn_mfma_f32_32x32x16_bf16(pa2, PKV(l2, h2), od, 0, 0, 0);
    od = __builtin_amdgcn_mfma_f32_32x32x16_bf16(pa3, PKV(l3, h3), od, 0, 0, 0);
}
__device__ __forceinline__ void pv_d0(f32x16* o, int vb, bf16x8 pa0, bf16x8 pa1, bf16x8 pa2, bf16x8 pa3) {
    pv_one<0>(o[0], vb, pa0, pa1, pa2, pa3); pv_one<1>(o[1], vb, pa0, pa1, pa2, pa3); pv_one<2>(o[2], vb, pa0, pa1, pa2, pa3); pv_one<3>(o[3], vb, pa0, pa1, pa2, pa3);
}
template <int D0> __device__ __forceinline__ void pv_one32(f32x16& od, int vb, bf16x8 pa0, bf16x8 pa1) {
    const s16x4 l0 = tr_read<v_rd_off(D0, 0, 0)>(vb), h0 = tr_read<v_rd_off(D0, 0, 1)>(vb), l1 = tr_read<v_rd_off(D0, 1, 0)>(vb), h1 = tr_read<v_rd_off(D0, 1, 1)>(vb);
    asm volatile("s_waitcnt lgkmcnt(0)" ::: "memory"); SBAR();
    od = __builtin_amdgcn_mfma_f32_32x32x16_bf16(pa0, PKV(l0, h0), od, 0, 0, 0);
    od = __builtin_amdgcn_mfma_f32_32x32x16_bf16(pa1, PKV(l1, h1), od, 0, 0, 0);
}

typedef float f32x4c __attribute__((ext_vector_type(4)));
struct ConvJob {
    const float *w_gate, *w_up, *w_down, *w_out, *g_ffn; unsigned short *WGU, *WDN, *WOUT;
    int next, end, stride;
};
struct ConvItem { const float* W; unsigned short* dst; int N, K, k0, n0, drow; };
constexpr int CV_GU = 32 * 88, CV_DN = 88 * 32, CV_OUT = 32 * 32, CV_TOTAL = 2 * CV_GU + CV_DN + CV_OUT;
__device__ __forceinline__ ConvItem conv_item(const float* Jw_gate, const float* Jw_up, const float* Jw_down, const float* Jw_out, unsigned short* JWGU, unsigned short* JWDN, unsigned short* JWOUT, int q) {
    ConvItem it;
    const bool gu = q < 2 * CV_GU, dn = !gu && q < 2 * CV_GU + CV_DN; const int up = (q >= CV_GU) ? 1 : 0;
    const int rg = q - up * CV_GU, kbg = rg / 88, nbg = rg - kbg * 88;
    const int rd = gu ? 0 : (dn ? q - 2 * CV_GU : q - 2 * CV_GU - CV_DN), kbd = rd >> 5, nbd = rd & 31;
    it.W = gu ? (up ? Jw_up : Jw_gate) : (dn ? Jw_down : Jw_out);
    it.dst = gu ? JWGU : (dn ? JWDN : JWOUT);
    it.N = gu ? 5632 : 2048; it.K = dn ? 5632 : 2048;
    it.k0 = 64 * (gu ? kbg : kbd); it.n0 = 64 * (gu ? nbg : nbd);
    it.drow = gu ? 256 * (it.n0 >> 7) + 128 * up + (it.n0 & 127) : it.n0;
    return it;
}
__device__ __forceinline__ void attn_dense_body(const bf16* __restrict__ Qb, const bf16* __restrict__ Kh, const bf16* __restrict__ Vh,
                                                unsigned short* __restrict__ Ob, int ldo, int dbase, int seq, char* lds, const int wave_in, ConvJob& cj,
                                                const bool second, unsigned short* __restrict__ Yb, const float lam, const float* __restrict__ subln) {
    using S8 = SM<125000>;
    const int wid = wave_in, lane = mk_lane(), tid = wid * 64 + lane, r32 = lane & 31, hi = lane >> 5;
    bf16* V_lds = (bf16*)lds; bf16* K_lds = (bf16*)(lds + 2 * SHM_V);
    float* ws = (float*)(lds + 2 * SHM_V + 2 * SHM_K) + wid * 64; float* li_l = ws; float* al_l = ws + 32;
    float m_reg = -1e30f, l_reg = 0; f32x16 o[4] = {}; bf16x8 qr[4];
    const bf16* Qw = Qb + (long)(wid * QBLK + r32) * LDR + dbase * 16 + hi * 8;
#pragma unroll
    for (int d0 = 0; d0 < 4; ++d0) qr[d0] = *reinterpret_cast<const bf16x8*>(Qw + d0 * 16);
    const int sr = tid >> 4, sc = (tid & 15) * 8, vst0 = v_st(sr, sc), vst1 = v_st(32 + sr, sc);
    const int vb0 = (int)(uintptr_t)V_lds + v_rd_base(lane);
    struct { bf16x8 vs0, vs1, ks0; } sr_[2];
    const int krow = tid >> 3, kcol = dbase * 16 + (tid & 7) * 8, kst0 = KSWZ(krow, kcol * 2);
#define SLOAD(i, k0) do { sr_[i].vs0 = *reinterpret_cast<const bf16x8*>(&Vh[(long)((k0) + sr) * LDR + sc]); sr_[i].vs1 = *reinterpret_cast<const bf16x8*>(&Vh[(long)((k0) + 32 + sr) * LDR + sc]); \
    sr_[i].ks0 = *reinterpret_cast<const bf16x8*>(&Kh[(long)((k0) + krow) * LDR + kcol]); } while (0)
#define SWRITE(b, i) do { *(bf16x8*)((char*)V_lds + (b) * SHM_V + vst0) = sr_[i].vs0;          \
    *(bf16x8*)((char*)V_lds + (b) * SHM_V + vst1) = sr_[i].vs1;                              \
    *(bf16x8*)((char*)K_lds + (b) * SHM_K + kst0) = sr_[i].ks0; } while (0)
#define SWAIT() do {} while (0)
#define RESC(a) do { if (__any((a) < 1.f)) { if (hi == 0) al_l[r32] = (a); asm volatile("s_waitcnt lgkmcnt(0)" ::: "memory"); \
    _Pragma("unroll") for (int d = 0; d < 4; ++d) _Pragma("unroll") for (int r = 0; r < 16; ++r) o[d][r] *= al_l[crow(r, hi)]; } } while (0)
    f32x16 pA0, pA1, pB0, pB1; float mnA, mnB, alA, alB; bf16x8 pa0, pa1, pa2, pa3; const int NT = seq / KVBLK;
    const float* const jwg = cj.w_gate; const float* const jwu = cj.w_up; const float* const jwd = cj.w_down; const float* const jwo = cj.w_out;
    unsigned short* const jGU = cj.WGU; unsigned short* const jDN = cj.WDN; unsigned short* const jOUT = cj.WOUT; const int jnext = cj.next, jend = cj.end, jstride = cj.stride;
    float* cscr = (float*)(lds + SHM_ATTN); f32x4c cv0, cv1; int slot = 0;
#define CV_Q(k) (min(jnext + (k) * jstride, jend))
#define CV_LOAD(q) do { const ConvItem it_ = conv_item(jwg, jwu, jwd, jwo, jGU, jDN, jOUT, (q)); const float* s_ = it_.W + (size_t)(it_.k0 + (tid >> 3)) * it_.N + it_.n0 + 8 * (tid & 7); \
    cv0 = *(const f32x4c*)s_; cv1 = *(const f32x4c*)(s_ + 4); } while (0)
#define CV_WRITE() do { f32x4c* d_ = (f32x4c*)(cscr + (tid >> 3) * 64 + 8 * ((tid & 7) ^ ((tid >> 6) & 7))); d_[0] = cv0; d_[1] = cv1; } while (0)
#define CV_STORE(q) do { const ConvItem it_ = conv_item(jwg, jwu, jwd, jwo, jGU, jDN, jOUT, (q)); const int n_ = tid >> 3, c_ = tid & 7; const float* s_ = cscr + (8 * c_) * 64 + (n_ ^ (8 * c_)); \
    u32x4 o_; o_.x = cvtpk(s_[0], s_[64]); o_.y = cvtpk(s_[128], s_[192]); o_.z = cvtpk(s_[256], s_[320]); o_.w = cvtpk(s_[384], s_[448]); \
    *(u32x4*)(it_.dst + (size_t)(it_.drow + n_) * it_.K + it_.k0 + 8 * c_) = o_; } while (0)
#define CV_CONSUME() do { CV_WRITE(); const int qn_ = CV_Q(slot + 1); CV_LOAD(qn_); } while (0)
#define CV_FINISH() do { const int qc_ = CV_Q(slot); CV_STORE(qc_); ++slot; } while (0)
    const int owed = (jnext > jend) ? 0 : (jend - jnext) / jstride + 1;
    const int ctrips = min((owed + 1) >> 1, (NT - 2) >> 1);
    if (ctrips > 0) { const int q0_ = CV_Q(0); CV_LOAD(q0_); }
    constexpr int SE = 0, SO = 1;
    SLOAD(SE, 0); asm volatile("s_waitcnt vmcnt(0)" ::: "memory"); SWRITE(0, SE); __syncthreads();
    qkt<4>(pA0, pA1, K_lds, qr, dbase, r32, hi); S8::partialSM(pA0, pA1, m_reg, mnA, alA);
    SLOAD(SO, KVBLK); if (2 < NT) SLOAD(SE, 2 * KVBLK);
    SWAIT(); SWRITE(1, SO); __syncthreads();
#define B_TRIP(CONV) do { \
        SBAR(); qkt<4>(pB0, pB1, (bf16*)((char*)K_lds + SHM_K), qr, dbase, r32, hi); \
        finishSM(pA0, pA1, alA, l_reg, pa0, pa1, pa2, pa3); SBAR(); \
        SLOAD(SO, (j + 2) * KVBLK); SBAR(); \
        pv_d0(o, vb0, pa0, pa1, pa2, pa3); S8::partialSM(pB0, pB1, m_reg, mnB, alB); \
        __syncthreads(); SWAIT(); SWRITE(0, SE); \
        if (CONV) CV_CONSUME(); \
        RESC(alB); __syncthreads(); \
        if (CONV) CV_FINISH(); \
        SBAR(); qkt<4>(pA0, pA1, K_lds, qr, dbase, r32, hi); \
        finishSM(pB0, pB1, alB, l_reg, pa0, pa1, pa2, pa3); SBAR(); \
        SLOAD(SE, min(j + 3, NT - 1) * KVBLK); SBAR();     \
        pv_d0(o, vb0 + (int)SHM_V, pa0, pa1, pa2, pa3); S8::partialSM(pA0, pA1, m_reg, mnA, alA); \
        __syncthreads(); SWAIT(); SWRITE(1, SO); \
        if (CONV) CV_CONSUME(); \
        RESC(alA); __syncthreads(); \
        if (CONV) CV_FINISH(); } while (0)
    int j = 1;
    for (int tr = 0; tr < ctrips; ++tr, j += 2) B_TRIP(true);
    for (; j + 1 < NT; j += 2) B_TRIP(false);
#undef B_TRIP
    cj.next = min(jnext + slot * jstride, jend + jstride);
    SBAR(); qkt<4>(pB0, pB1, (bf16*)((char*)K_lds + SHM_K), qr, dbase, r32, hi);
    finishSM(pA0, pA1, alA, l_reg, pa0, pa1, pa2, pa3); SBAR();
    pv_d0(o, vb0, pa0, pa1, pa2, pa3); S8::partialSM(pB0, pB1, m_reg, mnB, alB);
    __syncthreads(); RESC(alB);
    finishSM(pB0, pB1, alB, l_reg, pa0, pa1, pa2, pa3); SBAR();
    pv_d0(o, vb0 + (int)SHM_V, pa0, pa1, pa2, pa3);
    if (hi == 0) li_l[r32] = l_reg; asm volatile("s_waitcnt lgkmcnt(0)" ::: "memory");
    float rli[16];
#pragma unroll
    for (int r = 0; r < 16; ++r) rli[r] = __builtin_amdgcn_rcpf(li_l[crow(r, hi)]);
    unsigned short* Ow = (unsigned short*)(lds + SHM_ATTN + 16384) + wid * 4096;
    if (!second) {
#pragma unroll
        for (int r = 0; r < 16; ++r) { int orow = crow(r, hi);
#pragma unroll
            for (int d0 = 0; d0 < 4; ++d0) Ow[orow * 128 + d0 * 32 + r32] = f2bf1(o[d0][r] * rli[r]); }
        asm volatile("s_waitcnt lgkmcnt(0)" ::: "memory");
    } else {
        float ssq[16];
#pragma unroll
        for (int r = 0; r < 16; ++r) { const int orow = crow(r, hi); ssq[r] = 0.f;
#pragma unroll
            for (int d0 = 0; d0 < 4; ++d0) { const float o0 = __uint_as_float((unsigned)Ow[orow * 128 + d0 * 32 + r32] << 16);
                const float d = o0 - lam * (o[d0][r] * rli[r]); o[d0][r] = d; ssq[r] += d * d; } }
#pragma unroll
        for (int r = 0; r < 16; ++r) { float v = ssq[r]; v += __shfl_xor(v, 1); v += __shfl_xor(v, 2); v += __shfl_xor(v, 4); v += __shfl_xor(v, 8); v += __shfl_xor(v, 16); ssq[r] = v; }
        float sl[4];
#pragma unroll
        for (int d0 = 0; d0 < 4; ++d0) sl[d0] = subln[d0 * 32 + r32] * 0.8f;
        unsigned short* Yw = Yb + (long)(wid * QBLK) * 2048;
#pragma unroll
        for (int r = 0; r < 16; ++r) { const int orow = crow(r, hi); const float rs = 1.0f / sqrtf(ssq[r] * (1.0f / 128.0f) + 1e-5f);
#pragma unroll
            for (int d0 = 0; d0 < 4; ++d0) Yw[(long)orow * 2048 + d0 * 32 + r32] = f2bf1(o[d0][r] * rs * sl[d0]); }
    }
#undef CV_LOAD
#undef CV_Q
#undef CV_STORE
#undef CV_WRITE
#undef CV_CONSUME
#undef CV_FINISH
#undef SLOAD
#undef SWRITE
#undef SWAIT
#undef RESC
}

__device__ __forceinline__ void swa_wave_unit(const bf16* __restrict__ base, long rstride, int qc, int kc, int vc, int t0, int L,
                                              unsigned short* __restrict__ Ob, long ostride, float* __restrict__ Lb, long lstride, char* lds_w, float* scr) {
    constexpr float SCALE = 0.088388347648318440f, C = SCALE * 1.4426950408889634f;
    const int lane = mk_lane(), r32 = lane & 31, hi = lane >> 5;
    bf16* K_lds = (bf16*)lds_w; char* V_lds = lds_w + 8192;
    bf16x8 qr[8];
    { const bf16* Qw = base + (long)(t0 + r32) * rstride + qc + hi * 8;
#pragma unroll
      for (int d0 = 0; d0 < 8; ++d0) qr[d0] = *reinterpret_cast<const bf16x8*>(Qw + d0 * 16); }
    const int srow = lane >> 4, scol = (lane & 15) * 8;
    const bf16* kbase = base + (long)srow * rstride + kc + scol; const bf16* vbase = base + (long)srow * rstride + vc + scol;
    bf16x8 st[2][8];
#define TILE_K0(i) (t0 - 64 + 32 * (i))
#define TILE_OK(i) (TILE_K0(i) >= 0 && TILE_K0(i) < L)
#define TILE_KC(i) (min(max(TILE_K0(i), 0), L - 32))
#define LD_TILE(buf, pbase, i) do { const bf16* p_ = (pbase) + (long)TILE_KC(i) * rstride; _Pragma("unroll") for (int j = 0; j < 8; ++j) st[buf][j] = *reinterpret_cast<const bf16x8*>(p_ + (long)(4 * j) * rstride); } while (0)
    f32x16 s[5];
    LD_TILE(0, kbase, 0);
#pragma unroll
    for (int i = 0; i < 5; ++i) {
        if (i < 4) LD_TILE((i + 1) & 1, kbase, i + 1); else LD_TILE((i + 1) & 1, vbase, 0);
#pragma unroll
        for (int j = 0; j < 8; ++j) *(bf16x8*)((char*)K_lds + KSWZ(4 * j + srow, scol * 2)) = st[i & 1][j];
        f32x16 p = f32x16{};
#pragma unroll
        for (int d0 = 0; d0 < 8; ++d0) { const int cb = (d0 * 16 + hi * 8) * 2;
            const bf16x8 b0 = *reinterpret_cast<const bf16x8*>((const char*)K_lds + KSWZ(r32, cb));
            p = __builtin_amdgcn_mfma_f32_32x32x16_bf16(b0, qr[d0], p, 0, 0, 0); }
        const bool ok = TILE_OK(i);
#pragma unroll
        for (int r = 0; r < 16; ++r) {
            bool keep = ok;
            if (i == 0) keep = keep && (crow(r, hi) >= r32);
            if (i == 4) keep = keep && (crow(r, hi) <= r32);
            s[i][r] = keep ? p[r] : -1e30f;
        }
    }
    float m = -1e30f;
#pragma unroll
    for (int i = 0; i < 5; ++i)
#pragma unroll
        for (int r = 0; r < 16; ++r) m = fmaxf(m, s[i][r]);
    { auto rr = __builtin_amdgcn_permlane32_swap(__float_as_uint(m), __float_as_uint(m), false, false);
      m = fmaxf(__uint_as_float(rr[0]), __uint_as_float(rr[1])); }
    const float mC = -m * C; float l = 0.f;
#pragma unroll
    for (int i = 0; i < 5; ++i)
#pragma unroll
        for (int r = 0; r < 16; ++r) { s[i][r] = __builtin_amdgcn_exp2f(fmaf(s[i][r], C, mC)); l += s[i][r]; }
    { auto rr = __builtin_amdgcn_permlane32_swap(__float_as_uint(l), __float_as_uint(l), false, false);
      l = __uint_as_float(rr[0]) + __uint_as_float(rr[1]); }
    bf16x8 pa[5][2];
#pragma unroll
    for (int i = 0; i < 5; ++i) { PK4(s[i], 0, pa[i][0]); PK4(s[i], 8, pa[i][1]); }
    f32x16 o[4] = {};
    const int vb = (int)(uintptr_t)V_lds + v_rd_base(lane);
#pragma unroll
    for (int i = 0; i < 5; ++i) {
        if (i < 4) LD_TILE(i & 1, vbase, i + 1);
#pragma unroll
        for (int j = 0; j < 8; ++j) *(bf16x8*)(V_lds + v_st(4 * j + srow, scol)) = st[(i + 1) & 1][j];
        asm volatile("s_waitcnt lgkmcnt(0)" ::: "memory");
        pv_one32<0>(o[0], vb, pa[i][0], pa[i][1]); pv_one32<1>(o[1], vb, pa[i][0], pa[i][1]); pv_one32<2>(o[2], vb, pa[i][0], pa[i][1]); pv_one32<3>(o[3], vb, pa[i][0], pa[i][1]);
    }
#undef TILE_K0
#undef TILE_OK
#undef TILE_KC
#undef LD_TILE
    if (hi == 0) { scr[r32] = l; Lb[(long)(t0 + r32) * lstride] = m * SCALE + __logf(l); }
    asm volatile("s_waitcnt lgkmcnt(0)" ::: "memory");
    float rli[16];
#pragma unroll
    for (int r = 0; r < 16; ++r) rli[r] = __builtin_amdgcn_rcpf(scr[crow(r, hi)]);
#pragma unroll
    for (int r = 0; r < 16; ++r) { const long orow = (long)(t0 + crow(r, hi)) * ostride;
#pragma unroll
        for (int d0 = 0; d0 < 4; ++d0) Ob[orow + d0 * 32 + r32] = f2bf1(o[d0][r] * rli[r]); }
    asm volatile("s_waitcnt lgkmcnt(0)" ::: "memory");
}
__device__ __forceinline__ void swa_wg_unit(const bf16* __restrict__ QKVb, int gbr, int sub0, int qt0, int sstep, unsigned short* __restrict__ OAg, float* __restrict__ LSEg, char* lds, float* scr, const int wid) {
    constexpr float SCALE = 0.088388347648318440f, C = SCALE * 1.4426950408889634f;
    const int lane = mk_lane(), tid = wid * 64 + lane, r32 = lane & 31, hi = lane >> 5;
    const int dsh = 2 * gbr, dil = 1 << dsh, L = 2048 >> dsh, nblk = L >> 5; const bool big = nblk >= 8;
    const long rstride = (long)dil * LDR;
#define SUB_BASE(sub) (QKVb + ((size_t)((sub) >> (3 + dsh)) * 2048 + (((sub) >> 3) & (dil - 1))) * LDR + ((sub) & 7) * 128)
    const int srow = tid >> 4, scol = (tid & 15) * 8;
    bf16x8 kst[12], vst[12];
#pragma unroll
    for (int sl = 0; sl < 12; ++sl) {
        const int sub_s = big ? sub0 : sub0 + ((sl >> 2) & 1) * sstep; const int kt_s = big ? min(max(qt0 - 2 + sl, 0), nblk - 1) : (sl & 3);
        const bf16* p_ = SUB_BASE(sub_s) + (long)(kt_s * 32 + srow) * rstride + scol;
        kst[sl] = *reinterpret_cast<const bf16x8*>(p_ + 1024);
    }
    const int sub_w = big ? sub0 : sub0 + (wid >> 2) * sstep; const int qt = big ? qt0 + wid : (wid & 3); const int t0 = qt * 32;
    const bf16* base_w = SUB_BASE(sub_w);
    bf16x8 qr[8];
    { const bf16* Qw = base_w + (long)(t0 + r32) * rstride + hi * 8;
#pragma unroll
      for (int d0 = 0; d0 < 8; ++d0) qr[d0] = *reinterpret_cast<const bf16x8*>(Qw + d0 * 16); }
#pragma unroll
    for (int sl = 0; sl < 12; ++sl) *(bf16x8*)(lds + sl * 8192 + KSWZ(srow, scol * 2)) = kst[sl];
#pragma unroll
    for (int sl = 0; sl < 12; ++sl) {
        const int sub_s = big ? sub0 : sub0 + ((sl >> 2) & 1) * sstep; const int kt_s = big ? min(max(qt0 - 2 + sl, 0), nblk - 1) : (sl & 3);
        const bf16* p_ = SUB_BASE(sub_s) + (long)(kt_s * 32 + srow) * rstride + scol;
        vst[sl] = *reinterpret_cast<const bf16x8*>(p_ + 2048);
    }
    __syncthreads();
    f32x16 s[5];
#pragma unroll
    for (int i = 0; i < 5; ++i) {
        const int kt = qt - 2 + i; const bool ok = kt >= 0 && kt < nblk;
        const int slot = big ? wid + i : 4 * (wid >> 2) + min(max(kt, 0), 3);
        const char* Ks = lds + slot * 8192;
        f32x16 p = f32x16{};
#pragma unroll
        for (int d0 = 0; d0 < 8; ++d0) { const int cb = (d0 * 16 + hi * 8) * 2;
            const bf16x8 b0 = *reinterpret_cast<const bf16x8*>(Ks + KSWZ(r32, cb));
            p = __builtin_amdgcn_mfma_f32_32x32x16_bf16(b0, qr[d0], p, 0, 0, 0); }
#pragma unroll
        for (int r = 0; r < 16; ++r) {
            bool keep = ok;
            if (i == 0) keep = keep && (crow(r, hi) >= r32);
            if (i == 4) keep = keep && (crow(r, hi) <= r32);
            s[i][r] = keep ? p[r] : -1e30f;
        }
    }
    float m = -1e30f;
#pragma unroll
    for (int i = 0; i < 5; ++i)
#pragma unroll
        for (int r = 0; r < 16; ++r) m = fmaxf(m, s[i][r]);
    { auto rr = __builtin_amdgcn_permlane32_swap(__float_as_uint(m), __float_as_uint(m), false, false);
      m = fmaxf(__uint_as_float(rr[0]), __uint_as_float(rr[1])); }
    const float mC = -m * C; float l = 0.f;
#pragma unroll
    for (int i = 0; i < 5; ++i)
#pragma unroll
        for (int r = 0; r < 16; ++r) { s[i][r] = __builtin_amdgcn_exp2f(fmaf(s[i][r], C, mC)); l += s[i][r]; }
    { auto rr = __builtin_amdgcn_permlane32_swap(__float_as_uint(l), __float_as_uint(l), false, false);
      l = __uint_as_float(rr[0]) + __uint_as_float(rr[1]); }
    bf16x8 pa[5][2];
#pragma unroll
    for (int i = 0; i < 5; ++i) { PK4(s[i], 0, pa[i][0]); PK4(s[i], 8, pa[i][1]); }
    __syncthreads();
#pragma unroll
    for (int sl = 0; sl < 12; ++sl) *(bf16x8*)(lds + sl * 8192 + v_st(srow, scol)) = vst[sl];
    __syncthreads();
    f32x16 o[4] = {};
#pragma unroll
    for (int i = 0; i < 5; ++i) {
        const int kt = qt - 2 + i;
        const int slot = big ? wid + i : 4 * (wid >> 2) + min(max(kt, 0), 3);
        const int vb = (int)(uintptr_t)(lds + slot * 8192) + v_rd_base(lane);
        pv_one32<0>(o[0], vb, pa[i][0], pa[i][1]); pv_one32<1>(o[1], vb, pa[i][0], pa[i][1]); pv_one32<2>(o[2], vb, pa[i][0], pa[i][1]); pv_one32<3>(o[3], vb, pa[i][0], pa[i][1]);
    }
    const size_t tok0 = ((size_t)(sub_w >> (3 + dsh)) * 2048 + ((sub_w >> 3) & (dil - 1))); const int hh = sub_w & 7;
    if (hi == 0) { scr[r32] = l; LSEg[(tok0 + (size_t)(t0 + r32) * dil) * 8 + hh] = m * SCALE + __logf(l); }
    asm volatile("s_waitcnt lgkmcnt(0)" ::: "memory");
    float rli[16];
#pragma unroll
    for (int r = 0; r < 16; ++r) rli[r] = __builtin_amdgcn_rcpf(scr[crow(r, hi)]);
#pragma unroll
    for (int r = 0; r < 16; ++r) { unsigned short* orow = OAg + (tok0 + (size_t)(t0 + crow(r, hi)) * dil) * 1024 + hh * 128;
#pragma unroll
        for (int d0 = 0; d0 < 4; ++d0) orow[d0 * 32 + r32] = f2bf1(o[d0][r] * rli[r]); }
    asm volatile("s_waitcnt lgkmcnt(0)" ::: "memory");
    __syncthreads();
#undef SUB_BASE
}
#undef SBAR
}
#ifndef MK_DUP_PHASE
#define MK_DUP_PHASE -1
#endif
#define NREP(k) (1 + (MK_DUP_PHASE == (k) ? 1 : 0))
#ifndef MK_ONE_LAUNCH
#define MK_ONE_LAUNCH 1
#endif
constexpr int NWAVES = 8;
constexpr int BATCH = 4, SEQ = 2048, DM = 2048, M = BATCH * SEQ, NIN = 6144, DFF = 5632, NGU = 2 * DFF, NHEAD = 8, HD = 128;
constexpr float RMS_EPS = 1e-6f, SUBLN_EPS = 1e-5f, LAM_INIT = 0.2f;
constexpr size_t MiB = 1u << 20;
constexpr size_t WS_SS1 = 0, WS_SS2 = 64 * 1024, WS_LSE = 1 * MiB;
constexpr size_t WS_QKV = 2 * MiB;
constexpr size_t WS_Y = 162 * MiB;
constexpr size_t WS_H = 34 * MiB;
constexpr size_t WS_WIN = 98 * MiB, WS_XN = 122 * MiB;
constexpr size_t WS_OA = 98 * MiB;
constexpr size_t WS_WOUT = 154 * MiB;
constexpr size_t WS_OB = 162 * MiB, WS_XG = 2 * MiB;
constexpr size_t WS_WGU = 194 * MiB, WS_WDN = 238 * MiB, WS_END = 260 * MiB;
static_assert(WS_H + (size_t)M * DFF * 2 <= WS_WOUT && WS_XG + (size_t)M * DM * 2 <= WS_H && WS_Y + (size_t)M * DM * 2 <= WS_WGU && WS_OA + (size_t)3 * M * 1024 * 2 <= WS_WOUT && WS_WDN + (size_t)DM * DFF * 2 <= WS_END && WS_WGU + (size_t)NGU * DM * 2 <= WS_WDN && WS_QKV + (size_t)M * NIN * 2 <= WS_WIN, "d_ws map");
constexpr int RING_BYTES = 131072, LDS_BYTES = 163840, MISC_OFF = 163584;
constexpr size_t WS_BAR = 128 * 1024, WS_CNT = 144 * 1024, WS_FLAG = 152 * 1024, WS_GRP = 160 * 1024, BAR_BYTES = 40 * 1024;

#define GAS __attribute__((address_space(1)))
#define LAS __attribute__((address_space(3)))
typedef unsigned short bf16;
typedef unsigned v4u __attribute__((ext_vector_type(4)));
typedef float f32x4 __attribute__((ext_vector_type(4)));
#define LDS_WAIT() asm volatile("s_waitcnt lgkmcnt(0)" ::: "memory")
__device__ __forceinline__ unsigned f2bf(float f) { unsigned u = __builtin_bit_cast(unsigned, f); return (u + 0x7fffu + ((u >> 16) & 1u)) >> 16; }
__device__ __forceinline__ unsigned pk2(float lo, float hi) { return f2bf(lo) | (f2bf(hi) << 16); }
__device__ __forceinline__ float bflo(unsigned w) { return __uint_as_float(w << 16); }
__device__ __forceinline__ float bfhi(unsigned w) { return __uint_as_float(w & 0xffff0000u); }
__device__ __forceinline__ float wave_sum(float v) {
#pragma unroll
    for (int o = 1; o < 64; o <<= 1) v += __shfl_xor(v, o);
    return v;
}
__device__ __forceinline__ void transpose_item(const float* W, int K, int N, bf16* WT, int k0, int n0, int dst_row0, LAS float* scr, int lane, const float* ks = nullptr) {
    float wv[32];
#pragma unroll
    for (int i = 0; i < 32; ++i) { const int kk = 2 * i + (lane >> 5); wv[i] = W[(size_t)(k0 + kk) * N + n0 + (lane & 31)]; }
#pragma unroll
    for (int i = 0; i < 32; ++i) { const int kk = 2 * i + (lane >> 5); scr[kk * 33 + (lane & 31)] = wv[i]; }
    LDS_WAIT(); asm volatile("" ::: "memory");
    const int c = lane & 7;
    f32x4 g0 = {1.f, 1.f, 1.f, 1.f}, g1 = {1.f, 1.f, 1.f, 1.f};
    if (ks) { g0 = *(const f32x4*)(ks + k0 + 8 * c); g1 = *(const f32x4*)(ks + k0 + 8 * c + 4); }
#pragma unroll
    for (int j = 0; j < 4; ++j) { const int n = (lane >> 3) + 8 * j; const LAS float* s = scr + (8 * c) * 33 + n;
        v4u o; o.x = pk2(s[0 * 33] * g0.x, s[1 * 33] * g0.y); o.y = pk2(s[2 * 33] * g0.z, s[3 * 33] * g0.w); o.z = pk2(s[4 * 33] * g1.x, s[5 * 33] * g1.y); o.w = pk2(s[6 * 33] * g1.z, s[7 * 33] * g1.w);
        *(GAS v4u*)(WT + (size_t)(dst_row0 + n) * K + k0 + 8 * c) = o; }
    LDS_WAIT(); asm volatile("" ::: "memory");
}

#define XB_TMO      128
#define XB_XCNT(j)  (256  + 64 * (j))
#define XB_XSUB(j)  (1280 + 64 * (j))
#define XB_XGEN(j)  (2304 + 64 * (j))
#define XB_TOP      3328
#define XB_TOPGEN   3392
#define XCD_BAR_WORDS 3456
#define XB_SPIN_CAP (1u << 18)

__device__ __forceinline__ unsigned xb_ld(unsigned* p)              { return __hip_atomic_load(p, __ATOMIC_RELAXED, __HIP_MEMORY_SCOPE_AGENT); }
__device__ __forceinline__ unsigned xb_add(unsigned* p, unsigned v) { return __hip_atomic_fetch_add(p, v, __ATOMIC_RELAXED, __HIP_MEMORY_SCOPE_AGENT); }
__device__ __forceinline__ unsigned xb_xcc_id() { return (unsigned)__builtin_amdgcn_s_getreg((3 << 11) | 20) & 0xFu; }
#define XB_SPIN(cond, bar) do { unsigned _sp = 0; while (cond) { __builtin_amdgcn_s_sleep(1); \
    if ((++_sp & 255u) == 0u) { if (xb_ld(&(bar)[XB_TMO])) break; if (_sp > XB_SPIN_CAP) { atomicAdd(&(bar)[XB_TMO], 1u); break; } } } } while (0)

struct XcdBarrier {
    unsigned* bar; unsigned x;
    volatile LAS unsigned* st;
};

__device__ __forceinline__ XcdBarrier xcd_barrier_post(unsigned* bar, volatile LAS unsigned* st, const int wave_in) {
    XcdBarrier b; b.bar = bar; b.x = xb_xcc_id(); b.st = st;
    if (wave_in == 0 && mk_lane() == 0) (void)xb_add(&bar[XB_XCNT(b.x)], 1u);
    return b;
}
__device__ __forceinline__ void xcd_barrier_complete(unsigned* bar, unsigned x, unsigned& nloc, unsigned& nx) {
    const unsigned G = gridDim.x * gridDim.y * gridDim.z;
    unsigned sum, cnt, mine, sp = 0u;
    for (;;) {
        sum = 0u; cnt = 0u; mine = 0u;
#pragma unroll
        for (unsigned j = 0; j < 16; ++j) { const unsigned c = xb_ld(&bar[XB_XCNT(j)]); sum += c; cnt += (c > 0u) ? 1u : 0u; mine = (j == x) ? c : mine; }
        if (sum == G) break;
        __builtin_amdgcn_s_sleep(1);
        if ((++sp & 255u) == 0u) { if (xb_ld(&bar[XB_TMO])) break; if (sp > XB_SPIN_CAP) { atomicAdd(&bar[XB_TMO], 1u); break; } }
    }
    nloc = mine > 0u ? mine : 1u; nx = cnt > 0u ? cnt : 1u;
}

__device__ __forceinline__ void xcd_barrier(const XcdBarrier& b, const int wave_in) {
    asm volatile("s_waitcnt vmcnt(0)" ::: "memory");
    __syncthreads();
    if (wave_in == 0 && mk_lane() == 0) {
        unsigned* bar = b.bar;
        __builtin_amdgcn_s_waitcnt(0);
        unsigned nloc = b.st[0], nx = b.st[1];
        if (nloc == 0u) { xcd_barrier_complete(bar, b.x, nloc, nx); b.st[0] = nloc; b.st[1] = nx; }
        const unsigned old = xb_add(&bar[XB_XSUB(b.x)], 1u);
        const unsigned gen = old / nloc;
        if (old + 1u == (gen + 1u) * nloc) {
            __builtin_amdgcn_fence(__ATOMIC_RELEASE, "agent");
            asm volatile("s_waitcnt vmcnt(0)" ::: "memory");
            const unsigned og = xb_add(&bar[XB_TOP], 1u);
            const unsigned tg = og / nx;
            if (og + 1u == (tg + 1u) * nx) xb_add(&bar[XB_TOPGEN], 1u);
            else XB_SPIN(xb_ld(&bar[XB_TOPGEN]) == tg, bar);
            __builtin_amdgcn_fence(__ATOMIC_ACQUIRE, "agent");
            xb_add(&bar[XB_XGEN(b.x)], 1u);
            asm volatile("s_waitcnt vmcnt(0)" ::: "memory");
        } else {
            XB_SPIN(xb_ld(&bar[XB_XGEN(b.x)]) == gen, bar);
            __builtin_amdgcn_fence(__ATOMIC_ACQUIRE, "agent");
            asm volatile("s_waitcnt vmcnt(0)" ::: "memory");
        }
    }
    __syncthreads();
}
struct Args { const float* in[11]; float* out; unsigned char* ws; int ph_lo, ph_hi; };
constexpr int NPHASE = 7;

__global__ void __launch_bounds__(NWAVES * 64, 2) mk_fwd(Args args) {
    extern __shared__ __attribute__((aligned(16))) unsigned char lds[];
    LAS unsigned char* ldsl = (LAS unsigned char*)lds;
    const int wave = __builtin_amdgcn_readfirstlane((int)threadIdx.x >> 6);
    const int G = gridDim.x, bx = blockIdx.x;
    const int vcu = (G % 8 == 0) ? (bx % 8) * (G / 8) + bx / 8 : bx;
    const int gw = vcu * NWAVES + wave, NGW = G * NWAVES;
    unsigned char* ws = args.ws;
    const float* x = args.in[0]; const float* g_attn = args.in[1]; const float* w_in = args.in[2]; const float* lambda_qk = args.in[3]; const float* subln = args.in[4];
    const float* w_out = args.in[5]; const float* g_ffn = args.in[6]; const float* w_gate = args.in[7]; const float* w_up = args.in[8]; const float* w_down = args.in[9];
    const float* g_final = args.in[10];
    float* out = args.out;
    float* SS1 = (float*)(ws + WS_SS1); float* SS2 = (float*)(ws + WS_SS2); float* LSE = (float*)(ws + WS_LSE);
    bf16* QKV = (bf16*)(ws + WS_QKV); bf16* WGU = (bf16*)(ws + WS_WGU); bf16* WDN = (bf16*)(ws + WS_WDN); bf16* HB = (bf16*)(ws + WS_H);
    bf16* WIN = (bf16*)(ws + WS_WIN); bf16* XN = (bf16*)(ws + WS_XN); bf16* OA = (bf16*)(ws + WS_OA); bf16* WOUT = (bf16*)(ws + WS_WOUT);
    bf16* OB = (bf16*)(ws + WS_OB); bf16* XG = (bf16*)(ws + WS_XG); bf16* Y = (bf16*)(ws + WS_Y);
    const int lo = args.ph_lo, hi_ph = args.ph_hi;
#define IN(k) (lo <= (k) && (k) < hi_ph)
    if (wave == 0) { const int l0 = mk_lane(); if (l0 < 32) ((LAS unsigned*)(ldsl + MISC_OFF))[l0] = 0u; }
    __syncthreads();
    XcdBarrier bar; bar.bar = (unsigned*)(ws + WS_BAR); bar.x = 0; bar.st = nullptr;
    if (hi_ph - lo > 1) bar = xcd_barrier_post((unsigned*)(ws + WS_BAR), (volatile LAS unsigned*)(ldsl + MISC_OFF), wave);
    if (lo < -1000) cg::this_grid().sync();
#define SEAM(k) do { if (IN(k) && IN((k) + 1)) { for (int rb = 0; rb < (MK_DUP_PHASE == 30 ? 3 : 1); ++rb) xcd_barrier(bar, wave); } } while (0)

    if (IN(0)) for (int rep = 0; rep < NREP(0); ++rep) { const int lane = mk_lane(), tid = wave * 64 + lane;
        LAS float* scr = (LAS float*)(ldsl + wave * 16384);
        constexpr int I_IN = (DM / 64) * (NIN / 32), I_OUT = (DM / 64) * (DM / 32);
        for (int it = gw; it < I_IN; it += NGW) {
            if (it < I_IN) { const int nblk = NIN / 32, kb = it / nblk, nb = it % nblk; transpose_item(w_in, DM, NIN, WIN, 64 * kb, 32 * nb, 32 * nb, scr, lane); }
            else { const int r = it - I_IN; const int nblk = DM / 32, kb = r / nblk, nb = r % nblk; transpose_item(w_out, DM, DM, WOUT, 64 * kb, 32 * nb, 32 * nb, scr, lane); }
        }
        for (int m = gw; m < M; m += NGW) {
            const GAS f32x4* xr = (const GAS f32x4*)(x + (size_t)m * DM) + lane;
            f32x4 v[8]; float s = 0.f;
#pragma unroll
            for (int j = 0; j < 8; ++j) { v[j] = xr[64 * j]; s += (v[j].x * v[j].x + v[j].y * v[j].y) + (v[j].z * v[j].z + v[j].w * v[j].w); }
            const float rstd = 1.0f / sqrtf(wave_sum(s) * (1.f / DM) + RMS_EPS);
            GAS unsigned long long* o8 = (GAS unsigned long long*)(XN + (size_t)m * DM) + lane;
#pragma unroll
            for (int j = 0; j < 8; ++j) { const f32x4 gg = *((const GAS f32x4*)g_attn + lane + 64 * j);
                o8[64 * j] = (unsigned long long)pk2(v[j].x * rstd * gg.x, v[j].y * rstd * gg.y) | ((unsigned long long)pk2(v[j].z * rstd * gg.z, v[j].w * rstd * gg.w) << 32); }
        }
        for (int i = bx * (NWAVES * 64) + tid; i < M; i += G * NWAVES * 64) { SS1[i] = 0.f; SS2[i] = 0.f; }
    }
    SEAM(0);
    if (IN(1)) {
        pg8::Gemm g{XN, WIN, M, NIN, DM}; pg8::StaticOrder S; S.init(M, NIN, G, bx); S.dup = NREP(1);
        pg8::EpiQKV E{QKV, NIN};
        pg8::gemm_phase<pg8::EpiQKV, pg8::StaticOrder, true, true>(ldsl, g, S, E, wave);
    }
    SEAM(1);
    if (IN(2)) { const int lane = mk_lane();
        float lam;
        { const float a = lambda_qk[lane] * lambda_qk[64 + lane], b2 = lambda_qk[128 + lane] * lambda_qk[192 + lane];
          lam = __expf(wave_sum(a)) - __expf(wave_sum(b2)) + LAM_INIT; }
        const int grp = vcu >> 3, k = vcu & 7, gb = grp >> 3, gh = grp & 7;
        const att::bf16* rowb = (const att::bf16*)QKV + (size_t)gb * SEQ * NIN;
        att::ConvJob cj{w_gate, w_up, w_down, w_out, g_ffn, WGU, WDN, WOUT, vcu, vcu + G * ((att::CV_TOTAL - 1 - vcu) / G), G};
        for (int i = 0; i < 2 * NREP(20); ++i) {
            const int c = i & 1;
            att::attn_dense_body(rowb + (size_t)k * 256 * NIN + 3072 + gh * HD, rowb + 4096 + gh * HD, rowb + 5120 + gh * HD, nullptr, 1024, 4 * c, SEQ, (char*)lds, wave, cj,
                                 c == 1, Y + ((size_t)gb * SEQ + k * 256) * DM + 1024 + gh * HD, lam, subln);
        }
        __syncthreads();
        { float* scr = (float*)((char*)lds + RING_BYTES) + wave * 64;
          for (int rep = 0; rep < NREP(21); ++rep) {
            att::swa_wg_unit((const att::bf16*)QKV, 0, gb * 8 + gh, 8 * k, 0, OA, LSE, (char*)lds, scr, wave);
            att::swa_wg_unit((const att::bf16*)QKV, 1, (gb * 4 + (k >> 1)) * 8 + gh, 8 * (k & 1), 0, OA + (size_t)M * 1024, LSE + (size_t)M * 8, (char*)lds, scr, wave);
            att::swa_wg_unit((const att::bf16*)QKV, 2, (gb * 16 + 2 * k) * 8 + gh, 0, 8, OA + (size_t)2 * M * 1024, LSE + (size_t)2 * M * 8, (char*)lds, scr, wave);
          } }
        asm volatile("s_waitcnt vmcnt(0)" ::: "memory"); __syncthreads();
        if (wave == 0 && lane == 0) {
            unsigned* gc = (unsigned*)(ws + WS_GRP) + 64 * grp;
            __builtin_amdgcn_fence(__ATOMIC_RELEASE, "agent"); asm volatile("s_waitcnt vmcnt(0)" ::: "memory");
            __hip_atomic_fetch_add(gc, 1u, __ATOMIC_RELAXED, __HIP_MEMORY_SCOPE_AGENT);
            unsigned sp = 0; while (__hip_atomic_load(gc, __ATOMIC_RELAXED, __HIP_MEMORY_SCOPE_AGENT) < 8u) { __builtin_amdgcn_s_sleep(2); if (++sp > (1u << 22)) break; }
            __builtin_amdgcn_fence(__ATOMIC_ACQUIRE, "agent"); asm volatile("s_waitcnt vmcnt(0)" ::: "memory");
        }
        __syncthreads();
        { const int col = (lane & 15) * 8;
#pragma unroll 2
          for (int it = 0; it < 8; ++it) {
            const size_t m = (size_t)gb * SEQ + k * 256 + wave * 32 + it * 4 + (lane >> 4);
            const float l0 = LSE[m * 8 + gh], l1 = LSE[((size_t)M + m) * 8 + gh], l2 = LSE[((size_t)2 * M + m) * 8 + gh];
            const float mx = fmaxf(l0, fmaxf(l1, l2)); float w0 = __expf(l0 - mx), w1 = __expf(l1 - mx), w2 = __expf(l2 - mx);
            const float inv = 1.0f / (w0 + w1 + w2); w0 *= inv; w1 *= inv; w2 *= inv;
            const v4u a0 = *(const GAS v4u*)(OA + m * 1024 + gh * HD + col), a1 = *(const GAS v4u*)(OA + ((size_t)M + m) * 1024 + gh * HD + col), a2 = *(const GAS v4u*)(OA + ((size_t)2 * M + m) * 1024 + gh * HD + col);
            v4u ya;
#pragma unroll
            for (int i = 0; i < 4; ++i) ya[i] = pk2(w0 * bflo(a0[i]) + w1 * bflo(a1[i]) + w2 * bflo(a2[i]), w0 * bfhi(a0[i]) + w1 * bfhi(a1[i]) + w2 * bfhi(a2[i]));
            *(GAS v4u*)(Y + m * DM + gh * HD + col) = ya;
          } }
        __syncthreads();
    }
    SEAM(2);
    if (IN(4)) {
        pg8::Gemm g{Y, WOUT, M, DM, DM}; pg8::StaticOrder S; S.init(M, DM, G, bx); S.dup = NREP(4);
        pg8::EpiOut E{x, XG, g_ffn, SS1, DM};
        pg8::gemm_phase<pg8::EpiOut, pg8::StaticOrder, true, true>(ldsl, g, S, E, wave);
    }
    SEAM(4);
    if (IN(5)) {
        pg8::Gemm g{XG, WGU, M, NGU, DM}; pg8::StaticOrder S; S.init(M, NGU, G, bx); S.dup = NREP(5);
        S.split_from = -1  ; S.kh_bytes = (DM / 2) * 2; S.kh_nt = DM / 128;
        pg8::EpiGateUp E{HB, DFF, SS1, 1.0f / DM, RMS_EPS, (pg8::f32x4*)(ws + WS_Y), (unsigned*)(ws + WS_FLAG)};
        pg8::gemm_phase<pg8::EpiGateUp, pg8::StaticOrder, true, true>(ldsl, g, S, E, wave);
    }
    SEAM(5);
    if (IN(6)) {
        pg8::Gemm g{HB, WDN, M, DM, DFF}; pg8::StaticOrder S; S.init(M, DM, G, bx);
        pg8::EpiDownNorm E{XG, g_ffn, out, g_final, SS2, (unsigned*)(ws + WS_CNT), DM, 1.0f / DM, RMS_EPS};
        pg8::gemm_phase<pg8::EpiDownNorm, pg8::StaticOrder, false, true>(ldsl, g, S, E, wave);
    }
#undef IN
#undef SEAM
}

extern "C" void kernel_launch(void* const* d_in, const int* in_sizes, int n_in, void* d_out, int out_size, void* d_ws, size_t ws_size, hipStream_t stream) {
    static int grid = 0;
    if (grid == 0) {
        if (n_in != 11 || in_sizes[0] != M * DM || out_size != M * DM || ws_size < WS_END) { fprintf(stderr, "kernel_launch: shape/workspace mismatch (n_in %d, in0 %d, out %d, ws %zu)\n", n_in, n_in > 0 ? in_sizes[0] : -1, out_size, ws_size); grid = -1; return; }
        int dev = 0, cus = 0, per_cu = 0;
        if (hipGetDevice(&dev) != hipSuccess || hipDeviceGetAttribute(&cus, hipDeviceAttributeMultiprocessorCount, dev) != hipSuccess) { grid = -1; return; }
        if (hipFuncSetAttribute((const void*)mk_fwd, hipFuncAttributeMaxDynamicSharedMemorySize, LDS_BYTES) != hipSuccess) { fprintf(stderr, "kernel_launch: hipFuncSetAttribute failed\n"); grid = -1; return; }
        if (hipOccupancyMaxActiveBlocksPerMultiprocessor(&per_cu, (const void*)mk_fwd, NWAVES * 64, LDS_BYTES) != hipSuccess || per_cu < 1) { fprintf(stderr, "kernel_launch: occupancy query says %d\n", per_cu); per_cu = 1; }
        (void)hipGetLastError();
        grid = cus;
        if (grid != 256) { fprintf(stderr, "kernel_launch: this kernel needs a 256-CU device (got %d)\n", cus); grid = -1; return; }
    }
    if (grid < 0) return;
    Args a{};
    for (int i = 0; i < 11; ++i) a.in[i] = (const float*)d_in[i];
    a.out = (float*)d_out; a.ws = (unsigned char*)d_ws;
#if MK_ONE_LAUNCH
    if (hipMemsetAsync((char*)d_ws + WS_BAR, 0, BAR_BYTES, stream) != hipSuccess) { fprintf(stderr, "kernel_launch: memset failed\n"); return; }
    a.ph_lo = 0; a.ph_hi = NPHASE;
    void* kargs[] = {&a};
    hipError_t e = hipLaunchCooperativeKernel((const void*)mk_fwd, dim3(grid), dim3(NWAVES * 64), kargs, LDS_BYTES, stream);
    if (e != hipSuccess) fprintf(stderr, "kernel_launch: cooperative launch failed: %s (grid %d)\n", hipGetErrorString(e), grid);
#else
    for (int p = 0; p < NPHASE; ++p) {
        a.ph_lo = p; a.ph_hi = p + 1;
        hipLaunchKernelGGL(mk_fwd, dim3(grid), dim3(NWAVES * 64), LDS_BYTES, stream, a);
    }
#endif
}
```

```cpp
#include <hip/hip_runtime.h>
#include <hip/hip_cooperative_groups.h>
#include <hip/hip_bf16.h>
#include <cstdio>
#include <cstdint>
#include <cmath>
namespace cg = cooperative_groups;
__device__ __forceinline__ int mk_lane() { int l; asm volatile("v_mbcnt_lo_u32_b32 %0, -1, 0\n\tv_mbcnt_hi_u32_b32 %0, -1, %0" : "=v"(l)); return l & 63; }
namespace pg8 {
#define PG8_LAS __attribute__((address_space(3)))
typedef unsigned short bf16_t;
typedef short bf16x8 __attribute__((ext_vector_type(8)));
typedef float f32x4 __attribute__((ext_vector_type(4)));
typedef unsigned u32x4 __attribute__((ext_vector_type(4)));
constexpr int BM = 256, BK = 64, HALF = 128, HTB = HALF * BK * 2  , STAGE_BYTES = 8 * HTB, NXCD = 8, WGM = 8;

__host__ __device__ __forceinline__ int lds_byte(int r, int c) { const int st = (r >> 4) * 2 + (c >> 5), rr = r & 15, cc = c & 31, ob = rr * 64 + cc * 2; return st * 1024 + (ob ^ (((ob >> 9) & 1) << 5)); }
__host__ __device__ __forceinline__ void stage_rc(int b, int& R, int& C) { const int st = b / 1024, sb = b % 1024, swz = sb ^ (((sb >> 9) & 1) << 5); R = (st >> 1) * 16 + swz / 64; C = (st & 1) * 32 + (swz % 64) / 2; }
__host__ __device__ __forceinline__ int perm32(int rho) { const int n = rho >> 4, i = rho & 15; return 8 * (i >> 2) + 4 * n + (i & 3); }

struct Unit { int pm, pn, first, khalf, koff, nt, ul; };
struct Gemm { const bf16_t* A; const bf16_t* Bt; int M, N, K; };

struct StaticOrder {
    int nM, nN, nwg, G, c, dup, split_from, kh_bytes, kh_nt;
    __host__ __device__ void init(int M, int N, int G_, int c_) { nM = M / BM; nN = N / BM; nwg = nM * nN; G = G_; c = c_; dup = 1; split_from = -1; kh_bytes = 0; kh_nt = 0; }
    __host__ __device__ bool next(int i, Unit& u) const {
        long L = (long)(i / dup) * G + c; u.khalf = 0; u.koff = 0; u.nt = 0; u.ul = 0;
        if (split_from >= 0 && (long)(i / dup) * G >= split_from) {
            if ((long)(i / dup) * G > split_from) return false;
            u.ul = c >> 1; L = split_from + u.ul; u.khalf = 1 + (c & 1); u.koff = (c & 1) ? kh_bytes : 0; u.nt = kh_nt; }
        if (L >= nwg) return false;
        int wgid = (int)L; { const int q = nwg / NXCD, r = nwg % NXCD, xcd = wgid % NXCD, off = wgid / NXCD; wgid = (xcd < r ? xcd * (q + 1) : r * (q + 1) + (xcd - r) * q) + off; }
        const int nig = WGM * nN, gid = wgid / nig, fm = gid * WGM, gsz = (nM - fm) < WGM ? (nM - fm) : WGM;
        u.pm = fm + ((wgid % nig) % gsz); u.pn = (wgid % nig) / gsz; u.first = (i % dup) == 0; return true;
    }
    __device__ __forceinline__ void a_ready(const Unit&) const {}
    __device__ __forceinline__ void done(const Unit&) const {}
};

__device__ __forceinline__ unsigned cvt_pk_bf16(float lo, float hi) { unsigned r; asm volatile("v_cvt_pk_bf16_f32 %0, %1, %2" : "=v"(r) : "v"(lo), "v"(hi)); return r; }
typedef float f32x2 __attribute__((ext_vector_type(2)));
__device__ __forceinline__ float invf_a(int f) {
    constexpr float T[16] = {1.0f, 0.4403666f, 0.19392274f, 0.0853971f, 0.03760603f, 0.01656044f, 0.0072926646f, 0.003211446f,
                             0.0014142136f, 0.00062277244f, 0.0002742482f, 0.000120769735f, 5.3182957e-05f, 2.342e-05f, 1.0313385e-05f, 4.5416705e-06f};
    return T[f];
}
__device__ __forceinline__ void sincos_rev(float ang, float& s, float& c) {
    const float rev = ang * 0.15915494309189535f; const float fr = rev - __builtin_floorf(rev);
    s = __builtin_amdgcn_sinf(fr); c = __builtin_amdgcn_cosf(fr);
}
struct EpiQKV {
    static constexpr bool PERM = true, AFTER_DRAIN = false;
    bf16_t* O; int ldc;
    __device__ __forceinline__ void operator()(const f32x4 (&acc)[2][2][4][2], const Unit& u, int wr, int wc, int fr, int fq) const {
        const int row0 = u.pm * BM + wr * 64 + fr;
        const int sec = u.pn >> 2;
        const int col0 = u.pn * BM + wc * 32 + 8 * fq;
        const bool ropeA = (sec <= 1) && (wc == 0);
        const bool ropeB = (sec == 3 || sec == 4) && ((wc & 1) == 0);
#pragma unroll
        for (int ai = 0; ai < 2; ++ai)
#pragma unroll
            for (int m = 0; m < 4; ++m) {
                const int row = row0 + ai * HALF + m * 16;
                const float pos = (float)(row & 2047);
                bf16_t* rowp = O + (size_t)row * ldc + col0;
                float cs[8], sn[8];
                if (ropeA) {
                    const int fb = 8 * (fq & 1);
#pragma unroll
                    for (int i = 0; i < 8; ++i) { float f0 = invf_a(i), f1 = invf_a(8 + i); sincos_rev(pos * (fb ? f1 : f0), sn[i], cs[i]); }
                    const float sg = (fq >= 2) ? 1.f : -1.f;
#pragma unroll
                    for (int i = 0; i < 8; ++i) sn[i] *= sg;
                } else if (ropeB) {
#pragma unroll
                    for (int i = 0; i < 8; ++i) sincos_rev(pos * invf_a(2 * i), sn[i], cs[i]);
                    const float sg = (fq == 1) ? 1.f : -1.f;
#pragma unroll
                    for (int i = 0; i < 8; ++i) sn[i] *= sg;
                }
#pragma unroll
                for (int bj = 0; bj < 2; ++bj) {
                    f32x4 v0 = acc[ai][bj][m][0], v1 = acc[ai][bj][m][1];
                    if (ropeA) {
                        f32x4 p0, p1;
#pragma unroll
                        for (int i = 0; i < 4; ++i) { p0[i] = __shfl_xor(v0[i], 32); p1[i] = __shfl_xor(v1[i], 32); }
#pragma unroll
                        for (int i = 0; i < 4; ++i) { v0[i] = v0[i] * cs[i] + p0[i] * sn[i]; v1[i] = v1[i] * cs[4 + i] + p1[i] * sn[4 + i]; }
                    } else if (ropeB) {
                        f32x4 p0, p1;
#pragma unroll
                        for (int i = 0; i < 4; ++i) { p0[i] = __shfl_xor(v0[i], 16); p1[i] = __shfl_xor(v1[i], 16); }
                        if (fq < 2) {
#pragma unroll
                            for (int i = 0; i < 4; ++i) { v0[i] = v0[i] * cs[i] + p0[i] * sn[i]; v1[i] = v1[i] * cs[4 + i] + p1[i] * sn[4 + i]; }
                        }
                    }
                    u32x4 w; w.x = cvt_pk_bf16(v0[0], v0[1]); w.y = cvt_pk_bf16(v0[2], v0[3]); w.z = cvt_pk_bf16(v1[0], v1[1]); w.w = cvt_pk_bf16(v1[2], v1[3]);
                    *(u32x4*)(rowp + bj * HALF) = w;
                }
            }
    }
};
struct EpiOut {
    static constexpr bool PERM = false, AFTER_DRAIN = false;
    const float* base; bf16_t* xg; const float* g; float* ss; int ldc;
    __device__ __forceinline__ void operator()(const f32x4 (&acc)[2][2][4][2], const Unit& u, int wr, int wc, int fr, int fq) const {
        typedef unsigned u32x2v __attribute__((ext_vector_type(2)));
        const int col0 = u.pn * BM + wc * 32 + 4 * fq;
        f32x4 gv[2][2];
#pragma unroll
        for (int bj = 0; bj < 2; ++bj)
#pragma unroll
            for (int n = 0; n < 2; ++n) gv[bj][n] = *(const f32x4*)(g + col0 + bj * HALF + n * 16);
#pragma unroll
        for (int ai = 0; ai < 2; ++ai)
#pragma unroll
            for (int m = 0; m < 4; ++m) {
                const int row = u.pm * BM + ai * HALF + wr * 64 + m * 16 + fr; const size_t off = (size_t)row * ldc + col0; float s = 0.f;
#pragma unroll
                for (int bj = 0; bj < 2; ++bj)
#pragma unroll
                    for (int n = 0; n < 2; ++n) {
                        const f32x4 x1 = *(const f32x4*)(base + off + bj * HALF + n * 16) + acc[ai][bj][m][n];
                        s += (x1[0] * x1[0] + x1[1] * x1[1]) + (x1[2] * x1[2] + x1[3] * x1[3]);
                        const f32x4 y = x1 * gv[bj][n]; u32x2v w; w.x = cvt_pk_bf16(y[0], y[1]); w.y = cvt_pk_bf16(y[2], y[3]);
                        *(u32x2v*)(xg + off + bj * HALF + n * 16) = w;
                    }
                s += __shfl_xor(s, 16); s += __shfl_xor(s, 32);
                if (fq == 0 && u.first) atomicAdd(ss + row, s);
            }
    }
};
struct EpiGateUp {
    static constexpr bool PERM = true, AFTER_DRAIN = false;
    bf16_t* H; int ldh; const float* ss; float inv_n, eps; f32x4* part; unsigned* flag;
    __device__ __forceinline__ void operator()(const f32x4 (&acc)[2][2][4][2], const Unit& u, int wr, int wc, int fr, int fq) const {
        const int tid = (wr * 4 + wc) * 64 + fq * 16 + fr;
        f32x4* pp = part + (size_t)u.ul * (32 * 512) + tid;
        if (u.khalf == 1) {
#pragma unroll
            for (int ai = 0; ai < 2; ++ai)
#pragma unroll
                for (int bj = 0; bj < 2; ++bj)
#pragma unroll
                    for (int m = 0; m < 4; ++m)
#pragma unroll
                        for (int n = 0; n < 2; ++n) pp[(size_t)(((ai * 2 + bj) * 4 + m) * 2 + n) * 512] = acc[ai][bj][m][n];
            asm volatile("s_waitcnt vmcnt(0)" ::: "memory"); __builtin_amdgcn_s_barrier(); asm volatile("" ::: "memory");
            if (tid == 0) { __builtin_amdgcn_fence(__ATOMIC_RELEASE, "agent"); asm volatile("s_waitcnt vmcnt(0)" ::: "memory");
                __hip_atomic_store(flag + 16 * u.ul, 1u, __ATOMIC_RELAXED, __HIP_MEMORY_SCOPE_AGENT); }
            return;
        }
        if (u.khalf == 2) {
            if (tid < 64) { unsigned sp = 0;
                while ((unsigned)__builtin_amdgcn_readfirstlane(__hip_atomic_load(flag + 16 * u.ul, __ATOMIC_RELAXED, __HIP_MEMORY_SCOPE_AGENT)) == 0u) { __builtin_amdgcn_s_sleep(2); if (++sp > (1u << 22)) break; }
                __builtin_amdgcn_fence(__ATOMIC_ACQUIRE, "agent"); asm volatile("s_waitcnt vmcnt(0)" ::: "memory"); }
            asm volatile("s_waitcnt vmcnt(0) lgkmcnt(0)" ::: "memory"); __builtin_amdgcn_s_barrier(); asm volatile("" ::: "memory");
        }
        const int col0 = u.pn * HALF + wc * 32 + 8 * fq;
#pragma unroll
        for (int ai = 0; ai < 2; ++ai)
#pragma unroll
            for (int m = 0; m < 4; ++m) {
                const int row = u.pm * BM + ai * HALF + wr * 64 + m * 16 + fr;
                const float rstd = 1.0f / sqrtf(ss[row] * inv_n + eps);
                f32x4 gq[2], uq[2];
#pragma unroll
                for (int n = 0; n < 2; ++n) { gq[n] = acc[ai][0][m][n]; uq[n] = acc[ai][1][m][n]; }
                if (u.khalf == 2) {
#pragma unroll
                    for (int n = 0; n < 2; ++n) { gq[n] += pp[(size_t)(((ai * 2 + 0) * 4 + m) * 2 + n) * 512]; uq[n] += pp[(size_t)(((ai * 2 + 1) * 4 + m) * 2 + n) * 512]; }
                }
                float hv[8];
#pragma unroll
                for (int n = 0; n < 2; ++n)
#pragma unroll
                    for (int i = 0; i < 4; ++i) { const float gg = gq[n][i] * rstd, uu = uq[n][i] * rstd;
                        hv[4 * n + i] = gg * __builtin_amdgcn_rcpf(1.0f + __builtin_amdgcn_exp2f(-1.4426950408889634f * gg)) * uu; }
                u32x4 w; w.x = cvt_pk_bf16(hv[0], hv[1]); w.y = cvt_pk_bf16(hv[2], hv[3]); w.z = cvt_pk_bf16(hv[4], hv[5]); w.w = cvt_pk_bf16(hv[6], hv[7]);
                *(u32x4*)(H + (size_t)row * ldh + col0) = w;
            }
    }
};
struct EpiDown {
    static constexpr bool PERM = false, AFTER_DRAIN = false;
    const bf16_t* base; float* out; float* ss; int ldc;
    __device__ __forceinline__ void operator()(const f32x4 (&acc)[2][2][4][2], const Unit& u, int wr, int wc, int fr, int fq) const {
        typedef unsigned u32x2v __attribute__((ext_vector_type(2)));
        const int col0 = u.pn * BM + wc * 32 + 4 * fq;
#pragma unroll
        for (int ai = 0; ai < 2; ++ai)
#pragma unroll
            for (int m = 0; m < 4; ++m) {
                const int row = u.pm * BM + ai * HALF + wr * 64 + m * 16 + fr; const size_t off = (size_t)row * ldc + col0; float s = 0.f;
#pragma unroll
                for (int bj = 0; bj < 2; ++bj)
#pragma unroll
                    for (int n = 0; n < 2; ++n) {
                        const u32x2v rb = *(const u32x2v*)(base + off + bj * HALF + n * 16);
                        f32x4 x2 = acc[ai][bj][m][n];
                        x2[0] += __uint_as_float(rb.x << 16); x2[1] += __uint_as_float(rb.x & 0xffff0000u); x2[2] += __uint_as_float(rb.y << 16); x2[3] += __uint_as_float(rb.y & 0xffff0000u);
                        *(f32x4*)(out + off + bj * HALF + n * 16) = x2;
                        s += (x2[0] * x2[0] + x2[1] * x2[1]) + (x2[2] * x2[2] + x2[3] * x2[3]);
                    }
                s += __shfl_xor(s, 16); s += __shfl_xor(s, 32);
                if (fq == 0 && u.first) atomicAdd(ss + row, s);
            }
    }
};
struct EpiDownNorm {
    static constexpr bool PERM = false, AFTER_DRAIN = true;
    const bf16_t* base; const float* gres; float* out; const float* g; float* ss; unsigned* cnt; int ldc; float inv_n, eps;
    __device__ __forceinline__ void fused(f32x4 (&acc)[2][2][4][2], const Unit& u, int wr, int wc, int fr, int fq, PG8_LAS unsigned char* lds, int wid, int lane) const {
        typedef unsigned u32x2v __attribute__((ext_vector_type(2)));
        const int col0 = u.pn * BM + wc * 32 + 4 * fq;
        f32x4 rg[2][2];
#pragma unroll
        for (int bj = 0; bj < 2; ++bj)
#pragma unroll
            for (int n = 0; n < 2; ++n) { const f32x4 t = *(const f32x4*)(gres + col0 + bj * HALF + n * 16); rg[bj][n] = (f32x4){1.0f / t[0], 1.0f / t[1], 1.0f / t[2], 1.0f / t[3]}; }
#pragma unroll
        for (int ai = 0; ai < 2; ++ai)
#pragma unroll
            for (int m = 0; m < 4; ++m) {
                const int row = u.pm * BM + ai * HALF + wr * 64 + m * 16 + fr; const size_t off = (size_t)row * ldc + col0; float s = 0.f;
#pragma unroll
                for (int bj = 0; bj < 2; ++bj)
#pragma unroll
                    for (int n = 0; n < 2; ++n) {
                        const u32x2v rb = *(const u32x2v*)(base + off + bj * HALF + n * 16);
                        f32x4 x2 = acc[ai][bj][m][n];
                        x2[0] += __uint_as_float(rb.x << 16) * rg[bj][n][0]; x2[1] += __uint_as_float(rb.x & 0xffff0000u) * rg[bj][n][1]; x2[2] += __uint_as_float(rb.y << 16) * rg[bj][n][2]; x2[3] += __uint_as_float(rb.y & 0xffff0000u) * rg[bj][n][3];
                        acc[ai][bj][m][n] = x2;
                        s += (x2[0] * x2[0] + x2[1] * x2[1]) + (x2[2] * x2[2] + x2[3] * x2[3]);
                    }
                s += __shfl_xor(s, 16); s += __shfl_xor(s, 32);
                if (fq == 0) atomicAdd(ss + row, s);
            }
        asm volatile("s_waitcnt vmcnt(0)" ::: "memory");
        __builtin_amdgcn_s_barrier(); asm volatile("" ::: "memory");
        if (wid == 0) {
            unsigned* c = cnt + 64 * u.pm;
            if (lane == 0) __hip_atomic_fetch_add(c, 1u, __ATOMIC_RELAXED, __HIP_MEMORY_SCOPE_AGENT);
            unsigned sp = 0;
            while ((unsigned)__builtin_amdgcn_readfirstlane(__hip_atomic_load(c, __ATOMIC_RELAXED, __HIP_MEMORY_SCOPE_AGENT)) < 8u) { __builtin_amdgcn_s_sleep(2); if (++sp > (1u << 22)) break; }
            __builtin_amdgcn_fence(__ATOMIC_ACQUIRE, "agent");
        }
        asm volatile("s_waitcnt vmcnt(0) lgkmcnt(0)" ::: "memory"); __builtin_amdgcn_s_barrier(); asm volatile("" ::: "memory");
        f32x4 gv[2][2];
#pragma unroll
        for (int bj = 0; bj < 2; ++bj)
#pragma unroll
            for (int n = 0; n < 2; ++n) gv[bj][n] = *(const f32x4*)(g + col0 + bj * HALF + n * 16);
#pragma unroll
        for (int ai = 0; ai < 2; ++ai)
#pragma unroll
            for (int m = 0; m < 4; ++m) {
                const int row = u.pm * BM + ai * HALF + wr * 64 + m * 16 + fr; const size_t off = (size_t)row * ldc + col0;
                const float rstd = 1.0f / sqrtf(__hip_atomic_load(ss + row, __ATOMIC_RELAXED, __HIP_MEMORY_SCOPE_AGENT) * inv_n + eps);
#pragma unroll
                for (int bj = 0; bj < 2; ++bj)
#pragma unroll
                    for (int n = 0; n < 2; ++n) *(f32x4*)(out + off + bj * HALF + n * 16) = acc[ai][bj][m][n] * rstd * gv[bj][n];
            }
    }
};
template <class Epi, class Sched, bool ALIGN_EPI = false, bool SP2 = false>
__device__ __forceinline__ void gemm_phase(PG8_LAS unsigned char* lds, const Gemm g, const Sched& S, const Epi& E, const int wave_in) {
    const int wid = wave_in, lane = mk_lane(), tid = wid * 64 + lane, wr = wid >> 2, wc = wid & 3, fr = lane & 15, fq = lane >> 4;
    const int K = g.K, nt = K / BK;
    unsigned voffA[2], voffB[2];
#pragma unroll
    for (int i = 0; i < 2; ++i) { int R, C; stage_rc(tid * 16 + i * 8192, R, C); const int Rb = Epi::PERM ? ((R & ~31) + perm32(R & 31)) : R;
        voffA[i] = (unsigned)(R * K + C) * 2u; voffB[i] = (unsigned)(Rb * K + C) * 2u; }
    const size_t kstep = (size_t)(BK * 2);
    const size_t hstep = (size_t)HALF * K * 2;
    const size_t tstep = 2 * hstep;
    const unsigned ldsw = (unsigned)wid * 1024u;
    const int aoff = lds_byte(wr * 64 + fr, fq * 8), boff = lds_byte(wc * 32 + fr, fq * 8);
#define PG8_SA(b, h) (((b) * 2 + (h)) * HTB)
#define PG8_SB(b, h) ((4 + (b) * 2 + (h)) * HTB)
#define PG8_STAGE(bufoff, gbase, voff) do { _Pragma("unroll") for (int _i = 0; _i < 2; ++_i) \
        __builtin_amdgcn_global_load_lds((const unsigned*)((const char*)(gbase) + (voff)[_i]), (PG8_LAS unsigned*)(lds + (bufoff) + ldsw + _i * 8192), 16, 0, 0); } while (0)
#define PG8_LDA(dst, b, h) do { _Pragma("unroll") for (int m = 0; m < 4; ++m) _Pragma("unroll") for (int k = 0; k < 2; ++k) dst[m][k] = *(const PG8_LAS bf16x8*)(lds + PG8_SA(b, h) + aoff + m * 2048 + k * 1024); } while (0)
#define PG8_LDB(dst, b, h) do { _Pragma("unroll") for (int n = 0; n < 2; ++n) _Pragma("unroll") for (int k = 0; k < 2; ++k) dst[n][k] = *(const PG8_LAS bf16x8*)(lds + PG8_SB(b, h) + boff + n * 2048 + k * 1024); } while (0)
#define PG8_MMA(ai, bj, At, Bt) do { __builtin_amdgcn_s_setprio(1); _Pragma("unroll") for (int m = 0; m < 4; ++m) _Pragma("unroll") for (int n = 0; n < 2; ++n) _Pragma("unroll") for (int k = 0; k < 2; ++k) \
        acc[ai][bj][m][n] = __builtin_amdgcn_mfma_f32_16x16x32_bf16(Bt[n][k], At[m][k], acc[ai][bj][m][n], 0, 0, 0); __builtin_amdgcn_s_setprio(0); } while (0)
#define PG8_WAIT_V(n) asm volatile("s_waitcnt vmcnt(" #n ")" ::: "memory")
#define PG8_WAIT_L(n) asm volatile("s_waitcnt lgkmcnt(" #n ")" ::: "memory")
#define PG8_BAR __builtin_amdgcn_s_barrier()
#define PG8_SCHED __builtin_amdgcn_sched_barrier(0)
    Unit cur, nxt; int ui = 0;
    if (!S.next(0, cur)) return;
    f32x4 acc[2][2][4][2];
#pragma unroll
    for (int a = 0; a < 2; ++a)
#pragma unroll
        for (int b = 0; b < 2; ++b)
#pragma unroll
            for (int m = 0; m < 4; ++m)
#pragma unroll
                for (int n = 0; n < 2; ++n) acc[a][b][m][n] = (f32x4){0.f, 0.f, 0.f, 0.f};
    bf16x8 At[4][2], B0[2][2], B1[2][2];
    const char* cA = (const char*)g.A + (size_t)cur.pm * tstep + cur.koff; const char* cB = (const char*)g.Bt + (size_t)cur.pn * tstep + cur.koff; int ntc = cur.nt ? cur.nt : nt;
    S.a_ready(cur);
    if constexpr (SP2) {
        PG8_STAGE(PG8_SB(0, 0), cB, voffB); PG8_STAGE(PG8_SB(0, 1), cB + hstep, voffB); PG8_STAGE(PG8_SA(0, 0), cA, voffA); PG8_STAGE(PG8_SA(0, 1), cA + hstep, voffA);
        if (wr == 1) PG8_BAR;
        PG8_WAIT_V(2); PG8_BAR;
        PG8_STAGE(PG8_SB(1, 0), cB + kstep, voffB); PG8_STAGE(PG8_SA(1, 0), cA + kstep, voffA); PG8_STAGE(PG8_SB(1, 1), cB + hstep + kstep, voffB);
        PG8_WAIT_V(6); PG8_BAR;
    } else {
        PG8_STAGE(PG8_SB(0, 0), cB, voffB); PG8_STAGE(PG8_SA(0, 0), cA, voffA); PG8_STAGE(PG8_SB(0, 1), cB + hstep, voffB); PG8_STAGE(PG8_SA(0, 1), cA + hstep, voffA);
        if (wr == 1) PG8_BAR;
        PG8_WAIT_V(4); PG8_BAR;
        PG8_STAGE(PG8_SB(1, 0), cB + kstep, voffB); PG8_STAGE(PG8_SA(1, 0), cA + kstep, voffA); PG8_STAGE(PG8_SB(1, 1), cB + hstep + kstep, voffB);
        PG8_WAIT_V(6); PG8_BAR;
    }
    for (;;) {
        const bool has_next = S.next(ui + 1, nxt);
        const char* nA = has_next ? (const char*)g.A + (size_t)nxt.pm * tstep + nxt.koff : cA; const char* nB = has_next ? (const char*)g.Bt + (size_t)nxt.pn * tstep + nxt.koff : cB;
        for (int t = 0; t < ntc; t += 2) {
            const bool last = (t == ntc - 2);
            const char* a1 = cA + (size_t)(t + 1) * kstep;
            const char* a2 = last ? nA : cA + (size_t)(t + 2) * kstep; const char* b2 = last ? nB : cB + (size_t)(t + 2) * kstep;
            const char* a3 = a2 + kstep; const char* b3 = b2 + kstep;
            if (last && has_next) S.a_ready(nxt);
            if constexpr (SP2) {
            PG8_LDB(B0, 0, 0); PG8_LDB(B1, 0, 1); PG8_SCHED; PG8_LDA(At, 0, 0); PG8_STAGE(PG8_SA(1, 1), a1 + hstep, voffA);
            PG8_WAIT_V(8); PG8_WAIT_L(0); PG8_BAR; PG8_MMA(0, 0, At, B0); PG8_MMA(0, 1, At, B1); PG8_BAR; PG8_SCHED;
            PG8_LDA(At, 0, 1); PG8_STAGE(PG8_SB(0, 0), b2, voffB); PG8_STAGE(PG8_SB(0, 1), b2 + hstep, voffB); PG8_STAGE(PG8_SA(0, 0), a2, voffA);
            PG8_WAIT_V(8); PG8_WAIT_L(0); PG8_BAR; PG8_MMA(1, 0, At, B0); PG8_MMA(1, 1, At, B1); PG8_BAR; PG8_SCHED;
            PG8_LDB(B0, 1, 0); PG8_LDB(B1, 1, 1); PG8_SCHED; PG8_LDA(At, 1, 0); PG8_STAGE(PG8_SA(0, 1), a2 + hstep, voffA);
            PG8_WAIT_V(8); PG8_WAIT_L(0); PG8_BAR; PG8_MMA(0, 0, At, B0); PG8_MMA(0, 1, At, B1); PG8_BAR; PG8_SCHED;
            PG8_LDA(At, 1, 1); PG8_STAGE(PG8_SB(1, 0), b3, voffB); PG8_STAGE(PG8_SB(1, 1), b3 + hstep, voffB); PG8_STAGE(PG8_SA(1, 0), a3, voffA);
            PG8_WAIT_V(8); PG8_WAIT_L(0); PG8_BAR; PG8_MMA(1, 0, At, B0); PG8_MMA(1, 1, At, B1); PG8_BAR; PG8_SCHED;
            } else {
            PG8_LDB(B0, 0, 0); PG8_SCHED; PG8_LDA(At, 0, 0); PG8_STAGE(PG8_SA(1, 1), a1 + hstep, voffA);
            PG8_WAIT_L(8); PG8_BAR; PG8_WAIT_L(0); PG8_MMA(0, 0, At, B0); PG8_BAR; PG8_SCHED;
            PG8_LDB(B1, 0, 1); PG8_STAGE(PG8_SB(0, 0), b2, voffB);
            PG8_BAR; PG8_WAIT_L(0); PG8_MMA(0, 1, At, B1); PG8_BAR;
            PG8_LDA(At, 0, 1); PG8_STAGE(PG8_SA(0, 0), a2, voffA);
            PG8_BAR; PG8_WAIT_L(0); PG8_MMA(1, 0, At, B0); PG8_BAR; PG8_SCHED;
            PG8_STAGE(PG8_SB(0, 1), b2 + hstep, voffB);
            PG8_WAIT_V(6); PG8_BAR; PG8_MMA(1, 1, At, B1); PG8_BAR;
            PG8_LDB(B0, 1, 0); PG8_SCHED; PG8_LDA(At, 1, 0); PG8_STAGE(PG8_SA(0, 1), a2 + hstep, voffA);
            PG8_WAIT_L(8); PG8_BAR; PG8_WAIT_L(0); PG8_MMA(0, 0, At, B0); PG8_BAR; PG8_SCHED;
            PG8_LDB(B1, 1, 1); PG8_STAGE(PG8_SB(1, 0), b3, voffB);
            PG8_BAR; PG8_WAIT_L(0); PG8_MMA(0, 1, At, B1); PG8_BAR;
            PG8_LDA(At, 1, 1); PG8_STAGE(PG8_SA(1, 0), a3, voffA);
            PG8_BAR; PG8_WAIT_L(0); PG8_MMA(1, 0, At, B0); PG8_BAR; PG8_SCHED;
            PG8_STAGE(PG8_SB(1, 1), b3 + hstep, voffB);
            PG8_WAIT_V(6); PG8_BAR; PG8_MMA(1, 1, At, B1); PG8_BAR;
            }
        }
        if constexpr (ALIGN_EPI) { if (wr == 0) PG8_BAR; }
        if constexpr (!Epi::AFTER_DRAIN) { E(acc, cur, wr, wc, fr, fq); S.done(cur); }
        if (!has_next) break;
#pragma unroll
        for (int a = 0; a < 2; ++a)
#pragma unroll
            for (int b = 0; b < 2; ++b)
#pragma unroll
                for (int m = 0; m < 4; ++m)
#pragma unroll
                    for (int n = 0; n < 2; ++n) acc[a][b][m][n] = (f32x4){0.f, 0.f, 0.f, 0.f};
        cur = nxt; cA = nA; cB = nB; ++ui; ntc = cur.nt ? cur.nt : nt;
        if constexpr (ALIGN_EPI) { if (wr == 1) PG8_BAR; }
    }
    PG8_WAIT_V(0);
    if constexpr (!ALIGN_EPI) { if (wr == 0) PG8_BAR; }
    PG8_BAR;
    if constexpr (Epi::AFTER_DRAIN) { E.fused(acc, cur, wr, wc, fr, fq, lds, wid, lane); S.done(cur); }
#undef PG8_SA
#undef PG8_SB
#undef PG8_STAGE
#undef PG8_LDA
#undef PG8_LDB
#undef PG8_MMA
#undef PG8_WAIT_V
#undef PG8_WAIT_L
#undef PG8_BAR
#undef PG8_SCHED
}
}
namespace att {
using bf16 = __hip_bfloat16;
using bf16x8 = __attribute__((ext_vector_type(8))) short;
using s16x4  = __attribute__((ext_vector_type(4))) short;
using f32x16 = __attribute__((ext_vector_type(16))) float;
using u32x4  = __attribute__((ext_vector_type(4))) unsigned;
constexpr int D = 128, NW = 8, QBLK = 32, KVBLK = 64;
constexpr int LDR = 6144;
constexpr size_t SHM_V = KVBLK * D * 2, SHM_K = KVBLK * D * 2, SHM_ATTN = 2 * SHM_V + 2 * SHM_K + NW * 64 * 4;
#define KSWZ(row, colB) ((row) * 256 + ((colB) ^ (((row) & 7) << 4)))
#define SBAR() __builtin_amdgcn_sched_barrier(0)
__device__ __forceinline__ int crow(int r, int hi) { return (r & 3) + 8 * (r >> 2) + 4 * hi; }
__device__ __forceinline__ unsigned cvtpk(float lo, float hi) { unsigned r; asm volatile("v_cvt_pk_bf16_f32 %0, %1, %2" : "=v"(r) : "v"(lo), "v"(hi)); return r; }
__device__ __forceinline__ unsigned short f2bf1(float x) { return (unsigned short)(cvtpk(x, x) & 0xffffu); }
#define PK4(P, BASE, OUT) do { unsigned a0 = cvtpk(P[BASE + 0], P[BASE + 1]), a1 = cvtpk(P[BASE + 2], P[BASE + 3]);   \
    unsigned b0 = cvtpk(P[BASE + 4], P[BASE + 5]), b1 = cvtpk(P[BASE + 6], P[BASE + 7]);                              \
    auto r0 = __builtin_amdgcn_permlane32_swap(a0, b0, false, false); auto r1 = __builtin_amdgcn_permlane32_swap(a1, b1, false, false); \
    u32x4 w = {r0[0], r1[0], r0[1], r1[1]}; OUT = *reinterpret_cast<bf16x8*>(&w); } while (0)

template <int SCALE_E6>
struct SM {
    static constexpr float SCALE = SCALE_E6 == 125000 ? 0.125f : 0.088388347648318440f;
    static constexpr float THR = 8.f;
    static __device__ __forceinline__ void partialSM(f32x16& p0, f32x16& p1, float& m_reg, float& mn, float& alpha) {
        constexpr float C = SCALE * 1.4426950408889634f;
        float pmax = p0[0];
#pragma unroll
        for (int r = 1; r < 16; ++r) pmax = fmaxf(pmax, p0[r]);
#pragma unroll
        for (int r = 0; r < 16; ++r) pmax = fmaxf(pmax, p1[r]);
        { auto rr = __builtin_amdgcn_permlane32_swap(__float_as_uint(pmax), __float_as_uint(pmax), false, false);
          pmax = fmaxf(__uint_as_float(rr[0]), __uint_as_float(rr[1])); }
        if (__builtin_expect(__all(pmax - m_reg <= THR / SCALE), 1)) { mn = m_reg; alpha = 1.f; }
        else { mn = fmaxf(m_reg, pmax); alpha = __builtin_amdgcn_exp2f((m_reg - mn) * C); m_reg = mn; }
        float mnC = -mn * C;
#pragma unroll
        for (int r = 0; r < 16; ++r) p0[r] = fmaf(p0[r], C, mnC);
#pragma unroll
        for (int r = 0; r < 16; ++r) p1[r] = fmaf(p1[r], C, mnC);
#pragma unroll
        for (int r = 0; r < 16; ++r) p0[r] = __builtin_amdgcn_exp2f(p0[r]);
    }
};
__device__ __forceinline__ void finishSM(f32x16& p0, f32x16& p1, float alpha, float& l_reg, bf16x8& pa0, bf16x8& pa1, bf16x8& pa2, bf16x8& pa3) {
#pragma unroll
    for (int r = 0; r < 16; ++r) p1[r] = __builtin_amdgcn_exp2f(p1[r]);
    float ps = 0;
#pragma unroll
    for (int r = 0; r < 16; ++r) ps += p0[r];
#pragma unroll
    for (int r = 0; r < 16; ++r) ps += p1[r];
    { auto rr = __builtin_amdgcn_permlane32_swap(__float_as_uint(ps), __float_as_uint(ps), false, false);
      ps = __uint_as_float(rr[0]) + __uint_as_float(rr[1]); }
    l_reg = l_reg * alpha + ps;
    PK4(p0, 0, pa0); PK4(p0, 8, pa1); PK4(p1, 0, pa2); PK4(p1, 8, pa3);
}
template <int ND0>
__device__ __forceinline__ void qkt(f32x16& p0, f32x16& p1, const bf16* Ks, const bf16x8* qr, int dbase, int r32, int hi) {
    p0 = f32x16{}; p1 = f32x16{};
#pragma unroll
    for (int d0 = 0; d0 < ND0; ++d0) { int cb = ((dbase + d0) * 16 + hi * 8) * 2;
        bf16x8 b0 = *reinterpret_cast<const bf16x8*>((const char*)Ks + KSWZ(r32, cb));
        bf16x8 b1 = *reinterpret_cast<const bf16x8*>((const char*)Ks + KSWZ(32 + r32, cb));
        p0 = __builtin_amdgcn_mfma_f32_32x32x16_bf16(b0, qr[d0], p0, 0, 0, 0);
        p1 = __builtin_amdgcn_mfma_f32_32x32x16_bf16(b1, qr[d0], p1, 0, 0, 0); }
}
__device__ __forceinline__ int v_st(int k, int c) { const int kk = (k & ~0xC) | ((k & 4) << 1) | ((k & 8) >> 1); return ((kk >> 3) * 4 + (c >> 5)) * 512 + ((kk & 7) * 32 + (c & 31)) * 2; }
__device__ __forceinline__ int v_rd_base(int lane) { return ((lane & 3) << 3) | (((lane >> 2) & 3) << 6) | (((lane >> 4) & 1) << 5) | (((lane >> 5) & 1) << 8); }
constexpr int v_rd_off(int d0, int ks, int half) { return d0 * 512 + ks * 4096 + half * 2048; }
template <int OFF> __device__ __forceinline__ s16x4 tr_read(int vb) {
    s16x4 r; asm volatile("ds_read_b64_tr_b16 %0, %1 offset:%2" : "=&v"(r) : "v"(vb), "i"(OFF) : "memory"); return r;
}
#define PKV(L, H) (bf16x8){L[0], L[1], L[2], L[3], H[0], H[1], H[2], H[3]}
template <int D0> __device__ __forceinline__ void pv_one(f32x16& od, int vb, bf16x8 pa0, bf16x8 pa1, bf16x8 pa2, bf16x8 pa3) {
    const s16x4 l0 = tr_read<v_rd_off(D0, 0, 0)>(vb), h0 = tr_read<v_rd_off(D0, 0, 1)>(vb), l1 = tr_read<v_rd_off(D0, 1, 0)>(vb), h1 = tr_read<v_rd_off(D0, 1, 1)>(vb);
    const s16x4 l2 = tr_read<v_rd_off(D0, 2, 0)>(vb), h2 = tr_read<v_rd_off(D0, 2, 1)>(vb), l3 = tr_read<v_rd_off(D0, 3, 0)>(vb), h3 = tr_read<v_rd_off(D0, 3, 1)>(vb);
    asm volatile("s_waitcnt lgkmcnt(0)" ::: "memory"); SBAR();
    od = __builtin_amdgcn_mfma_f32_32x32x16_bf16(pa0, PKV(l0, h0), od, 0, 0, 0);
    od = __builtin_amdgcn_mfma_f32_32x32x16_bf16(pa1, PKV(l1, h1), od, 0, 0, 0);
    od = __builtin_amdgcn_mfma_f32_32x32x16_bf16(pa2, PKV(l2, h2), od, 0, 0, 0);
    od = __builtin_amdgcn_mfma_f32_32x32x16_bf16(pa3, PKV(l3, h3), od, 0, 0, 0);
}
__device__ __forceinline__ void pv_d0(f32x16* o, int vb, bf16x8 pa0, bf16x8 pa1, bf16x8 pa2, bf16x8 pa3) {
    pv_one<0>(o[0], vb, pa0, pa1, pa2, pa3); pv_one<1>(o[1], vb, pa0, pa1, pa2, pa3); pv_one<2>(o[2], vb, pa0, pa1, pa2, pa3); pv_one<3>(o[3], vb, pa0, pa1, pa2, pa3);
}
template <int D0> __device__ __forceinline__ void pv_one32(f32x16& od, int vb, bf16x8 pa0, bf16x8 pa1) {
    const s16x4 l0 = tr_read<v_rd_off(D0, 0, 0)>(vb), h0 = tr_read<v_rd_off(D0, 0, 1)>(vb), l1 = tr_read<v_rd_off(D0, 1, 0)>(vb), h1 = tr_read<v_rd_off(D0, 1, 1)>(vb);
    asm volatile("s_waitcnt lgkmcnt(0)" ::: "memory"); SBAR();
    od = __builtin_amdgcn_mfma_f32_32x32x16_bf16(pa0, PKV(l0, h0), od, 0, 0, 0);
    od = __builtin_amdgcn_mfma_f32_32x32x16_bf16(pa1, PKV(l1, h1), od, 0, 0, 0);
}

typedef float f32x4c __attribute__((ext_vector_type(4)));
struct ConvJob {
    const float *w_gate, *w_up, *w_down, *w_out, *g_ffn; unsigned short *WGU, *WDN, *WOUT;
    int next, end, stride;
};
struct ConvItem { const float* W; unsigned short* dst; int N, K, k0, n0, drow; };
constexpr int CV_GU = 32 * 88, CV_OUT = 32 * 32, CV_TOTAL = 2 * CV_GU + CV_OUT;
__device__ __forceinline__ ConvItem conv_item(const float* Jw_gate, const float* Jw_up, const float* Jw_down, const float* Jw_out, unsigned short* JWGU, unsigned short* JWDN, unsigned short* JWOUT, int q) {
    ConvItem it;
    const bool gu = q < 2 * CV_GU; const int up = (q >= CV_GU) ? 1 : 0;
    const int rg = q - up * CV_GU, kbg = rg / 88, nbg = rg - kbg * 88;
    const int rd = gu ? 0 : q - 2 * CV_GU, kbd = rd >> 5, nbd = rd & 31;
    it.W = gu ? (up ? Jw_up : Jw_gate) : Jw_out;
    it.dst = gu ? JWGU : JWOUT;
    it.N = gu ? 5632 : 2048; it.K = 2048;
    it.k0 = 64 * (gu ? kbg : kbd); it.n0 = 64 * (gu ? nbg : nbd);
    it.drow = gu ? 256 * (it.n0 >> 7) + 128 * up + (it.n0 & 127) : it.n0;
    return it;
}
__device__ __forceinline__ void attn_dense_body(const bf16* __restrict__ Qb, const bf16* __restrict__ Kh, const bf16* __restrict__ Vh,
                                                unsigned short* __restrict__ Ob, int ldo, int dbase, int seq, char* lds, const int wave_in, ConvJob& cj,
                                                const bool second, unsigned short* __restrict__ Yb, const float lam, const float* __restrict__ subln) {
    using S8 = SM<125000>;
    const int wid = wave_in, lane = mk_lane(), tid = wid * 64 + lane, r32 = lane & 31, hi = lane >> 5;
    bf16* V_lds = (bf16*)lds; bf16* K_lds = (bf16*)(lds + 2 * SHM_V);
    float* ws = (float*)(lds + 2 * SHM_V + 2 * SHM_K) + wid * 64; float* li_l = ws; float* al_l = ws + 32;
    float m_reg = -1e30f, l_reg = 0; f32x16 o[4] = {}; bf16x8 qr[4];
    const bf16* Qw = Qb + (long)(wid * QBLK + r32) * LDR + dbase * 16 + hi * 8;
#pragma unroll
    for (int d0 = 0; d0 < 4; ++d0) qr[d0] = *reinterpret_cast<const bf16x8*>(Qw + d0 * 16);
    const int sr = tid >> 4, sc = (tid & 15) * 8, vst0 = v_st(sr, sc), vst1 = v_st(32 + sr, sc);
    const int vb0 = (int)(uintptr_t)V_lds + v_rd_base(lane);
    struct { bf16x8 vs0, vs1, ks0; } sr_[2];
    const int krow = tid >> 3, kcol = dbase * 16 + (tid & 7) * 8, kst0 = KSWZ(krow, kcol * 2);
#define SLOAD(i, k0) do { sr_[i].vs0 = *reinterpret_cast<const bf16x8*>(&Vh[(long)((k0) + sr) * LDR + sc]); sr_[i].vs1 = *reinterpret_cast<const bf16x8*>(&Vh[(long)((k0) + 32 + sr) * LDR + sc]); \
    sr_[i].ks0 = *reinterpret_cast<const bf16x8*>(&Kh[(long)((k0) + krow) * LDR + kcol]); } while (0)
#define SWRITE(b, i) do { *(bf16x8*)((char*)V_lds + (b) * SHM_V + vst0) = sr_[i].vs0;          \
    *(bf16x8*)((char*)V_lds + (b) * SHM_V + vst1) = sr_[i].vs1;                              \
    *(bf16x8*)((char*)K_lds + (b) * SHM_K + kst0) = sr_[i].ks0; } while (0)
#define SWAIT() do {} while (0)
#define RESC(a) do { if (__any((a) < 1.f)) { if (hi == 0) al_l[r32] = (a); asm volatile("s_waitcnt lgkmcnt(0)" ::: "memory"); \
    _Pragma("unroll") for (int d = 0; d < 4; ++d) _Pragma("unroll") for (int r = 0; r < 16; ++r) o[d][r] *= al_l[crow(r, hi)]; } } while (0)
    f32x16 pA0, pA1, pB0, pB1; float mnA, mnB, alA, alB; bf16x8 pa0, pa1, pa2, pa3; const int NT = seq / KVBLK;
    const float* const jwg = cj.w_gate; const float* const jwu = cj.w_up; const float* const jwd = cj.w_down; const float* const jwo = cj.w_out;
    unsigned short* const jGU = cj.WGU; unsigned short* const jDN = cj.WDN; unsigned short* const jOUT = cj.WOUT; const int jnext = cj.next, jend = cj.end, jstride = cj.stride;
    float* cscr = (float*)(lds + SHM_ATTN); f32x4c cv0, cv1; int slot = 0;
#define CV_Q(k) (min(jnext + (k) * jstride, jend))
#define CV_LOAD(q) do { const ConvItem it_ = conv_item(jwg, jwu, jwd, jwo, jGU, jDN, jOUT, (q)); const float* s_ = it_.W + (size_t)(it_.k0 + (tid >> 3)) * it_.N + it_.n0 + 8 * (tid & 7); \
    cv0 = *(const f32x4c*)s_; cv1 = *(const f32x4c*)(s_ + 4); } while (0)
#define CV_WRITE() do { f32x4c* d_ = (f32x4c*)(cscr + (tid >> 3) * 64 + 8 * ((tid & 7) ^ ((tid >> 6) & 7))); d_[0] = cv0; d_[1] = cv1; } while (0)
#define CV_STORE(q) do { const ConvItem it_ = conv_item(jwg, jwu, jwd, jwo, jGU, jDN, jOUT, (q)); const int n_ = tid >> 3, c_ = tid & 7; const float* s_ = cscr + (8 * c_) * 64 + (n_ ^ (8 * c_)); \
    u32x4 o_; o_.x = cvtpk(s_[0], s_[64]); o_.y = cvtpk(s_[128], s_[192]); o_.z = cvtpk(s_[256], s_[320]); o_.w = cvtpk(s_[384], s_[448]); \
    *(u32x4*)(it_.dst + (size_t)(it_.drow + n_) * it_.K + it_.k0 + 8 * c_) = o_; } while (0)
#define CV_CONSUME() do { CV_WRITE(); const int qn_ = CV_Q(slot + 1); CV_LOAD(qn_); } while (0)
#define CV_FINISH() do { const int qc_ = CV_Q(slot); CV_STORE(qc_); ++slot; } while (0)
    const int owed = (jnext > jend) ? 0 : (jend - jnext) / jstride + 1;
    const int ctrips = min((owed + 1) >> 1, (NT - 2) >> 1);
    if (ctrips > 0) { const int q0_ = CV_Q(0); CV_LOAD(q0_); }
    constexpr int SE = 0, SO = 1;
    SLOAD(SE, 0); asm volatile("s_waitcnt vmcnt(0)" ::: "memory"); SWRITE(0, SE); __syncthreads();
    qkt<4>(pA0, pA1, K_lds, qr, dbase, r32, hi); S8::partialSM(pA0, pA1, m_reg, mnA, alA);
    SLOAD(SO, KVBLK); if (2 < NT) SLOAD(SE, 2 * KVBLK);
    SWAIT(); SWRITE(1, SO); __syncthreads();
#define B_TRIP(CONV) do { \
        SBAR(); qkt<4>(pB0, pB1, (bf16*)((char*)K_lds + SHM_K), qr, dbase, r32, hi); \
        finishSM(pA0, pA1, alA, l_reg, pa0, pa1, pa2, pa3); SBAR(); \
        SLOAD(SO, (j + 2) * KVBLK); SBAR(); \
        pv_d0(o, vb0, pa0, pa1, pa2, pa3); S8::partialSM(pB0, pB1, m_reg, mnB, alB); \
        __syncthreads(); SWAIT(); SWRITE(0, SE); \
        if (CONV) CV_CONSUME(); \
        RESC(alB); __syncthreads(); \
        if (CONV) CV_FINISH(); \
        SBAR(); qkt<4>(pA0, pA1, K_lds, qr, dbase, r32, hi); \
        finishSM(pB0, pB1, alB, l_reg, pa0, pa1, pa2, pa3); SBAR(); \
        SLOAD(SE, min(j + 3, NT - 1) * KVBLK); SBAR();     \
        pv_d0(o, vb0 + (int)SHM_V, pa0, pa1, pa2, pa3); S8::partialSM(pA0, pA1, m_reg, mnA, alA); \
        __syncthreads(); SWAIT(); SWRITE(1, SO); \
        if (CONV) CV_CONSUME(); \
        RESC(alA); __syncthreads(); \
        if (CONV) CV_FINISH(); } while (0)
    int j = 1;
    for (int tr = 0; tr < ctrips; ++tr, j += 2) B_TRIP(true);
    for (; j + 1 < NT; j += 2) B_TRIP(false);
#undef B_TRIP
    cj.next = min(jnext + slot * jstride, jend + jstride);
    SBAR(); qkt<4>(pB0, pB1, (bf16*)((char*)K_lds + SHM_K), qr, dbase, r32, hi);
    finishSM(pA0, pA1, alA, l_reg, pa0, pa1, pa2, pa3); SBAR();
    pv_d0(o, vb0, pa0, pa1, pa2, pa3); S8::partialSM(pB0, pB1, m_reg, mnB, alB);
    __syncthreads(); RESC(alB);
    finishSM(pB0, pB1, alB, l_reg, pa0, pa1, pa2, pa3); SBAR();
    pv_d0(o, vb0 + (int)SHM_V, pa0, pa1, pa2, pa3);
    if (hi == 0) li_l[r32] = l_reg; asm volatile("s_waitcnt lgkmcnt(0)" ::: "memory");
    float rli[16];
#pragma unroll
    for (int r = 0; r < 16; ++r) rli[r] = __builtin_amdgcn_rcpf(li_l[crow(r, hi)]);
    unsigned short* Ow = (unsigned short*)(lds + SHM_ATTN + 16384) + wid * 4096;
    if (!second) {
#pragma unroll
        for (int r = 0; r < 16; ++r) { int orow = crow(r, hi);
#pragma unroll
            for (int d0 = 0; d0 < 4; ++d0) Ow[orow * 128 + d0 * 32 + r32] = f2bf1(o[d0][r] * rli[r]); }
        asm volatile("s_waitcnt lgkmcnt(0)" ::: "memory");
    } else {
        float ssq[16];
#pragma unroll
        for (int r = 0; r < 16; ++r) { const int orow = crow(r, hi); ssq[r] = 0.f;
#pragma unroll
            for (int d0 = 0; d0 < 4; ++d0) { const float o0 = __uint_as_float((unsigned)Ow[orow * 128 + d0 * 32 + r32] << 16);
                const float d = o0 - lam * (o[d0][r] * rli[r]); o[d0][r] = d; ssq[r] += d * d; } }
#pragma unroll
        for (int r = 0; r < 16; ++r) { float v = ssq[r]; v += __shfl_xor(v, 1); v += __shfl_xor(v, 2); v += __shfl_xor(v, 4); v += __shfl_xor(v, 8); v += __shfl_xor(v, 16); ssq[r] = v; }
        float sl[4];
#pragma unroll
        for (int d0 = 0; d0 < 4; ++d0) sl[d0] = subln[d0 * 32 + r32] * 0.8f;
        unsigned short* Yw = Yb + (long)(wid * QBLK) * 2048;
#pragma unroll
        for (int r = 0; r < 16; ++r) { const int orow = crow(r, hi); const float rs = 1.0f / sqrtf(ssq[r] * (1.0f / 128.0f) + 1e-5f);
#pragma unroll
            for (int d0 = 0; d0 < 4; ++d0) Yw[(long)orow * 2048 + d0 * 32 + r32] = f2bf1(o[d0][r] * rs * sl[d0]); }
    }
#undef CV_LOAD
#undef CV_Q
#undef CV_STORE
#undef CV_WRITE
#undef CV_CONSUME
#undef CV_FINISH
#undef SLOAD
#undef SWRITE
#undef SWAIT
#undef RESC
}

__device__ __forceinline__ void swa_wave_unit(const bf16* __restrict__ base, long rstride, int qc, int kc, int vc, int t0, int L,
                                              unsigned short* __restrict__ Ob, long ostride, float* __restrict__ Lb, long lstride, char* lds_w, float* scr) {
    constexpr float SCALE = 0.088388347648318440f, C = SCALE * 1.4426950408889634f;
    const int lane = mk_lane(), r32 = lane & 31, hi = lane >> 5;
    bf16* K_lds = (bf16*)lds_w; char* V_lds = lds_w + 8192;
    bf16x8 qr[8];
    { const bf16* Qw = base + (long)(t0 + r32) * rstride + qc + hi * 8;
#pragma unroll
      for (int d0 = 0; d0 < 8; ++d0) qr[d0] = *reinterpret_cast<const bf16x8*>(Qw + d0 * 16); }
    const int srow = lane >> 4, scol = (lane & 15) * 8;
    const bf16* kbase = base + (long)srow * rstride + kc + scol; const bf16* vbase = base + (long)srow * rstride + vc + scol;
    bf16x8 st[2][8];
#define TILE_K0(i) (t0 - 64 + 32 * (i))
#define TILE_OK(i) (TILE_K0(i) >= 0 && TILE_K0(i) < L)
#define TILE_KC(i) (min(max(TILE_K0(i), 0), L - 32))
#define LD_TILE(buf, pbase, i) do { const bf16* p_ = (pbase) + (long)TILE_KC(i) * rstride; _Pragma("unroll") for (int j = 0; j < 8; ++j) st[buf][j] = *reinterpret_cast<const bf16x8*>(p_ + (long)(4 * j) * rstride); } while (0)
    f32x16 s[5];
    LD_TILE(0, kbase, 0);
#pragma unroll
    for (int i = 0; i < 5; ++i) {
        if (i < 4) LD_TILE((i + 1) & 1, kbase, i + 1); else LD_TILE((i + 1) & 1, vbase, 0);
#pragma unroll
        for (int j = 0; j < 8; ++j) *(bf16x8*)((char*)K_lds + KSWZ(4 * j + srow, scol * 2)) = st[i & 1][j];
        f32x16 p = f32x16{};
#pragma unroll
        for (int d0 = 0; d0 < 8; ++d0) { const int cb = (d0 * 16 + hi * 8) * 2;
            const bf16x8 b0 = *reinterpret_cast<const bf16x8*>((const char*)K_lds + KSWZ(r32, cb));
            p = __builtin_amdgcn_mfma_f32_32x32x16_bf16(b0, qr[d0], p, 0, 0, 0); }
        const bool ok = TILE_OK(i);
#pragma unroll
        for (int r = 0; r < 16; ++r) {
            bool keep = ok;
            if (i == 0) keep = keep && (crow(r, hi) >= r32);
            if (i == 4) keep = keep && (crow(r, hi) <= r32);
            s[i][r] = keep ? p[r] : -1e30f;
        }
    }
    float m = -1e30f;
#pragma unroll
    for (int i = 0; i < 5; ++i)
#pragma unroll
        for (int r = 0; r < 16; ++r) m = fmaxf(m, s[i][r]);
    { auto rr = __builtin_amdgcn_permlane32_swap(__float_as_uint(m), __float_as_uint(m), false, false);
      m = fmaxf(__uint_as_float(rr[0]), __uint_as_float(rr[1])); }
    const float mC = -m * C; float l = 0.f;
#pragma unroll
    for (int i = 0; i < 5; ++i)
#pragma unroll
        for (int r = 0; r < 16; ++r) { s[i][r] = __builtin_amdgcn_exp2f(fmaf(s[i][r], C, mC)); l += s[i][r]; }
    { auto rr = __builtin_amdgcn_permlane32_swap(__float_as_uint(l), __float_as_uint(l), false, false);
      l = __uint_as_float(rr[0]) + __uint_as_float(rr[1]); }
    bf16x8 pa[5][2];
#pragma unroll
    for (int i = 0; i < 5; ++i) { PK4(s[i], 0, pa[i][0]); PK4(s[i], 8, pa[i][1]); }
    f32x16 o[4] = {};
    const int vb = (int)(uintptr_t)V_lds + v_rd_base(lane);
#pragma unroll
    for (int i = 0; i < 5; ++i) {
        if (i < 4) LD_TILE(i & 1, vbase, i + 1);
#pragma unroll
        for (int j = 0; j < 8; ++j) *(bf16x8*)(V_lds + v_st(4 * j + srow, scol)) = st[(i + 1) & 1][j];
        asm volatile("s_waitcnt lgkmcnt(0)" ::: "memory");
        pv_one32<0>(o[0], vb, pa[i][0], pa[i][1]); pv_one32<1>(o[1], vb, pa[i][0], pa[i][1]); pv_one32<2>(o[2], vb, pa[i][0], pa[i][1]); pv_one32<3>(o[3], vb, pa[i][0], pa[i][1]);
    }
#undef TILE_K0
#undef TILE_OK
#undef TILE_KC
#undef LD_TILE
    if (hi == 0) { scr[r32] = l; Lb[(long)(t0 + r32) * lstride] = m * SCALE + __logf(l); }
    asm volatile("s_waitcnt lgkmcnt(0)" ::: "memory");
    float rli[16];
#pragma unroll
    for (int r = 0; r < 16; ++r) rli[r] = __builtin_amdgcn_rcpf(scr[crow(r, hi)]);
#pragma unroll
    for (int r = 0; r < 16; ++r) { const long orow = (long)(t0 + crow(r, hi)) * ostride;
#pragma unroll
        for (int d0 = 0; d0 < 4; ++d0) Ob[orow + d0 * 32 + r32] = f2bf1(o[d0][r] * rli[r]); }
    asm volatile("s_waitcnt lgkmcnt(0)" ::: "memory");
}
__device__ __forceinline__ void swa_wg_unit(const bf16* __restrict__ QKVb, int gbr, int sub0, int qt0, int sstep, unsigned short* __restrict__ OAg, float* __restrict__ LSEg, char* lds, float* scr, const int wid) {
    constexpr float SCALE = 0.088388347648318440f, C = SCALE * 1.4426950408889634f;
    const int lane = mk_lane(), tid = wid * 64 + lane, r32 = lane & 31, hi = lane >> 5;
    const int dsh = 2 * gbr, dil = 1 << dsh, L = 2048 >> dsh, nblk = L >> 5; const bool big = nblk >= 8;
    const long rstride = (long)dil * LDR;
#define SUB_BASE(sub) (QKVb + ((size_t)((sub) >> (3 + dsh)) * 2048 + (((sub) >> 3) & (dil - 1))) * LDR + ((sub) & 7) * 128)
    const int srow = tid >> 4, scol = (tid & 15) * 8;
    bf16x8 kst[12], vst[12];
#pragma unroll
    for (int sl = 0; sl < 12; ++sl) {
        const int sub_s = big ? sub0 : sub0 + ((sl >> 2) & 1) * sstep; const int kt_s = big ? min(max(qt0 - 2 + sl, 0), nblk - 1) : (sl & 3);
        const bf16* p_ = SUB_BASE(sub_s) + (long)(kt_s * 32 + srow) * rstride + scol;
        kst[sl] = *reinterpret_cast<const bf16x8*>(p_ + 1024);
    }
    const int sub_w = big ? sub0 : sub0 + (wid >> 2) * sstep; const int qt = big ? qt0 + wid : (wid & 3); const int t0 = qt * 32;
    const bf16* base_w = SUB_BASE(sub_w);
    bf16x8 qr[8];
    { const bf16* Qw = base_w + (long)(t0 + r32) * rstride + hi * 8;
#pragma unroll
      for (int d0 = 0; d0 < 8; ++d0) qr[d0] = *reinterpret_cast<const bf16x8*>(Qw + d0 * 16); }
#pragma unroll
    for (int sl = 0; sl < 12; ++sl) *(bf16x8*)(lds + sl * 8192 + KSWZ(srow, scol * 2)) = kst[sl];
#pragma unroll
    for (int sl = 0; sl < 12; ++sl) {
        const int sub_s = big ? sub0 : sub0 + ((sl >> 2) & 1) * sstep; const int kt_s = big ? min(max(qt0 - 2 + sl, 0), nblk - 1) : (sl & 3);
        const bf16* p_ = SUB_BASE(sub_s) + (long)(kt_s * 32 + srow) * rstride + scol;
        vst[sl] = *reinterpret_cast<const bf16x8*>(p_ + 2048);
    }
    __syncthreads();
    f32x16 s[5];
#pragma unroll
    for (int i = 0; i < 5; ++i) {
        const int kt = qt - 2 + i; const bool ok = kt >= 0 && kt < nblk;
        const int slot = big ? wid + i : 4 * (wid >> 2) + min(max(kt, 0), 3);
        const char* Ks = lds + slot * 8192;
        f32x16 p = f32x16{};
#pragma unroll
        for (int d0 = 0; d0 < 8; ++d0) { const int cb = (d0 * 16 + hi * 8) * 2;
            const bf16x8 b0 = *reinterpret_cast<const bf16x8*>(Ks + KSWZ(r32, cb));
            p = __builtin_amdgcn_mfma_f32_32x32x16_bf16(b0, qr[d0], p, 0, 0, 0); }
#pragma unroll
        for (int r = 0; r < 16; ++r) {
            bool keep = ok;
            if (i == 0) keep = keep && (crow(r, hi) >= r32);
            if (i == 4) keep = keep && (crow(r, hi) <= r32);
            s[i][r] = keep ? p[r] : -1e30f;
        }
    }
    float m = -1e30f;
#pragma unroll
    for (int i = 0; i < 5; ++i)
#pragma unroll
        for (int r = 0; r < 16; ++r) m = fmaxf(m, s[i][r]);
    { auto rr = __builtin_amdgcn_permlane32_swap(__float_as_uint(m), __float_as_uint(m), false, false);
      m = fmaxf(__uint_as_float(rr[0]), __uint_as_float(rr[1])); }
    const float mC = -m * C; float l = 0.f;
#pragma unroll
    for (int i = 0; i < 5; ++i)
#pragma unroll
        for (int r = 0; r < 16; ++r) { s[i][r] = __builtin_amdgcn_exp2f(fmaf(s[i][r], C, mC)); l += s[i][r]; }
    { auto rr = __builtin_amdgcn_permlane32_swap(__float_as_uint(l), __float_as_uint(l), false, false);
      l = __uint_as_float(rr[0]) + __uint_as_float(rr[1]); }
    bf16x8 pa[5][2];
#pragma unroll
    for (int i = 0; i < 5; ++i) { PK4(s[i], 0, pa[i][0]); PK4(s[i], 8, pa[i][1]); }
    __syncthreads();
#pragma unroll
    for (int sl = 0; sl < 12; ++sl) *(bf16x8*)(lds + sl * 8192 + v_st(srow, scol)) = vst[sl];
    __syncthreads();
    f32x16 o[4] = {};
#pragma unroll
    for (int i = 0; i < 5; ++i) {
        const int kt = qt - 2 + i;
        const int slot = big ? wid + i : 4 * (wid >> 2) + min(max(kt, 0), 3);
        const int vb = (int)(uintptr_t)(lds + slot * 8192) + v_rd_base(lane);
        pv_one32<0>(o[0], vb, pa[i][0], pa[i][1]); pv_one32<1>(o[1], vb, pa[i][0], pa[i][1]); pv_one32<2>(o[2], vb, pa[i][0], pa[i][1]); pv_one32<3>(o[3], vb, pa[i][0], pa[i][1]);
    }
    const size_t tok0 = ((size_t)(sub_w >> (3 + dsh)) * 2048 + ((sub_w >> 3) & (dil - 1))); const int hh = sub_w & 7;
    if (hi == 0) { scr[r32] = l; LSEg[(tok0 + (size_t)(t0 + r32) * dil) * 8 + hh] = m * SCALE + __logf(l); }
    asm volatile("s_waitcnt lgkmcnt(0)" ::: "memory");
    float rli[16];
#pragma unroll
    for (int r = 0; r < 16; ++r) rli[r] = __builtin_amdgcn_rcpf(scr[crow(r, hi)]);
#pragma unroll
    for (int r = 0; r < 16; ++r) { unsigned short* orow = OAg + (tok0 + (size_t)(t0 + crow(r, hi)) * dil) * 1024 + hh * 128;
#pragma unroll
        for (int d0 = 0; d0 < 4; ++d0) orow[d0 * 32 + r32] = f2bf1(o[d0][r] * rli[r]); }
    asm volatile("s_waitcnt lgkmcnt(0)" ::: "memory");
    __syncthreads();
#undef SUB_BASE
}
#undef SBAR
}
#ifndef MK_DUP_PHASE
#define MK_DUP_PHASE -1
#endif
#define NREP(k) (1 + (MK_DUP_PHASE == (k) ? 1 : 0))
#ifndef MK_TIME_PHASE
#define MK_TIME_PHASE -1
#endif
#ifndef MK_ONE_LAUNCH
#define MK_ONE_LAUNCH 1
#endif
constexpr int NWAVES = 8;
constexpr int BATCH = 4, SEQ = 2048, DM = 2048, M = BATCH * SEQ, NIN = 6144, DFF = 5632, NGU = 2 * DFF, NHEAD = 8, HD = 128;
constexpr float RMS_EPS = 1e-6f, SUBLN_EPS = 1e-5f, LAM_INIT = 0.2f;
constexpr size_t MiB = 1u << 20;
constexpr size_t WS_SS1 = 0, WS_SS2 = 64 * 1024, WS_LSE = 1 * MiB;
constexpr size_t WS_QKV = 2 * MiB;
constexpr size_t WS_Y = 162 * MiB;
constexpr size_t WS_H = 34 * MiB;
constexpr size_t WS_WIN = 98 * MiB, WS_XN = 122 * MiB;
constexpr size_t WS_OA = 98 * MiB;
constexpr size_t WS_WOUT = 154 * MiB;
constexpr size_t WS_OB = 162 * MiB, WS_XG = 2 * MiB;
constexpr size_t WS_WGU = 194 * MiB, WS_WDN = 238 * MiB, WS_END = 260 * MiB;
static_assert(WS_H + (size_t)M * DFF * 2 <= WS_WOUT && WS_XG + (size_t)M * DM * 2 <= WS_H && WS_Y + (size_t)M * DM * 2 <= WS_WGU && WS_OA + (size_t)3 * M * 1024 * 2 <= WS_WOUT && WS_WDN + (size_t)DM * DFF * 2 <= WS_END && WS_WGU + (size_t)NGU * DM * 2 <= WS_WDN && WS_QKV + (size_t)M * NIN * 2 <= WS_WIN, "d_ws map");
constexpr int RING_BYTES = 131072, LDS_BYTES = 163840, MISC_OFF = 163584;
constexpr size_t WS_BAR = 128 * 1024, WS_CNT = 144 * 1024, WS_FLAG = 152 * 1024, WS_GRP = 160 * 1024, BAR_BYTES = 40 * 1024;

#define GAS __attribute__((address_space(1)))
#define LAS __attribute__((address_space(3)))
typedef unsigned short bf16;
typedef unsigned v4u __attribute__((ext_vector_type(4)));
typedef float f32x4 __attribute__((ext_vector_type(4)));
#define LDS_WAIT() asm volatile("s_waitcnt lgkmcnt(0)" ::: "memory")
__device__ __forceinline__ unsigned f2bf(float f) { unsigned u = __builtin_bit_cast(unsigned, f); return (u + 0x7fffu + ((u >> 16) & 1u)) >> 16; }
__device__ __forceinline__ unsigned pk2(float lo, float hi) { return f2bf(lo) | (f2bf(hi) << 16); }
__device__ __forceinline__ float bflo(unsigned w) { return __uint_as_float(w << 16); }
__device__ __forceinline__ float bfhi(unsigned w) { return __uint_as_float(w & 0xffff0000u); }
__device__ __forceinline__ float wave_sum(float v) {
#pragma unroll
    for (int o = 1; o < 64; o <<= 1) v += __shfl_xor(v, o);
    return v;
}
__device__ __forceinline__ void transpose_item(const float* W, int K, int N, bf16* WT, int k0, int n0, int dst_row0, LAS float* scr, int lane, const float* ks = nullptr) {
    float wv[32];
#pragma unroll
    for (int i = 0; i < 32; ++i) { const int kk = 2 * i + (lane >> 5); wv[i] = W[(size_t)(k0 + kk) * N + n0 + (lane & 31)]; }
#pragma unroll
    for (int i = 0; i < 32; ++i) { const int kk = 2 * i + (lane >> 5); scr[kk * 33 + (lane & 31)] = wv[i]; }
    LDS_WAIT(); asm volatile("" ::: "memory");
    const int c = lane & 7;
    f32x4 g0 = {1.f, 1.f, 1.f, 1.f}, g1 = {1.f, 1.f, 1.f, 1.f};
    if (ks) { g0 = *(const f32x4*)(ks + k0 + 8 * c); g1 = *(const f32x4*)(ks + k0 + 8 * c + 4); }
#pragma unroll
    for (int j = 0; j < 4; ++j) { const int n = (lane >> 3) + 8 * j; const LAS float* s = scr + (8 * c) * 33 + n;
        v4u o; o.x = pk2(s[0 * 33] * g0.x, s[1 * 33] * g0.y); o.y = pk2(s[2 * 33] * g0.z, s[3 * 33] * g0.w); o.z = pk2(s[4 * 33] * g1.x, s[5 * 33] * g1.y); o.w = pk2(s[6 * 33] * g1.z, s[7 * 33] * g1.w);
        *(GAS v4u*)(WT + (size_t)(dst_row0 + n) * K + k0 + 8 * c) = o; }
    LDS_WAIT(); asm volatile("" ::: "memory");
}

#define XB_TMO      128
#define XB_XCNT(j)  (256  + 64 * (j))
#define XB_XSUB(j)  (1280 + 64 * (j))
#define XB_XGEN(j)  (2304 + 64 * (j))
#define XB_TOP      3328
#define XB_TOPGEN   3392
#define XCD_BAR_WORDS 3456
#define XB_SPIN_CAP (1u << 18)

__device__ __forceinline__ unsigned xb_ld(unsigned* p)              { return __hip_atomic_load(p, __ATOMIC_RELAXED, __HIP_MEMORY_SCOPE_AGENT); }
__device__ __forceinline__ unsigned xb_add(unsigned* p, unsigned v) { return __hip_atomic_fetch_add(p, v, __ATOMIC_RELAXED, __HIP_MEMORY_SCOPE_AGENT); }
__device__ __forceinline__ unsigned xb_xcc_id() { return (unsigned)__builtin_amdgcn_s_getreg((3 << 11) | 20) & 0xFu; }
#define XB_SPIN(cond, bar) do { unsigned _sp = 0; while (cond) { __builtin_amdgcn_s_sleep(1); \
    if ((++_sp & 255u) == 0u) { if (xb_ld(&(bar)[XB_TMO])) break; if (_sp > XB_SPIN_CAP) { atomicAdd(&(bar)[XB_TMO], 1u); break; } } } } while (0)

struct XcdBarrier {
    unsigned* bar; unsigned x;
    volatile LAS unsigned* st;
};

__device__ __forceinline__ XcdBarrier xcd_barrier_post(unsigned* bar, volatile LAS unsigned* st, const int wave_in) {
    XcdBarrier b; b.bar = bar; b.x = xb_xcc_id(); b.st = st;
    if (wave_in == 0 && mk_lane() == 0) (void)xb_add(&bar[XB_XCNT(b.x)], 1u);
    return b;
}
__device__ __forceinline__ void xcd_barrier_complete(unsigned* bar, unsigned x, unsigned& nloc, unsigned& nx) {
    const unsigned G = gridDim.x * gridDim.y * gridDim.z;
    unsigned sum, cnt, mine, sp = 0u;
    for (;;) {
        sum = 0u; cnt = 0u; mine = 0u;
#pragma unroll
        for (unsigned j = 0; j < 16; ++j) { const unsigned c = xb_ld(&bar[XB_XCNT(j)]); sum += c; cnt += (c > 0u) ? 1u : 0u; mine = (j == x) ? c : mine; }
        if (sum == G) break;
        __builtin_amdgcn_s_sleep(1);
        if ((++sp & 255u) == 0u) { if (xb_ld(&bar[XB_TMO])) break; if (sp > XB_SPIN_CAP) { atomicAdd(&bar[XB_TMO], 1u); break; } }
    }
    nloc = mine > 0u ? mine : 1u; nx = cnt > 0u ? cnt : 1u;
}

__device__ __forceinline__ void xcd_barrier(const XcdBarrier& b, const int wave_in) {
    asm volatile("s_waitcnt vmcnt(0)" ::: "memory");
    __syncthreads();
    if (wave_in == 0 && mk_lane() == 0) {
        unsigned* bar = b.bar;
        __builtin_amdgcn_s_waitcnt(0);
        unsigned nloc = b.st[0], nx = b.st[1];
        if (nloc == 0u) { xcd_barrier_complete(bar, b.x, nloc, nx); b.st[0] = nloc; b.st[1] = nx; }
        const unsigned old = xb_add(&bar[XB_XSUB(b.x)], 1u);
        const unsigned gen = old / nloc;
        if (old + 1u == (gen + 1u) * nloc) {
            __builtin_amdgcn_fence(__ATOMIC_RELEASE, "agent");
            asm volatile("s_waitcnt vmcnt(0)" ::: "memory");
            const unsigned og = xb_add(&bar[XB_TOP], 1u);
            const unsigned tg = og / nx;
            if (og + 1u == (tg + 1u) * nx) xb_add(&bar[XB_TOPGEN], 1u);
            else XB_SPIN(xb_ld(&bar[XB_TOPGEN]) == tg, bar);
            __builtin_amdgcn_fence(__ATOMIC_ACQUIRE, "agent");
            xb_add(&bar[XB_XGEN(b.x)], 1u);
            asm volatile("s_waitcnt vmcnt(0)" ::: "memory");
        } else {
            XB_SPIN(xb_ld(&bar[XB_XGEN(b.x)]) == gen, bar);
            __builtin_amdgcn_fence(__ATOMIC_ACQUIRE, "agent");
            asm volatile("s_waitcnt vmcnt(0)" ::: "memory");
        }
    }
    __syncthreads();
}
struct Args { const float* in[11]; float* out; unsigned char* ws; int ph_lo, ph_hi; };
constexpr int NPHASE = 7;

__global__ void __launch_bounds__(NWAVES * 64, 2) mk_fwd(Args args) {
    extern __shared__ __attribute__((aligned(16))) unsigned char lds[];
    LAS unsigned char* ldsl = (LAS unsigned char*)lds;
    const int wave = __builtin_amdgcn_readfirstlane((int)threadIdx.x >> 6);
    const int G = gridDim.x, bx = blockIdx.x;
    const int vcu = (G % 8 == 0) ? (bx % 8) * (G / 8) + bx / 8 : bx;
    const int gw = vcu * NWAVES + wave, NGW = G * NWAVES;
    unsigned char* ws = args.ws;
    const float* x = args.in[0]; const float* g_attn = args.in[1]; const float* w_in = args.in[2]; const float* lambda_qk = args.in[3]; const float* subln = args.in[4];
    const float* w_out = args.in[5]; const float* g_ffn = args.in[6]; const float* w_gate = args.in[7]; const float* w_up = args.in[8]; const float* w_down = args.in[9];
    const float* g_final = args.in[10];
    float* out = args.out;
    float* SS1 = (float*)(ws + WS_SS1); float* SS2 = (float*)(ws + WS_SS2); float* LSE = (float*)(ws + WS_LSE);
    bf16* QKV = (bf16*)(ws + WS_QKV); bf16* WGU = (bf16*)(ws + WS_WGU); bf16* WDN = (bf16*)(ws + WS_WDN); bf16* HB = (bf16*)(ws + WS_H);
    bf16* WIN = (bf16*)(ws + WS_WIN); bf16* XN = (bf16*)(ws + WS_XN); bf16* OA = (bf16*)(ws + WS_OA); bf16* WOUT = (bf16*)(ws + WS_WOUT);
    bf16* OB = (bf16*)(ws + WS_OB); bf16* XG = (bf16*)(ws + WS_XG); bf16* Y = (bf16*)(ws + WS_Y);
    const int lo = args.ph_lo, hi_ph = args.ph_hi;
#define IN(k) (lo <= (k) && (k) < hi_ph)
    if (wave == 0) { const int l0 = mk_lane(); if (l0 < 32) ((LAS unsigned*)(ldsl + MISC_OFF))[l0] = 0u; }
    __syncthreads();
    XcdBarrier bar; bar.bar = (unsigned*)(ws + WS_BAR); bar.x = 0; bar.st = nullptr;
    if (hi_ph - lo > 1) bar = xcd_barrier_post((unsigned*)(ws + WS_BAR), (volatile LAS unsigned*)(ldsl + MISC_OFF), wave);
    if (lo < -1000) cg::this_grid().sync();
#define STAMP(k) do { if (MK_TIME_PHASE >= 0) { const unsigned long long t_ = __builtin_amdgcn_s_memrealtime(); if ((k) == MK_TIME_PHASE) tph0 = t_; if ((k) == MK_TIME_PHASE + 1) tph1 = t_; } } while (0)
    unsigned long long tph0 = 0, tph1 = 0; STAMP(0);
#define SEAM(k) do { if (IN(k) && IN((k) + 1)) { for (int rb = 0; rb < (MK_DUP_PHASE == 30 ? 3 : 1); ++rb) xcd_barrier(bar, wave); } } while (0)

    if (IN(0)) for (int rep = 0; rep < NREP(0); ++rep) { const int lane = mk_lane(), tid = wave * 64 + lane;
        LAS float* scr = (LAS float*)(ldsl + wave * 16384);
        constexpr int I_IN = (DM / 64) * (NIN / 32), I_OUT = (DM / 64) * (DM / 32);
        for (int it = gw; it < I_IN; it += NGW) {
            if (it < I_IN) { const int nblk = NIN / 32, kb = it / nblk, nb = it % nblk; transpose_item(w_in, DM, NIN, WIN, 64 * kb, 32 * nb, 32 * nb, scr, lane); }
            else { const int r = it - I_IN; const int nblk = DM / 32, kb = r / nblk, nb = r % nblk; transpose_item(w_out, DM, DM, WOUT, 64 * kb, 32 * nb, 32 * nb, scr, lane); }
        }
        for (int m = gw; m < M; m += NGW) {
            const GAS f32x4* xr = (const GAS f32x4*)(x + (size_t)m * DM) + lane;
            f32x4 v[8]; float s = 0.f;
#pragma unroll
            for (int j = 0; j < 8; ++j) { v[j] = xr[64 * j]; s += (v[j].x * v[j].x + v[j].y * v[j].y) + (v[j].z * v[j].z + v[j].w * v[j].w); }
            const float rstd = 1.0f / sqrtf(wave_sum(s) * (1.f / DM) + RMS_EPS);
            GAS unsigned long long* o8 = (GAS unsigned long long*)(XN + (size_t)m * DM) + lane;
#pragma unroll
            for (int j = 0; j < 8; ++j) { const f32x4 gg = *((const GAS f32x4*)g_attn + lane + 64 * j);
                o8[64 * j] = (unsigned long long)pk2(v[j].x * rstd * gg.x, v[j].y * rstd * gg.y) | ((unsigned long long)pk2(v[j].z * rstd * gg.z, v[j].w * rstd * gg.w) << 32); }
        }
        for (int i = bx * (NWAVES * 64) + tid; i < M; i += G * NWAVES * 64) { SS1[i] = 0.f; SS2[i] = 0.f; }
    }
    SEAM(0); STAMP(1);
    if (IN(1)) {
        pg8::Gemm g{XN, WIN, M, NIN, DM}; pg8::StaticOrder S; S.init(M, NIN, G, bx); S.dup = NREP(1);
        pg8::EpiQKV E{QKV, NIN};
        pg8::gemm_phase<pg8::EpiQKV, pg8::StaticOrder, true, true>(ldsl, g, S, E, wave);
    }
    SEAM(1); STAMP(2);
    if (IN(2)) { const int lane = mk_lane();
        float lam;
        { const float a = lambda_qk[lane] * lambda_qk[64 + lane], b2 = lambda_qk[128 + lane] * lambda_qk[192 + lane];
          lam = __expf(wave_sum(a)) - __expf(wave_sum(b2)) + LAM_INIT; }
        const int grp = vcu >> 3, k = vcu & 7, gb = grp >> 3, gh = grp & 7;
        const att::bf16* rowb = (const att::bf16*)QKV + (size_t)gb * SEQ * NIN;
        att::ConvJob cj{w_gate, w_up, w_down, w_out, g_ffn, WGU, WDN, WOUT, vcu, vcu + G * ((att::CV_TOTAL - 1 - vcu) / G), G};
        for (int i = 0; i < 2 * NREP(20); ++i) {
            const int c = i & 1;
            att::attn_dense_body(rowb + (size_t)k * 256 * NIN + 3072 + gh * HD, rowb + 4096 + gh * HD, rowb + 5120 + gh * HD, nullptr, 1024, 4 * c, SEQ, (char*)lds, wave, cj,
                                 c == 1, Y + ((size_t)gb * SEQ + k * 256) * DM + 1024 + gh * HD, lam, subln);
        }
        __syncthreads();
        { float* scr = (float*)((char*)lds + RING_BYTES) + wave * 64;
          for (int rep = 0; rep < NREP(21); ++rep) {
            att::swa_wg_unit((const att::bf16*)QKV, 0, gb * 8 + gh, 8 * k, 0, OA, LSE, (char*)lds, scr, wave);
            att::swa_wg_unit((const att::bf16*)QKV, 1, (gb * 4 + (k >> 1)) * 8 + gh, 8 * (k & 1), 0, OA + (size_t)M * 1024, LSE + (size_t)M * 8, (char*)lds, scr, wave);
            att::swa_wg_unit((const att::bf16*)QKV, 2, (gb * 16 + 2 * k) * 8 + gh, 0, 8, OA + (size_t)2 * M * 1024, LSE + (size_t)2 * M * 8, (char*)lds, scr, wave);
          } }
        asm volatile("s_waitcnt vmcnt(0)" ::: "memory"); __syncthreads();
        if (wave == 0 && lane == 0) {
            unsigned* gc = (unsigned*)(ws + WS_GRP) + 64 * grp;
            __builtin_amdgcn_fence(__ATOMIC_RELEASE, "agent"); asm volatile("s_waitcnt vmcnt(0)" ::: "memory");
            __hip_atomic_fetch_add(gc, 1u, __ATOMIC_RELAXED, __HIP_MEMORY_SCOPE_AGENT);
            unsigned sp = 0; while (__hip_atomic_load(gc, __ATOMIC_RELAXED, __HIP_MEMORY_SCOPE_AGENT) < 8u) { __builtin_amdgcn_s_sleep(2); if (++sp > (1u << 22)) break; }
            __builtin_amdgcn_fence(__ATOMIC_ACQUIRE, "agent"); asm volatile("s_waitcnt vmcnt(0)" ::: "memory");
        }
        __syncthreads();
        { const int col = (lane & 15) * 8;
#pragma unroll 2
          for (int it = 0; it < 8; ++it) {
            const size_t m = (size_t)gb * SEQ + k * 256 + wave * 32 + it * 4 + (lane >> 4);
            const float l0 = LSE[m * 8 + gh], l1 = LSE[((size_t)M + m) * 8 + gh], l2 = LSE[((size_t)2 * M + m) * 8 + gh];
            const float mx = fmaxf(l0, fmaxf(l1, l2)); float w0 = __expf(l0 - mx), w1 = __expf(l1 - mx), w2 = __expf(l2 - mx);
            const float inv = 1.0f / (w0 + w1 + w2); w0 *= inv; w1 *= inv; w2 *= inv;
            const v4u a0 = *(const GAS v4u*)(OA + m * 1024 + gh * HD + col), a1 = *(const GAS v4u*)(OA + ((size_t)M + m) * 1024 + gh * HD + col), a2 = *(const GAS v4u*)(OA + ((size_t)2 * M + m) * 1024 + gh * HD + col);
            v4u ya;
#pragma unroll
            for (int i = 0; i < 4; ++i) ya[i] = pk2(w0 * bflo(a0[i]) + w1 * bflo(a1[i]) + w2 * bflo(a2[i]), w0 * bfhi(a0[i]) + w1 * bfhi(a1[i]) + w2 * bfhi(a2[i]));
            *(GAS v4u*)(Y + m * DM + gh * HD + col) = ya;
          } }
        __syncthreads();
    }
    SEAM(2); STAMP(3);
    if (IN(4)) {
        pg8::Gemm g{Y, WOUT, M, DM, DM}; pg8::StaticOrder S; S.init(M, DM, G, bx); S.dup = NREP(4);
        pg8::EpiOut E{x, XG, g_ffn, SS1, DM};
        pg8::gemm_phase<pg8::EpiOut, pg8::StaticOrder, true, true>(ldsl, g, S, E, wave);
    }
    SEAM(4); STAMP(4);
    if (IN(5)) {
        pg8::Gemm g{XG, WGU, M, NGU, DM}; pg8::StaticOrder S; S.init(M, NGU, G, bx); S.dup = NREP(5);
        S.split_from = -1  ; S.kh_bytes = (DM / 2) * 2; S.kh_nt = DM / 128;
        pg8::EpiGateUp E{HB, DFF, SS1, 1.0f / DM, RMS_EPS, (pg8::f32x4*)(ws + WS_Y), (unsigned*)(ws + WS_FLAG)};
        pg8::gemm_phase<pg8::EpiGateUp, pg8::StaticOrder, true, true>(ldsl, g, S, E, wave);
        if (bx >= 128 && G == 256) {
            const int lane = mk_lane(); LAS float* scr = (LAS float*)(ldsl + wave * 16384);
            constexpr int I_D = (DFF / 64) * (DM / 32);
            for (int it = (bx - 128) * NWAVES + wave; it < I_D; it += 128 * NWAVES) { const int nblk = DM / 32, kb = it / nblk, nb = it % nblk; transpose_item(w_down, DFF, DM, WDN, 64 * kb, 32 * nb, 32 * nb, scr, lane); }
        }
    }
    SEAM(5); STAMP(5);
    if (IN(6)) {
        pg8::Gemm g{HB, WDN, M, DM, DFF}; pg8::StaticOrder S; S.init(M, DM, G, bx);
        pg8::EpiDownNorm E{XG, g_ffn, out, g_final, SS2, (unsigned*)(ws + WS_CNT), DM, 1.0f / DM, RMS_EPS};
        pg8::gemm_phase<pg8::EpiDownNorm, pg8::StaticOrder, false, true>(ldsl, g, S, E, wave);
    }
    STAMP(6);
    if (MK_TIME_PHASE >= 0 && bx == 0 && wave == 0) { if (tph1 == 0) tph1 = __builtin_amdgcn_s_memrealtime(); const unsigned long long t0_ = __builtin_amdgcn_s_memrealtime(); while (__builtin_amdgcn_s_memrealtime() - t0_ < tph1 - tph0) __builtin_amdgcn_s_sleep(8); }
#undef IN
#undef SEAM
}

extern "C" void kernel_launch(void* const* d_in, const int* in_sizes, int n_in, void* d_out, int out_size, void* d_ws, size_t ws_size, hipStream_t stream) {
    static int grid = 0;
    if (grid == 0) {
        if (n_in != 11 || in_sizes[0] != M * DM || out_size != M * DM || ws_size < WS_END) { fprintf(stderr, "kernel_launch: shape/workspace mismatch (n_in %d, in0 %d, out %d, ws %zu)\n", n_in, n_in > 0 ? in_sizes[0] : -1, out_size, ws_size); grid = -1; return; }
        int dev = 0, cus = 0, per_cu = 0;
        if (hipGetDevice(&dev) != hipSuccess || hipDeviceGetAttribute(&cus, hipDeviceAttributeMultiprocessorCount, dev) != hipSuccess) { grid = -1; return; }
        if (hipFuncSetAttribute((const void*)mk_fwd, hipFuncAttributeMaxDynamicSharedMemorySize, LDS_BYTES) != hipSuccess) { fprintf(stderr, "kernel_launch: hipFuncSetAttribute failed\n"); grid = -1; return; }
        if (hipOccupancyMaxActiveBlocksPerMultiprocessor(&per_cu, (const void*)mk_fwd, NWAVES * 64, LDS_BYTES) != hipSuccess || per_cu < 1) { fprintf(stderr, "kernel_launch: occupancy query says %d\n", per_cu); per_cu = 1; }
        (void)hipGetLastError();
        grid = cus;
        if (grid != 256) { fprintf(stderr, "kernel_launch: this kernel needs a 256-CU device (got %d)\n", cus); grid = -1; return; }
    }
    if (grid < 0) return;
    Args a{};
    for (int i = 0; i < 11; ++i) a.in[i] = (const float*)d_in[i];
    a.out = (float*)d_out; a.ws = (unsigned char*)d_ws;
#if MK_ONE_LAUNCH
    if (hipMemsetAsync((char*)d_ws + WS_BAR, 0, BAR_BYTES, stream) != hipSuccess) { fprintf(stderr, "kernel_launch: memset failed\n"); return; }
#ifdef MK_PROBE_MEMSET2
    (void)hipMemsetAsync((char*)d_ws + WS_BAR, 0, BAR_BYTES, stream);
#endif
    a.ph_lo = 0; a.ph_hi = NPHASE;
    void* kargs[] = {&a};
    hipError_t e = hipLaunchCooperativeKernel((const void*)mk_fwd, dim3(grid), dim3(NWAVES * 64), kargs, LDS_BYTES, stream);
    if (e != hipSuccess) fprintf(stderr, "kernel_launch: cooperative launch failed: %s (grid %d)\n", hipGetErrorString(e), grid);
#else
    for (int p = 0; p < NPHASE; ++p) {
        a.ph_lo = p; a.ph_hi = p + 1;
        hipLaunchKernelGGL(mk_fwd, dim3(grid), dim3(NWAVES * 64), LDS_BYTES, stream, a);
    }
#endif
}
```

```cpp
#include <hip/hip_runtime.h>
#include <hip/hip_cooperative_groups.h>
#include <hip/hip_bf16.h>
#include <cstdio>
#include <cstdint>
#include <cmath>
namespace cg = cooperative_groups;
__device__ __forceinline__ int mk_lane() { int l; asm volatile("v_mbcnt_lo_u32_b32 %0, -1, 0\n\tv_mbcnt_hi_u32_b32 %0, -1, %0" : "=v"(l)); return l & 63; }
namespace pg8 {
#define PG8_LAS __attribute__((address_space(3)))
typedef unsigned short bf16_t;
typedef short bf16x8 __attribute__((ext_vector_type(8)));
typedef float f32x4 __attribute__((ext_vector_type(4)));
typedef unsigned u32x4 __attribute__((ext_vector_type(4)));
constexpr int BM = 256, BK = 64, HALF = 128, HTB = HALF * BK * 2  , STAGE_BYTES = 8 * HTB, NXCD = 8, WGM = 8;

__host__ __device__ __forceinline__ int lds_byte(int r, int c) { const int st = (r >> 4) * 2 + (c >> 5), rr = r & 15, cc = c & 31, ob = rr * 64 + cc * 2; return st * 1024 + (ob ^ (((ob >> 9) & 1) << 5)); }
__host__ __device__ __forceinline__ void stage_rc(int b, int& R, int& C) { const int st = b / 1024, sb = b % 1024, swz = sb ^ (((sb >> 9) & 1) << 5); R = (st >> 1) * 16 + swz / 64; C = (st & 1) * 32 + (swz % 64) / 2; }
__host__ __device__ __forceinline__ int perm32(int rho) { const int n = rho >> 4, i = rho & 15; return 8 * (i >> 2) + 4 * n + (i & 3); }

struct Unit { int pm, pn, first, khalf, koff, nt, ul; };
struct Gemm { const bf16_t* A; const bf16_t* Bt; int M, N, K; };

struct StaticOrder {
    int nM, nN, nwg, G, c, dup, split_from, kh_bytes, kh_nt, wgm;
    __host__ __device__ void init(int M, int N, int G_, int c_) { nM = M / BM; nN = N / BM; nwg = nM * nN; G = G_; c = c_; dup = 1; wgm = WGM; split_from = -1; kh_bytes = 0; kh_nt = 0; }
    __host__ __device__ bool next(int i, Unit& u) const {
        long L = (long)(i / dup) * G + c; u.khalf = 0; u.koff = 0; u.nt = 0; u.ul = 0;
        if (split_from >= 0 && (long)(i / dup) * G >= split_from) {
            if ((long)(i / dup) * G > split_from) return false;
            u.ul = c >> 1; L = split_from + u.ul; u.khalf = 1 + (c & 1); u.koff = (c & 1) ? kh_bytes : 0; u.nt = kh_nt; }
        if (L >= nwg) return false;
        int wgid = (int)L; { const int q = nwg / NXCD, r = nwg % NXCD, xcd = wgid % NXCD, off = wgid / NXCD; wgid = (xcd < r ? xcd * (q + 1) : r * (q + 1) + (xcd - r) * q) + off; }
        const int nig = wgm * nN, gid = wgid / nig, fm = gid * wgm, gsz = (nM - fm) < wgm ? (nM - fm) : wgm;
        u.pm = fm + ((wgid % nig) % gsz); u.pn = (wgid % nig) / gsz; u.first = (i % dup) == 0; return true;
    }
    __device__ __forceinline__ void a_ready(const Unit&) const {}
    __device__ __forceinline__ void done(const Unit&) const {}
};

__device__ __forceinline__ unsigned cvt_pk_bf16(float lo, float hi) { unsigned r; asm volatile("v_cvt_pk_bf16_f32 %0, %1, %2" : "=v"(r) : "v"(lo), "v"(hi)); return r; }
typedef float f32x2 __attribute__((ext_vector_type(2)));
__device__ __forceinline__ float invf_a(int f) {
    constexpr float T[16] = {1.0f, 0.4403666f, 0.19392274f, 0.0853971f, 0.03760603f, 0.01656044f, 0.0072926646f, 0.003211446f,
                             0.0014142136f, 0.00062277244f, 0.0002742482f, 0.000120769735f, 5.3182957e-05f, 2.342e-05f, 1.0313385e-05f, 4.5416705e-06f};
    return T[f];
}
__device__ __forceinline__ void sincos_rev(float ang, float& s, float& c) {
    const float rev = ang * 0.15915494309189535f; const float fr = rev - __builtin_floorf(rev);
    s = __builtin_amdgcn_sinf(fr); c = __builtin_amdgcn_cosf(fr);
}
struct EpiQKV {
    static constexpr bool PERM = true, AFTER_DRAIN = false;
    bf16_t* O; int ldc;
    __device__ __forceinline__ void operator()(const f32x4 (&acc)[2][2][4][2], const Unit& u, int wr, int wc, int fr, int fq) const {
        const int row0 = u.pm * BM + wr * 64 + fr;
        const int sec = u.pn >> 2;
        const int col0 = u.pn * BM + wc * 32 + 8 * fq;
        const bool ropeA = (sec <= 1) && (wc == 0);
        const bool ropeB = (sec == 3 || sec == 4) && ((wc & 1) == 0);
#pragma unroll
        for (int ai = 0; ai < 2; ++ai)
#pragma unroll
            for (int m = 0; m < 4; ++m) {
                const int row = row0 + ai * HALF + m * 16;
                const float pos = (float)(row & 2047);
                bf16_t* rowp = O + (size_t)row * ldc + col0;
                float cs[8], sn[8];
                if (ropeA) {
                    const int fb = 8 * (fq & 1);
#pragma unroll
                    for (int i = 0; i < 8; ++i) { float f0 = invf_a(i), f1 = invf_a(8 + i); sincos_rev(pos * (fb ? f1 : f0), sn[i], cs[i]); }
                    const float sg = (fq >= 2) ? 1.f : -1.f;
#pragma unroll
                    for (int i = 0; i < 8; ++i) sn[i] *= sg;
                } else if (ropeB) {
#pragma unroll
                    for (int i = 0; i < 8; ++i) sincos_rev(pos * invf_a(2 * i), sn[i], cs[i]);
                    const float sg = (fq == 1) ? 1.f : -1.f;
#pragma unroll
                    for (int i = 0; i < 8; ++i) sn[i] *= sg;
                }
#pragma unroll
                for (int bj = 0; bj < 2; ++bj) {
                    f32x4 v0 = acc[ai][bj][m][0], v1 = acc[ai][bj][m][1];
                    if (ropeA) {
                        f32x4 p0, p1;
#pragma unroll
                        for (int i = 0; i < 4; ++i) { p0[i] = __shfl_xor(v0[i], 32); p1[i] = __shfl_xor(v1[i], 32); }
#pragma unroll
                        for (int i = 0; i < 4; ++i) { v0[i] = v0[i] * cs[i] + p0[i] * sn[i]; v1[i] = v1[i] * cs[4 + i] + p1[i] * sn[4 + i]; }
                    } else if (ropeB) {
                        f32x4 p0, p1;
#pragma unroll
                        for (int i = 0; i < 4; ++i) { p0[i] = __shfl_xor(v0[i], 16); p1[i] = __shfl_xor(v1[i], 16); }
                        if (fq < 2) {
#pragma unroll
                            for (int i = 0; i < 4; ++i) { v0[i] = v0[i] * cs[i] + p0[i] * sn[i]; v1[i] = v1[i] * cs[4 + i] + p1[i] * sn[4 + i]; }
                        }
                    }
                    u32x4 w; w.x = cvt_pk_bf16(v0[0], v0[1]); w.y = cvt_pk_bf16(v0[2], v0[3]); w.z = cvt_pk_bf16(v1[0], v1[1]); w.w = cvt_pk_bf16(v1[2], v1[3]);
                    *(u32x4*)(rowp + bj * HALF) = w;
                }
            }
    }
};
struct EpiOut {
    static constexpr bool PERM = false, AFTER_DRAIN = false;
    const float* base; bf16_t* xg; const float* g; float* ss; int ldc;
    __device__ __forceinline__ void operator()(const f32x4 (&acc)[2][2][4][2], const Unit& u, int wr, int wc, int fr, int fq) const {
        typedef unsigned u32x2v __attribute__((ext_vector_type(2)));
        const int col0 = u.pn * BM + wc * 32 + 4 * fq;
        f32x4 gv[2][2];
#pragma unroll
        for (int bj = 0; bj < 2; ++bj)
#pragma unroll
            for (int n = 0; n < 2; ++n) gv[bj][n] = *(const f32x4*)(g + col0 + bj * HALF + n * 16);
#pragma unroll
        for (int ai = 0; ai < 2; ++ai)
#pragma unroll
            for (int m = 0; m < 4; ++m) {
                const int row = u.pm * BM + ai * HALF + wr * 64 + m * 16 + fr; const size_t off = (size_t)row * ldc + col0; float s = 0.f;
#pragma unroll
                for (int bj = 0; bj < 2; ++bj)
#pragma unroll
                    for (int n = 0; n < 2; ++n) {
                        const f32x4 x1 = *(const f32x4*)(base + off + bj * HALF + n * 16) + acc[ai][bj][m][n];
                        s += (x1[0] * x1[0] + x1[1] * x1[1]) + (x1[2] * x1[2] + x1[3] * x1[3]);
                        const f32x4 y = x1 * gv[bj][n]; u32x2v w; w.x = cvt_pk_bf16(y[0], y[1]); w.y = cvt_pk_bf16(y[2], y[3]);
                        *(u32x2v*)(xg + off + bj * HALF + n * 16) = w;
                    }
                s += __shfl_xor(s, 16); s += __shfl_xor(s, 32);
                if (fq == 0 && u.first) atomicAdd(ss + row, s);
            }
    }
};
struct EpiGateUp {
    static constexpr bool PERM = true, AFTER_DRAIN = false;
    bf16_t* H; int ldh; const float* ss; float inv_n, eps; f32x4* part; unsigned* flag;
    __device__ __forceinline__ void operator()(const f32x4 (&acc)[2][2][4][2], const Unit& u, int wr, int wc, int fr, int fq) const {
        const int tid = (wr * 4 + wc) * 64 + fq * 16 + fr;
        f32x4* pp = part + (size_t)u.ul * (32 * 512) + tid;
        if (u.khalf == 1) {
#pragma unroll
            for (int ai = 0; ai < 2; ++ai)
#pragma unroll
                for (int bj = 0; bj < 2; ++bj)
#pragma unroll
                    for (int m = 0; m < 4; ++m)
#pragma unroll
                        for (int n = 0; n < 2; ++n) pp[(size_t)(((ai * 2 + bj) * 4 + m) * 2 + n) * 512] = acc[ai][bj][m][n];
            asm volatile("s_waitcnt vmcnt(0)" ::: "memory"); __builtin_amdgcn_s_barrier(); asm volatile("" ::: "memory");
            if (tid == 0) { __builtin_amdgcn_fence(__ATOMIC_RELEASE, "agent"); asm volatile("s_waitcnt vmcnt(0)" ::: "memory");
                __hip_atomic_store(flag + 16 * u.ul, 1u, __ATOMIC_RELAXED, __HIP_MEMORY_SCOPE_AGENT); }
            return;
        }
        if (u.khalf == 2) {
            if (tid < 64) { unsigned sp = 0;
                while ((unsigned)__builtin_amdgcn_readfirstlane(__hip_atomic_load(flag + 16 * u.ul, __ATOMIC_RELAXED, __HIP_MEMORY_SCOPE_AGENT)) == 0u) { __builtin_amdgcn_s_sleep(2); if (++sp > (1u << 22)) break; }
                __builtin_amdgcn_fence(__ATOMIC_ACQUIRE, "agent"); asm volatile("s_waitcnt vmcnt(0)" ::: "memory"); }
            asm volatile("s_waitcnt vmcnt(0) lgkmcnt(0)" ::: "memory"); __builtin_amdgcn_s_barrier(); asm volatile("" ::: "memory");
        }
        const int col0 = u.pn * HALF + wc * 32 + 8 * fq;
#pragma unroll
        for (int ai = 0; ai < 2; ++ai)
#pragma unroll
            for (int m = 0; m < 4; ++m) {
                const int row = u.pm * BM + ai * HALF + wr * 64 + m * 16 + fr;
                const float rstd = 1.0f / sqrtf(ss[row] * inv_n + eps);
                f32x4 gq[2], uq[2];
#pragma unroll
                for (int n = 0; n < 2; ++n) { gq[n] = acc[ai][0][m][n]; uq[n] = acc[ai][1][m][n]; }
                if (u.khalf == 2) {
#pragma unroll
                    for (int n = 0; n < 2; ++n) { gq[n] += pp[(size_t)(((ai * 2 + 0) * 4 + m) * 2 + n) * 512]; uq[n] += pp[(size_t)(((ai * 2 + 1) * 4 + m) * 2 + n) * 512]; }
                }
                float hv[8];
#pragma unroll
                for (int n = 0; n < 2; ++n)
#pragma unroll
                    for (int i = 0; i < 4; ++i) { const float gg = gq[n][i] * rstd, uu = uq[n][i] * rstd;
                        hv[4 * n + i] = gg * __builtin_amdgcn_rcpf(1.0f + __builtin_amdgcn_exp2f(-1.4426950408889634f * gg)) * uu; }
                u32x4 w; w.x = cvt_pk_bf16(hv[0], hv[1]); w.y = cvt_pk_bf16(hv[2], hv[3]); w.z = cvt_pk_bf16(hv[4], hv[5]); w.w = cvt_pk_bf16(hv[6], hv[7]);
                *(u32x4*)(H + (size_t)row * ldh + col0) = w;
            }
    }
};
struct EpiDown {
    static constexpr bool PERM = false, AFTER_DRAIN = false;
    const bf16_t* base; float* out; float* ss; int ldc;
    __device__ __forceinline__ void operator()(const f32x4 (&acc)[2][2][4][2], const Unit& u, int wr, int wc, int fr, int fq) const {
        typedef unsigned u32x2v __attribute__((ext_vector_type(2)));
        const int col0 = u.pn * BM + wc * 32 + 4 * fq;
#pragma unroll
        for (int ai = 0; ai < 2; ++ai)
#pragma unroll
            for (int m = 0; m < 4; ++m) {
                const int row = u.pm * BM + ai * HALF + wr * 64 + m * 16 + fr; const size_t off = (size_t)row * ldc + col0; float s = 0.f;
#pragma unroll
                for (int bj = 0; bj < 2; ++bj)
#pragma unroll
                    for (int n = 0; n < 2; ++n) {
                        const u32x2v rb = *(const u32x2v*)(base + off + bj * HALF + n * 16);
                        f32x4 x2 = acc[ai][bj][m][n];
                        x2[0] += __uint_as_float(rb.x << 16); x2[1] += __uint_as_float(rb.x & 0xffff0000u); x2[2] += __uint_as_float(rb.y << 16); x2[3] += __uint_as_float(rb.y & 0xffff0000u);
                        *(f32x4*)(out + off + bj * HALF + n * 16) = x2;
                        s += (x2[0] * x2[0] + x2[1] * x2[1]) + (x2[2] * x2[2] + x2[3] * x2[3]);
                    }
                s += __shfl_xor(s, 16); s += __shfl_xor(s, 32);
                if (fq == 0 && u.first) atomicAdd(ss + row, s);
            }
    }
};
struct EpiDownNorm {
    static constexpr bool PERM = false, AFTER_DRAIN = true;
    const bf16_t* base; const float* gres; float* out; const float* g; float* ss; unsigned* cnt; int ldc; float inv_n, eps;
    __device__ __forceinline__ void fused(f32x4 (&acc)[2][2][4][2], const Unit& u, int wr, int wc, int fr, int fq, PG8_LAS unsigned char* lds, int wid, int lane) const {
        typedef unsigned u32x2v __attribute__((ext_vector_type(2)));
        const int col0 = u.pn * BM + wc * 32 + 4 * fq;
        f32x4 rg[2][2];
#pragma unroll
        for (int bj = 0; bj < 2; ++bj)
#pragma unroll
            for (int n = 0; n < 2; ++n) { const f32x4 t = *(const f32x4*)(gres + col0 + bj * HALF + n * 16); rg[bj][n] = (f32x4){1.0f / t[0], 1.0f / t[1], 1.0f / t[2], 1.0f / t[3]}; }
#pragma unroll
        for (int ai = 0; ai < 2; ++ai)
#pragma unroll
            for (int m = 0; m < 4; ++m) {
                const int row = u.pm * BM + ai * HALF + wr * 64 + m * 16 + fr; const size_t off = (size_t)row * ldc + col0; float s = 0.f;
#pragma unroll
                for (int bj = 0; bj < 2; ++bj)
#pragma unroll
                    for (int n = 0; n < 2; ++n) {
                        const u32x2v rb = *(const u32x2v*)(base + off + bj * HALF + n * 16);
                        f32x4 x2 = acc[ai][bj][m][n];
                        x2[0] += __uint_as_float(rb.x << 16) * rg[bj][n][0]; x2[1] += __uint_as_float(rb.x & 0xffff0000u) * rg[bj][n][1]; x2[2] += __uint_as_float(rb.y << 16) * rg[bj][n][2]; x2[3] += __uint_as_float(rb.y & 0xffff0000u) * rg[bj][n][3];
                        acc[ai][bj][m][n] = x2;
                        s += (x2[0] * x2[0] + x2[1] * x2[1]) + (x2[2] * x2[2] + x2[3] * x2[3]);
                    }
                s += __shfl_xor(s, 16); s += __shfl_xor(s, 32);
                if (fq == 0) atomicAdd(ss + row, s);
            }
        asm volatile("s_waitcnt vmcnt(0)" ::: "memory");
        __builtin_amdgcn_s_barrier(); asm volatile("" ::: "memory");
        if (wid == 0) {
            unsigned* c = cnt + 64 * u.pm;
            if (lane == 0) __hip_atomic_fetch_add(c, 1u, __ATOMIC_RELAXED, __HIP_MEMORY_SCOPE_AGENT);
            unsigned sp = 0;
            while ((unsigned)__builtin_amdgcn_readfirstlane(__hip_atomic_load(c, __ATOMIC_RELAXED, __HIP_MEMORY_SCOPE_AGENT)) < 8u) { __builtin_amdgcn_s_sleep(2); if (++sp > (1u << 22)) break; }
            __builtin_amdgcn_fence(__ATOMIC_ACQUIRE, "agent");
        }
        asm volatile("s_waitcnt vmcnt(0) lgkmcnt(0)" ::: "memory"); __builtin_amdgcn_s_barrier(); asm volatile("" ::: "memory");
        f32x4 gv[2][2];
#pragma unroll
        for (int bj = 0; bj < 2; ++bj)
#pragma unroll
            for (int n = 0; n < 2; ++n) gv[bj][n] = *(const f32x4*)(g + col0 + bj * HALF + n * 16);
#pragma unroll
        for (int ai = 0; ai < 2; ++ai)
#pragma unroll
            for (int m = 0; m < 4; ++m) {
                const int row = u.pm * BM + ai * HALF + wr * 64 + m * 16 + fr; const size_t off = (size_t)row * ldc + col0;
                const float rstd = 1.0f / sqrtf(__hip_atomic_load(ss + row, __ATOMIC_RELAXED, __HIP_MEMORY_SCOPE_AGENT) * inv_n + eps);
#pragma unroll
                for (int bj = 0; bj < 2; ++bj)
#pragma unroll
                    for (int n = 0; n < 2; ++n) *(f32x4*)(out + off + bj * HALF + n * 16) = acc[ai][bj][m][n] * rstd * gv[bj][n];
            }
    }
};
template <class Epi, class Sched, bool ALIGN_EPI = false, bool SP2 = false>
__device__ __forceinline__ void gemm_phase(PG8_LAS unsigned char* lds, const Gemm g, const Sched& S, const Epi& E, const int wave_in) {
    const int wid = wave_in, lane = mk_lane(), tid = wid * 64 + lane, wr = wid >> 2, wc = wid & 3, fr = lane & 15, fq = lane >> 4;
    const int K = g.K, nt = K / BK;
    unsigned voffA[2], voffB[2];
#pragma unroll
    for (int i = 0; i < 2; ++i) { int R, C; stage_rc(tid * 16 + i * 8192, R, C); const int Rb = Epi::PERM ? ((R & ~31) + perm32(R & 31)) : R;
        voffA[i] = (unsigned)(R * K + C) * 2u; voffB[i] = (unsigned)(Rb * K + C) * 2u; }
    const size_t kstep = (size_t)(BK * 2);
    const size_t hstep = (size_t)HALF * K * 2;
    const size_t tstep = 2 * hstep;
    const unsigned ldsw = (unsigned)wid * 1024u;
    const int aoff = lds_byte(wr * 64 + fr, fq * 8), boff = lds_byte(wc * 32 + fr, fq * 8);
#define PG8_SA(b, h) (((b) * 2 + (h)) * HTB)
#define PG8_SB(b, h) ((4 + (b) * 2 + (h)) * HTB)
#define PG8_STAGE(bufoff, gbase, voff) do { _Pragma("unroll") for (int _i = 0; _i < 2; ++_i) \
        __builtin_amdgcn_global_load_lds((const unsigned*)((const char*)(gbase) + (voff)[_i]), (PG8_LAS unsigned*)(lds + (bufoff) + ldsw + _i * 8192), 16, 0, 0); } while (0)
#define PG8_LDA(dst, b, h) do { _Pragma("unroll") for (int m = 0; m < 4; ++m) _Pragma("unroll") for (int k = 0; k < 2; ++k) dst[m][k] = *(const PG8_LAS bf16x8*)(lds + PG8_SA(b, h) + aoff + m * 2048 + k * 1024); } while (0)
#define PG8_LDB(dst, b, h) do { _Pragma("unroll") for (int n = 0; n < 2; ++n) _Pragma("unroll") for (int k = 0; k < 2; ++k) dst[n][k] = *(const PG8_LAS bf16x8*)(lds + PG8_SB(b, h) + boff + n * 2048 + k * 1024); } while (0)
#define PG8_MMA(ai, bj, At, Bt) do { __builtin_amdgcn_s_setprio(1); _Pragma("unroll") for (int m = 0; m < 4; ++m) _Pragma("unroll") for (int n = 0; n < 2; ++n) _Pragma("unroll") for (int k = 0; k < 2; ++k) \
        acc[ai][bj][m][n] = __builtin_amdgcn_mfma_f32_16x16x32_bf16(Bt[n][k], At[m][k], acc[ai][bj][m][n], 0, 0, 0); __builtin_amdgcn_s_setprio(0); } while (0)
#define PG8_WAIT_V(n) asm volatile("s_waitcnt vmcnt(" #n ")" ::: "memory")
#define PG8_WAIT_L(n) asm volatile("s_waitcnt lgkmcnt(" #n ")" ::: "memory")
#define PG8_BAR __builtin_amdgcn_s_barrier()
#define PG8_SCHED __builtin_amdgcn_sched_barrier(0)
    Unit cur, nxt; int ui = 0;
    if (!S.next(0, cur)) return;
    f32x4 acc[2][2][4][2];
#pragma unroll
    for (int a = 0; a < 2; ++a)
#pragma unroll
        for (int b = 0; b < 2; ++b)
#pragma unroll
            for (int m = 0; m < 4; ++m)
#pragma unroll
                for (int n = 0; n < 2; ++n) acc[a][b][m][n] = (f32x4){0.f, 0.f, 0.f, 0.f};
    bf16x8 At[4][2], B0[2][2], B1[2][2];
    const char* cA = (const char*)g.A + (size_t)cur.pm * tstep + cur.koff; const char* cB = (const char*)g.Bt + (size_t)cur.pn * tstep + cur.koff; int ntc = cur.nt ? cur.nt : nt;
    S.a_ready(cur);
    if constexpr (SP2) {
        PG8_STAGE(PG8_SB(0, 0), cB, voffB); PG8_STAGE(PG8_SB(0, 1), cB + hstep, voffB); PG8_STAGE(PG8_SA(0, 0), cA, voffA); PG8_STAGE(PG8_SA(0, 1), cA + hstep, voffA);
        if (wr == 1) PG8_BAR;
        PG8_WAIT_V(2); PG8_BAR;
        PG8_STAGE(PG8_SB(1, 0), cB + kstep, voffB); PG8_STAGE(PG8_SA(1, 0), cA + kstep, voffA); PG8_STAGE(PG8_SB(1, 1), cB + hstep + kstep, voffB);
        PG8_WAIT_V(6); PG8_BAR;
    } else {
        PG8_STAGE(PG8_SB(0, 0), cB, voffB); PG8_STAGE(PG8_SA(0, 0), cA, voffA); PG8_STAGE(PG8_SB(0, 1), cB + hstep, voffB); PG8_STAGE(PG8_SA(0, 1), cA + hstep, voffA);
        if (wr == 1) PG8_BAR;
        PG8_WAIT_V(4); PG8_BAR;
        PG8_STAGE(PG8_SB(1, 0), cB + kstep, voffB); PG8_STAGE(PG8_SA(1, 0), cA + kstep, voffA); PG8_STAGE(PG8_SB(1, 1), cB + hstep + kstep, voffB);
        PG8_WAIT_V(6); PG8_BAR;
    }
    for (;;) {
        const bool has_next = S.next(ui + 1, nxt);
        const char* nA = has_next ? (const char*)g.A + (size_t)nxt.pm * tstep + nxt.koff : cA; const char* nB = has_next ? (const char*)g.Bt + (size_t)nxt.pn * tstep + nxt.koff : cB;
        for (int t = 0; t < ntc; t += 2) {
            const bool last = (t == ntc - 2);
            const char* a1 = cA + (size_t)(t + 1) * kstep;
            const char* a2 = last ? nA : cA + (size_t)(t + 2) * kstep; const char* b2 = last ? nB : cB + (size_t)(t + 2) * kstep;
            const char* a3 = a2 + kstep; const char* b3 = b2 + kstep;
            if (last && has_next) S.a_ready(nxt);
            if constexpr (SP2) {
            PG8_LDB(B0, 0, 0); PG8_LDB(B1, 0, 1); PG8_SCHED; PG8_LDA(At, 0, 0); PG8_STAGE(PG8_SA(1, 1), a1 + hstep, voffA);
            PG8_WAIT_V(8); PG8_WAIT_L(0); PG8_BAR; PG8_MMA(0, 0, At, B0); PG8_MMA(0, 1, At, B1); PG8_BAR; PG8_SCHED;
            PG8_LDA(At, 0, 1); PG8_STAGE(PG8_SB(0, 0), b2, voffB); PG8_STAGE(PG8_SB(0, 1), b2 + hstep, voffB); PG8_STAGE(PG8_SA(0, 0), a2, voffA);
            PG8_WAIT_V(8); PG8_WAIT_L(0); PG8_BAR; PG8_MMA(1, 0, At, B0); PG8_MMA(1, 1, At, B1); PG8_BAR; PG8_SCHED;
            PG8_LDB(B0, 1, 0); PG8_LDB(B1, 1, 1); PG8_SCHED; PG8_LDA(At, 1, 0); PG8_STAGE(PG8_SA(0, 1), a2 + hstep, voffA);
            PG8_WAIT_V(8); PG8_WAIT_L(0); PG8_BAR; PG8_MMA(0, 0, At, B0); PG8_MMA(0, 1, At, B1); PG8_BAR; PG8_SCHED;
            PG8_LDA(At, 1, 1); PG8_STAGE(PG8_SB(1, 0), b3, voffB); PG8_STAGE(PG8_SB(1, 1), b3 + hstep, voffB); PG8_STAGE(PG8_SA(1, 0), a3, voffA);
            PG8_WAIT_V(8); PG8_WAIT_L(0); PG8_BAR; PG8_MMA(1, 0, At, B0); PG8_MMA(1, 1, At, B1); PG8_BAR; PG8_SCHED;
            } else {
            PG8_LDB(B0, 0, 0); PG8_SCHED; PG8_LDA(At, 0, 0); PG8_STAGE(PG8_SA(1, 1), a1 + hstep, voffA);
            PG8_WAIT_L(8); PG8_BAR; PG8_WAIT_L(0); PG8_MMA(0, 0, At, B0); PG8_BAR; PG8_SCHED;
            PG8_LDB(B1, 0, 1); PG8_STAGE(PG8_SB(0, 0), b2, voffB);
            PG8_BAR; PG8_WAIT_L(0); PG8_MMA(0, 1, At, B1); PG8_BAR;
            PG8_LDA(At, 0, 1); PG8_STAGE(PG8_SA(0, 0), a2, voffA);
            PG8_BAR; PG8_WAIT_L(0); PG8_MMA(1, 0, At, B0); PG8_BAR; PG8_SCHED;
            PG8_STAGE(PG8_SB(0, 1), b2 + hstep, voffB);
            PG8_WAIT_V(6); PG8_BAR; PG8_MMA(1, 1, At, B1); PG8_BAR;
            PG8_LDB(B0, 1, 0); PG8_SCHED; PG8_LDA(At, 1, 0); PG8_STAGE(PG8_SA(0, 1), a2 + hstep, voffA);
            PG8_WAIT_L(8); PG8_BAR; PG8_WAIT_L(0); PG8_MMA(0, 0, At, B0); PG8_BAR; PG8_SCHED;
            PG8_LDB(B1, 1, 1); PG8_STAGE(PG8_SB(1, 0), b3, voffB);
            PG8_BAR; PG8_WAIT_L(0); PG8_MMA(0, 1, At, B1); PG8_BAR;
            PG8_LDA(At, 1, 1); PG8_STAGE(PG8_SA(1, 0), a3, voffA);
            PG8_BAR; PG8_WAIT_L(0); PG8_MMA(1, 0, At, B0); PG8_BAR; PG8_SCHED;
            PG8_STAGE(PG8_SB(1, 1), b3 + hstep, voffB);
            PG8_WAIT_V(6); PG8_BAR; PG8_MMA(1, 1, At, B1); PG8_BAR;
            }
        }
        if constexpr (ALIGN_EPI) { if (wr == 0) PG8_BAR; }
        if constexpr (!Epi::AFTER_DRAIN) { E(acc, cur, wr, wc, fr, fq); S.done(cur); }
        if (!has_next) break;
#pragma unroll
        for (int a = 0; a < 2; ++a)
#pragma unroll
            for (int b = 0; b < 2; ++b)
#pragma unroll
                for (int m = 0; m < 4; ++m)
#pragma unroll
                    for (int n = 0; n < 2; ++n) acc[a][b][m][n] = (f32x4){0.f, 0.f, 0.f, 0.f};
        cur = nxt; cA = nA; cB = nB; ++ui; ntc = cur.nt ? cur.nt : nt;
        if constexpr (ALIGN_EPI) { if (wr == 1) PG8_BAR; }
    }
    PG8_WAIT_V(0);
    if constexpr (!ALIGN_EPI) { if (wr == 0) PG8_BAR; }
    PG8_BAR;
    if constexpr (Epi::AFTER_DRAIN) { E.fused(acc, cur, wr, wc, fr, fq, lds, wid, lane); S.done(cur); }
#undef PG8_SA
#undef PG8_SB
#undef PG8_STAGE
#undef PG8_LDA
#undef PG8_LDB
#undef PG8_MMA
#undef PG8_WAIT_V
#undef PG8_WAIT_L
#undef PG8_BAR
#undef PG8_SCHED
}
}
namespace att {
using bf16 = __hip_bfloat16;
using bf16x8 = __attribute__((ext_vector_type(8))) short;
using s16x4  = __attribute__((ext_vector_type(4))) short;
using f32x16 = __attribute__((ext_vector_type(16))) float;
using u32x4  = __attribute__((ext_vector_type(4))) unsigned;
constexpr int D = 128, NW = 8, QBLK = 32, KVBLK = 64;
constexpr int LDR = 6144;
constexpr size_t SHM_V = KVBLK * D * 2, SHM_K = KVBLK * D * 2, SHM_ATTN = 2 * SHM_V + 2 * SHM_K + NW * 64 * 4;
#define KSWZ(row, colB) ((row) * 256 + ((colB) ^ (((row) & 7) << 4)))
#define SBAR() __builtin_amdgcn_sched_barrier(0)
__device__ __forceinline__ int crow(int r, int hi) { return (r & 3) + 8 * (r >> 2) + 4 * hi; }
__device__ __forceinline__ unsigned cvtpk(float lo, float hi) { unsigned r; asm volatile("v_cvt_pk_bf16_f32 %0, %1, %2" : "=v"(r) : "v"(lo), "v"(hi)); return r; }
__device__ __forceinline__ unsigned short f2bf1(float x) { return (unsigned short)(cvtpk(x, x) & 0xffffu); }
#define PK4(P, BASE, OUT) do { unsigned a0 = cvtpk(P[BASE + 0], P[BASE + 1]), a1 = cvtpk(P[BASE + 2], P[BASE + 3]);   \
    unsigned b0 = cvtpk(P[BASE + 4], P[BASE + 5]), b1 = cvtpk(P[BASE + 6], P[BASE + 7]);                              \
    auto r0 = __builtin_amdgcn_permlane32_swap(a0, b0, false, false); auto r1 = __builtin_amdgcn_permlane32_swap(a1, b1, false, false); \
    u32x4 w = {r0[0], r1[0], r0[1], r1[1]}; OUT = *reinterpret_cast<bf16x8*>(&w); } while (0)

template <int SCALE_E6>
struct SM {
    static constexpr float SCALE = SCALE_E6 == 125000 ? 0.125f : 0.088388347648318440f;
    static constexpr float THR = 8.f;
    static __device__ __forceinline__ void partialSM(f32x16& p0, f32x16& p1, float& m_reg, float& mn, float& alpha) {
        constexpr float C = SCALE * 1.4426950408889634f;
        float pmax = p0[0];
#pragma unroll
        for (int r = 1; r < 16; ++r) pmax = fmaxf(pmax, p0[r]);
#pragma unroll
        for (int r = 0; r < 16; ++r) pmax = fmaxf(pmax, p1[r]);
        { auto rr = __builtin_amdgcn_permlane32_swap(__float_as_uint(pmax), __float_as_uint(pmax), false, false);
          pmax = fmaxf(__uint_as_float(rr[0]), __uint_as_float(rr[1])); }
        if (__builtin_expect(__all(pmax - m_reg <= THR / SCALE), 1)) { mn = m_reg; alpha = 1.f; }
        else { mn = fmaxf(m_reg, pmax); alpha = __builtin_amdgcn_exp2f((m_reg - mn) * C); m_reg = mn; }
        float mnC = -mn * C;
#pragma unroll
        for (int r = 0; r < 16; ++r) p0[r] = fmaf(p0[r], C, mnC);
#pragma unroll
        for (int r = 0; r < 16; ++r) p1[r] = fmaf(p1[r], C, mnC);
#pragma unroll
        for (int r = 0; r < 16; ++r) p0[r] = __builtin_amdgcn_exp2f(p0[r]);
    }
};
__device__ __forceinline__ void finishSM(f32x16& p0, f32x16& p1, float alpha, float& l_reg, bf16x8& pa0, bf16x8& pa1, bf16x8& pa2, bf16x8& pa3) {
#pragma unroll
    for (int r = 0; r < 16; ++r) p1[r] = __builtin_amdgcn_exp2f(p1[r]);
    float ps = 0;
#pragma unroll
    for (int r = 0; r < 16; ++r) ps += p0[r];
#pragma unroll
    for (int r = 0; r < 16; ++r) ps += p1[r];
    { auto rr = __builtin_amdgcn_permlane32_swap(__float_as_uint(ps), __float_as_uint(ps), false, false);
      ps = __uint_as_float(rr[0]) + __uint_as_float(rr[1]); }
    l_reg = l_reg * alpha + ps;
    PK4(p0, 0, pa0); PK4(p0, 8, pa1); PK4(p1, 0, pa2); PK4(p1, 8, pa3);
}
template <int ND0>
__device__ __forceinline__ void qkt(f32x16& p0, f32x16& p1, const bf16* Ks, const bf16x8* qr, int dbase, int r32, int hi) {
    p0 = f32x16{}; p1 = f32x16{};
#pragma unroll
    for (int d0 = 0; d0 < ND0; ++d0) { int cb = ((dbase + d0) * 16 + hi * 8) * 2;
        bf16x8 b0 = *reinterpret_cast<const bf16x8*>((const char*)Ks + KSWZ(r32, cb));
        bf16x8 b1 = *reinterpret_cast<const bf16x8*>((const char*)Ks + KSWZ(32 + r32, cb));
        p0 = __builtin_amdgcn_mfma_f32_32x32x16_bf16(b0, qr[d0], p0, 0, 0, 0);
        p1 = __builtin_amdgcn_mfma_f32_32x32x16_bf16(b1, qr[d0], p1, 0, 0, 0); }
}
__device__ __forceinline__ int v_st(int k, int c) { const int kk = (k & ~0xC) | ((k & 4) << 1) | ((k & 8) >> 1); return ((kk >> 3) * 4 + (c >> 5)) * 512 + ((kk & 7) * 32 + (c & 31)) * 2; }
__device__ __forceinline__ int v_rd_base(int lane) { return ((lane & 3) << 3) | (((lane >> 2) & 3) << 6) | (((lane >> 4) & 1) << 5) | (((lane >> 5) & 1) << 8); }
constexpr int v_rd_off(int d0, int ks, int half) { return d0 * 512 + ks * 4096 + half * 2048; }
template <int OFF> __device__ __forceinline__ s16x4 tr_read(int vb) {
    s16x4 r; asm volatile("ds_read_b64_tr_b16 %0, %1 offset:%2" : "=&v"(r) : "v"(vb), "i"(OFF) : "memory"); return r;
}
#define PKV(L, H) (bf16x8){L[0], L[1], L[2], L[3], H[0], H[1], H[2], H[3]}
template <int D0> __device__ __forceinline__ void pv_one(f32x16& od, int vb, bf16x8 pa0, bf16x8 pa1, bf16x8 pa2, bf16x8 pa3) {
    const s16x4 l0 = tr_read<v_rd_off(D0, 0, 0)>(vb), h0 = tr_read<v_rd_off(D0, 0, 1)>(vb), l1 = tr_read<v_rd_off(D0, 1, 0)>(vb), h1 = tr_read<v_rd_off(D0, 1, 1)>(vb);
    const s16x4 l2 = tr_read<v_rd_off(D0, 2, 0)>(vb), h2 = tr_read<v_rd_off(D0, 2, 1)>(vb), l3 = tr_read<v_rd_off(D0, 3, 0)>(vb), h3 = tr_read<v_rd_off(D0, 3, 1)>(vb);
    asm volatile("s_waitcnt lgkmcnt(0)" ::: "memory"); SBAR();
    od = __builtin_amdgcn_mfma_f32_32x32x16_bf16(pa0, PKV(l0, h0), od, 0, 0, 0);
    od = __builtin_amdgcn_mfma_f32_32x32x16_bf16(pa1, PKV(l1, h1), od, 0, 0, 0);
    od = __builtin_amdgcn_mfma_f32_32x32x16_bf16(pa2, PKV(l2, h2), od, 0, 0, 0);
    od = __builtin_amdgcn_mfma_f32_32x32x16_bf16(pa3, PKV(l3, h3), od, 0, 0, 0);
}
__device__ __forceinline__ void pv_d0(f32x16* o, int vb, bf16x8 pa0, bf16x8 pa1, bf16x8 pa2, bf16x8 pa3) {
    pv_one<0>(o[0], vb, pa0, pa1, pa2, pa3); pv_one<1>(o[1], vb, pa0, pa1, pa2, pa3); pv_one<2>(o[2], vb, pa0, pa1, pa2, pa3); pv_one<3>(o[3], vb, pa0, pa1, pa2, pa3);
}
template <int D0> __device__ __forceinline__ void pv_one32(f32x16& od, int vb, bf16x8 pa0, bf16x8 pa1) {
    const s16x4 l0 = tr_read<v_rd_off(D0, 0, 0)>(vb), h0 = tr_read<v_rd_off(D0, 0, 1)>(vb), l1 = tr_read<v_rd_off(D0, 1, 0)>(vb), h1 = tr_read<v_rd_off(D0, 1, 1)>(vb);
    asm volatile("s_waitcnt lgkmcnt(0)" ::: "memory"); SBAR();
    od = __builtin_amdgcn_mfma_f32_32x32x16_bf16(pa0, PKV(l0, h0), od, 0, 0, 0);
    od = __builtin_amdgcn_mfma_f32_32x32x16_bf16(pa1, PKV(l1, h1), od, 0, 0, 0);
}

typedef float f32x4c __attribute__((ext_vector_type(4)));
struct ConvJob {
    const float *w_gate, *w_up, *w_down, *w_out, *g_ffn; unsigned short *WGU, *WDN, *WOUT;
    int next, end, stride;
};
struct ConvItem { const float* W; unsigned short* dst; int N, K, k0, n0, drow; };
constexpr int CV_GU = 32 * 88, CV_OUT = 32 * 32, CV_TOTAL = 2 * CV_GU + CV_OUT;
__device__ __forceinline__ ConvItem conv_item(const float* Jw_gate, const float* Jw_up, const float* Jw_down, const float* Jw_out, unsigned short* JWGU, unsigned short* JWDN, unsigned short* JWOUT, int q) {
    ConvItem it;
    const bool gu = q < 2 * CV_GU; const int up = (q >= CV_GU) ? 1 : 0;
    const int rg = q - up * CV_GU, kbg = rg / 88, nbg = rg - kbg * 88;
    const int rd = gu ? 0 : q - 2 * CV_GU, kbd = rd >> 5, nbd = rd & 31;
    it.W = gu ? (up ? Jw_up : Jw_gate) : Jw_out;
    it.dst = gu ? JWGU : JWOUT;
    it.N = gu ? 5632 : 2048; it.K = 2048;
    it.k0 = 64 * (gu ? kbg : kbd); it.n0 = 64 * (gu ? nbg : nbd);
    it.drow = gu ? 256 * (it.n0 >> 7) + 128 * up + (it.n0 & 127) : it.n0;
    return it;
}
__device__ __forceinline__ void attn_dense_body(const bf16* __restrict__ Qb, const bf16* __restrict__ Kh, const bf16* __restrict__ Vh,
                                                unsigned short* __restrict__ Ob, int ldo, int dbase, int seq, char* lds, const int wave_in, ConvJob& cj,
                                                const bool second, unsigned short* __restrict__ Yb, const float lam, const float* __restrict__ subln) {
    using S8 = SM<125000>;
    const int wid = wave_in, lane = mk_lane(), tid = wid * 64 + lane, r32 = lane & 31, hi = lane >> 5;
    bf16* V_lds = (bf16*)lds; bf16* K_lds = (bf16*)(lds + 2 * SHM_V);
    float* ws = (float*)(lds + 2 * SHM_V + 2 * SHM_K) + wid * 64; float* li_l = ws; float* al_l = ws + 32;
    float m_reg = -1e30f, l_reg = 0; f32x16 o[4] = {}; bf16x8 qr[4];
    const bf16* Qw = Qb + (long)(wid * QBLK + r32) * LDR + dbase * 16 + hi * 8;
#pragma unroll
    for (int d0 = 0; d0 < 4; ++d0) qr[d0] = *reinterpret_cast<const bf16x8*>(Qw + d0 * 16);
    const int sr = tid >> 4, sc = (tid & 15) * 8, vst0 = v_st(sr, sc), vst1 = v_st(32 + sr, sc);
    const int vb0 = (int)(uintptr_t)V_lds + v_rd_base(lane);
    struct { bf16x8 vs0, vs1, ks0; } sr_[2];
    const int krow = tid >> 3, kcol = dbase * 16 + (tid & 7) * 8, kst0 = KSWZ(krow, kcol * 2);
#define SLOAD(i, k0) do { sr_[i].vs0 = *reinterpret_cast<const bf16x8*>(&Vh[(long)((k0) + sr) * LDR + sc]); sr_[i].vs1 = *reinterpret_cast<const bf16x8*>(&Vh[(long)((k0) + 32 + sr) * LDR + sc]); \
    sr_[i].ks0 = *reinterpret_cast<const bf16x8*>(&Kh[(long)((k0) + krow) * LDR + kcol]); } while (0)
#define SWRITE(b, i) do { *(bf16x8*)((char*)V_lds + (b) * SHM_V + vst0) = sr_[i].vs0;          \
    *(bf16x8*)((char*)V_lds + (b) * SHM_V + vst1) = sr_[i].vs1;                              \
    *(bf16x8*)((char*)K_lds + (b) * SHM_K + kst0) = sr_[i].ks0; } while (0)
#define SWAIT() do {} while (0)
#define RESC(a) do { if (__any((a) < 1.f)) { if (hi == 0) al_l[r32] = (a); asm volatile("s_waitcnt lgkmcnt(0)" ::: "memory"); \
    _Pragma("unroll") for (int d = 0; d < 4; ++d) _Pragma("unroll") for (int r = 0; r < 16; ++r) o[d][r] *= al_l[crow(r, hi)]; } } while (0)
    f32x16 pA0, pA1, pB0, pB1; float mnA, mnB, alA, alB; bf16x8 pa0, pa1, pa2, pa3; const int NT = seq / KVBLK;
    const float* const jwg = cj.w_gate; const float* const jwu = cj.w_up; const float* const jwd = cj.w_down; const float* const jwo = cj.w_out;
    unsigned short* const jGU = cj.WGU; unsigned short* const jDN = cj.WDN; unsigned short* const jOUT = cj.WOUT; const int jnext = cj.next, jend = cj.end, jstride = cj.stride;
    float* cscr = (float*)(lds + SHM_ATTN); f32x4c cv0, cv1; int slot = 0;
#define CV_Q(k) (min(jnext + (k) * jstride, jend))
#define CV_LOAD(q) do { const ConvItem it_ = conv_item(jwg, jwu, jwd, jwo, jGU, jDN, jOUT, (q)); const float* s_ = it_.W + (size_t)(it_.k0 + (tid >> 3)) * it_.N + it_.n0 + 8 * (tid & 7); \
    cv0 = *(const f32x4c*)s_; cv1 = *(const f32x4c*)(s_ + 4); } while (0)
#define CV_WRITE() do { f32x4c* d_ = (f32x4c*)(cscr + (tid >> 3) * 64 + 8 * ((tid & 7) ^ ((tid >> 6) & 7))); d_[0] = cv0; d_[1] = cv1; } while (0)
#define CV_STORE(q) do { const ConvItem it_ = conv_item(jwg, jwu, jwd, jwo, jGU, jDN, jOUT, (q)); const int n_ = tid >> 3, c_ = tid & 7; const float* s_ = cscr + (8 * c_) * 64 + (n_ ^ (8 * c_)); \
    u32x4 o_; o_.x = cvtpk(s_[0], s_[64]); o_.y = cvtpk(s_[128], s_[192]); o_.z = cvtpk(s_[256], s_[320]); o_.w = cvtpk(s_[384], s_[448]); \
    *(u32x4*)(it_.dst + (size_t)(it_.drow + n_) * it_.K + it_.k0 + 8 * c_) = o_; } while (0)
#define CV_CONSUME() do { CV_WRITE(); const int qn_ = CV_Q(slot + 1); CV_LOAD(qn_); } while (0)
#define CV_FINISH() do { const int qc_ = CV_Q(slot); CV_STORE(qc_); ++slot; } while (0)
    const int owed = (jnext > jend) ? 0 : (jend - jnext) / jstride + 1;
    const int ctrips = min((owed + 1) >> 1, (NT - 2) >> 1);
    if (ctrips > 0) { const int q0_ = CV_Q(0); CV_LOAD(q0_); }
    constexpr int SE = 0, SO = 1;
    SLOAD(SE, 0); asm volatile("s_waitcnt vmcnt(0)" ::: "memory"); SWRITE(0, SE); __syncthreads();
    qkt<4>(pA0, pA1, K_lds, qr, dbase, r32, hi); S8::partialSM(pA0, pA1, m_reg, mnA, alA);
    SLOAD(SO, KVBLK); if (2 < NT) SLOAD(SE, 2 * KVBLK);
    SWAIT(); SWRITE(1, SO); __syncthreads();
#define B_TRIP(CONV) do { \
        SBAR(); qkt<4>(pB0, pB1, (bf16*)((char*)K_lds + SHM_K), qr, dbase, r32, hi); \
        finishSM(pA0, pA1, alA, l_reg, pa0, pa1, pa2, pa3); SBAR(); \
        SLOAD(SO, (j + 2) * KVBLK); SBAR(); \
        pv_d0(o, vb0, pa0, pa1, pa2, pa3); S8::partialSM(pB0, pB1, m_reg, mnB, alB); \
        __syncthreads(); SWAIT(); SWRITE(0, SE); \
        if (CONV) CV_CONSUME(); \
        RESC(alB); __syncthreads(); \
        if (CONV) CV_FINISH(); \
        SBAR(); qkt<4>(pA0, pA1, K_lds, qr, dbase, r32, hi); \
        finishSM(pB0, pB1, alB, l_reg, pa0, pa1, pa2, pa3); SBAR(); \
        SLOAD(SE, min(j + 3, NT - 1) * KVBLK); SBAR();     \
        pv_d0(o, vb0 + (int)SHM_V, pa0, pa1, pa2, pa3); S8::partialSM(pA0, pA1, m_reg, mnA, alA); \
        __syncthreads(); SWAIT(); SWRITE(1, SO); \
        if (CONV) CV_CONSUME(); \
        RESC(alA); __syncthreads(); \
        if (CONV) CV_FINISH(); } while (0)
    int j = 1;
    for (int tr = 0; tr < ctrips; ++tr, j += 2) B_TRIP(true);
    for (; j + 1 < NT; j += 2) B_TRIP(false);
#undef B_TRIP
    cj.next = min(jnext + slot * jstride, jend + jstride);
    SBAR(); qkt<4>(pB0, pB1, (bf16*)((char*)K_lds + SHM_K), qr, dbase, r32, hi);
    finishSM(pA0, pA1, alA, l_reg, pa0, pa1, pa2, pa3); SBAR();
    pv_d0(o, vb0, pa0, pa1, pa2, pa3); S8::partialSM(pB0, pB1, m_reg, mnB, alB);
    __syncthreads(); RESC(alB);
    finishSM(pB0, pB1, alB, l_reg, pa0, pa1, pa2, pa3); SBAR();
    pv_d0(o, vb0 + (int)SHM_V, pa0, pa1, pa2, pa3);
    if (hi == 0) li_l[r32] = l_reg; asm volatile("s_waitcnt lgkmcnt(0)" ::: "memory");
    float rli[16];
#pragma unroll
    for (int r = 0; r < 16; ++r) rli[r] = __builtin_amdgcn_rcpf(li_l[crow(r, hi)]);
    unsigned short* Ow = (unsigned short*)(lds + SHM_ATTN + 16384) + wid * 4096;
    if (!second) {
#pragma unroll
        for (int r = 0; r < 16; ++r) { int orow = crow(r, hi);
#pragma unroll
            for (int d0 = 0; d0 < 4; ++d0) Ow[orow * 128 + d0 * 32 + r32] = f2bf1(o[d0][r] * rli[r]); }
        asm volatile("s_waitcnt lgkmcnt(0)" ::: "memory");
    } else {
        float ssq[16];
#pragma unroll
        for (int r = 0; r < 16; ++r) { const int orow = crow(r, hi); ssq[r] = 0.f;
#pragma unroll
            for (int d0 = 0; d0 < 4; ++d0) { const float o0 = __uint_as_float((unsigned)Ow[orow * 128 + d0 * 32 + r32] << 16);
                const float d = o0 - lam * (o[d0][r] * rli[r]); o[d0][r] = d; ssq[r] += d * d; } }
#pragma unroll
        for (int r = 0; r < 16; ++r) { float v = ssq[r]; v += __shfl_xor(v, 1); v += __shfl_xor(v, 2); v += __shfl_xor(v, 4); v += __shfl_xor(v, 8); v += __shfl_xor(v, 16); ssq[r] = v; }
        float sl[4];
#pragma unroll
        for (int d0 = 0; d0 < 4; ++d0) sl[d0] = subln[d0 * 32 + r32] * 0.8f;
        unsigned short* Yw = Yb + (long)(wid * QBLK) * 2048;
#pragma unroll
        for (int r = 0; r < 16; ++r) { const int orow = crow(r, hi); const float rs = 1.0f / sqrtf(ssq[r] * (1.0f / 128.0f) + 1e-5f);
#pragma unroll
            for (int d0 = 0; d0 < 4; ++d0) Yw[(long)orow * 2048 + d0 * 32 + r32] = f2bf1(o[d0][r] * rs * sl[d0]); }
    }
#undef CV_LOAD
#undef CV_Q
#undef CV_STORE
#undef CV_WRITE
#undef CV_CONSUME
#undef CV_FINISH
#undef SLOAD
#undef SWRITE
#undef SWAIT
#undef RESC
}

__device__ __forceinline__ void swa_wave_unit(const bf16* __restrict__ base, long rstride, int qc, int kc, int vc, int t0, int L,
                                              unsigned short* __restrict__ Ob, long ostride, float* __restrict__ Lb, long lstride, char* lds_w, float* scr) {
    constexpr float SCALE = 0.088388347648318440f, C = SCALE * 1.4426950408889634f;
    const int lane = mk_lane(), r32 = lane & 31, hi = lane >> 5;
    bf16* K_lds = (bf16*)lds_w; char* V_lds = lds_w + 8192;
    bf16x8 qr[8];
    { const bf16* Qw = base + (long)(t0 + r32) * rstride + qc + hi * 8;
#pragma unroll
      for (int d0 = 0; d0 < 8; ++d0) qr[d0] = *reinterpret_cast<const bf16x8*>(Qw + d0 * 16); }
    const int srow = lane >> 4, scol = (lane & 15) * 8;
    const bf16* kbase = base + (long)srow * rstride + kc + scol; const bf16* vbase = base + (long)srow * rstride + vc + scol;
    bf16x8 st[2][8];
#define TILE_K0(i) (t0 - 64 + 32 * (i))
#define TILE_OK(i) (TILE_K0(i) >= 0 && TILE_K0(i) < L)
#define TILE_KC(i) (min(max(TILE_K0(i), 0), L - 32))
#define LD_TILE(buf, pbase, i) do { const bf16* p_ = (pbase) + (long)TILE_KC(i) * rstride; _Pragma("unroll") for (int j = 0; j < 8; ++j) st[buf][j] = *reinterpret_cast<const bf16x8*>(p_ + (long)(4 * j) * rstride); } while (0)
    f32x16 s[5];
    LD_TILE(0, kbase, 0);
#pragma unroll
    for (int i = 0; i < 5; ++i) {
        if (i < 4) LD_TILE((i + 1) & 1, kbase, i + 1); else LD_TILE((i + 1) & 1, vbase, 0);
#pragma unroll
        for (int j = 0; j < 8; ++j) *(bf16x8*)((char*)K_lds + KSWZ(4 * j + srow, scol * 2)) = st[i & 1][j];
        f32x16 p = f32x16{};
#pragma unroll
        for (int d0 = 0; d0 < 8; ++d0) { const int cb = (d0 * 16 + hi * 8) * 2;
            const bf16x8 b0 = *reinterpret_cast<const bf16x8*>((const char*)K_lds + KSWZ(r32, cb));
            p = __builtin_amdgcn_mfma_f32_32x32x16_bf16(b0, qr[d0], p, 0, 0, 0); }
        const bool ok = TILE_OK(i);
#pragma unroll
        for (int r = 0; r < 16; ++r) {
            bool keep = ok;
            if (i == 0) keep = keep && (crow(r, hi) >= r32);
            if (i == 4) keep = keep && (crow(r, hi) <= r32);
            s[i][r] = keep ? p[r] : -1e30f;
        }
    }
    float m = -1e30f;
#pragma unroll
    for (int i = 0; i < 5; ++i)
#pragma unroll
        for (int r = 0; r < 16; ++r) m = fmaxf(m, s[i][r]);
    { auto rr = __builtin_amdgcn_permlane32_swap(__float_as_uint(m), __float_as_uint(m), false, false);
      m = fmaxf(__uint_as_float(rr[0]), __uint_as_float(rr[1])); }
    const float mC = -m * C; float l = 0.f;
#pragma unroll
    for (int i = 0; i < 5; ++i)
#pragma unroll
        for (int r = 0; r < 16; ++r) { s[i][r] = __builtin_amdgcn_exp2f(fmaf(s[i][r], C, mC)); l += s[i][r]; }
    { auto rr = __builtin_amdgcn_permlane32_swap(__float_as_uint(l), __float_as_uint(l), false, false);
      l = __uint_as_float(rr[0]) + __uint_as_float(rr[1]); }
    bf16x8 pa[5][2];
#pragma unroll
    for (int i = 0; i < 5; ++i) { PK4(s[i], 0, pa[i][0]); PK4(s[i], 8, pa[i][1]); }
    f32x16 o[4] = {};
    const int vb = (int)(uintptr_t)V_lds + v_rd_base(lane);
#pragma unroll
    for (int i = 0; i < 5; ++i) {
        if (i < 4) LD_TILE(i & 1, vbase, i + 1);
#pragma unroll
        for (int j = 0; j < 8; ++j) *(bf16x8*)(V_lds + v_st(4 * j + srow, scol)) = st[(i + 1) & 1][j];
        asm volatile("s_waitcnt lgkmcnt(0)" ::: "memory");
        pv_one32<0>(o[0], vb, pa[i][0], pa[i][1]); pv_one32<1>(o[1], vb, pa[i][0], pa[i][1]); pv_one32<2>(o[2], vb, pa[i][0], pa[i][1]); pv_one32<3>(o[3], vb, pa[i][0], pa[i][1]);
    }
#undef TILE_K0
#undef TILE_OK
#undef TILE_KC
#undef LD_TILE
    if (hi == 0) { scr[r32] = l; Lb[(long)(t0 + r32) * lstride] = m * SCALE + __logf(l); }
    asm volatile("s_waitcnt lgkmcnt(0)" ::: "memory");
    float rli[16];
#pragma unroll
    for (int r = 0; r < 16; ++r) rli[r] = __builtin_amdgcn_rcpf(scr[crow(r, hi)]);
#pragma unroll
    for (int r = 0; r < 16; ++r) { const long orow = (long)(t0 + crow(r, hi)) * ostride;
#pragma unroll
        for (int d0 = 0; d0 < 4; ++d0) Ob[orow + d0 * 32 + r32] = f2bf1(o[d0][r] * rli[r]); }
    asm volatile("s_waitcnt lgkmcnt(0)" ::: "memory");
}
__device__ __forceinline__ void swa_wg_unit(const bf16* __restrict__ QKVb, int gbr, int sub0, int qt0, int sstep, unsigned short* __restrict__ OAg, float* __restrict__ LSEg, char* lds, float* scr, const int wid) {
    constexpr float SCALE = 0.088388347648318440f, C = SCALE * 1.4426950408889634f;
    const int lane = mk_lane(), tid = wid * 64 + lane, r32 = lane & 31, hi = lane >> 5;
    const int dsh = 2 * gbr, dil = 1 << dsh, L = 2048 >> dsh, nblk = L >> 5; const bool big = nblk >= 8;
    const long rstride = (long)dil * LDR;
#define SUB_BASE(sub) (QKVb + ((size_t)((sub) >> (3 + dsh)) * 2048 + (((sub) >> 3) & (dil - 1))) * LDR + ((sub) & 7) * 128)
    const int srow = tid >> 4, scol = (tid & 15) * 8;
    bf16x8 kst[12], vst[12];
#pragma unroll
    for (int sl = 0; sl < 12; ++sl) {
        const int sub_s = big ? sub0 : sub0 + ((sl >> 2) & 1) * sstep; const int kt_s = big ? min(max(qt0 - 2 + sl, 0), nblk - 1) : (sl & 3);
        const bf16* p_ = SUB_BASE(sub_s) + (long)(kt_s * 32 + srow) * rstride + scol;
        kst[sl] = *reinterpret_cast<const bf16x8*>(p_ + 1024);
    }
    const int sub_w = big ? sub0 : sub0 + (wid >> 2) * sstep; const int qt = big ? qt0 + wid : (wid & 3); const int t0 = qt * 32;
    const bf16* base_w = SUB_BASE(sub_w);
    bf16x8 qr[8];
    { const bf16* Qw = base_w + (long)(t0 + r32) * rstride + hi * 8;
#pragma unroll
      for (int d0 = 0; d0 < 8; ++d0) qr[d0] = *reinterpret_cast<const bf16x8*>(Qw + d0 * 16); }
#pragma unroll
    for (int sl = 0; sl < 12; ++sl) *(bf16x8*)(lds + sl * 8192 + KSWZ(srow, scol * 2)) = kst[sl];
#pragma unroll
    for (int sl = 0; sl < 12; ++sl) {
        const int sub_s = big ? sub0 : sub0 + ((sl >> 2) & 1) * sstep; const int kt_s = big ? min(max(qt0 - 2 + sl, 0), nblk - 1) : (sl & 3);
        const bf16* p_ = SUB_BASE(sub_s) + (long)(kt_s * 32 + srow) * rstride + scol;
        vst[sl] = *reinterpret_cast<const bf16x8*>(p_ + 2048);
    }
    __syncthreads();
    f32x16 s[5];
#pragma unroll
    for (int i = 0; i < 5; ++i) {
        const int kt = qt - 2 + i; const bool ok = kt >= 0 && kt < nblk;
        const int slot = big ? wid + i : 4 * (wid >> 2) + min(max(kt, 0), 3);
        const char* Ks = lds + slot * 8192;
        f32x16 p = f32x16{};
#pragma unroll
        for (int d0 = 0; d0 < 8; ++d0) { const int cb = (d0 * 16 + hi * 8) * 2;
            const bf16x8 b0 = *reinterpret_cast<const bf16x8*>(Ks + KSWZ(r32, cb));
            p = __builtin_amdgcn_mfma_f32_32x32x16_bf16(b0, qr[d0], p, 0, 0, 0); }
#pragma unroll
        for (int r = 0; r < 16; ++r) {
            bool keep = ok;
            if (i == 0) keep = keep && (crow(r, hi) >= r32);
            if (i == 4) keep = keep && (crow(r, hi) <= r32);
            s[i][r] = keep ? p[r] : -1e30f;
        }
    }
    float m = -1e30f;
#pragma unroll
    for (int i = 0; i < 5; ++i)
#pragma unroll
        for (int r = 0; r < 16; ++r) m = fmaxf(m, s[i][r]);
    { auto rr = __builtin_amdgcn_permlane32_swap(__float_as_uint(m), __float_as_uint(m), false, false);
      m = fmaxf(__uint_as_float(rr[0]), __uint_as_float(rr[1])); }
    const float mC = -m * C; float l = 0.f;
#pragma unroll
    for (int i = 0; i < 5; ++i)
#pragma unroll
        for (int r = 0; r < 16; ++r) { s[i][r] = __builtin_amdgcn_exp2f(fmaf(s[i][r], C, mC)); l += s[i][r]; }
    { auto rr = __builtin_amdgcn_permlane32_swap(__float_as_uint(l), __float_as_uint(l), false, false);
      l = __uint_as_float(rr[0]) + __uint_as_float(rr[1]); }
    bf16x8 pa[5][2];
#pragma unroll
    for (int i = 0; i < 5; ++i) { PK4(s[i], 0, pa[i][0]); PK4(s[i], 8, pa[i][1]); }
    __syncthreads();
#pragma unroll
    for (int sl = 0; sl < 12; ++sl) *(bf16x8*)(lds + sl * 8192 + v_st(srow, scol)) = vst[sl];
    __syncthreads();
    f32x16 o[4] = {};
#pragma unroll
    for (int i = 0; i < 5; ++i) {
        const int kt = qt - 2 + i;
        const int slot = big ? wid + i : 4 * (wid >> 2) + min(max(kt, 0), 3);
        const int vb = (int)(uintptr_t)(lds + slot * 8192) + v_rd_base(lane);
        pv_one32<0>(o[0], vb, pa[i][0], pa[i][1]); pv_one32<1>(o[1], vb, pa[i][0], pa[i][1]); pv_one32<2>(o[2], vb, pa[i][0], pa[i][1]); pv_one32<3>(o[3], vb, pa[i][0], pa[i][1]);
    }
    const size_t tok0 = ((size_t)(sub_w >> (3 + dsh)) * 2048 + ((sub_w >> 3) & (dil - 1))); const int hh = sub_w & 7;
    if (hi == 0) { scr[r32] = l; LSEg[(tok0 + (size_t)(t0 + r32) * dil) * 8 + hh] = m * SCALE + __logf(l); }
    asm volatile("s_waitcnt lgkmcnt(0)" ::: "memory");
    float rli[16];
#pragma unroll
    for (int r = 0; r < 16; ++r) rli[r] = __builtin_amdgcn_rcpf(scr[crow(r, hi)]);
#pragma unroll
    for (int r = 0; r < 16; ++r) { unsigned short* orow = OAg + (tok0 + (size_t)(t0 + crow(r, hi)) * dil) * 1024 + hh * 128;
#pragma unroll
        for (int d0 = 0; d0 < 4; ++d0) orow[d0 * 32 + r32] = f2bf1(o[d0][r] * rli[r]); }
    asm volatile("s_waitcnt lgkmcnt(0)" ::: "memory");
    __syncthreads();
#undef SUB_BASE
}
#undef SBAR
}
#ifndef MK_DUP_PHASE
#define MK_DUP_PHASE -1
#endif
#define NREP(k) (1 + (MK_DUP_PHASE == (k) ? 1 : 0))
#ifndef WGM_P1
#define WGM_P1 4
#endif
#ifndef WGM_P4
#define WGM_P4 8
#endif
#ifndef WGM_P5
#define WGM_P5 2
#endif
#ifndef WGM_P6
#define WGM_P6 8
#endif
#ifndef MK_TIME_PHASE
#define MK_TIME_PHASE -1
#endif
#ifndef MK_ONE_LAUNCH
#define MK_ONE_LAUNCH 1
#endif
constexpr int NWAVES = 8;
constexpr int BATCH = 4, SEQ = 2048, DM = 2048, M = BATCH * SEQ, NIN = 6144, DFF = 5632, NGU = 2 * DFF, NHEAD = 8, HD = 128;
constexpr float RMS_EPS = 1e-6f, SUBLN_EPS = 1e-5f, LAM_INIT = 0.2f;
constexpr size_t MiB = 1u << 20;
constexpr size_t WS_SS1 = 0, WS_SS2 = 64 * 1024, WS_LSE = 1 * MiB;
constexpr size_t WS_QKV = 2 * MiB;
constexpr size_t WS_Y = 162 * MiB;
constexpr size_t WS_H = 34 * MiB;
constexpr size_t WS_WIN = 98 * MiB, WS_XN = 122 * MiB;
constexpr size_t WS_OA = 98 * MiB;
constexpr size_t WS_WOUT = 154 * MiB;
constexpr size_t WS_OB = 162 * MiB, WS_XG = 2 * MiB;
constexpr size_t WS_WGU = 194 * MiB, WS_WDN = 238 * MiB, WS_END = 260 * MiB;
static_assert(WS_H + (size_t)M * DFF * 2 <= WS_WOUT && WS_XG + (size_t)M * DM * 2 <= WS_H && WS_Y + (size_t)M * DM * 2 <= WS_WGU && WS_OA + (size_t)3 * M * 1024 * 2 <= WS_WOUT && WS_WDN + (size_t)DM * DFF * 2 <= WS_END && WS_WGU + (size_t)NGU * DM * 2 <= WS_WDN && WS_QKV + (size_t)M * NIN * 2 <= WS_WIN, "d_ws map");
constexpr int RING_BYTES = 131072, LDS_BYTES = 163840, MISC_OFF = 163584;
constexpr size_t WS_BAR = 128 * 1024, WS_CNT = 144 * 1024, WS_FLAG = 152 * 1024, WS_GRP = 160 * 1024, BAR_BYTES = 40 * 1024;

#define GAS __attribute__((address_space(1)))
#define LAS __attribute__((address_space(3)))
typedef unsigned short bf16;
typedef unsigned v4u __attribute__((ext_vector_type(4)));
typedef float f32x4 __attribute__((ext_vector_type(4)));
#define LDS_WAIT() asm volatile("s_waitcnt lgkmcnt(0)" ::: "memory")
__device__ __forceinline__ unsigned f2bf(float f) { unsigned u = __builtin_bit_cast(unsigned, f); return (u + 0x7fffu + ((u >> 16) & 1u)) >> 16; }
__device__ __forceinline__ unsigned pk2(float lo, float hi) { return f2bf(lo) | (f2bf(hi) << 16); }
__device__ __forceinline__ float bflo(unsigned w) { return __uint_as_float(w << 16); }
__device__ __forceinline__ float bfhi(unsigned w) { return __uint_as_float(w & 0xffff0000u); }
__device__ __forceinline__ float wave_sum(float v) {
#pragma unroll
    for (int o = 1; o < 64; o <<= 1) v += __shfl_xor(v, o);
    return v;
}
__device__ __forceinline__ void transpose_item(const float* W, int K, int N, bf16* WT, int k0, int n0, int dst_row0, LAS float* scr, int lane, const float* ks = nullptr) {
    float wv[32];
#pragma unroll
    for (int i = 0; i < 32; ++i) { const int kk = 2 * i + (lane >> 5); wv[i] = W[(size_t)(k0 + kk) * N + n0 + (lane & 31)]; }
#pragma unroll
    for (int i = 0; i < 32; ++i) { const int kk = 2 * i + (lane >> 5); scr[kk * 33 + (lane & 31)] = wv[i]; }
    LDS_WAIT(); asm volatile("" ::: "memory");
    const int c = lane & 7;
    f32x4 g0 = {1.f, 1.f, 1.f, 1.f}, g1 = {1.f, 1.f, 1.f, 1.f};
    if (ks) { g0 = *(const f32x4*)(ks + k0 + 8 * c); g1 = *(const f32x4*)(ks + k0 + 8 * c + 4); }
#pragma unroll
    for (int j = 0; j < 4; ++j) { const int n = (lane >> 3) + 8 * j; const LAS float* s = scr + (8 * c) * 33 + n;
        v4u o; o.x = pk2(s[0 * 33] * g0.x, s[1 * 33] * g0.y); o.y = pk2(s[2 * 33] * g0.z, s[3 * 33] * g0.w); o.z = pk2(s[4 * 33] * g1.x, s[5 * 33] * g1.y); o.w = pk2(s[6 * 33] * g1.z, s[7 * 33] * g1.w);
        *(GAS v4u*)(WT + (size_t)(dst_row0 + n) * K + k0 + 8 * c) = o; }
    LDS_WAIT(); asm volatile("" ::: "memory");
}

#define XB_TMO      128
#define XB_XCNT(j)  (256  + 64 * (j))
#define XB_XSUB(j)  (1280 + 64 * (j))
#define XB_XGEN(j)  (2304 + 64 * (j))
#define XB_TOP      3328
#define XB_TOPGEN   3392
#define XCD_BAR_WORDS 3456
#define XB_SPIN_CAP (1u << 18)

__device__ __forceinline__ unsigned xb_ld(unsigned* p)              { return __hip_atomic_load(p, __ATOMIC_RELAXED, __HIP_MEMORY_SCOPE_AGENT); }
__device__ __forceinline__ unsigned xb_add(unsigned* p, unsigned v) { return __hip_atomic_fetch_add(p, v, __ATOMIC_RELAXED, __HIP_MEMORY_SCOPE_AGENT); }
__device__ __forceinline__ unsigned xb_xcc_id() { return (unsigned)__builtin_amdgcn_s_getreg((3 << 11) | 20) & 0xFu; }
#define XB_SPIN(cond, bar) do { unsigned _sp = 0; while (cond) { __builtin_amdgcn_s_sleep(1); \
    if ((++_sp & 255u) == 0u) { if (xb_ld(&(bar)[XB_TMO])) break; if (_sp > XB_SPIN_CAP) { atomicAdd(&(bar)[XB_TMO], 1u); break; } } } } while (0)

struct XcdBarrier {
    unsigned* bar; unsigned x;
    volatile LAS unsigned* st;
};

__device__ __forceinline__ XcdBarrier xcd_barrier_post(unsigned* bar, volatile LAS unsigned* st, const int wave_in) {
    XcdBarrier b; b.bar = bar; b.x = xb_xcc_id(); b.st = st;
    if (wave_in == 0 && mk_lane() == 0) (void)xb_add(&bar[XB_XCNT(b.x)], 1u);
    return b;
}
__device__ __forceinline__ void xcd_barrier_complete(unsigned* bar, unsigned x, unsigned& nloc, unsigned& nx) {
    const unsigned G = gridDim.x * gridDim.y * gridDim.z;
    unsigned sum, cnt, mine, sp = 0u;
    for (;;) {
        sum = 0u; cnt = 0u; mine = 0u;
#pragma unroll
        for (unsigned j = 0; j < 16; ++j) { const unsigned c = xb_ld(&bar[XB_XCNT(j)]); sum += c; cnt += (c > 0u) ? 1u : 0u; mine = (j == x) ? c : mine; }
        if (sum == G) break;
        __builtin_amdgcn_s_sleep(1);
        if ((++sp & 255u) == 0u) { if (xb_ld(&bar[XB_TMO])) break; if (sp > XB_SPIN_CAP) { atomicAdd(&bar[XB_TMO], 1u); break; } }
    }
    nloc = mine > 0u ? mine : 1u; nx = cnt > 0u ? cnt : 1u;
}

__device__ __forceinline__ void xcd_barrier(const XcdBarrier& b, const int wave_in) {
    asm volatile("s_waitcnt vmcnt(0)" ::: "memory");
    __syncthreads();
    if (wave_in == 0 && mk_lane() == 0) {
        unsigned* bar = b.bar;
        __builtin_amdgcn_s_waitcnt(0);
        unsigned nloc = b.st[0], nx = b.st[1];
        if (nloc == 0u) { xcd_barrier_complete(bar, b.x, nloc, nx); b.st[0] = nloc; b.st[1] = nx; }
        const unsigned old = xb_add(&bar[XB_XSUB(b.x)], 1u);
        const unsigned gen = old / nloc;
        if (old + 1u == (gen + 1u) * nloc) {
            __builtin_amdgcn_fence(__ATOMIC_RELEASE, "agent");
            asm volatile("s_waitcnt vmcnt(0)" ::: "memory");
            const unsigned og = xb_add(&bar[XB_TOP], 1u);
            const unsigned tg = og / nx;
            if (og + 1u == (tg + 1u) * nx) xb_add(&bar[XB_TOPGEN], 1u);
            else XB_SPIN(xb_ld(&bar[XB_TOPGEN]) == tg, bar);
            __builtin_amdgcn_fence(__ATOMIC_ACQUIRE, "agent");
            xb_add(&bar[XB_XGEN(b.x)], 1u);
            asm volatile("s_waitcnt vmcnt(0)" ::: "memory");
        } else {
            XB_SPIN(xb_ld(&bar[XB_XGEN(b.x)]) == gen, bar);
            __builtin_amdgcn_fence(__ATOMIC_ACQUIRE, "agent");
            asm volatile("s_waitcnt vmcnt(0)" ::: "memory");
        }
    }
    __syncthreads();
}
struct Args { const float* in[11]; float* out; unsigned char* ws; int ph_lo, ph_hi; };
constexpr int NPHASE = 7;

__global__ void __launch_bounds__(NWAVES * 64, 2) mk_fwd(Args args) {
    extern __shared__ __attribute__((aligned(16))) unsigned char lds[];
    LAS unsigned char* ldsl = (LAS unsigned char*)lds;
    const int wave = __builtin_amdgcn_readfirstlane((int)threadIdx.x >> 6);
    const int G = gridDim.x, bx = blockIdx.x;
    const int vcu = (G % 8 == 0) ? (bx % 8) * (G / 8) + bx / 8 : bx;
    const int gw = vcu * NWAVES + wave, NGW = G * NWAVES;
    unsigned char* ws = args.ws;
    const float* x = args.in[0]; const float* g_attn = args.in[1]; const float* w_in = args.in[2]; const float* lambda_qk = args.in[3]; const float* subln = args.in[4];
    const float* w_out = args.in[5]; const float* g_ffn = args.in[6]; const float* w_gate = args.in[7]; const float* w_up = args.in[8]; const float* w_down = args.in[9];
    const float* g_final = args.in[10];
    float* out = args.out;
    float* SS1 = (float*)(ws + WS_SS1); float* SS2 = (float*)(ws + WS_SS2); float* LSE = (float*)(ws + WS_LSE);
    bf16* QKV = (bf16*)(ws + WS_QKV); bf16* WGU = (bf16*)(ws + WS_WGU); bf16* WDN = (bf16*)(ws + WS_WDN); bf16* HB = (bf16*)(ws + WS_H);
    bf16* WIN = (bf16*)(ws + WS_WIN); bf16* XN = (bf16*)(ws + WS_XN); bf16* OA = (bf16*)(ws + WS_OA); bf16* WOUT = (bf16*)(ws + WS_WOUT);
    bf16* OB = (bf16*)(ws + WS_OB); bf16* XG = (bf16*)(ws + WS_XG); bf16* Y = (bf16*)(ws + WS_Y);
    const int lo = args.ph_lo, hi_ph = args.ph_hi;
#define IN(k) (lo <= (k) && (k) < hi_ph)
    if (wave == 0) { const int l0 = mk_lane(); if (l0 < 32) ((LAS unsigned*)(ldsl + MISC_OFF))[l0] = 0u; }
    __syncthreads();
    XcdBarrier bar; bar.bar = (unsigned*)(ws + WS_BAR); bar.x = 0; bar.st = nullptr;
    if (hi_ph - lo > 1) bar = xcd_barrier_post((unsigned*)(ws + WS_BAR), (volatile LAS unsigned*)(ldsl + MISC_OFF), wave);
    if (lo < -1000) cg::this_grid().sync();
#define STAMP(k) do { if (MK_TIME_PHASE >= 0) { const unsigned long long t_ = __builtin_amdgcn_s_memrealtime(); if ((k) == MK_TIME_PHASE) tph0 = t_; if ((k) == MK_TIME_PHASE + 1) tph1 = t_; } } while (0)
    unsigned long long tph0 = 0, tph1 = 0; STAMP(0);
#define SEAM(k) do { if (IN(k) && IN((k) + 1)) { for (int rb = 0; rb < (MK_DUP_PHASE == 30 ? 3 : 1); ++rb) xcd_barrier(bar, wave); } } while (0)

    if (IN(0)) for (int rep = 0; rep < NREP(0); ++rep) { const int lane = mk_lane(), tid = wave * 64 + lane;
        LAS float* scr = (LAS float*)(ldsl + wave * 16384);
        constexpr int I_IN = (DM / 64) * (NIN / 32), I_OUT = (DM / 64) * (DM / 32);
        for (int it = gw; it < I_IN; it += NGW) {
            if (it < I_IN) { const int nblk = NIN / 32, kb = it / nblk, nb = it % nblk; transpose_item(w_in, DM, NIN, WIN, 64 * kb, 32 * nb, 32 * nb, scr, lane); }
            else { const int r = it - I_IN; const int nblk = DM / 32, kb = r / nblk, nb = r % nblk; transpose_item(w_out, DM, DM, WOUT, 64 * kb, 32 * nb, 32 * nb, scr, lane); }
        }
        for (int m = gw; m < M; m += NGW) {
            const GAS f32x4* xr = (const GAS f32x4*)(x + (size_t)m * DM) + lane;
            f32x4 v[8]; float s = 0.f;
#pragma unroll
            for (int j = 0; j < 8; ++j) { v[j] = xr[64 * j]; s += (v[j].x * v[j].x + v[j].y * v[j].y) + (v[j].z * v[j].z + v[j].w * v[j].w); }
            const float rstd = 1.0f / sqrtf(wave_sum(s) * (1.f / DM) + RMS_EPS);
            GAS unsigned long long* o8 = (GAS unsigned long long*)(XN + (size_t)m * DM) + lane;
#pragma unroll
            for (int j = 0; j < 8; ++j) { const f32x4 gg = *((const GAS f32x4*)g_attn + lane + 64 * j);
                o8[64 * j] = (unsigned long long)pk2(v[j].x * rstd * gg.x, v[j].y * rstd * gg.y) | ((unsigned long long)pk2(v[j].z * rstd * gg.z, v[j].w * rstd * gg.w) << 32); }
        }
        for (int i = bx * (NWAVES * 64) + tid; i < M; i += G * NWAVES * 64) { SS1[i] = 0.f; SS2[i] = 0.f; }
    }
    SEAM(0); STAMP(1);
    if (IN(1)) {
        pg8::Gemm g{XN, WIN, M, NIN, DM}; pg8::StaticOrder S; S.init(M, NIN, G, bx); S.dup = NREP(1); S.wgm = WGM_P1;
        pg8::EpiQKV E{QKV, NIN};
        pg8::gemm_phase<pg8::EpiQKV, pg8::StaticOrder, true, true>(ldsl, g, S, E, wave);
    }
    SEAM(1); STAMP(2);
    if (IN(2)) { const int lane = mk_lane();
        float lam;
        { const float a = lambda_qk[lane] * lambda_qk[64 + lane], b2 = lambda_qk[128 + lane] * lambda_qk[192 + lane];
          lam = __expf(wave_sum(a)) - __expf(wave_sum(b2)) + LAM_INIT; }
        const int grp = vcu >> 3, k = vcu & 7, gb = grp >> 3, gh = grp & 7;
        const att::bf16* rowb = (const att::bf16*)QKV + (size_t)gb * SEQ * NIN;
        att::ConvJob cj{w_gate, w_up, w_down, w_out, g_ffn, WGU, WDN, WOUT, vcu, vcu + G * ((att::CV_TOTAL - 1 - vcu) / G), G};
        for (int i = 0; i < 2 * NREP(20); ++i) {
            const int c = i & 1;
            att::attn_dense_body(rowb + (size_t)k * 256 * NIN + 3072 + gh * HD, rowb + 4096 + gh * HD, rowb + 5120 + gh * HD, nullptr, 1024, 4 * c, SEQ, (char*)lds, wave, cj,
                                 c == 1, Y + ((size_t)gb * SEQ + k * 256) * DM + 1024 + gh * HD, lam, subln);
        }
        __syncthreads();
        { float* scr = (float*)((char*)lds + RING_BYTES) + wave * 64;
          for (int rep = 0; rep < NREP(21); ++rep) {
            att::swa_wg_unit((const att::bf16*)QKV, 0, gb * 8 + gh, 8 * k, 0, OA, LSE, (char*)lds, scr, wave);
            att::swa_wg_unit((const att::bf16*)QKV, 1, (gb * 4 + (k >> 1)) * 8 + gh, 8 * (k & 1), 0, OA + (size_t)M * 1024, LSE + (size_t)M * 8, (char*)lds, scr, wave);
            att::swa_wg_unit((const att::bf16*)QKV, 2, (gb * 16 + 2 * k) * 8 + gh, 0, 8, OA + (size_t)2 * M * 1024, LSE + (size_t)2 * M * 8, (char*)lds, scr, wave);
          } }
        asm volatile("s_waitcnt vmcnt(0)" ::: "memory"); __syncthreads();
        if (wave == 0 && lane == 0) {
            unsigned* gc = (unsigned*)(ws + WS_GRP) + 64 * grp;
            __builtin_amdgcn_fence(__ATOMIC_RELEASE, "agent"); asm volatile("s_waitcnt vmcnt(0)" ::: "memory");
            __hip_atomic_fetch_add(gc, 1u, __ATOMIC_RELAXED, __HIP_MEMORY_SCOPE_AGENT);
            unsigned sp = 0; while (__hip_atomic_load(gc, __ATOMIC_RELAXED, __HIP_MEMORY_SCOPE_AGENT) < 8u) { __builtin_amdgcn_s_sleep(2); if (++sp > (1u << 22)) break; }
            __builtin_amdgcn_fence(__ATOMIC_ACQUIRE, "agent"); asm volatile("s_waitcnt vmcnt(0)" ::: "memory");
        }
        __syncthreads();
        { const int col = (lane & 15) * 8;
#pragma unroll 2
          for (int it = 0; it < 8; ++it) {
            const size_t m = (size_t)gb * SEQ + k * 256 + wave * 32 + it * 4 + (lane >> 4);
            const float l0 = LSE[m * 8 + gh], l1 = LSE[((size_t)M + m) * 8 + gh], l2 = LSE[((size_t)2 * M + m) * 8 + gh];
            const float mx = fmaxf(l0, fmaxf(l1, l2)); float w0 = __expf(l0 - mx), w1 = __expf(l1 - mx), w2 = __expf(l2 - mx);
            const float inv = 1.0f / (w0 + w1 + w2); w0 *= inv; w1 *= inv; w2 *= inv;
            const v4u a0 = *(const GAS v4u*)(OA + m * 1024 + gh * HD + col), a1 = *(const GAS v4u*)(OA + ((size_t)M + m) * 1024 + gh * HD + col), a2 = *(const GAS v4u*)(OA + ((size_t)2 * M + m) * 1024 + gh * HD + col);
            v4u ya;
#pragma unroll
            for (int i = 0; i < 4; ++i) ya[i] = pk2(w0 * bflo(a0[i]) + w1 * bflo(a1[i]) + w2 * bflo(a2[i]), w0 * bfhi(a0[i]) + w1 * bfhi(a1[i]) + w2 * bfhi(a2[i]));
            *(GAS v4u*)(Y + m * DM + gh * HD + col) = ya;
          } }
        __syncthreads();
    }
    SEAM(2); STAMP(3);
    if (IN(4)) {
        pg8::Gemm g{Y, WOUT, M, DM, DM}; pg8::StaticOrder S; S.init(M, DM, G, bx); S.dup = NREP(4); S.wgm = WGM_P4;
        pg8::EpiOut E{x, XG, g_ffn, SS1, DM};
        pg8::gemm_phase<pg8::EpiOut, pg8::StaticOrder, true, true>(ldsl, g, S, E, wave);
    }
    SEAM(4); STAMP(4);
    if (IN(5)) {
        pg8::Gemm g{XG, WGU, M, NGU, DM}; pg8::StaticOrder S; S.init(M, NGU, G, bx); S.dup = NREP(5); S.wgm = WGM_P5;
        S.split_from = -1  ; S.kh_bytes = (DM / 2) * 2; S.kh_nt = DM / 128;
        pg8::EpiGateUp E{HB, DFF, SS1, 1.0f / DM, RMS_EPS, (pg8::f32x4*)(ws + WS_Y), (unsigned*)(ws + WS_FLAG)};
        pg8::gemm_phase<pg8::EpiGateUp, pg8::StaticOrder, true, true>(ldsl, g, S, E, wave);
        if (bx >= 128 && G == 256) {
            const int lane = mk_lane(); LAS float* scr = (LAS float*)(ldsl + wave * 16384);
            constexpr int I_D = (DFF / 64) * (DM / 32);
            for (int it = (bx - 128) * NWAVES + wave; it < I_D; it += 128 * NWAVES) { const int nblk = DM / 32, kb = it / nblk, nb = it % nblk; transpose_item(w_down, DFF, DM, WDN, 64 * kb, 32 * nb, 32 * nb, scr, lane); }
        }
    }
    SEAM(5); STAMP(5);
    if (IN(6)) {
        pg8::Gemm g{HB, WDN, M, DM, DFF}; pg8::StaticOrder S; S.init(M, DM, G, bx); S.wgm = WGM_P6;
        pg8::EpiDownNorm E{XG, g_ffn, out, g_final, SS2, (unsigned*)(ws + WS_CNT), DM, 1.0f / DM, RMS_EPS};
        pg8::gemm_phase<pg8::EpiDownNorm, pg8::StaticOrder, false, true>(ldsl, g, S, E, wave);
    }
    STAMP(6);
    if (MK_TIME_PHASE >= 0 && bx == 0 && wave == 0) { if (tph1 == 0) tph1 = __builtin_amdgcn_s_memrealtime(); const unsigned long long t0_ = __builtin_amdgcn_s_memrealtime(); while (__builtin_amdgcn_s_memrealtime() - t0_ < tph1 - tph0) __builtin_amdgcn_s_sleep(8); }
#undef IN
#undef SEAM
}

extern "C" void kernel_launch(void* const* d_in, const int* in_sizes, int n_in, void* d_out, int out_size, void* d_ws, size_t ws_size, hipStream_t stream) {
    static int grid = 0;
    if (grid == 0) {
        if (n_in != 11 || in_sizes[0] != M * DM || out_size != M * DM || ws_size < WS_END) { fprintf(stderr, "kernel_launch: shape/workspace mismatch (n_in %d, in0 %d, out %d, ws %zu)\n", n_in, n_in > 0 ? in_sizes[0] : -1, out_size, ws_size); grid = -1; return; }
        int dev = 0, cus = 0, per_cu = 0;
        if (hipGetDevice(&dev) != hipSuccess || hipDeviceGetAttribute(&cus, hipDeviceAttributeMultiprocessorCount, dev) != hipSuccess) { grid = -1; return; }
        if (hipFuncSetAttribute((const void*)mk_fwd, hipFuncAttributeMaxDynamicSharedMemorySize, LDS_BYTES) != hipSuccess) { fprintf(stderr, "kernel_launch: hipFuncSetAttribute failed\n"); grid = -1; return; }
        if (hipOccupancyMaxActiveBlocksPerMultiprocessor(&per_cu, (const void*)mk_fwd, NWAVES * 64, LDS_BYTES) != hipSuccess || per_cu < 1) { fprintf(stderr, "kernel_launch: occupancy query says %d\n", per_cu); per_cu = 1; }
        (void)hipGetLastError();
        grid = cus;
        if (grid != 256) { fprintf(stderr, "kernel_launch: this kernel needs a 256-CU device (got %d)\n", cus); grid = -1; return; }
    }
    if (grid < 0) return;
    Args a{};
    for (int i = 0; i < 11; ++i) a.in[i] = (const float*)d_in[i];
    a.out = (float*)d_out; a.ws = (unsigned char*)d_ws;
#if MK_ONE_LAUNCH
    if (hipMemsetAsync((char*)d_ws + WS_BAR, 0, BAR_BYTES, stream) != hipSuccess) { fprintf(stderr, "kernel_launch: memset failed\n"); return; }
#ifdef MK_PROBE_MEMSET2
    (void)hipMemsetAsync((char*)d_ws + WS_BAR, 0, BAR_BYTES, stream);
#endif
    a.ph_lo = 0; a.ph_hi = NPHASE;
    void* kargs[] = {&a};
    hipError_t e = hipLaunchCooperativeKernel((const void*)mk_fwd, dim3(grid), dim3(NWAVES * 64), kargs, LDS_BYTES, stream);
    if (e != hipSuccess) fprintf(stderr, "kernel_launch: cooperative launch failed: %s (grid %d)\n", hipGetErrorString(e), grid);
#else
    for (int p = 0; p < NPHASE; ++p) {
        a.ph_lo = p; a.ph_hi = p + 1;
        hipLaunchKernelGGL(mk_fwd, dim3(grid), dim3(NWAVES * 64), LDS_BYTES, stream, a);
    }
#endif
}
```

```cpp
#include <hip/hip_runtime.h>
#include <hip/hip_cooperative_groups.h>
#include <hip/hip_bf16.h>
#include <cstdio>
#include <cstdint>
#include <cmath>
namespace cg = cooperative_groups;
__device__ __forceinline__ int mk_lane() { int l; asm volatile("v_mbcnt_lo_u32_b32 %0, -1, 0\n\tv_mbcnt_hi_u32_b32 %0, -1, %0" : "=v"(l)); return l & 63; }
namespace pg8 {
#define PG8_LAS __attribute__((address_space(3)))
typedef unsigned short bf16_t;
typedef short bf16x8 __attribute__((ext_vector_type(8)));
typedef float f32x4 __attribute__((ext_vector_type(4)));
typedef unsigned u32x4 __attribute__((ext_vector_type(4)));
constexpr int BM = 256, BK = 64, HALF = 128, HTB = HALF * BK * 2  , STAGE_BYTES = 8 * HTB, NXCD = 8, WGM = 8;

__host__ __device__ __forceinline__ int lds_byte(int r, int c) { const int st = (r >> 4) * 2 + (c >> 5), rr = r & 15, cc = c & 31, ob = rr * 64 + cc * 2; return st * 1024 + (ob ^ (((ob >> 9) & 1) << 5)); }
__host__ __device__ __forceinline__ void stage_rc(int b, int& R, int& C) { const int st = b / 1024, sb = b % 1024, swz = sb ^ (((sb >> 9) & 1) << 5); R = (st >> 1) * 16 + swz / 64; C = (st & 1) * 32 + (swz % 64) / 2; }
__host__ __device__ __forceinline__ int perm32(int rho) { const int n = rho >> 4, i = rho & 15; return 8 * (i >> 2) + 4 * n + (i & 3); }

struct Unit { int pm, pn, first, khalf, koff, nt, ul; };
struct Gemm { const bf16_t* A; const bf16_t* Bt; int M, N, K; };

struct StaticOrder {
    int nM, nN, nwg, G, c, dup, split_from, kh_bytes, kh_nt, wgm;
    __host__ __device__ void init(int M, int N, int G_, int c_) { nM = M / BM; nN = N / BM; nwg = nM * nN; G = G_; c = c_; dup = 1; wgm = WGM; split_from = -1; kh_bytes = 0; kh_nt = 0; }
    __host__ __device__ bool next(int i, Unit& u) const {
        long L = (long)(i / dup) * G + c; u.khalf = 0; u.koff = 0; u.nt = 0; u.ul = 0;
        if (split_from >= 0 && (long)(i / dup) * G >= split_from) {
            if ((long)(i / dup) * G > split_from) return false;
            u.ul = c >> 1; L = split_from + u.ul; u.khalf = 1 + (c & 1); u.koff = (c & 1) ? kh_bytes : 0; u.nt = kh_nt; }
        if (L >= nwg) return false;
        int wgid = (int)L; { const int q = nwg / NXCD, r = nwg % NXCD, xcd = wgid % NXCD, off = wgid / NXCD; wgid = (xcd < r ? xcd * (q + 1) : r * (q + 1) + (xcd - r) * q) + off; }
        const int nig = wgm * nN, gid = wgid / nig, fm = gid * wgm, gsz = (nM - fm) < wgm ? (nM - fm) : wgm;
        u.pm = fm + ((wgid % nig) % gsz); u.pn = (wgid % nig) / gsz; u.first = (i % dup) == 0; return true;
    }
    __device__ __forceinline__ void a_ready(const Unit&) const {}
    __device__ __forceinline__ void done(const Unit&) const {}
};

__device__ __forceinline__ unsigned cvt_pk_bf16(float lo, float hi) { unsigned r; asm volatile("v_cvt_pk_bf16_f32 %0, %1, %2" : "=v"(r) : "v"(lo), "v"(hi)); return r; }
typedef float f32x2 __attribute__((ext_vector_type(2)));
__device__ __forceinline__ float invf_a(int f) {
    constexpr float T[16] = {1.0f, 0.4403666f, 0.19392274f, 0.0853971f, 0.03760603f, 0.01656044f, 0.0072926646f, 0.003211446f,
                             0.0014142136f, 0.00062277244f, 0.0002742482f, 0.000120769735f, 5.3182957e-05f, 2.342e-05f, 1.0313385e-05f, 4.5416705e-06f};
    return T[f];
}
__device__ __forceinline__ void sincos_rev(float ang, float& s, float& c) {
    const float rev = ang * 0.15915494309189535f; const float fr = rev - __builtin_floorf(rev);
    s = __builtin_amdgcn_sinf(fr); c = __builtin_amdgcn_cosf(fr);
}
struct EpiQKV {
    static constexpr bool PERM = true, AFTER_DRAIN = false;
    bf16_t* O; int ldc;
    __device__ __forceinline__ void operator()(const f32x4 (&acc)[2][2][4][2], const Unit& u, int wr, int wc, int fr, int fq) const {
        const int row0 = u.pm * BM + wr * 64 + fr;
        const int sec = u.pn >> 2;
        const int col0 = u.pn * BM + wc * 32 + 8 * fq;
        const bool ropeA = (sec <= 1) && (wc == 0);
        const bool ropeB = (sec == 3 || sec == 4) && ((wc & 1) == 0);
#pragma unroll
        for (int ai = 0; ai < 2; ++ai)
#pragma unroll
            for (int m = 0; m < 4; ++m) {
                const int row = row0 + ai * HALF + m * 16;
                const float pos = (float)(row & 2047);
                bf16_t* rowp = O + (size_t)row * ldc + col0;
                float cs[8], sn[8];
                if (ropeA) {
                    const int fb = 8 * (fq & 1);
#pragma unroll
                    for (int i = 0; i < 8; ++i) { float f0 = invf_a(i), f1 = invf_a(8 + i); sincos_rev(pos * (fb ? f1 : f0), sn[i], cs[i]); }
                    const float sg = (fq >= 2) ? 1.f : -1.f;
#pragma unroll
                    for (int i = 0; i < 8; ++i) sn[i] *= sg;
                } else if (ropeB) {
#pragma unroll
                    for (int i = 0; i < 8; ++i) sincos_rev(pos * invf_a(2 * i), sn[i], cs[i]);
                    const float sg = (fq == 1) ? 1.f : -1.f;
#pragma unroll
                    for (int i = 0; i < 8; ++i) sn[i] *= sg;
                }
#pragma unroll
                for (int bj = 0; bj < 2; ++bj) {
                    f32x4 v0 = acc[ai][bj][m][0], v1 = acc[ai][bj][m][1];
                    if (ropeA) {
                        f32x4 p0, p1;
#pragma unroll
                        for (int i = 0; i < 4; ++i) { p0[i] = __shfl_xor(v0[i], 32); p1[i] = __shfl_xor(v1[i], 32); }
#pragma unroll
                        for (int i = 0; i < 4; ++i) { v0[i] = v0[i] * cs[i] + p0[i] * sn[i]; v1[i] = v1[i] * cs[4 + i] + p1[i] * sn[4 + i]; }
                    } else if (ropeB) {
                        f32x4 p0, p1;
#pragma unroll
                        for (int i = 0; i < 4; ++i) { p0[i] = __shfl_xor(v0[i], 16); p1[i] = __shfl_xor(v1[i], 16); }
                        if (fq < 2) {
#pragma unroll
                            for (int i = 0; i < 4; ++i) { v0[i] = v0[i] * cs[i] + p0[i] * sn[i]; v1[i] = v1[i] * cs[4 + i] + p1[i] * sn[4 + i]; }
                        }
                    }
                    u32x4 w; w.x = cvt_pk_bf16(v0[0], v0[1]); w.y = cvt_pk_bf16(v0[2], v0[3]); w.z = cvt_pk_bf16(v1[0], v1[1]); w.w = cvt_pk_bf16(v1[2], v1[3]);
                    *(u32x4*)(rowp + bj * HALF) = w;
                }
            }
    }
};
struct EpiOut {
    static constexpr bool PERM = false, AFTER_DRAIN = false;
    const float* base; bf16_t* xg; const float* g; float* ss; int ldc;
    __device__ __forceinline__ void operator()(const f32x4 (&acc)[2][2][4][2], const Unit& u, int wr, int wc, int fr, int fq) const {
        typedef unsigned u32x2v __attribute__((ext_vector_type(2)));
        const int col0 = u.pn * BM + wc * 32 + 4 * fq;
        f32x4 gv[2][2];
#pragma unroll
        for (int bj = 0; bj < 2; ++bj)
#pragma unroll
            for (int n = 0; n < 2; ++n) gv[bj][n] = *(const f32x4*)(g + col0 + bj * HALF + n * 16);
#pragma unroll
        for (int ai = 0; ai < 2; ++ai)
#pragma unroll
            for (int m = 0; m < 4; ++m) {
                const int row = u.pm * BM + ai * HALF + wr * 64 + m * 16 + fr; const size_t off = (size_t)row * ldc + col0; float s = 0.f;
#pragma unroll
                for (int bj = 0; bj < 2; ++bj)
#pragma unroll
                    for (int n = 0; n < 2; ++n) {
                        const f32x4 x1 = *(const f32x4*)(base + off + bj * HALF + n * 16) + acc[ai][bj][m][n];
                        s += (x1[0] * x1[0] + x1[1] * x1[1]) + (x1[2] * x1[2] + x1[3] * x1[3]);
                        const f32x4 y = x1 * gv[bj][n]; u32x2v w; w.x = cvt_pk_bf16(y[0], y[1]); w.y = cvt_pk_bf16(y[2], y[3]);
                        *(u32x2v*)(xg + off + bj * HALF + n * 16) = w;
                    }
                s += __shfl_xor(s, 16); s += __shfl_xor(s, 32);
                if (fq == 0 && u.first) atomicAdd(ss + row, s);
            }
    }
};
struct EpiGateUp {
    static constexpr bool PERM = true, AFTER_DRAIN = false;
    bf16_t* H; int ldh; const float* ss; float inv_n, eps; f32x4* part; unsigned* flag;
    __device__ __forceinline__ void operator()(const f32x4 (&acc)[2][2][4][2], const Unit& u, int wr, int wc, int fr, int fq) const {
        const int tid = (wr * 4 + wc) * 64 + fq * 16 + fr;
        f32x4* pp = part + (size_t)u.ul * (32 * 512) + tid;
        if (u.khalf == 1) {
#pragma unroll
            for (int ai = 0; ai < 2; ++ai)
#pragma unroll
                for (int bj = 0; bj < 2; ++bj)
#pragma unroll
                    for (int m = 0; m < 4; ++m)
#pragma unroll
                        for (int n = 0; n < 2; ++n) pp[(size_t)(((ai * 2 + bj) * 4 + m) * 2 + n) * 512] = acc[ai][bj][m][n];
            asm volatile("s_waitcnt vmcnt(0)" ::: "memory"); __builtin_amdgcn_s_barrier(); asm volatile("" ::: "memory");
            if (tid == 0) { __builtin_amdgcn_fence(__ATOMIC_RELEASE, "agent"); asm volatile("s_waitcnt vmcnt(0)" ::: "memory");
                __hip_atomic_store(flag + 16 * u.ul, 1u, __ATOMIC_RELAXED, __HIP_MEMORY_SCOPE_AGENT); }
            return;
        }
        if (u.khalf == 2) {
            if (tid < 64) { unsigned sp = 0;
                while ((unsigned)__builtin_amdgcn_readfirstlane(__hip_atomic_load(flag + 16 * u.ul, __ATOMIC_RELAXED, __HIP_MEMORY_SCOPE_AGENT)) == 0u) { __builtin_amdgcn_s_sleep(2); if (++sp > (1u << 22)) break; }
                __builtin_amdgcn_fence(__ATOMIC_ACQUIRE, "agent"); asm volatile("s_waitcnt vmcnt(0)" ::: "memory"); }
            asm volatile("s_waitcnt vmcnt(0) lgkmcnt(0)" ::: "memory"); __builtin_amdgcn_s_barrier(); asm volatile("" ::: "memory");
        }
        const int col0 = u.pn * HALF + wc * 32 + 8 * fq;
#pragma unroll
        for (int ai = 0; ai < 2; ++ai)
#pragma unroll
            for (int m = 0; m < 4; ++m) {
                const int row = u.pm * BM + ai * HALF + wr * 64 + m * 16 + fr;
                const float rstd = 1.0f / sqrtf(ss[row] * inv_n + eps);
                f32x4 gq[2], uq[2];
#pragma unroll
                for (int n = 0; n < 2; ++n) { gq[n] = acc[ai][0][m][n]; uq[n] = acc[ai][1][m][n]; }
                if (u.khalf == 2) {
#pragma unroll
                    for (int n = 0; n < 2; ++n) { gq[n] += pp[(size_t)(((ai * 2 + 0) * 4 + m) * 2 + n) * 512]; uq[n] += pp[(size_t)(((ai * 2 + 1) * 4 + m) * 2 + n) * 512]; }
                }
                float hv[8];
#pragma unroll
                for (int n = 0; n < 2; ++n)
#pragma unroll
                    for (int i = 0; i < 4; ++i) { const float gg = gq[n][i] * rstd, uu = uq[n][i] * rstd;
                        hv[4 * n + i] = gg * __builtin_amdgcn_rcpf(1.0f + __builtin_amdgcn_exp2f(-1.4426950408889634f * gg)) * uu; }
                u32x4 w; w.x = cvt_pk_bf16(hv[0], hv[1]); w.y = cvt_pk_bf16(hv[2], hv[3]); w.z = cvt_pk_bf16(hv[4], hv[5]); w.w = cvt_pk_bf16(hv[6], hv[7]);
                *(u32x4*)(H + (size_t)row * ldh + col0) = w;
            }
    }
};
struct EpiDown {
    static constexpr bool PERM = false, AFTER_DRAIN = false;
    const bf16_t* base; float* out; float* ss; int ldc;
    __device__ __forceinline__ void operator()(const f32x4 (&acc)[2][2][4][2], const Unit& u, int wr, int wc, int fr, int fq) const {
        typedef unsigned u32x2v __attribute__((ext_vector_type(2)));
        const int col0 = u.pn * BM + wc * 32 + 4 * fq;
#pragma unroll
        for (int ai = 0; ai < 2; ++ai)
#pragma unroll
            for (int m = 0; m < 4; ++m) {
                const int row = u.pm * BM + ai * HALF + wr * 64 + m * 16 + fr; const size_t off = (size_t)row * ldc + col0; float s = 0.f;
#pragma unroll
                for (int bj = 0; bj < 2; ++bj)
#pragma unroll
                    for (int n = 0; n < 2; ++n) {
                        const u32x2v rb = *(const u32x2v*)(base + off + bj * HALF + n * 16);
                        f32x4 x2 = acc[ai][bj][m][n];
                        x2[0] += __uint_as_float(rb.x << 16); x2[1] += __uint_as_float(rb.x & 0xffff0000u); x2[2] += __uint_as_float(rb.y << 16); x2[3] += __uint_as_float(rb.y & 0xffff0000u);
                        *(f32x4*)(out + off + bj * HALF + n * 16) = x2;
                        s += (x2[0] * x2[0] + x2[1] * x2[1]) + (x2[2] * x2[2] + x2[3] * x2[3]);
                    }
                s += __shfl_xor(s, 16); s += __shfl_xor(s, 32);
                if (fq == 0 && u.first) atomicAdd(ss + row, s);
            }
    }
};
struct EpiDownNorm {
    static constexpr bool PERM = false, AFTER_DRAIN = true;
    const bf16_t* base; const float* gres; float* out; const float* g; float* ss; unsigned* cnt; int ldc; float inv_n, eps;
    __device__ __forceinline__ void fused(f32x4 (&acc)[2][2][4][2], const Unit& u, int wr, int wc, int fr, int fq, PG8_LAS unsigned char* lds, int wid, int lane) const {
        typedef unsigned u32x2v __attribute__((ext_vector_type(2)));
        const int col0 = u.pn * BM + wc * 32 + 4 * fq;
        f32x4 rg[2][2];
#pragma unroll
        for (int bj = 0; bj < 2; ++bj)
#pragma unroll
            for (int n = 0; n < 2; ++n) { const f32x4 t = *(const f32x4*)(gres + col0 + bj * HALF + n * 16); rg[bj][n] = (f32x4){1.0f / t[0], 1.0f / t[1], 1.0f / t[2], 1.0f / t[3]}; }
#pragma unroll
        for (int ai = 0; ai < 2; ++ai)
#pragma unroll
            for (int m = 0; m < 4; ++m) {
                const int row = u.pm * BM + ai * HALF + wr * 64 + m * 16 + fr; const size_t off = (size_t)row * ldc + col0; float s = 0.f;
#pragma unroll
                for (int bj = 0; bj < 2; ++bj)
#pragma unroll
                    for (int n = 0; n < 2; ++n) {
                        const u32x2v rb = *(const u32x2v*)(base + off + bj * HALF + n * 16);
                        f32x4 x2 = acc[ai][bj][m][n];
                        x2[0] += __uint_as_float(rb.x << 16) * rg[bj][n][0]; x2[1] += __uint_as_float(rb.x & 0xffff0000u) * rg[bj][n][1]; x2[2] += __uint_as_float(rb.y << 16) * rg[bj][n][2]; x2[3] += __uint_as_float(rb.y & 0xffff0000u) * rg[bj][n][3];
                        acc[ai][bj][m][n] = x2;
                        s += (x2[0] * x2[0] + x2[1] * x2[1]) + (x2[2] * x2[2] + x2[3] * x2[3]);
                    }
                s += __shfl_xor(s, 16); s += __shfl_xor(s, 32);
                if (fq == 0) atomicAdd(ss + row, s);
            }
        asm volatile("s_waitcnt vmcnt(0)" ::: "memory");
        __builtin_amdgcn_s_barrier(); asm volatile("" ::: "memory");
        if (wid == 0) {
            unsigned* c = cnt + 64 * u.pm;
            if (lane == 0) __hip_atomic_fetch_add(c, 1u, __ATOMIC_RELAXED, __HIP_MEMORY_SCOPE_AGENT);
            unsigned sp = 0;
            while ((unsigned)__builtin_amdgcn_readfirstlane(__hip_atomic_load(c, __ATOMIC_RELAXED, __HIP_MEMORY_SCOPE_AGENT)) < 8u) { __builtin_amdgcn_s_sleep(2); if (++sp > (1u << 22)) break; }
            __builtin_amdgcn_fence(__ATOMIC_ACQUIRE, "agent");
        }
        asm volatile("s_waitcnt vmcnt(0) lgkmcnt(0)" ::: "memory"); __builtin_amdgcn_s_barrier(); asm volatile("" ::: "memory");
        f32x4 gv[2][2];
#pragma unroll
        for (int bj = 0; bj < 2; ++bj)
#pragma unroll
            for (int n = 0; n < 2; ++n) gv[bj][n] = *(const f32x4*)(g + col0 + bj * HALF + n * 16);
#pragma unroll
        for (int ai = 0; ai < 2; ++ai)
#pragma unroll
            for (int m = 0; m < 4; ++m) {
                const int row = u.pm * BM + ai * HALF + wr * 64 + m * 16 + fr; const size_t off = (size_t)row * ldc + col0;
                const float rstd = 1.0f / sqrtf(__hip_atomic_load(ss + row, __ATOMIC_RELAXED, __HIP_MEMORY_SCOPE_AGENT) * inv_n + eps);
#pragma unroll
                for (int bj = 0; bj < 2; ++bj)
#pragma unroll
                    for (int n = 0; n < 2; ++n) *(f32x4*)(out + off + bj * HALF + n * 16) = acc[ai][bj][m][n] * rstd * gv[bj][n];
            }
    }
};
template <class Epi, class Sched, bool ALIGN_EPI = false, bool SP2 = false>
__device__ __forceinline__ void gemm_phase(PG8_LAS unsigned char* lds, const Gemm g, const Sched& S, const Epi& E, const int wave_in) {
    const int wid = wave_in, lane = mk_lane(), tid = wid * 64 + lane, wr = wid >> 2, wc = wid & 3, fr = lane & 15, fq = lane >> 4;
    const int K = g.K, nt = K / BK;
    unsigned voffA[2], voffB[2];
#pragma unroll
    for (int i = 0; i < 2; ++i) { int R, C; stage_rc(tid * 16 + i * 8192, R, C); const int Rb = Epi::PERM ? ((R & ~31) + perm32(R & 31)) : R;
        voffA[i] = (unsigned)(R * K + C) * 2u; voffB[i] = (unsigned)(Rb * K + C) * 2u; }
    const size_t kstep = (size_t)(BK * 2);
    const size_t hstep = (size_t)HALF * K * 2;
    const size_t tstep = 2 * hstep;
    const unsigned ldsw = (unsigned)wid * 1024u;
    const int aoff = lds_byte(wr * 64 + fr, fq * 8), boff = lds_byte(wc * 32 + fr, fq * 8);
#define PG8_SA(b, h) (((b) * 2 + (h)) * HTB)
#define PG8_SB(b, h) ((4 + (b) * 2 + (h)) * HTB)
#define PG8_STAGE(bufoff, gbase, voff) do { _Pragma("unroll") for (int _i = 0; _i < 2; ++_i) \
        __builtin_amdgcn_global_load_lds((const unsigned*)((const char*)(gbase) + (voff)[_i]), (PG8_LAS unsigned*)(lds + (bufoff) + ldsw + _i * 8192), 16, 0, 0); } while (0)
#define PG8_LDA(dst, b, h) do { _Pragma("unroll") for (int m = 0; m < 4; ++m) _Pragma("unroll") for (int k = 0; k < 2; ++k) dst[m][k] = *(const PG8_LAS bf16x8*)(lds + PG8_SA(b, h) + aoff + m * 2048 + k * 1024); } while (0)
#define PG8_LDB(dst, b, h) do { _Pragma("unroll") for (int n = 0; n < 2; ++n) _Pragma("unroll") for (int k = 0; k < 2; ++k) dst[n][k] = *(const PG8_LAS bf16x8*)(lds + PG8_SB(b, h) + boff + n * 2048 + k * 1024); } while (0)
#define PG8_MMA(ai, bj, At, Bt) do { __builtin_amdgcn_s_setprio(1); _Pragma("unroll") for (int m = 0; m < 4; ++m) _Pragma("unroll") for (int n = 0; n < 2; ++n) _Pragma("unroll") for (int k = 0; k < 2; ++k) \
        acc[ai][bj][m][n] = __builtin_amdgcn_mfma_f32_16x16x32_bf16(Bt[n][k], At[m][k], acc[ai][bj][m][n], 0, 0, 0); __builtin_amdgcn_s_setprio(0); } while (0)
#define PG8_WAIT_V(n) asm volatile("s_waitcnt vmcnt(" #n ")" ::: "memory")
#define PG8_WAIT_L(n) asm volatile("s_waitcnt lgkmcnt(" #n ")" ::: "memory")
#define PG8_BAR __builtin_amdgcn_s_barrier()
#define PG8_SCHED __builtin_amdgcn_sched_barrier(0)
    Unit cur, nxt; int ui = 0;
    if (!S.next(0, cur)) return;
    f32x4 acc[2][2][4][2];
#pragma unroll
    for (int a = 0; a < 2; ++a)
#pragma unroll
        for (int b = 0; b < 2; ++b)
#pragma unroll
            for (int m = 0; m < 4; ++m)
#pragma unroll
                for (int n = 0; n < 2; ++n) acc[a][b][m][n] = (f32x4){0.f, 0.f, 0.f, 0.f};
    bf16x8 At[4][2], B0[2][2], B1[2][2];
    const char* cA = (const char*)g.A + (size_t)cur.pm * tstep + cur.koff; const char* cB = (const char*)g.Bt + (size_t)cur.pn * tstep + cur.koff; int ntc = cur.nt ? cur.nt : nt;
    S.a_ready(cur);
    if constexpr (SP2) {
        PG8_STAGE(PG8_SB(0, 0), cB, voffB); PG8_STAGE(PG8_SB(0, 1), cB + hstep, voffB); PG8_STAGE(PG8_SA(0, 0), cA, voffA); PG8_STAGE(PG8_SA(0, 1), cA + hstep, voffA);
        if (wr == 1) PG8_BAR;
        PG8_WAIT_V(2); PG8_BAR;
        PG8_STAGE(PG8_SB(1, 0), cB + kstep, voffB); PG8_STAGE(PG8_SA(1, 0), cA + kstep, voffA); PG8_STAGE(PG8_SB(1, 1), cB + hstep + kstep, voffB);
        PG8_WAIT_V(6); PG8_BAR;
    } else {
        PG8_STAGE(PG8_SB(0, 0), cB, voffB); PG8_STAGE(PG8_SA(0, 0), cA, voffA); PG8_STAGE(PG8_SB(0, 1), cB + hstep, voffB); PG8_STAGE(PG8_SA(0, 1), cA + hstep, voffA);
        if (wr == 1) PG8_BAR;
        PG8_WAIT_V(4); PG8_BAR;
        PG8_STAGE(PG8_SB(1, 0), cB + kstep, voffB); PG8_STAGE(PG8_SA(1, 0), cA + kstep, voffA); PG8_STAGE(PG8_SB(1, 1), cB + hstep + kstep, voffB);
        PG8_WAIT_V(6); PG8_BAR;
    }
    for (;;) {
        const bool has_next = S.next(ui + 1, nxt);
        const char* nA = has_next ? (const char*)g.A + (size_t)nxt.pm * tstep + nxt.koff : cA; const char* nB = has_next ? (const char*)g.Bt + (size_t)nxt.pn * tstep + nxt.koff : cB;
        for (int t = 0; t < ntc; t += 2) {
            const bool last = (t == ntc - 2);
            const char* a1 = cA + (size_t)(t + 1) * kstep;
            const char* a2 = last ? nA : cA + (size_t)(t + 2) * kstep; const char* b2 = last ? nB : cB + (size_t)(t + 2) * kstep;
            const char* a3 = a2 + kstep; const char* b3 = b2 + kstep;
            if (last && has_next) S.a_ready(nxt);
            if constexpr (SP2) {
            PG8_LDB(B0, 0, 0); PG8_LDB(B1, 0, 1); PG8_SCHED; PG8_LDA(At, 0, 0); PG8_STAGE(PG8_SA(1, 1), a1 + hstep, voffA);
            PG8_WAIT_V(8); PG8_WAIT_L(0); PG8_BAR; PG8_MMA(0, 0, At, B0); PG8_MMA(0, 1, At, B1); PG8_BAR; PG8_SCHED;
            PG8_LDA(At, 0, 1); PG8_STAGE(PG8_SB(0, 0), b2, voffB); PG8_STAGE(PG8_SB(0, 1), b2 + hstep, voffB); PG8_STAGE(PG8_SA(0, 0), a2, voffA);
            PG8_WAIT_V(8); PG8_WAIT_L(0); PG8_BAR; PG8_MMA(1, 0, At, B0); PG8_MMA(1, 1, At, B1); PG8_BAR; PG8_SCHED;
            PG8_LDB(B0, 1, 0); PG8_LDB(B1, 1, 1); PG8_SCHED; PG8_LDA(At, 1, 0); PG8_STAGE(PG8_SA(0, 1), a2 + hstep, voffA);
            PG8_WAIT_V(8); PG8_WAIT_L(0); PG8_BAR; PG8_MMA(0, 0, At, B0); PG8_MMA(0, 1, At, B1); PG8_BAR; PG8_SCHED;
            PG8_LDA(At, 1, 1); PG8_STAGE(PG8_SB(1, 0), b3, voffB); PG8_STAGE(PG8_SB(1, 1), b3 + hstep, voffB); PG8_STAGE(PG8_SA(1, 0), a3, voffA);
            PG8_WAIT_V(8); PG8_WAIT_L(0); PG8_BAR; PG8_MMA(1, 0, At, B0); PG8_MMA(1, 1, At, B1); PG8_BAR; PG8_SCHED;
            } else {
            PG8_LDB(B0, 0, 0); PG8_SCHED; PG8_LDA(At, 0, 0); PG8_STAGE(PG8_SA(1, 1), a1 + hstep, voffA);
            PG8_WAIT_L(8); PG8_BAR; PG8_WAIT_L(0); PG8_MMA(0, 0, At, B0); PG8_BAR; PG8_SCHED;
            PG8_LDB(B1, 0, 1); PG8_STAGE(PG8_SB(0, 0), b2, voffB);
            PG8_BAR; PG8_WAIT_L(0); PG8_MMA(0, 1, At, B1); PG8_BAR;
            PG8_LDA(At, 0, 1); PG8_STAGE(PG8_SA(0, 0), a2, voffA);
            PG8_BAR; PG8_WAIT_L(0); PG8_MMA(1, 0, At, B0); PG8_BAR; PG8_SCHED;
            PG8_STAGE(PG8_SB(0, 1), b2 + hstep, voffB);
            PG8_WAIT_V(6); PG8_BAR; PG8_MMA(1, 1, At, B1); PG8_BAR;
            PG8_LDB(B0, 1, 0); PG8_SCHED; PG8_LDA(At, 1, 0); PG8_STAGE(PG8_SA(0, 1), a2 + hstep, voffA);
            PG8_WAIT_L(8); PG8_BAR; PG8_WAIT_L(0); PG8_MMA(0, 0, At, B0); PG8_BAR; PG8_SCHED;
            PG8_LDB(B1, 1, 1); PG8_STAGE(PG8_SB(1, 0), b3, voffB);
            PG8_BAR; PG8_WAIT_L(0); PG8_MMA(0, 1, At, B1); PG8_BAR;
            PG8_LDA(At, 1, 1); PG8_STAGE(PG8_SA(1, 0), a3, voffA);
            PG8_BAR; PG8_WAIT_L(0); PG8_MMA(1, 0, At, B0); PG8_BAR; PG8_SCHED;
            PG8_STAGE(PG8_SB(1, 1), b3 + hstep, voffB);
            PG8_WAIT_V(6); PG8_BAR; PG8_MMA(1, 1, At, B1); PG8_BAR;
            }
        }
        if constexpr (ALIGN_EPI) { if (wr == 0) PG8_BAR; }
        if constexpr (!Epi::AFTER_DRAIN) { E(acc, cur, wr, wc, fr, fq); S.done(cur); }
        if (!has_next) break;
#pragma unroll
        for (int a = 0; a < 2; ++a)
#pragma unroll
            for (int b = 0; b < 2; ++b)
#pragma unroll
                for (int m = 0; m < 4; ++m)
#pragma unroll
                    for (int n = 0; n < 2; ++n) acc[a][b][m][n] = (f32x4){0.f, 0.f, 0.f, 0.f};
        cur = nxt; cA = nA; cB = nB; ++ui; ntc = cur.nt ? cur.nt : nt;
        if constexpr (ALIGN_EPI) { if (wr == 1) PG8_BAR; }
    }
    PG8_WAIT_V(0);
    if constexpr (!ALIGN_EPI) { if (wr == 0) PG8_BAR; }
    PG8_BAR;
    if constexpr (Epi::AFTER_DRAIN) { E.fused(acc, cur, wr, wc, fr, fq, lds, wid, lane); S.done(cur); }
#undef PG8_SA
#undef PG8_SB
#undef PG8_STAGE
#undef PG8_LDA
#undef PG8_LDB
#undef PG8_MMA
#undef PG8_WAIT_V
#undef PG8_WAIT_L
#undef PG8_BAR
#undef PG8_SCHED
}
}
namespace att {
using bf16 = __hip_bfloat16;
using bf16x8 = __attribute__((ext_vector_type(8))) short;
using s16x4  = __attribute__((ext_vector_type(4))) short;
using f32x16 = __attribute__((ext_vector_type(16))) float;
using u32x4  = __attribute__((ext_vector_type(4))) unsigned;
constexpr int D = 128, NW = 8, QBLK = 32, KVBLK = 64;
constexpr int LDR = 6144;
constexpr size_t SHM_V = KVBLK * D * 2, SHM_K = KVBLK * D * 2, SHM_ATTN = 2 * SHM_V + 2 * SHM_K + NW * 64 * 4;
#define KSWZ(row, colB) ((row) * 256 + ((colB) ^ (((row) & 7) << 4)))
#define SBAR() __builtin_amdgcn_sched_barrier(0)
__device__ __forceinline__ int crow(int r, int hi) { return (r & 3) + 8 * (r >> 2) + 4 * hi; }
__device__ __forceinline__ unsigned cvtpk(float lo, float hi) { unsigned r; asm volatile("v_cvt_pk_bf16_f32 %0, %1, %2" : "=v"(r) : "v"(lo), "v"(hi)); return r; }
__device__ __forceinline__ unsigned short f2bf1(float x) { return (unsigned short)(cvtpk(x, x) & 0xffffu); }
#define PK4(P, BASE, OUT) do { unsigned a0 = cvtpk(P[BASE + 0], P[BASE + 1]), a1 = cvtpk(P[BASE + 2], P[BASE + 3]);   \
    unsigned b0 = cvtpk(P[BASE + 4], P[BASE + 5]), b1 = cvtpk(P[BASE + 6], P[BASE + 7]);                              \
    auto r0 = __builtin_amdgcn_permlane32_swap(a0, b0, false, false); auto r1 = __builtin_amdgcn_permlane32_swap(a1, b1, false, false); \
    u32x4 w = {r0[0], r1[0], r0[1], r1[1]}; OUT = *reinterpret_cast<bf16x8*>(&w); } while (0)

template <int SCALE_E6>
struct SM {
    static constexpr float SCALE = SCALE_E6 == 125000 ? 0.125f : 0.088388347648318440f;
    static constexpr float THR = 8.f;
    static __device__ __forceinline__ void partialSM(f32x16& p0, f32x16& p1, float& m_reg, float& mn, float& alpha) {
        constexpr float C = SCALE * 1.4426950408889634f;
        float pmax = p0[0];
#pragma unroll
        for (int r = 1; r < 16; ++r) pmax = fmaxf(pmax, p0[r]);
#pragma unroll
        for (int r = 0; r < 16; ++r) pmax = fmaxf(pmax, p1[r]);
        { auto rr = __builtin_amdgcn_permlane32_swap(__float_as_uint(pmax), __float_as_uint(pmax), false, false);
          pmax = fmaxf(__uint_as_float(rr[0]), __uint_as_float(rr[1])); }
        if (__builtin_expect(__all(pmax - m_reg <= THR / SCALE), 1)) { mn = m_reg; alpha = 1.f; }
        else { mn = fmaxf(m_reg, pmax); alpha = __builtin_amdgcn_exp2f((m_reg - mn) * C); m_reg = mn; }
        float mnC = -mn * C;
#pragma unroll
        for (int r = 0; r < 16; ++r) p0[r] = fmaf(p0[r], C, mnC);
#pragma unroll
        for (int r = 0; r < 16; ++r) p1[r] = fmaf(p1[r], C, mnC);
#pragma unroll
        for (int r = 0; r < 16; ++r) p0[r] = __builtin_amdgcn_exp2f(p0[r]);
    }
};
__device__ __forceinline__ void finishSM(f32x16& p0, f32x16& p1, float alpha, float& l_reg, bf16x8& pa0, bf16x8& pa1, bf16x8& pa2, bf16x8& pa3) {
#pragma unroll
    for (int r = 0; r < 16; ++r) p1[r] = __builtin_amdgcn_exp2f(p1[r]);
    float ps = 0;
#pragma unroll
    for (int r = 0; r < 16; ++r) ps += p0[r];
#pragma unroll
    for (int r = 0; r < 16; ++r) ps += p1[r];
    { auto rr = __builtin_amdgcn_permlane32_swap(__float_as_uint(ps), __float_as_uint(ps), false, false);
      ps = __uint_as_float(rr[0]) + __uint_as_float(rr[1]); }
    l_reg = l_reg * alpha + ps;
    PK4(p0, 0, pa0); PK4(p0, 8, pa1); PK4(p1, 0, pa2); PK4(p1, 8, pa3);
}
template <int ND0>
__device__ __forceinline__ void qkt(f32x16& p0, f32x16& p1, const bf16* Ks, const bf16x8* qr, int dbase, int r32, int hi) {
    p0 = f32x16{}; p1 = f32x16{};
#pragma unroll
    for (int d0 = 0; d0 < ND0; ++d0) { int cb = ((dbase + d0) * 16 + hi * 8) * 2;
        bf16x8 b0 = *reinterpret_cast<const bf16x8*>((const char*)Ks + KSWZ(r32, cb));
        bf16x8 b1 = *reinterpret_cast<const bf16x8*>((const char*)Ks + KSWZ(32 + r32, cb));
        p0 = __builtin_amdgcn_mfma_f32_32x32x16_bf16(b0, qr[d0], p0, 0, 0, 0);
        p1 = __builtin_amdgcn_mfma_f32_32x32x16_bf16(b1, qr[d0], p1, 0, 0, 0); }
}
__device__ __forceinline__ int v_st(int k, int c) { const int kk = (k & ~0xC) | ((k & 4) << 1) | ((k & 8) >> 1); return ((kk >> 3) * 4 + (c >> 5)) * 512 + ((kk & 7) * 32 + (c & 31)) * 2; }
__device__ __forceinline__ int v_rd_base(int lane) { return ((lane & 3) << 3) | (((lane >> 2) & 3) << 6) | (((lane >> 4) & 1) << 5) | (((lane >> 5) & 1) << 8); }
constexpr int v_rd_off(int d0, int ks, int half) { return d0 * 512 + ks * 4096 + half * 2048; }
template <int OFF> __device__ __forceinline__ s16x4 tr_read(int vb) {
    s16x4 r; asm volatile("ds_read_b64_tr_b16 %0, %1 offset:%2" : "=&v"(r) : "v"(vb), "i"(OFF) : "memory"); return r;
}
#define PKV(L, H) (bf16x8){L[0], L[1], L[2], L[3], H[0], H[1], H[2], H[3]}
template <int D0> __device__ __forceinline__ void pv_one(f32x16& od, int vb, bf16x8 pa0, bf16x8 pa1, bf16x8 pa2, bf16x8 pa3) {
    const s16x4 l0 = tr_read<v_rd_off(D0, 0, 0)>(vb), h0 = tr_read<v_rd_off(D0, 0, 1)>(vb), l1 = tr_read<v_rd_off(D0, 1, 0)>(vb), h1 = tr_read<v_rd_off(D0, 1, 1)>(vb);
    const s16x4 l2 = tr_read<v_rd_off(D0, 2, 0)>(vb), h2 = tr_read<v_rd_off(D0, 2, 1)>(vb), l3 = tr_read<v_rd_off(D0, 3, 0)>(vb), h3 = tr_read<v_rd_off(D0, 3, 1)>(vb);
    asm volatile("s_waitcnt lgkmcnt(0)" ::: "memory"); SBAR();
    od = __builtin_amdgcn_mfma_f32_32x32x16_bf16(pa0, PKV(l0, h0), od, 0, 0, 0);
    od = __builtin_amdgcn_mfma_f32_32x32x16_bf16(pa1, PKV(l1, h1), od, 0, 0, 0);
    od = __builtin_amdgcn_mfma_f32_32x32x16_bf16(pa2, PKV(l2, h2), od, 0, 0, 0);
    od = __builtin_amdgcn_mfma_f32_32x32x16_bf16(pa3, PKV(l3, h3), od, 0, 0, 0);
}
__device__ __forceinline__ void pv_d0(f32x16* o, int vb, bf16x8 pa0, bf16x8 pa1, bf16x8 pa2, bf16x8 pa3) {
    pv_one<0>(o[0], vb, pa0, pa1, pa2, pa3); pv_one<1>(o[1], vb, pa0, pa1, pa2, pa3); pv_one<2>(o[2], vb, pa0, pa1, pa2, pa3); pv_one<3>(o[3], vb, pa0, pa1, pa2, pa3);
}
template <int D0> __device__ __forceinline__ void pv_one32(f32x16& od, int vb, bf16x8 pa0, bf16x8 pa1) {
    const s16x4 l0 = tr_read<v_rd_off(D0, 0, 0)>(vb), h0 = tr_read<v_rd_off(D0, 0, 1)>(vb), l1 = tr_read<v_rd_off(D0, 1, 0)>(vb), h1 = tr_read<v_rd_off(D0, 1, 1)>(vb);
    asm volatile("s_waitcnt lgkmcnt(0)" ::: "memory"); SBAR();
    od = __builtin_amdgcn_mfma_f32_32x32x16_bf16(pa0, PKV(l0, h0), od, 0, 0, 0);
    od = __builtin_amdgcn_mfma_f32_32x32x16_bf16(pa1, PKV(l1, h1), od, 0, 0, 0);
}

typedef float f32x4c __attribute__((ext_vector_type(4)));
struct ConvJob {
    const float *w_gate, *w_up, *w_down, *w_out, *g_ffn; unsigned short *WGU, *WDN, *WOUT;
    int next, end, stride;
};
struct ConvItem { const float* W; unsigned short* dst; int N, K, k0, n0, drow; };
constexpr int CV_GU = 32 * 88, CV_OUT = 32 * 32, CV_TOTAL = 2 * CV_GU + CV_OUT;
__device__ __forceinline__ ConvItem conv_item(const float* Jw_gate, const float* Jw_up, const float* Jw_down, const float* Jw_out, unsigned short* JWGU, unsigned short* JWDN, unsigned short* JWOUT, int q) {
    ConvItem it;
    const bool gu = q < 2 * CV_GU; const int up = (q >= CV_GU) ? 1 : 0;
    const int rg = q - up * CV_GU, kbg = rg / 88, nbg = rg - kbg * 88;
    const int rd = gu ? 0 : q - 2 * CV_GU, kbd = rd >> 5, nbd = rd & 31;
    it.W = gu ? (up ? Jw_up : Jw_gate) : Jw_out;
    it.dst = gu ? JWGU : JWOUT;
    it.N = gu ? 5632 : 2048; it.K = 2048;
    it.k0 = 64 * (gu ? kbg : kbd); it.n0 = 64 * (gu ? nbg : nbd);
    it.drow = gu ? 256 * (it.n0 >> 7) + 128 * up + (it.n0 & 127) : it.n0;
    return it;
}
__device__ __forceinline__ void attn_dense_body(const bf16* __restrict__ Qb, const bf16* __restrict__ Kh, const bf16* __restrict__ Vh,
                                                unsigned short* __restrict__ Ob, int ldo, int dbase, int seq, char* lds, const int wave_in, ConvJob& cj,
                                                const bool second, unsigned short* __restrict__ Yb, const float lam, const float* __restrict__ subln) {
    using S8 = SM<125000>;
    const int wid = wave_in, lane = mk_lane(), tid = wid * 64 + lane, r32 = lane & 31, hi = lane >> 5;
    bf16* V_lds = (bf16*)lds; bf16* K_lds = (bf16*)(lds + 2 * SHM_V);
    float* ws = (float*)(lds + 2 * SHM_V + 2 * SHM_K) + wid * 64; float* li_l = ws; float* al_l = ws + 32;
    float m_reg = -1e30f, l_reg = 0; f32x16 o[4] = {}; bf16x8 qr[4];
    const bf16* Qw = Qb + (long)(wid * QBLK + r32) * LDR + dbase * 16 + hi * 8;
#pragma unroll
    for (int d0 = 0; d0 < 4; ++d0) qr[d0] = *reinterpret_cast<const bf16x8*>(Qw + d0 * 16);
    const int sr = tid >> 4, sc = (tid & 15) * 8, vst0 = v_st(sr, sc), vst1 = v_st(32 + sr, sc);
    const int vb0 = (int)(uintptr_t)V_lds + v_rd_base(lane);
    struct { bf16x8 vs0, vs1, ks0; } sr_[2];
    const int krow = tid >> 3, kcol = dbase * 16 + (tid & 7) * 8, kst0 = KSWZ(krow, kcol * 2);
#define SLOAD(i, k0) do { sr_[i].vs0 = *reinterpret_cast<const bf16x8*>(&Vh[(long)((k0) + sr) * LDR + sc]); sr_[i].vs1 = *reinterpret_cast<const bf16x8*>(&Vh[(long)((k0) + 32 + sr) * LDR + sc]); \
    sr_[i].ks0 = *reinterpret_cast<const bf16x8*>(&Kh[(long)((k0) + krow) * LDR + kcol]); } while (0)
#define SWRITE(b, i) do { *(bf16x8*)((char*)V_lds + (b) * SHM_V + vst0) = sr_[i].vs0;          \
    *(bf16x8*)((char*)V_lds + (b) * SHM_V + vst1) = sr_[i].vs1;                              \
    *(bf16x8*)((char*)K_lds + (b) * SHM_K + kst0) = sr_[i].ks0; } while (0)
#define SWAIT() do {} while (0)
#define RESC(a) do { if (__any((a) < 1.f)) { if (hi == 0) al_l[r32] = (a); asm volatile("s_waitcnt lgkmcnt(0)" ::: "memory"); \
    _Pragma("unroll") for (int d = 0; d < 4; ++d) _Pragma("unroll") for (int r = 0; r < 16; ++r) o[d][r] *= al_l[crow(r, hi)]; } } while (0)
    f32x16 pA0, pA1, pB0, pB1; float mnA, mnB, alA, alB; bf16x8 pa0, pa1, pa2, pa3; const int NT = seq / KVBLK;
    const float* const jwg = cj.w_gate; const float* const jwu = cj.w_up; const float* const jwd = cj.w_down; const float* const jwo = cj.w_out;
    unsigned short* const jGU = cj.WGU; unsigned short* const jDN = cj.WDN; unsigned short* const jOUT = cj.WOUT; const int jnext = cj.next, jend = cj.end, jstride = cj.stride;
    float* cscr = (float*)(lds + SHM_ATTN); f32x4c cv0, cv1; int slot = 0;
#define CV_Q(k) (min(jnext + (k) * jstride, jend))
#define CV_LOAD(q) do { const ConvItem it_ = conv_item(jwg, jwu, jwd, jwo, jGU, jDN, jOUT, (q)); const float* s_ = it_.W + (size_t)(it_.k0 + (tid >> 3)) * it_.N + it_.n0 + 8 * (tid & 7); \
    cv0 = *(const f32x4c*)s_; cv1 = *(const f32x4c*)(s_ + 4); } while (0)
#define CV_WRITE() do { f32x4c* d_ = (f32x4c*)(cscr + (tid >> 3) * 64 + 8 * ((tid & 7) ^ ((tid >> 6) & 7))); d_[0] = cv0; d_[1] = cv1; } while (0)
#define CV_STORE(q) do { const ConvItem it_ = conv_item(jwg, jwu, jwd, jwo, jGU, jDN, jOUT, (q)); const int n_ = tid >> 3, c_ = tid & 7; const float* s_ = cscr + (8 * c_) * 64 + (n_ ^ (8 * c_)); \
    u32x4 o_; o_.x = cvtpk(s_[0], s_[64]); o_.y = cvtpk(s_[128], s_[192]); o_.z = cvtpk(s_[256], s_[320]); o_.w = cvtpk(s_[384], s_[448]); \
    *(u32x4*)(it_.dst + (size_t)(it_.drow + n_) * it_.K + it_.k0 + 8 * c_) = o_; } while (0)
#define CV_CONSUME() do { CV_WRITE(); const int qn_ = CV_Q(slot + 1); CV_LOAD(qn_); } while (0)
#define CV_FINISH() do { const int qc_ = CV_Q(slot); CV_STORE(qc_); ++slot; } while (0)
    const int owed = (jnext > jend) ? 0 : (jend - jnext) / jstride + 1;
    const int ctrips = min((owed + 1) >> 1, (NT - 2) >> 1);
    if (ctrips > 0) { const int q0_ = CV_Q(0); CV_LOAD(q0_); }
    constexpr int SE = 0, SO = 1;
    SLOAD(SE, 0); asm volatile("s_waitcnt vmcnt(0)" ::: "memory"); SWRITE(0, SE); __syncthreads();
    qkt<4>(pA0, pA1, K_lds, qr, dbase, r32, hi); S8::partialSM(pA0, pA1, m_reg, mnA, alA);
    SLOAD(SO, KVBLK); if (2 < NT) SLOAD(SE, 2 * KVBLK);
    SWAIT(); SWRITE(1, SO); __syncthreads();
#define B_TRIP(CONV) do { \
        SBAR(); qkt<4>(pB0, pB1, (bf16*)((char*)K_lds + SHM_K), qr, dbase, r32, hi); \
        finishSM(pA0, pA1, alA, l_reg, pa0, pa1, pa2, pa3); SBAR(); \
        SLOAD(SO, (j + 2) * KVBLK); SBAR(); \
        pv_d0(o, vb0, pa0, pa1, pa2, pa3); S8::partialSM(pB0, pB1, m_reg, mnB, alB); \
        __syncthreads(); SWAIT(); SWRITE(0, SE); \
        if (CONV) CV_CONSUME(); \
        RESC(alB); __syncthreads(); \
        if (CONV) CV_FINISH(); \
        SBAR(); qkt<4>(pA0, pA1, K_lds, qr, dbase, r32, hi); \
        finishSM(pB0, pB1, alB, l_reg, pa0, pa1, pa2, pa3); SBAR(); \
        SLOAD(SE, min(j + 3, NT - 1) * KVBLK); SBAR();     \
        pv_d0(o, vb0 + (int)SHM_V, pa0, pa1, pa2, pa3); S8::partialSM(pA0, pA1, m_reg, mnA, alA); \
        __syncthreads(); SWAIT(); SWRITE(1, SO); \
        if (CONV) CV_CONSUME(); \
        RESC(alA); __syncthreads(); \
        if (CONV) CV_FINISH(); } while (0)
    int j = 1;
    for (int tr = 0; tr < ctrips; ++tr, j += 2) B_TRIP(true);
    for (; j + 1 < NT; j += 2) B_TRIP(false);
#undef B_TRIP
    cj.next = min(jnext + slot * jstride, jend + jstride);
    SBAR(); qkt<4>(pB0, pB1, (bf16*)((char*)K_lds + SHM_K), qr, dbase, r32, hi);
    finishSM(pA0, pA1, alA, l_reg, pa0, pa1, pa2, pa3); SBAR();
    pv_d0(o, vb0, pa0, pa1, pa2, pa3); S8::partialSM(pB0, pB1, m_reg, mnB, alB);
    __syncthreads(); RESC(alB);
    finishSM(pB0, pB1, alB, l_reg, pa0, pa1, pa2, pa3); SBAR();
    pv_d0(o, vb0 + (int)SHM_V, pa0, pa1, pa2, pa3);
    if (hi == 0) li_l[r32] = l_reg; asm volatile("s_waitcnt lgkmcnt(0)" ::: "memory");
    float rli[16];
#pragma unroll
    for (int r = 0; r < 16; ++r) rli[r] = __builtin_amdgcn_rcpf(li_l[crow(r, hi)]);
    unsigned short* Ow = (unsigned short*)(lds + SHM_ATTN + 16384) + wid * 4096;
    if (!second) {
#pragma unroll
        for (int r = 0; r < 16; ++r) { int orow = crow(r, hi);
#pragma unroll
            for (int d0 = 0; d0 < 4; ++d0) Ow[orow * 128 + d0 * 32 + r32] = f2bf1(o[d0][r] * rli[r]); }
        asm volatile("s_waitcnt lgkmcnt(0)" ::: "memory");
    } else {
        float ssq[16];
#pragma unroll
        for (int r = 0; r < 16; ++r) { const int orow = crow(r, hi); ssq[r] = 0.f;
#pragma unroll
            for (int d0 = 0; d0 < 4; ++d0) { const float o0 = __uint_as_float((unsigned)Ow[orow * 128 + d0 * 32 + r32] << 16);
                const float d = o0 - lam * (o[d0][r] * rli[r]); o[d0][r] = d; ssq[r] += d * d; } }
#pragma unroll
        for (int r = 0; r < 16; ++r) { float v = ssq[r]; v += __shfl_xor(v, 1); v += __shfl_xor(v, 2); v += __shfl_xor(v, 4); v += __shfl_xor(v, 8); v += __shfl_xor(v, 16); ssq[r] = v; }
        float sl[4];
#pragma unroll
        for (int d0 = 0; d0 < 4; ++d0) sl[d0] = subln[d0 * 32 + r32] * 0.8f;
        unsigned short* Yw = Yb + (long)(wid * QBLK) * 2048;
#pragma unroll
        for (int r = 0; r < 16; ++r) { const int orow = crow(r, hi); const float rs = 1.0f / sqrtf(ssq[r] * (1.0f / 128.0f) + 1e-5f);
#pragma unroll
            for (int d0 = 0; d0 < 4; ++d0) Ow[orow * 128 + d0 * 32 + r32] = f2bf1(o[d0][r] * rs * sl[d0]); }
        asm volatile("s_waitcnt lgkmcnt(0)" ::: "memory");
#pragma unroll
        for (int i = 0; i < 8; ++i) { const int idx = i * 64 + lane, row = idx >> 4, ch = idx & 15;
            const u32x4 v = *(const u32x4*)(Ow + row * 128 + ch * 8);
            *(u32x4*)(Yw + (long)row * 2048 + ch * 8) = v; }
        asm volatile("s_waitcnt lgkmcnt(0)" ::: "memory");
    }
#undef CV_LOAD
#undef CV_Q
#undef CV_STORE
#undef CV_WRITE
#undef CV_CONSUME
#undef CV_FINISH
#undef SLOAD
#undef SWRITE
#undef SWAIT
#undef RESC
}

__device__ __forceinline__ void swa_wave_unit(const bf16* __restrict__ base, long rstride, int qc, int kc, int vc, int t0, int L,
                                              unsigned short* __restrict__ Ob, long ostride, float* __restrict__ Lb, long lstride, char* lds_w, float* scr) {
    constexpr float SCALE = 0.088388347648318440f, C = SCALE * 1.4426950408889634f;
    const int lane = mk_lane(), r32 = lane & 31, hi = lane >> 5;
    bf16* K_lds = (bf16*)lds_w; char* V_lds = lds_w + 8192;
    bf16x8 qr[8];
    { const bf16* Qw = base + (long)(t0 + r32) * rstride + qc + hi * 8;
#pragma unroll
      for (int d0 = 0; d0 < 8; ++d0) qr[d0] = *reinterpret_cast<const bf16x8*>(Qw + d0 * 16); }
    const int srow = lane >> 4, scol = (lane & 15) * 8;
    const bf16* kbase = base + (long)srow * rstride + kc + scol; const bf16* vbase = base + (long)srow * rstride + vc + scol;
    bf16x8 st[2][8];
#define TILE_K0(i) (t0 - 64 + 32 * (i))
#define TILE_OK(i) (TILE_K0(i) >= 0 && TILE_K0(i) < L)
#define TILE_KC(i) (min(max(TILE_K0(i), 0), L - 32))
#define LD_TILE(buf, pbase, i) do { const bf16* p_ = (pbase) + (long)TILE_KC(i) * rstride; _Pragma("unroll") for (int j = 0; j < 8; ++j) st[buf][j] = *reinterpret_cast<const bf16x8*>(p_ + (long)(4 * j) * rstride); } while (0)
    f32x16 s[5];
    LD_TILE(0, kbase, 0);
#pragma unroll
    for (int i = 0; i < 5; ++i) {
        if (i < 4) LD_TILE((i + 1) & 1, kbase, i + 1); else LD_TILE((i + 1) & 1, vbase, 0);
#pragma unroll
        for (int j = 0; j < 8; ++j) *(bf16x8*)((char*)K_lds + KSWZ(4 * j + srow, scol * 2)) = st[i & 1][j];
        f32x16 p = f32x16{};
#pragma unroll
        for (int d0 = 0; d0 < 8; ++d0) { const int cb = (d0 * 16 + hi * 8) * 2;
            const bf16x8 b0 = *reinterpret_cast<const bf16x8*>((const char*)K_lds + KSWZ(r32, cb));
            p = __builtin_amdgcn_mfma_f32_32x32x16_bf16(b0, qr[d0], p, 0, 0, 0); }
        const bool ok = TILE_OK(i);
#pragma unroll
        for (int r = 0; r < 16; ++r) {
            bool keep = ok;
            if (i == 0) keep = keep && (crow(r, hi) >= r32);
            if (i == 4) keep = keep && (crow(r, hi) <= r32);
            s[i][r] = keep ? p[r] : -1e30f;
        }
    }
    float m = -1e30f;
#pragma unroll
    for (int i = 0; i < 5; ++i)
#pragma unroll
        for (int r = 0; r < 16; ++r) m = fmaxf(m, s[i][r]);
    { auto rr = __builtin_amdgcn_permlane32_swap(__float_as_uint(m), __float_as_uint(m), false, false);
      m = fmaxf(__uint_as_float(rr[0]), __uint_as_float(rr[1])); }
    const float mC = -m * C; float l = 0.f;
#pragma unroll
    for (int i = 0; i < 5; ++i)
#pragma unroll
        for (int r = 0; r < 16; ++r) { s[i][r] = __builtin_amdgcn_exp2f(fmaf(s[i][r], C, mC)); l += s[i][r]; }
    { auto rr = __builtin_amdgcn_permlane32_swap(__float_as_uint(l), __float_as_uint(l), false, false);
      l = __uint_as_float(rr[0]) + __uint_as_float(rr[1]); }
    bf16x8 pa[5][2];
#pragma unroll
    for (int i = 0; i < 5; ++i) { PK4(s[i], 0, pa[i][0]); PK4(s[i], 8, pa[i][1]); }
    f32x16 o[4] = {};
    const int vb = (int)(uintptr_t)V_lds + v_rd_base(lane);
#pragma unroll
    for (int i = 0; i < 5; ++i) {
        if (i < 4) LD_TILE(i & 1, vbase, i + 1);
#pragma unroll
        for (int j = 0; j < 8; ++j) *(bf16x8*)(V_lds + v_st(4 * j + srow, scol)) = st[(i + 1) & 1][j];
        asm volatile("s_waitcnt lgkmcnt(0)" ::: "memory");
        pv_one32<0>(o[0], vb, pa[i][0], pa[i][1]); pv_one32<1>(o[1], vb, pa[i][0], pa[i][1]); pv_one32<2>(o[2], vb, pa[i][0], pa[i][1]); pv_one32<3>(o[3], vb, pa[i][0], pa[i][1]);
    }
#undef TILE_K0
#undef TILE_OK
#undef TILE_KC
#undef LD_TILE
    if (hi == 0) { scr[r32] = l; Lb[(long)(t0 + r32) * lstride] = m * SCALE + __logf(l); }
    asm volatile("s_waitcnt lgkmcnt(0)" ::: "memory");
    float rli[16];
#pragma unroll
    for (int r = 0; r < 16; ++r) rli[r] = __builtin_amdgcn_rcpf(scr[crow(r, hi)]);
#pragma unroll
    for (int r = 0; r < 16; ++r) { const long orow = (long)(t0 + crow(r, hi)) * ostride;
#pragma unroll
        for (int d0 = 0; d0 < 4; ++d0) Ob[orow + d0 * 32 + r32] = f2bf1(o[d0][r] * rli[r]); }
    asm volatile("s_waitcnt lgkmcnt(0)" ::: "memory");
}
__device__ __forceinline__ void swa_wg_unit(const bf16* __restrict__ QKVb, int gbr, int sub0, int qt0, int sstep, unsigned short* __restrict__ OAg, float* __restrict__ LSEg, char* lds, float* scr, const int wid) {
    constexpr float SCALE = 0.088388347648318440f, C = SCALE * 1.4426950408889634f;
    const int lane = mk_lane(), tid = wid * 64 + lane, r32 = lane & 31, hi = lane >> 5;
    const int dsh = 2 * gbr, dil = 1 << dsh, L = 2048 >> dsh, nblk = L >> 5; const bool big = nblk >= 8;
    const long rstride = (long)dil * LDR;
#define SUB_BASE(sub) (QKVb + ((size_t)((sub) >> (3 + dsh)) * 2048 + (((sub) >> 3) & (dil - 1))) * LDR + ((sub) & 7) * 128)
    const int srow = tid >> 4, scol = (tid & 15) * 8;
    bf16x8 kst[12], vst[12];
#pragma unroll
    for (int sl = 0; sl < 12; ++sl) {
        const int sub_s = big ? sub0 : sub0 + ((sl >> 2) & 1) * sstep; const int kt_s = big ? min(max(qt0 - 2 + sl, 0), nblk - 1) : (sl & 3);
        const bf16* p_ = SUB_BASE(sub_s) + (long)(kt_s * 32 + srow) * rstride + scol;
        kst[sl] = *reinterpret_cast<const bf16x8*>(p_ + 1024);
    }
    const int sub_w = big ? sub0 : sub0 + (wid >> 2) * sstep; const int qt = big ? qt0 + wid : (wid & 3); const int t0 = qt * 32;
    const bf16* base_w = SUB_BASE(sub_w);
    bf16x8 qr[8];
    { const bf16* Qw = base_w + (long)(t0 + r32) * rstride + hi * 8;
#pragma unroll
      for (int d0 = 0; d0 < 8; ++d0) qr[d0] = *reinterpret_cast<const bf16x8*>(Qw + d0 * 16); }
#pragma unroll
    for (int sl = 0; sl < 12; ++sl) *(bf16x8*)(lds + sl * 8192 + KSWZ(srow, scol * 2)) = kst[sl];
#pragma unroll
    for (int sl = 0; sl < 12; ++sl) {
        const int sub_s = big ? sub0 : sub0 + ((sl >> 2) & 1) * sstep; const int kt_s = big ? min(max(qt0 - 2 + sl, 0), nblk - 1) : (sl & 3);
        const bf16* p_ = SUB_BASE(sub_s) + (long)(kt_s * 32 + srow) * rstride + scol;
        vst[sl] = *reinterpret_cast<const bf16x8*>(p_ + 2048);
    }
    __syncthreads();
    f32x16 s[5];
#pragma unroll
    for (int i = 0; i < 5; ++i) {
        const int kt = qt - 2 + i; const bool ok = kt >= 0 && kt < nblk;
        const int slot = big ? wid + i : 4 * (wid >> 2) + min(max(kt, 0), 3);
        const char* Ks = lds + slot * 8192;
        f32x16 p = f32x16{};
#pragma unroll
        for (int d0 = 0; d0 < 8; ++d0) { const int cb = (d0 * 16 + hi * 8) * 2;
            const bf16x8 b0 = *reinterpret_cast<const bf16x8*>(Ks + KSWZ(r32, cb));
            p = __builtin_amdgcn_mfma_f32_32x32x16_bf16(b0, qr[d0], p, 0, 0, 0); }
#pragma unroll
        for (int r = 0; r < 16; ++r) {
            bool keep = ok;
            if (i == 0) keep = keep && (crow(r, hi) >= r32);
            if (i == 4) keep = keep && (crow(r, hi) <= r32);
            s[i][r] = keep ? p[r] : -1e30f;
        }
    }
    float m = -1e30f;
#pragma unroll
    for (int i = 0; i < 5; ++i)
#pragma unroll
        for (int r = 0; r < 16; ++r) m = fmaxf(m, s[i][r]);
    { auto rr = __builtin_amdgcn_permlane32_swap(__float_as_uint(m), __float_as_uint(m), false, false);
      m = fmaxf(__uint_as_float(rr[0]), __uint_as_float(rr[1])); }
    const float mC = -m * C; float l = 0.f;
#pragma unroll
    for (int i = 0; i < 5; ++i)
#pragma unroll
        for (int r = 0; r < 16; ++r) { s[i][r] = __builtin_amdgcn_exp2f(fmaf(s[i][r], C, mC)); l += s[i][r]; }
    { auto rr = __builtin_amdgcn_permlane32_swap(__float_as_uint(l), __float_as_uint(l), false, false);
      l = __uint_as_float(rr[0]) + __uint_as_float(rr[1]); }
    bf16x8 pa[5][2];
#pragma unroll
    for (int i = 0; i < 5; ++i) { PK4(s[i], 0, pa[i][0]); PK4(s[i], 8, pa[i][1]); }
    __syncthreads();
#pragma unroll
    for (int sl = 0; sl < 12; ++sl) *(bf16x8*)(lds + sl * 8192 + v_st(srow, scol)) = vst[sl];
    __syncthreads();
    f32x16 o[4] = {};
#pragma unroll
    for (int i = 0; i < 5; ++i) {
        const int kt = qt - 2 + i;
        const int slot = big ? wid + i : 4 * (wid >> 2) + min(max(kt, 0), 3);
        const int vb = (int)(uintptr_t)(lds + slot * 8192) + v_rd_base(lane);
        pv_one32<0>(o[0], vb, pa[i][0], pa[i][1]); pv_one32<1>(o[1], vb, pa[i][0], pa[i][1]); pv_one32<2>(o[2], vb, pa[i][0], pa[i][1]); pv_one32<3>(o[3], vb, pa[i][0], pa[i][1]);
    }
    const size_t tok0 = ((size_t)(sub_w >> (3 + dsh)) * 2048 + ((sub_w >> 3) & (dil - 1))); const int hh = sub_w & 7;
    if (hi == 0) { scr[r32] = l; LSEg[(tok0 + (size_t)(t0 + r32) * dil) * 8 + hh] = m * SCALE + __logf(l); }
    asm volatile("s_waitcnt lgkmcnt(0)" ::: "memory");
    float rli[16];
#pragma unroll
    for (int r = 0; r < 16; ++r) rli[r] = __builtin_amdgcn_rcpf(scr[crow(r, hi)]);
    { unsigned short* stg = (unsigned short*)(lds + 98304) + wid * 2048;
#pragma unroll
      for (int ps = 0; ps < 2; ++ps) {
#pragma unroll
        for (int r = 8 * ps; r < 8 * ps + 8; ++r) { const int sr_ = crow(r, hi) - 16 * ps;
#pragma unroll
            for (int d0 = 0; d0 < 4; ++d0) stg[sr_ * 128 + d0 * 32 + r32] = f2bf1(o[d0][r] * rli[r]); }
        asm volatile("s_waitcnt lgkmcnt(0)" ::: "memory");
#pragma unroll
        for (int i = 0; i < 4; ++i) { const int idx = i * 64 + lane, row = idx >> 4, ch = idx & 15;
            const u32x4 v = *(const u32x4*)(stg + row * 128 + ch * 8);
            *(u32x4*)(OAg + (tok0 + (size_t)(t0 + 16 * ps + row) * dil) * 1024 + hh * 128 + ch * 8) = v; }
        asm volatile("s_waitcnt lgkmcnt(0)" ::: "memory");
      } }
    asm volatile("s_waitcnt lgkmcnt(0)" ::: "memory");
    __syncthreads();
#undef SUB_BASE
}
#undef SBAR
}
#ifndef MK_DUP_PHASE
#define MK_DUP_PHASE -1
#endif
#define NREP(k) (1 + (MK_DUP_PHASE == (k) ? 1 : 0))
#ifndef WGM_P1
#define WGM_P1 4
#endif
#ifndef WGM_P4
#define WGM_P4 8
#endif
#ifndef WGM_P5
#define WGM_P5 2
#endif
#ifndef WGM_P6
#define WGM_P6 8
#endif
#ifndef MK_TIME_PHASE
#define MK_TIME_PHASE -1
#endif
#ifndef MK_ONE_LAUNCH
#define MK_ONE_LAUNCH 1
#endif
constexpr int NWAVES = 8;
constexpr int BATCH = 4, SEQ = 2048, DM = 2048, M = BATCH * SEQ, NIN = 6144, DFF = 5632, NGU = 2 * DFF, NHEAD = 8, HD = 128;
constexpr float RMS_EPS = 1e-6f, SUBLN_EPS = 1e-5f, LAM_INIT = 0.2f;
constexpr size_t MiB = 1u << 20;
constexpr size_t WS_SS1 = 0, WS_SS2 = 64 * 1024, WS_LSE = 1 * MiB;
constexpr size_t WS_QKV = 2 * MiB;
constexpr size_t WS_Y = 162 * MiB;
constexpr size_t WS_H = 34 * MiB;
constexpr size_t WS_WIN = 98 * MiB, WS_XN = 122 * MiB;
constexpr size_t WS_OA = 98 * MiB;
constexpr size_t WS_WOUT = 154 * MiB;
constexpr size_t WS_OB = 162 * MiB, WS_XG = 2 * MiB;
constexpr size_t WS_WGU = 194 * MiB, WS_WDN = 238 * MiB, WS_END = 260 * MiB;
static_assert(WS_H + (size_t)M * DFF * 2 <= WS_WOUT && WS_XG + (size_t)M * DM * 2 <= WS_H && WS_Y + (size_t)M * DM * 2 <= WS_WGU && WS_OA + (size_t)3 * M * 1024 * 2 <= WS_WOUT && WS_WDN + (size_t)DM * DFF * 2 <= WS_END && WS_WGU + (size_t)NGU * DM * 2 <= WS_WDN && WS_QKV + (size_t)M * NIN * 2 <= WS_WIN, "d_ws map");
constexpr int RING_BYTES = 131072, LDS_BYTES = 163840, MISC_OFF = 163584;
constexpr size_t WS_BAR = 128 * 1024, WS_CNT = 144 * 1024, WS_FLAG = 152 * 1024, WS_GRP = 160 * 1024, BAR_BYTES = 40 * 1024;

#define GAS __attribute__((address_space(1)))
#define LAS __attribute__((address_space(3)))
typedef unsigned short bf16;
typedef unsigned v4u __attribute__((ext_vector_type(4)));
typedef float f32x4 __attribute__((ext_vector_type(4)));
#define LDS_WAIT() asm volatile("s_waitcnt lgkmcnt(0)" ::: "memory")
__device__ __forceinline__ unsigned f2bf(float f) { unsigned u = __builtin_bit_cast(unsigned, f); return (u + 0x7fffu + ((u >> 16) & 1u)) >> 16; }
__device__ __forceinline__ unsigned pk2(float lo, float hi) { return f2bf(lo) | (f2bf(hi) << 16); }
__device__ __forceinline__ float bflo(unsigned w) { return __uint_as_float(w << 16); }
__device__ __forceinline__ float bfhi(unsigned w) { return __uint_as_float(w & 0xffff0000u); }
__device__ __forceinline__ float wave_sum(float v) {
#pragma unroll
    for (int o = 1; o < 64; o <<= 1) v += __shfl_xor(v, o);
    return v;
}
__device__ __forceinline__ void transpose_item(const float* W, int K, int N, bf16* WT, int k0, int n0, int dst_row0, LAS float* scr, int lane, const float* ks = nullptr) {
    float wv[32];
#pragma unroll
    for (int i = 0; i < 32; ++i) { const int kk = 2 * i + (lane >> 5); wv[i] = W[(size_t)(k0 + kk) * N + n0 + (lane & 31)]; }
#pragma unroll
    for (int i = 0; i < 32; ++i) { const int kk = 2 * i + (lane >> 5); scr[kk * 33 + (lane & 31)] = wv[i]; }
    LDS_WAIT(); asm volatile("" ::: "memory");
    const int c = lane & 7;
    f32x4 g0 = {1.f, 1.f, 1.f, 1.f}, g1 = {1.f, 1.f, 1.f, 1.f};
    if (ks) { g0 = *(const f32x4*)(ks + k0 + 8 * c); g1 = *(const f32x4*)(ks + k0 + 8 * c + 4); }
#pragma unroll
    for (int j = 0; j < 4; ++j) { const int n = (lane >> 3) + 8 * j; const LAS float* s = scr + (8 * c) * 33 + n;
        v4u o; o.x = pk2(s[0 * 33] * g0.x, s[1 * 33] * g0.y); o.y = pk2(s[2 * 33] * g0.z, s[3 * 33] * g0.w); o.z = pk2(s[4 * 33] * g1.x, s[5 * 33] * g1.y); o.w = pk2(s[6 * 33] * g1.z, s[7 * 33] * g1.w);
        *(GAS v4u*)(WT + (size_t)(dst_row0 + n) * K + k0 + 8 * c) = o; }
    LDS_WAIT(); asm volatile("" ::: "memory");
}

#define XB_TMO      128
#define XB_XCNT(j)  (256  + 64 * (j))
#define XB_XSUB(j)  (1280 + 64 * (j))
#define XB_XGEN(j)  (2304 + 64 * (j))
#define XB_TOP      3328
#define XB_TOPGEN   3392
#define XCD_BAR_WORDS 3456
#define XB_SPIN_CAP (1u << 18)

__device__ __forceinline__ unsigned xb_ld(unsigned* p)              { return __hip_atomic_load(p, __ATOMIC_RELAXED, __HIP_MEMORY_SCOPE_AGENT); }
__device__ __forceinline__ unsigned xb_add(unsigned* p, unsigned v) { return __hip_atomic_fetch_add(p, v, __ATOMIC_RELAXED, __HIP_MEMORY_SCOPE_AGENT); }
__device__ __forceinline__ unsigned xb_xcc_id() { return (unsigned)__builtin_amdgcn_s_getreg((3 << 11) | 20) & 0xFu; }
#define XB_SPIN(cond, bar) do { unsigned _sp = 0; while (cond) { __builtin_amdgcn_s_sleep(1); \
    if ((++_sp & 255u) == 0u) { if (xb_ld(&(bar)[XB_TMO])) break; if (_sp > XB_SPIN_CAP) { atomicAdd(&(bar)[XB_TMO], 1u); break; } } } } while (0)

struct XcdBarrier {
    unsigned* bar; unsigned x;
    volatile LAS unsigned* st;
};

__device__ __forceinline__ XcdBarrier xcd_barrier_post(unsigned* bar, volatile LAS unsigned* st, const int wave_in) {
    XcdBarrier b; b.bar = bar; b.x = xb_xcc_id(); b.st = st;
    if (wave_in == 0 && mk_lane() == 0) (void)xb_add(&bar[XB_XCNT(b.x)], 1u);
    return b;
}
__device__ __forceinline__ void xcd_barrier_complete(unsigned* bar, unsigned x, unsigned& nloc, unsigned& nx) {
    const unsigned G = gridDim.x * gridDim.y * gridDim.z;
    unsigned sum, cnt, mine, sp = 0u;
    for (;;) {
        sum = 0u; cnt = 0u; mine = 0u;
#pragma unroll
        for (unsigned j = 0; j < 16; ++j) { const unsigned c = xb_ld(&bar[XB_XCNT(j)]); sum += c; cnt += (c > 0u) ? 1u : 0u; mine = (j == x) ? c : mine; }
        if (sum == G) break;
        __builtin_amdgcn_s_sleep(1);
        if ((++sp & 255u) == 0u) { if (xb_ld(&bar[XB_TMO])) break; if (sp > XB_SPIN_CAP) { atomicAdd(&bar[XB_TMO], 1u); break; } }
    }
    nloc = mine > 0u ? mine : 1u; nx = cnt > 0u ? cnt : 1u;
}

__device__ __forceinline__ void xcd_barrier(const XcdBarrier& b, const int wave_in) {
    asm volatile("s_waitcnt vmcnt(0)" ::: "memory");
    __syncthreads();
    if (wave_in == 0 && mk_lane() == 0) {
        unsigned* bar = b.bar;
        __builtin_amdgcn_s_waitcnt(0);
        unsigned nloc = b.st[0], nx = b.st[1];
        if (nloc == 0u) { xcd_barrier_complete(bar, b.x, nloc, nx); b.st[0] = nloc; b.st[1] = nx; }
        const unsigned old = xb_add(&bar[XB_XSUB(b.x)], 1u);
        const unsigned gen = old / nloc;
        if (old + 1u == (gen + 1u) * nloc) {
            __builtin_amdgcn_fence(__ATOMIC_RELEASE, "agent");
            asm volatile("s_waitcnt vmcnt(0)" ::: "memory");
            const unsigned og = xb_add(&bar[XB_TOP], 1u);
            const unsigned tg = og / nx;
            if (og + 1u == (tg + 1u) * nx) xb_add(&bar[XB_TOPGEN], 1u);
            else XB_SPIN(xb_ld(&bar[XB_TOPGEN]) == tg, bar);
            __builtin_amdgcn_fence(__ATOMIC_ACQUIRE, "agent");
            xb_add(&bar[XB_XGEN(b.x)], 1u);
            asm volatile("s_waitcnt vmcnt(0)" ::: "memory");
        } else {
            XB_SPIN(xb_ld(&bar[XB_XGEN(b.x)]) == gen, bar);
            __builtin_amdgcn_fence(__ATOMIC_ACQUIRE, "agent");
            asm volatile("s_waitcnt vmcnt(0)" ::: "memory");
        }
    }
    __syncthreads();
}
struct Args { const float* in[11]; float* out; unsigned char* ws; int ph_lo, ph_hi; };
constexpr int NPHASE = 7;

__global__ void __launch_bounds__(NWAVES * 64, 2) mk_fwd(Args args) {
    extern __shared__ __attribute__((aligned(16))) unsigned char lds[];
    LAS unsigned char* ldsl = (LAS unsigned char*)lds;
    const int wave = __builtin_amdgcn_readfirstlane((int)threadIdx.x >> 6);
    const int G = gridDim.x, bx = blockIdx.x;
    const int vcu = (G % 8 == 0) ? (bx % 8) * (G / 8) + bx / 8 : bx;
    const int gw = vcu * NWAVES + wave, NGW = G * NWAVES;
    unsigned char* ws = args.ws;
    const float* x = args.in[0]; const float* g_attn = args.in[1]; const float* w_in = args.in[2]; const float* lambda_qk = args.in[3]; const float* subln = args.in[4];
    const float* w_out = args.in[5]; const float* g_ffn = args.in[6]; const float* w_gate = args.in[7]; const float* w_up = args.in[8]; const float* w_down = args.in[9];
    const float* g_final = args.in[10];
    float* out = args.out;
    float* SS1 = (float*)(ws + WS_SS1); float* SS2 = (float*)(ws + WS_SS2); float* LSE = (float*)(ws + WS_LSE);
    bf16* QKV = (bf16*)(ws + WS_QKV); bf16* WGU = (bf16*)(ws + WS_WGU); bf16* WDN = (bf16*)(ws + WS_WDN); bf16* HB = (bf16*)(ws + WS_H);
    bf16* WIN = (bf16*)(ws + WS_WIN); bf16* XN = (bf16*)(ws + WS_XN); bf16* OA = (bf16*)(ws + WS_OA); bf16* WOUT = (bf16*)(ws + WS_WOUT);
    bf16* OB = (bf16*)(ws + WS_OB); bf16* XG = (bf16*)(ws + WS_XG); bf16* Y = (bf16*)(ws + WS_Y);
    const int lo = args.ph_lo, hi_ph = args.ph_hi;
#define IN(k) (lo <= (k) && (k) < hi_ph)
    if (wave == 0) { const int l0 = mk_lane(); if (l0 < 32) ((LAS unsigned*)(ldsl + MISC_OFF))[l0] = 0u; }
    __syncthreads();
    XcdBarrier bar; bar.bar = (unsigned*)(ws + WS_BAR); bar.x = 0; bar.st = nullptr;
    if (hi_ph - lo > 1) bar = xcd_barrier_post((unsigned*)(ws + WS_BAR), (volatile LAS unsigned*)(ldsl + MISC_OFF), wave);
    if (lo < -1000) cg::this_grid().sync();
#define STAMP(k) do { if (MK_TIME_PHASE >= 0) { const unsigned long long t_ = __builtin_amdgcn_s_memrealtime(); if ((k) == MK_TIME_PHASE) tph0 = t_; if ((k) == MK_TIME_PHASE + 1) tph1 = t_; } } while (0)
    unsigned long long tph0 = 0, tph1 = 0; STAMP(0);
#define SEAM(k) do { if (IN(k) && IN((k) + 1)) { for (int rb = 0; rb < (MK_DUP_PHASE == 30 ? 3 : 1); ++rb) xcd_barrier(bar, wave); } } while (0)

    if (IN(0)) for (int rep = 0; rep < NREP(0); ++rep) { const int lane = mk_lane(), tid = wave * 64 + lane;
        LAS float* scr = (LAS float*)(ldsl + wave * 16384);
        constexpr int I_IN = (DM / 64) * (NIN / 32), I_OUT = (DM / 64) * (DM / 32);
        for (int it = gw; it < I_IN; it += NGW) {
            if (it < I_IN) { const int nblk = NIN / 32, kb = it / nblk, nb = it % nblk; transpose_item(w_in, DM, NIN, WIN, 64 * kb, 32 * nb, 32 * nb, scr, lane); }
            else { const int r = it - I_IN; const int nblk = DM / 32, kb = r / nblk, nb = r % nblk; transpose_item(w_out, DM, DM, WOUT, 64 * kb, 32 * nb, 32 * nb, scr, lane); }
        }
        for (int m = gw; m < M; m += NGW) {
            const GAS f32x4* xr = (const GAS f32x4*)(x + (size_t)m * DM) + lane;
            f32x4 v[8]; float s = 0.f;
#pragma unroll
            for (int j = 0; j < 8; ++j) { v[j] = xr[64 * j]; s += (v[j].x * v[j].x + v[j].y * v[j].y) + (v[j].z * v[j].z + v[j].w * v[j].w); }
            const float rstd = 1.0f / sqrtf(wave_sum(s) * (1.f / DM) + RMS_EPS);
            GAS unsigned long long* o8 = (GAS unsigned long long*)(XN + (size_t)m * DM) + lane;
#pragma unroll
            for (int j = 0; j < 8; ++j) { const f32x4 gg = *((const GAS f32x4*)g_attn + lane + 64 * j);
                o8[64 * j] = (unsigned long long)pk2(v[j].x * rstd * gg.x, v[j].y * rstd * gg.y) | ((unsigned long long)pk2(v[j].z * rstd * gg.z, v[j].w * rstd * gg.w) << 32); }
        }
        for (int i = bx * (NWAVES * 64) + tid; i < M; i += G * NWAVES * 64) { SS1[i] = 0.f; SS2[i] = 0.f; }
    }
    SEAM(0); STAMP(1);
    if (IN(1)) {
        pg8::Gemm g{XN, WIN, M, NIN, DM}; pg8::StaticOrder S; S.init(M, NIN, G, bx); S.dup = NREP(1); S.wgm = WGM_P1;
        pg8::EpiQKV E{QKV, NIN};
        pg8::gemm_phase<pg8::EpiQKV, pg8::StaticOrder, true, true>(ldsl, g, S, E, wave);
    }
    SEAM(1); STAMP(2);
    if (IN(2)) { const int lane = mk_lane();
        float lam;
        { const float a = lambda_qk[lane] * lambda_qk[64 + lane], b2 = lambda_qk[128 + lane] * lambda_qk[192 + lane];
          lam = __expf(wave_sum(a)) - __expf(wave_sum(b2)) + LAM_INIT; }
        const int grp = vcu >> 3, k = vcu & 7, gb = grp >> 3, gh = grp & 7;
        const att::bf16* rowb = (const att::bf16*)QKV + (size_t)gb * SEQ * NIN;
        att::ConvJob cj{w_gate, w_up, w_down, w_out, g_ffn, WGU, WDN, WOUT, vcu, vcu + G * ((att::CV_TOTAL - 1 - vcu) / G), G};
        for (int i = 0; i < 2 * NREP(20); ++i) {
            const int c = i & 1;
            att::attn_dense_body(rowb + (size_t)k * 256 * NIN + 3072 + gh * HD, rowb + 4096 + gh * HD, rowb + 5120 + gh * HD, nullptr, 1024, 4 * c, SEQ, (char*)lds, wave, cj,
                                 c == 1, Y + ((size_t)gb * SEQ + k * 256) * DM + 1024 + gh * HD, lam, subln);
        }
        __syncthreads();
        { float* scr = (float*)((char*)lds + RING_BYTES) + wave * 64;
          for (int rep = 0; rep < NREP(21); ++rep) {
            att::swa_wg_unit((const att::bf16*)QKV, 0, gb * 8 + gh, 8 * k, 0, OA, LSE, (char*)lds, scr, wave);
            att::swa_wg_unit((const att::bf16*)QKV, 1, (gb * 4 + (k >> 1)) * 8 + gh, 8 * (k & 1), 0, OA + (size_t)M * 1024, LSE + (size_t)M * 8, (char*)lds, scr, wave);
            att::swa_wg_unit((const att::bf16*)QKV, 2, (gb * 16 + 2 * k) * 8 + gh, 0, 8, OA + (size_t)2 * M * 1024, LSE + (size_t)2 * M * 8, (char*)lds, scr, wave);
          } }
        asm volatile("s_waitcnt vmcnt(0)" ::: "memory"); __syncthreads();
        if (wave == 0 && lane == 0) {
            unsigned* gc = (unsigned*)(ws + WS_GRP) + 64 * grp;
            __builtin_amdgcn_fence(__ATOMIC_RELEASE, "agent"); asm volatile("s_waitcnt vmcnt(0)" ::: "memory");
            __hip_atomic_fetch_add(gc, 1u, __ATOMIC_RELAXED, __HIP_MEMORY_SCOPE_AGENT);
            unsigned sp = 0; while (__hip_atomic_load(gc, __ATOMIC_RELAXED, __HIP_MEMORY_SCOPE_AGENT) < 8u) { __builtin_amdgcn_s_sleep(2); if (++sp > (1u << 22)) break; }
            __builtin_amdgcn_fence(__ATOMIC_ACQUIRE, "agent"); asm volatile("s_waitcnt vmcnt(0)" ::: "memory");
        }
        __syncthreads();
        { const int col = (lane & 15) * 8;
#pragma unroll 2
          for (int it = 0; it < 8; ++it) {
            const size_t m = (size_t)gb * SEQ + k * 256 + wave * 32 + it * 4 + (lane >> 4);
            const float l0 = LSE[m * 8 + gh], l1 = LSE[((size_t)M + m) * 8 + gh], l2 = LSE[((size_t)2 * M + m) * 8 + gh];
            const float mx = fmaxf(l0, fmaxf(l1, l2)); float w0 = __expf(l0 - mx), w1 = __expf(l1 - mx), w2 = __expf(l2 - mx);
            const float inv = 1.0f / (w0 + w1 + w2); w0 *= inv; w1 *= inv; w2 *= inv;
            const v4u a0 = *(const GAS v4u*)(OA + m * 1024 + gh * HD + col), a1 = *(const GAS v4u*)(OA + ((size_t)M + m) * 1024 + gh * HD + col), a2 = *(const GAS v4u*)(OA + ((size_t)2 * M + m) * 1024 + gh * HD + col);
            v4u ya;
#pragma unroll
            for (int i = 0; i < 4; ++i) ya[i] = pk2(w0 * bflo(a0[i]) + w1 * bflo(a1[i]) + w2 * bflo(a2[i]), w0 * bfhi(a0[i]) + w1 * bfhi(a1[i]) + w2 * bfhi(a2[i]));
            *(GAS v4u*)(Y + m * DM + gh * HD + col) = ya;
          } }
        __syncthreads();
    }
    SEAM(2); STAMP(3);
    if (IN(4)) {
        pg8::Gemm g{Y, WOUT, M, DM, DM}; pg8::StaticOrder S; S.init(M, DM, G, bx); S.dup = NREP(4); S.wgm = WGM_P4;
        pg8::EpiOut E{x, XG, g_ffn, SS1, DM};
        pg8::gemm_phase<pg8::EpiOut, pg8::StaticOrder, true, true>(ldsl, g, S, E, wave);
    }
    SEAM(4); STAMP(4);
    if (IN(5)) {
        pg8::Gemm g{XG, WGU, M, NGU, DM}; pg8::StaticOrder S; S.init(M, NGU, G, bx); S.dup = NREP(5); S.wgm = WGM_P5;
        S.split_from = -1  ; S.kh_bytes = (DM / 2) * 2; S.kh_nt = DM / 128;
        pg8::EpiGateUp E{HB, DFF, SS1, 1.0f / DM, RMS_EPS, (pg8::f32x4*)(ws + WS_Y), (unsigned*)(ws + WS_FLAG)};
        pg8::gemm_phase<pg8::EpiGateUp, pg8::StaticOrder, true, true>(ldsl, g, S, E, wave);
        if (bx >= 128 && G == 256) {
            const int lane = mk_lane(); LAS float* scr = (LAS float*)(ldsl + wave * 16384);
            constexpr int I_D = (DFF / 64) * (DM / 32);
            for (int it = (bx - 128) * NWAVES + wave; it < I_D; it += 128 * NWAVES) { const int nblk = DM / 32, kb = it / nblk, nb = it % nblk; transpose_item(w_down, DFF, DM, WDN, 64 * kb, 32 * nb, 32 * nb, scr, lane); }
        }
    }
    SEAM(5); STAMP(5);
    if (IN(6)) {
        pg8::Gemm g{HB, WDN, M, DM, DFF}; pg8::StaticOrder S; S.init(M, DM, G, bx); S.wgm = WGM_P6;
        pg8::EpiDownNorm E{XG, g_ffn, out, g_final, SS2, (unsigned*)(ws + WS_CNT), DM, 1.0f / DM, RMS_EPS};
        pg8::gemm_phase<pg8::EpiDownNorm, pg8::StaticOrder, false, true>(ldsl, g, S, E, wave);
    }
    STAMP(6);
    if (MK_TIME_PHASE >= 0 && bx == 0 && wave == 0) { if (tph1 == 0) tph1 = __builtin_amdgcn_s_memrealtime(); const unsigned long long t0_ = __builtin_amdgcn_s_memrealtime(); while (__builtin_amdgcn_s_memrealtime() - t0_ < tph1 - tph0) __builtin_amdgcn_s_sleep(8); }
#undef IN
#undef SEAM
}

extern "C" void kernel_launch(void* const* d_in, const int* in_sizes, int n_in, void* d_out, int out_size, void* d_ws, size_t ws_size, hipStream_t stream) {
    static int grid = 0;
    if (grid == 0) {
        if (n_in != 11 || in_sizes[0] != M * DM || out_size != M * DM || ws_size < WS_END) { fprintf(stderr, "kernel_launch: shape/workspace mismatch (n_in %d, in0 %d, out %d, ws %zu)\n", n_in, n_in > 0 ? in_sizes[0] : -1, out_size, ws_size); grid = -1; return; }
        int dev = 0, cus = 0, per_cu = 0;
        if (hipGetDevice(&dev) != hipSuccess || hipDeviceGetAttribute(&cus, hipDeviceAttributeMultiprocessorCount, dev) != hipSuccess) { grid = -1; return; }
        if (hipFuncSetAttribute((const void*)mk_fwd, hipFuncAttributeMaxDynamicSharedMemorySize, LDS_BYTES) != hipSuccess) { fprintf(stderr, "kernel_launch: hipFuncSetAttribute failed\n"); grid = -1; return; }
        if (hipOccupancyMaxActiveBlocksPerMultiprocessor(&per_cu, (const void*)mk_fwd, NWAVES * 64, LDS_BYTES) != hipSuccess || per_cu < 1) { fprintf(stderr, "kernel_launch: occupancy query says %d\n", per_cu); per_cu = 1; }
        (void)hipGetLastError();
        grid = cus;
        if (grid != 256) { fprintf(stderr, "kernel_launch: this kernel needs a 256-CU device (got %d)\n", cus); grid = -1; return; }
    }
    if (grid < 0) return;
    Args a{};
    for (int i = 0; i < 11; ++i) a.in[i] = (const float*)d_in[i];
    a.out = (float*)d_out; a.ws = (unsigned char*)d_ws;
#if MK_ONE_LAUNCH
    if (hipMemsetAsync((char*)d_ws + WS_BAR, 0, BAR_BYTES, stream) != hipSuccess) { fprintf(stderr, "kernel_launch: memset failed\n"); return; }
#ifdef MK_PROBE_MEMSET2
    (void)hipMemsetAsync((char*)d_ws + WS_BAR, 0, BAR_BYTES, stream);
#endif
    a.ph_lo = 0; a.ph_hi = NPHASE;
    void* kargs[] = {&a};
    hipError_t e = hipLaunchCooperativeKernel((const void*)mk_fwd, dim3(grid), dim3(NWAVES * 64), kargs, LDS_BYTES, stream);
    if (e != hipSuccess) fprintf(stderr, "kernel_launch: cooperative launch failed: %s (grid %d)\n", hipGetErrorString(e), grid);
#else
    for (int p = 0; p < NPHASE; ++p) {
        a.ph_lo = p; a.ph_hi = p + 1;
        hipLaunchKernelGGL(mk_fwd, dim3(grid), dim3(NWAVES * 64), LDS_BYTES, stream, a);
    }
#endif
}
```

```cpp
#include <hip/hip_runtime.h>
#include <hip/hip_cooperative_groups.h>
#include <hip/hip_bf16.h>
#include <cstdio>
#include <cstdint>
#include <cmath>
namespace cg = cooperative_groups;
__device__ __forceinline__ int mk_lane() { int l; asm volatile("v_mbcnt_lo_u32_b32 %0, -1, 0\n\tv_mbcnt_hi_u32_b32 %0, -1, %0" : "=v"(l)); return l & 63; }
namespace pg8 {
#define PG8_LAS __attribute__((address_space(3)))
typedef unsigned short bf16_t;
typedef short bf16x8 __attribute__((ext_vector_type(8)));
typedef float f32x4 __attribute__((ext_vector_type(4)));
typedef unsigned u32x4 __attribute__((ext_vector_type(4)));
constexpr int BM = 256, BK = 64, HALF = 128, HTB = HALF * BK * 2  , STAGE_BYTES = 8 * HTB, NXCD = 8, WGM = 8;

__host__ __device__ __forceinline__ int lds_byte(int r, int c) { const int st = (r >> 4) * 2 + (c >> 5), rr = r & 15, cc = c & 31, ob = rr * 64 + cc * 2; return st * 1024 + (ob ^ (((ob >> 9) & 1) << 5)); }
__host__ __device__ __forceinline__ void stage_rc(int b, int& R, int& C) { const int st = b / 1024, sb = b % 1024, swz = sb ^ (((sb >> 9) & 1) << 5); R = (st >> 1) * 16 + swz / 64; C = (st & 1) * 32 + (swz % 64) / 2; }
__host__ __device__ __forceinline__ int perm32(int rho) { const int n = rho >> 4, i = rho & 15; return 8 * (i >> 2) + 4 * n + (i & 3); }

struct Unit { int pm, pn, first, khalf, koff, nt, ul; };
struct Gemm { const bf16_t* A; const bf16_t* Bt; int M, N, K; };

struct StaticOrder {
    int nM, nN, nwg, G, c, dup, split_from, kh_bytes, kh_nt, wgm;
    __host__ __device__ void init(int M, int N, int G_, int c_) { nM = M / BM; nN = N / BM; nwg = nM * nN; G = G_; c = c_; dup = 1; wgm = WGM; split_from = -1; kh_bytes = 0; kh_nt = 0; }
    __host__ __device__ bool next(int i, Unit& u) const {
        long L = (long)(i / dup) * G + c; u.khalf = 0; u.koff = 0; u.nt = 0; u.ul = 0;
        if (split_from >= 0 && (long)(i / dup) * G >= split_from) {
            if ((long)(i / dup) * G > split_from) return false;
            u.ul = c >> 1; L = split_from + u.ul; u.khalf = 1 + (c & 1); u.koff = (c & 1) ? kh_bytes : 0; u.nt = kh_nt; }
        if (L >= nwg) return false;
        int wgid = (int)L; { const int q = nwg / NXCD, r = nwg % NXCD, xcd = wgid % NXCD, off = wgid / NXCD; wgid = (xcd < r ? xcd * (q + 1) : r * (q + 1) + (xcd - r) * q) + off; }
        const int nig = wgm * nN, gid = wgid / nig, fm = gid * wgm, gsz = (nM - fm) < wgm ? (nM - fm) : wgm;
        u.pm = fm + ((wgid % nig) % gsz); u.pn = (wgid % nig) / gsz; u.first = (i % dup) == 0; return true;
    }
    __device__ __forceinline__ void a_ready(const Unit&) const {}
    __device__ __forceinline__ void done(const Unit&) const {}
};

__device__ __forceinline__ unsigned cvt_pk_bf16(float lo, float hi) { unsigned r; asm volatile("v_cvt_pk_bf16_f32 %0, %1, %2" : "=v"(r) : "v"(lo), "v"(hi)); return r; }
typedef float f32x2 __attribute__((ext_vector_type(2)));
__device__ __forceinline__ float invf_a(int f) {
    constexpr float T[16] = {1.0f, 0.4403666f, 0.19392274f, 0.0853971f, 0.03760603f, 0.01656044f, 0.0072926646f, 0.003211446f,
                             0.0014142136f, 0.00062277244f, 0.0002742482f, 0.000120769735f, 5.3182957e-05f, 2.342e-05f, 1.0313385e-05f, 4.5416705e-06f};
    return T[f];
}
__device__ __forceinline__ void sincos_rev(float ang, float& s, float& c) {
    const float rev = ang * 0.15915494309189535f; const float fr = rev - __builtin_floorf(rev);
    s = __builtin_amdgcn_sinf(fr); c = __builtin_amdgcn_cosf(fr);
}
struct EpiQKV {
    static constexpr bool PERM = true, AFTER_DRAIN = false;
    bf16_t* O; int ldc;
    __device__ __forceinline__ void operator()(const f32x4 (&acc)[2][2][4][2], const Unit& u, int wr, int wc, int fr, int fq) const {
        const int row0 = u.pm * BM + wr * 64 + fr;
        const int sec = u.pn >> 2;
        const int col0 = u.pn * BM + wc * 32 + 8 * fq;
        const bool ropeA = (sec <= 1) && (wc == 0);
        const bool ropeB = (sec == 3 || sec == 4) && ((wc & 1) == 0);
#pragma unroll
        for (int ai = 0; ai < 2; ++ai)
#pragma unroll
            for (int m = 0; m < 4; ++m) {
                const int row = row0 + ai * HALF + m * 16;
                const float pos = (float)(row & 2047);
                bf16_t* rowp = O + (size_t)row * ldc + col0;
                float cs[8], sn[8];
                if (ropeA) {
                    const int fb = 8 * (fq & 1);
#pragma unroll
                    for (int i = 0; i < 8; ++i) { float f0 = invf_a(i), f1 = invf_a(8 + i); sincos_rev(pos * (fb ? f1 : f0), sn[i], cs[i]); }
                    const float sg = (fq >= 2) ? 1.f : -1.f;
#pragma unroll
                    for (int i = 0; i < 8; ++i) sn[i] *= sg;
                } else if (ropeB) {
#pragma unroll
                    for (int i = 0; i < 8; ++i) sincos_rev(pos * invf_a(2 * i), sn[i], cs[i]);
                    const float sg = (fq == 1) ? 1.f : -1.f;
#pragma unroll
                    for (int i = 0; i < 8; ++i) sn[i] *= sg;
                }
#pragma unroll
                for (int bj = 0; bj < 2; ++bj) {
                    f32x4 v0 = acc[ai][bj][m][0], v1 = acc[ai][bj][m][1];
                    if (ropeA) {
                        f32x4 p0, p1;
#pragma unroll
                        for (int i = 0; i < 4; ++i) { p0[i] = __shfl_xor(v0[i], 32); p1[i] = __shfl_xor(v1[i], 32); }
#pragma unroll
                        for (int i = 0; i < 4; ++i) { v0[i] = v0[i] * cs[i] + p0[i] * sn[i]; v1[i] = v1[i] * cs[4 + i] + p1[i] * sn[4 + i]; }
                    } else if (ropeB) {
                        f32x4 p0, p1;
#pragma unroll
                        for (int i = 0; i < 4; ++i) { p0[i] = __shfl_xor(v0[i], 16); p1[i] = __shfl_xor(v1[i], 16); }
                        if (fq < 2) {
#pragma unroll
                            for (int i = 0; i < 4; ++i) { v0[i] = v0[i] * cs[i] + p0[i] * sn[i]; v1[i] = v1[i] * cs[4 + i] + p1[i] * sn[4 + i]; }
                        }
                    }
                    u32x4 w; w.x = cvt_pk_bf16(v0[0], v0[1]); w.y = cvt_pk_bf16(v0[2], v0[3]); w.z = cvt_pk_bf16(v1[0], v1[1]); w.w = cvt_pk_bf16(v1[2], v1[3]);
                    *(u32x4*)(rowp + bj * HALF) = w;
                }
            }
    }
};
struct EpiOut {
    static constexpr bool PERM = false, AFTER_DRAIN = false;
    const float* base; bf16_t* xg; const float* g; float* ss; int ldc;
    __device__ __forceinline__ void operator()(const f32x4 (&acc)[2][2][4][2], const Unit& u, int wr, int wc, int fr, int fq) const {
        typedef unsigned u32x2v __attribute__((ext_vector_type(2)));
        const int col0 = u.pn * BM + wc * 32 + 4 * fq;
        f32x4 gv[2][2];
#pragma unroll
        for (int bj = 0; bj < 2; ++bj)
#pragma unroll
            for (int n = 0; n < 2; ++n) gv[bj][n] = *(const f32x4*)(g + col0 + bj * HALF + n * 16);
#pragma unroll
        for (int ai = 0; ai < 2; ++ai)
#pragma unroll
            for (int m = 0; m < 4; ++m) {
                const int row = u.pm * BM + ai * HALF + wr * 64 + m * 16 + fr; const size_t off = (size_t)row * ldc + col0; float s = 0.f;
#pragma unroll
                for (int bj = 0; bj < 2; ++bj)
#pragma unroll
                    for (int n = 0; n < 2; ++n) {
                        const f32x4 x1 = *(const f32x4*)(base + off + bj * HALF + n * 16) + acc[ai][bj][m][n];
                        s += (x1[0] * x1[0] + x1[1] * x1[1]) + (x1[2] * x1[2] + x1[3] * x1[3]);
                        const f32x4 y = x1 * gv[bj][n]; u32x2v w; w.x = cvt_pk_bf16(y[0], y[1]); w.y = cvt_pk_bf16(y[2], y[3]);
                        *(u32x2v*)(xg + off + bj * HALF + n * 16) = w;
                    }
                s += __shfl_xor(s, 16); s += __shfl_xor(s, 32);
                if (fq == 0 && u.first) atomicAdd(ss + row, s);
            }
    }
};
struct EpiGateUp {
    static constexpr bool PERM = true, AFTER_DRAIN = false;
    bf16_t* H; int ldh; const float* ss; float inv_n, eps; f32x4* part; unsigned* flag;
    __device__ __forceinline__ void operator()(const f32x4 (&acc)[2][2][4][2], const Unit& u, int wr, int wc, int fr, int fq) const {
        const int tid = (wr * 4 + wc) * 64 + fq * 16 + fr;
        f32x4* pp = part + (size_t)u.ul * (32 * 512) + tid;
        if (u.khalf == 1) {
#pragma unroll
            for (int ai = 0; ai < 2; ++ai)
#pragma unroll
                for (int bj = 0; bj < 2; ++bj)
#pragma unroll
                    for (int m = 0; m < 4; ++m)
#pragma unroll
                        for (int n = 0; n < 2; ++n) pp[(size_t)(((ai * 2 + bj) * 4 + m) * 2 + n) * 512] = acc[ai][bj][m][n];
            asm volatile("s_waitcnt vmcnt(0)" ::: "memory"); __builtin_amdgcn_s_barrier(); asm volatile("" ::: "memory");
            if (tid == 0) { __builtin_amdgcn_fence(__ATOMIC_RELEASE, "agent"); asm volatile("s_waitcnt vmcnt(0)" ::: "memory");
                __hip_atomic_store(flag + 16 * u.ul, 1u, __ATOMIC_RELAXED, __HIP_MEMORY_SCOPE_AGENT); }
            return;
        }
        if (u.khalf == 2) {
            if (tid < 64) { unsigned sp = 0;
                while ((unsigned)__builtin_amdgcn_readfirstlane(__hip_atomic_load(flag + 16 * u.ul, __ATOMIC_RELAXED, __HIP_MEMORY_SCOPE_AGENT)) == 0u) { __builtin_amdgcn_s_sleep(2); if (++sp > (1u << 22)) break; }
                __builtin_amdgcn_fence(__ATOMIC_ACQUIRE, "agent"); asm volatile("s_waitcnt vmcnt(0)" ::: "memory"); }
            asm volatile("s_waitcnt vmcnt(0) lgkmcnt(0)" ::: "memory"); __builtin_amdgcn_s_barrier(); asm volatile("" ::: "memory");
        }
        const int col0 = u.pn * HALF + wc * 32 + 8 * fq;
#pragma unroll
        for (int ai = 0; ai < 2; ++ai)
#pragma unroll
            for (int m = 0; m < 4; ++m) {
                const int row = u.pm * BM + ai * HALF + wr * 64 + m * 16 + fr;
                const float rstd = 1.0f / sqrtf(ss[row] * inv_n + eps);
                f32x4 gq[2], uq[2];
#pragma unroll
                for (int n = 0; n < 2; ++n) { gq[n] = acc[ai][0][m][n]; uq[n] = acc[ai][1][m][n]; }
                if (u.khalf == 2) {
#pragma unroll
                    for (int n = 0; n < 2; ++n) { gq[n] += pp[(size_t)(((ai * 2 + 0) * 4 + m) * 2 + n) * 512]; uq[n] += pp[(size_t)(((ai * 2 + 1) * 4 + m) * 2 + n) * 512]; }
                }
                float hv[8];
#pragma unroll
                for (int n = 0; n < 2; ++n)
#pragma unroll
                    for (int i = 0; i < 4; ++i) { const float gg = gq[n][i] * rstd, uu = uq[n][i] * rstd;
                        hv[4 * n + i] = gg * __builtin_amdgcn_rcpf(1.0f + __builtin_amdgcn_exp2f(-1.4426950408889634f * gg)) * uu; }
                u32x4 w; w.x = cvt_pk_bf16(hv[0], hv[1]); w.y = cvt_pk_bf16(hv[2], hv[3]); w.z = cvt_pk_bf16(hv[4], hv[5]); w.w = cvt_pk_bf16(hv[6], hv[7]);
                *(u32x4*)(H + (size_t)row * ldh + col0) = w;
            }
    }
};
struct EpiDown {
    static constexpr bool PERM = false, AFTER_DRAIN = false;
    const bf16_t* base; float* out; float* ss; int ldc;
    __device__ __forceinline__ void operator()(const f32x4 (&acc)[2][2][4][2], const Unit& u, int wr, int wc, int fr, int fq) const {
        typedef unsigned u32x2v __attribute__((ext_vector_type(2)));
        const int col0 = u.pn * BM + wc * 32 + 4 * fq;
#pragma unroll
        for (int ai = 0; ai < 2; ++ai)
#pragma unroll
            for (int m = 0; m < 4; ++m) {
                const int row = u.pm * BM + ai * HALF + wr * 64 + m * 16 + fr; const size_t off = (size_t)row * ldc + col0; float s = 0.f;
#pragma unroll
                for (int bj = 0; bj < 2; ++bj)
#pragma unroll
                    for (int n = 0; n < 2; ++n) {
                        const u32x2v rb = *(const u32x2v*)(base + off + bj * HALF + n * 16);
                        f32x4 x2 = acc[ai][bj][m][n];
                        x2[0] += __uint_as_float(rb.x << 16); x2[1] += __uint_as_float(rb.x & 0xffff0000u); x2[2] += __uint_as_float(rb.y << 16); x2[3] += __uint_as_float(rb.y & 0xffff0000u);
                        *(f32x4*)(out + off + bj * HALF + n * 16) = x2;
                        s += (x2[0] * x2[0] + x2[1] * x2[1]) + (x2[2] * x2[2] + x2[3] * x2[3]);
                    }
                s += __shfl_xor(s, 16); s += __shfl_xor(s, 32);
                if (fq == 0 && u.first) atomicAdd(ss + row, s);
            }
    }
};
struct EpiDownNorm {
    static constexpr bool PERM = false, AFTER_DRAIN = true;
    const bf16_t* base; const float* gres; float* out; const float* g; float* ss; unsigned* cnt; int ldc; float inv_n, eps;
    __device__ __forceinline__ void fused(f32x4 (&acc)[2][2][4][2], const Unit& u, int wr, int wc, int fr, int fq, PG8_LAS unsigned char* lds, int wid, int lane) const {
        typedef unsigned u32x2v __attribute__((ext_vector_type(2)));
        const int col0 = u.pn * BM + wc * 32 + 4 * fq;
        f32x4 rg[2][2];
#pragma unroll
        for (int bj = 0; bj < 2; ++bj)
#pragma unroll
            for (int n = 0; n < 2; ++n) { const f32x4 t = *(const f32x4*)(gres + col0 + bj * HALF + n * 16); rg[bj][n] = (f32x4){1.0f / t[0], 1.0f / t[1], 1.0f / t[2], 1.0f / t[3]}; }
#pragma unroll
        for (int ai = 0; ai < 2; ++ai)
#pragma unroll
            for (int m = 0; m < 4; ++m) {
                const int row = u.pm * BM + ai * HALF + wr * 64 + m * 16 + fr; const size_t off = (size_t)row * ldc + col0; float s = 0.f;
#pragma unroll
                for (int bj = 0; bj < 2; ++bj)
#pragma unroll
                    for (int n = 0; n < 2; ++n) {
                        const u32x2v rb = *(const u32x2v*)(base + off + bj * HALF + n * 16);
                        f32x4 x2 = acc[ai][bj][m][n];
                        x2[0] += __uint_as_float(rb.x << 16) * rg[bj][n][0]; x2[1] += __uint_as_float(rb.x & 0xffff0000u) * rg[bj][n][1]; x2[2] += __uint_as_float(rb.y << 16) * rg[bj][n][2]; x2[3] += __uint_as_float(rb.y & 0xffff0000u) * rg[bj][n][3];
                        acc[ai][bj][m][n] = x2;
                        s += (x2[0] * x2[0] + x2[1] * x2[1]) + (x2[2] * x2[2] + x2[3] * x2[3]);
                    }
                s += __shfl_xor(s, 16); s += __shfl_xor(s, 32);
                if (fq == 0) atomicAdd(ss + row, s);
            }
        asm volatile("s_waitcnt vmcnt(0)" ::: "memory");
        __builtin_amdgcn_s_barrier(); asm volatile("" ::: "memory");
        if (wid == 0) {
            unsigned* c = cnt + 64 * u.pm;
            if (lane == 0) __hip_atomic_fetch_add(c, 1u, __ATOMIC_RELAXED, __HIP_MEMORY_SCOPE_AGENT);
            unsigned sp = 0;
            while ((unsigned)__builtin_amdgcn_readfirstlane(__hip_atomic_load(c, __ATOMIC_RELAXED, __HIP_MEMORY_SCOPE_AGENT)) < 8u) { __builtin_amdgcn_s_sleep(2); if (++sp > (1u << 22)) break; }
            __builtin_amdgcn_fence(__ATOMIC_ACQUIRE, "agent");
        }
        asm volatile("s_waitcnt vmcnt(0) lgkmcnt(0)" ::: "memory"); __builtin_amdgcn_s_barrier(); asm volatile("" ::: "memory");
        f32x4 gv[2][2];
#pragma unroll
        for (int bj = 0; bj < 2; ++bj)
#pragma unroll
            for (int n = 0; n < 2; ++n) gv[bj][n] = *(const f32x4*)(g + col0 + bj * HALF + n * 16);
#pragma unroll
        for (int ai = 0; ai < 2; ++ai)
#pragma unroll
            for (int m = 0; m < 4; ++m) {
                const int row = u.pm * BM + ai * HALF + wr * 64 + m * 16 + fr; const size_t off = (size_t)row * ldc + col0;
                const float rstd = 1.0f / sqrtf(__hip_atomic_load(ss + row, __ATOMIC_RELAXED, __HIP_MEMORY_SCOPE_AGENT) * inv_n + eps);
#pragma unroll
                for (int bj = 0; bj < 2; ++bj)
#pragma unroll
                    for (int n = 0; n < 2; ++n) *(f32x4*)(out + off + bj * HALF + n * 16) = acc[ai][bj][m][n] * rstd * gv[bj][n];
            }
    }
};
template <class Epi, class Sched, bool ALIGN_EPI = false, bool SP2 = false>
__device__ __forceinline__ void gemm_phase(PG8_LAS unsigned char* lds, const Gemm g, const Sched& S, const Epi& E, const int wave_in) {
    const int wid = wave_in, lane = mk_lane(), tid = wid * 64 + lane, wr = wid >> 2, wc = wid & 3, fr = lane & 15, fq = lane >> 4;
    const int K = g.K, nt = K / BK;
    unsigned voffA[2], voffB[2];
#pragma unroll
    for (int i = 0; i < 2; ++i) { int R, C; stage_rc(tid * 16 + i * 8192, R, C); const int Rb = Epi::PERM ? ((R & ~31) + perm32(R & 31)) : R;
        voffA[i] = (unsigned)(R * K + C) * 2u; voffB[i] = (unsigned)(Rb * K + C) * 2u; }
    const size_t kstep = (size_t)(BK * 2);
    const size_t hstep = (size_t)HALF * K * 2;
    const size_t tstep = 2 * hstep;
    const unsigned ldsw = (unsigned)wid * 1024u;
    const int aoff = lds_byte(wr * 64 + fr, fq * 8), boff = lds_byte(wc * 32 + fr, fq * 8);
#define PG8_SA(b, h) (((b) * 2 + (h)) * HTB)
#define PG8_SB(b, h) ((4 + (b) * 2 + (h)) * HTB)
#define PG8_STAGE(bufoff, gbase, voff) do { _Pragma("unroll") for (int _i = 0; _i < 2; ++_i) \
        __builtin_amdgcn_global_load_lds((const unsigned*)((const char*)(gbase) + (voff)[_i]), (PG8_LAS unsigned*)(lds + (bufoff) + ldsw + _i * 8192), 16, 0, 0); } while (0)
#define PG8_LDA(dst, b, h) do { _Pragma("unroll") for (int m = 0; m < 4; ++m) _Pragma("unroll") for (int k = 0; k < 2; ++k) dst[m][k] = *(const PG8_LAS bf16x8*)(lds + PG8_SA(b, h) + aoff + m * 2048 + k * 1024); } while (0)
#define PG8_LDB(dst, b, h) do { _Pragma("unroll") for (int n = 0; n < 2; ++n) _Pragma("unroll") for (int k = 0; k < 2; ++k) dst[n][k] = *(const PG8_LAS bf16x8*)(lds + PG8_SB(b, h) + boff + n * 2048 + k * 1024); } while (0)
#define PG8_MMA(ai, bj, At, Bt) do { __builtin_amdgcn_s_setprio(1); _Pragma("unroll") for (int m = 0; m < 4; ++m) _Pragma("unroll") for (int n = 0; n < 2; ++n) _Pragma("unroll") for (int k = 0; k < 2; ++k) \
        acc[ai][bj][m][n] = __builtin_amdgcn_mfma_f32_16x16x32_bf16(Bt[n][k], At[m][k], acc[ai][bj][m][n], 0, 0, 0); __builtin_amdgcn_s_setprio(0); } while (0)
#define PG8_WAIT_V(n) asm volatile("s_waitcnt vmcnt(" #n ")" ::: "memory")
#define PG8_WAIT_L(n) asm volatile("s_waitcnt lgkmcnt(" #n ")" ::: "memory")
#define PG8_BAR __builtin_amdgcn_s_barrier()
#define PG8_SCHED __builtin_amdgcn_sched_barrier(0)
    Unit cur, nxt; int ui = 0;
    if (!S.next(0, cur)) return;
    f32x4 acc[2][2][4][2];
#pragma unroll
    for (int a = 0; a < 2; ++a)
#pragma unroll
        for (int b = 0; b < 2; ++b)
#pragma unroll
            for (int m = 0; m < 4; ++m)
#pragma unroll
                for (int n = 0; n < 2; ++n) acc[a][b][m][n] = (f32x4){0.f, 0.f, 0.f, 0.f};
    bf16x8 At[4][2], B0[2][2], B1[2][2];
    const char* cA = (const char*)g.A + (size_t)cur.pm * tstep + cur.koff; const char* cB = (const char*)g.Bt + (size_t)cur.pn * tstep + cur.koff; int ntc = cur.nt ? cur.nt : nt;
    S.a_ready(cur);
    if constexpr (SP2) {
        PG8_STAGE(PG8_SB(0, 0), cB, voffB); PG8_STAGE(PG8_SB(0, 1), cB + hstep, voffB); PG8_STAGE(PG8_SA(0, 0), cA, voffA); PG8_STAGE(PG8_SA(0, 1), cA + hstep, voffA);
        if (wr == 1) PG8_BAR;
        PG8_WAIT_V(2); PG8_BAR;
        PG8_STAGE(PG8_SB(1, 0), cB + kstep, voffB); PG8_STAGE(PG8_SA(1, 0), cA + kstep, voffA); PG8_STAGE(PG8_SB(1, 1), cB + hstep + kstep, voffB);
        PG8_WAIT_V(6); PG8_BAR;
    } else {
        PG8_STAGE(PG8_SB(0, 0), cB, voffB); PG8_STAGE(PG8_SA(0, 0), cA, voffA); PG8_STAGE(PG8_SB(0, 1), cB + hstep, voffB); PG8_STAGE(PG8_SA(0, 1), cA + hstep, voffA);
        if (wr == 1) PG8_BAR;
        PG8_WAIT_V(4); PG8_BAR;
        PG8_STAGE(PG8_SB(1, 0), cB + kstep, voffB); PG8_STAGE(PG8_SA(1, 0), cA + kstep, voffA); PG8_STAGE(PG8_SB(1, 1), cB + hstep + kstep, voffB);
        PG8_WAIT_V(6); PG8_BAR;
    }
    for (;;) {
        const bool has_next = S.next(ui + 1, nxt);
        const char* nA = has_next ? (const char*)g.A + (size_t)nxt.pm * tstep + nxt.koff : cA; const char* nB = has_next ? (const char*)g.Bt + (size_t)nxt.pn * tstep + nxt.koff : cB;
        for (int t = 0; t < ntc; t += 2) {
            const bool last = (t == ntc - 2);
            const char* a1 = cA + (size_t)(t + 1) * kstep;
            const char* a2 = last ? nA : cA + (size_t)(t + 2) * kstep; const char* b2 = last ? nB : cB + (size_t)(t + 2) * kstep;
            const char* a3 = a2 + kstep; const char* b3 = b2 + kstep;
            if (last && has_next) S.a_ready(nxt);
            if constexpr (SP2) {
            PG8_LDB(B0, 0, 0); PG8_LDB(B1, 0, 1); PG8_SCHED; PG8_LDA(At, 0, 0); PG8_STAGE(PG8_SA(1, 1), a1 + hstep, voffA);
            PG8_WAIT_V(8); PG8_WAIT_L(0); PG8_BAR; PG8_MMA(0, 0, At, B0); PG8_MMA(0, 1, At, B1); PG8_BAR; PG8_SCHED;
            PG8_LDA(At, 0, 1); PG8_STAGE(PG8_SB(0, 0), b2, voffB); PG8_STAGE(PG8_SB(0, 1), b2 + hstep, voffB); PG8_STAGE(PG8_SA(0, 0), a2, voffA);
            PG8_WAIT_V(8); PG8_WAIT_L(0); PG8_BAR; PG8_MMA(1, 0, At, B0); PG8_MMA(1, 1, At, B1); PG8_BAR; PG8_SCHED;
            PG8_LDB(B0, 1, 0); PG8_LDB(B1, 1, 1); PG8_SCHED; PG8_LDA(At, 1, 0); PG8_STAGE(PG8_SA(0, 1), a2 + hstep, voffA);
            PG8_WAIT_V(8); PG8_WAIT_L(0); PG8_BAR; PG8_MMA(0, 0, At, B0); PG8_MMA(0, 1, At, B1); PG8_BAR; PG8_SCHED;
            PG8_LDA(At, 1, 1); PG8_STAGE(PG8_SB(1, 0), b3, voffB); PG8_STAGE(PG8_SB(1, 1), b3 + hstep, voffB); PG8_STAGE(PG8_SA(1, 0), a3, voffA);
            PG8_WAIT_V(8); PG8_WAIT_L(0); PG8_BAR; PG8_MMA(1, 0, At, B0); PG8_MMA(1, 1, At, B1); PG8_BAR; PG8_SCHED;
            } else {
            PG8_LDB(B0, 0, 0); PG8_SCHED; PG8_LDA(At, 0, 0); PG8_STAGE(PG8_SA(1, 1), a1 + hstep, voffA);
            PG8_WAIT_L(8); PG8_BAR; PG8_WAIT_L(0); PG8_MMA(0, 0, At, B0); PG8_BAR; PG8_SCHED;
            PG8_LDB(B1, 0, 1); PG8_STAGE(PG8_SB(0, 0), b2, voffB);
            PG8_BAR; PG8_WAIT_L(0); PG8_MMA(0, 1, At, B1); PG8_BAR;
            PG8_LDA(At, 0, 1); PG8_STAGE(PG8_SA(0, 0), a2, voffA);
            PG8_BAR; PG8_WAIT_L(0); PG8_MMA(1, 0, At, B0); PG8_BAR; PG8_SCHED;
            PG8_STAGE(PG8_SB(0, 1), b2 + hstep, voffB);
            PG8_WAIT_V(6); PG8_BAR; PG8_MMA(1, 1, At, B1); PG8_BAR;
            PG8_LDB(B0, 1, 0); PG8_SCHED; PG8_LDA(At, 1, 0); PG8_STAGE(PG8_SA(0, 1), a2 + hstep, voffA);
            PG8_WAIT_L(8); PG8_BAR; PG8_WAIT_L(0); PG8_MMA(0, 0, At, B0); PG8_BAR; PG8_SCHED;
            PG8_LDB(B1, 1, 1); PG8_STAGE(PG8_SB(1, 0), b3, voffB);
            PG8_BAR; PG8_WAIT_L(0); PG8_MMA(0, 1, At, B1); PG8_BAR;
            PG8_LDA(At, 1, 1); PG8_STAGE(PG8_SA(1, 0), a3, voffA);
            PG8_BAR; PG8_WAIT_L(0); PG8_MMA(1, 0, At, B0); PG8_BAR; PG8_SCHED;
            PG8_STAGE(PG8_SB(1, 1), b3 + hstep, voffB);
            PG8_WAIT_V(6); PG8_BAR; PG8_MMA(1, 1, At, B1); PG8_BAR;
            }
        }
        if constexpr (ALIGN_EPI) { if (wr == 0) PG8_BAR; }
        if constexpr (!Epi::AFTER_DRAIN) { E(acc, cur, wr, wc, fr, fq); S.done(cur); }
        if (!has_next) break;
#pragma unroll
        for (int a = 0; a < 2; ++a)
#pragma unroll
            for (int b = 0; b < 2; ++b)
#pragma unroll
                for (int m = 0; m < 4; ++m)
#pragma unroll
                    for (int n = 0; n < 2; ++n) acc[a][b][m][n] = (f32x4){0.f, 0.f, 0.f, 0.f};
        cur = nxt; cA = nA; cB = nB; ++ui; ntc = cur.nt ? cur.nt : nt;
        if constexpr (ALIGN_EPI) { if (wr == 1) PG8_BAR; }
    }
    PG8_WAIT_V(0);
    if constexpr (!ALIGN_EPI) { if (wr == 0) PG8_BAR; }
    PG8_BAR;
    if constexpr (Epi::AFTER_DRAIN) { E.fused(acc, cur, wr, wc, fr, fq, lds, wid, lane); S.done(cur); }
#undef PG8_SA
#undef PG8_SB
#undef PG8_STAGE
#undef PG8_LDA
#undef PG8_LDB
#undef PG8_MMA
#undef PG8_WAIT_V
#undef PG8_WAIT_L
#undef PG8_BAR
#undef PG8_SCHED
}
}
namespace att {
using bf16 = __hip_bfloat16;
using bf16x8 = __attribute__((ext_vector_type(8))) short;
using s16x4  = __attribute__((ext_vector_type(4))) short;
using f32x16 = __attribute__((ext_vector_type(16))) float;
using u32x4  = __attribute__((ext_vector_type(4))) unsigned;
constexpr int D = 128, NW = 8, QBLK = 32, KVBLK = 64;
constexpr int LDR = 6144;
constexpr size_t SHM_V = KVBLK * D * 2, SHM_K = KVBLK * D * 2, SHM_ATTN = 2 * SHM_V + 2 * SHM_K + NW * 64 * 4;
#define KSWZ(row, colB) ((row) * 256 + ((colB) ^ (((row) & 7) << 4)))
#define SBAR() __builtin_amdgcn_sched_barrier(0)
__device__ __forceinline__ int crow(int r, int hi) { return (r & 3) + 8 * (r >> 2) + 4 * hi; }
__device__ __forceinline__ unsigned cvtpk(float lo, float hi) { unsigned r; asm volatile("v_cvt_pk_bf16_f32 %0, %1, %2" : "=v"(r) : "v"(lo), "v"(hi)); return r; }
__device__ __forceinline__ unsigned short f2bf1(float x) { return (unsigned short)(cvtpk(x, x) & 0xffffu); }
#define PK4(P, BASE, OUT) do { unsigned a0 = cvtpk(P[BASE + 0], P[BASE + 1]), a1 = cvtpk(P[BASE + 2], P[BASE + 3]);   \
    unsigned b0 = cvtpk(P[BASE + 4], P[BASE + 5]), b1 = cvtpk(P[BASE + 6], P[BASE + 7]);                              \
    auto r0 = __builtin_amdgcn_permlane32_swap(a0, b0, false, false); auto r1 = __builtin_amdgcn_permlane32_swap(a1, b1, false, false); \
    u32x4 w = {r0[0], r1[0], r0[1], r1[1]}; OUT = *reinterpret_cast<bf16x8*>(&w); } while (0)

template <int SCALE_E6>
struct SM {
    static constexpr float SCALE = SCALE_E6 == 125000 ? 0.125f : 0.088388347648318440f;
    static constexpr float THR = 8.f;
    static __device__ __forceinline__ void partialSM(f32x16& p0, f32x16& p1, float& m_reg, float& mn, float& alpha) {
        constexpr float C = SCALE * 1.4426950408889634f;
        float pmax = p0[0];
#pragma unroll
        for (int r = 1; r < 16; ++r) pmax = fmaxf(pmax, p0[r]);
#pragma unroll
        for (int r = 0; r < 16; ++r) pmax = fmaxf(pmax, p1[r]);
        { auto rr = __builtin_amdgcn_permlane32_swap(__float_as_uint(pmax), __float_as_uint(pmax), false, false);
          pmax = fmaxf(__uint_as_float(rr[0]), __uint_as_float(rr[1])); }
        if (__builtin_expect(__all(pmax - m_reg <= THR / SCALE), 1)) { mn = m_reg; alpha = 1.f; }
        else { mn = fmaxf(m_reg, pmax); alpha = __builtin_amdgcn_exp2f((m_reg - mn) * C); m_reg = mn; }
        float mnC = -mn * C;
#pragma unroll
        for (int r = 0; r < 16; ++r) p0[r] = fmaf(p0[r], C, mnC);
#pragma unroll
        for (int r = 0; r < 16; ++r) p1[r] = fmaf(p1[r], C, mnC);
#pragma unroll
        for (int r = 0; r < 16; ++r) p0[r] = __builtin_amdgcn_exp2f(p0[r]);
    }
};
__device__ __forceinline__ void finishSM(f32x16& p0, f32x16& p1, float alpha, float& l_reg, bf16x8& pa0, bf16x8& pa1, bf16x8& pa2, bf16x8& pa3) {
#pragma unroll
    for (int r = 0; r < 16; ++r) p1[r] = __builtin_amdgcn_exp2f(p1[r]);
    float ps = 0;
#pragma unroll
    for (int r = 0; r < 16; ++r) ps += p0[r];
#pragma unroll
    for (int r = 0; r < 16; ++r) ps += p1[r];
    { auto rr = __builtin_amdgcn_permlane32_swap(__float_as_uint(ps), __float_as_uint(ps), false, false);
      ps = __uint_as_float(rr[0]) + __uint_as_float(rr[1]); }
    l_reg = l_reg * alpha + ps;
    PK4(p0, 0, pa0); PK4(p0, 8, pa1); PK4(p1, 0, pa2); PK4(p1, 8, pa3);
}
template <int ND0>
__device__ __forceinline__ void qkt(f32x16& p0, f32x16& p1, const bf16* Ks, const bf16x8* qr, int dbase, int r32, int hi) {
    p0 = f32x16{}; p1 = f32x16{};
#pragma unroll
    for (int d0 = 0; d0 < ND0; ++d0) { int cb = ((dbase + d0) * 16 + hi * 8) * 2;
        bf16x8 b0 = *reinterpret_cast<const bf16x8*>((const char*)Ks + KSWZ(r32, cb));
        bf16x8 b1 = *reinterpret_cast<const bf16x8*>((const char*)Ks + KSWZ(32 + r32, cb));
        p0 = __builtin_amdgcn_mfma_f32_32x32x16_bf16(b0, qr[d0], p0, 0, 0, 0);
        p1 = __builtin_amdgcn_mfma_f32_32x32x16_bf16(b1, qr[d0], p1, 0, 0, 0); }
}
__device__ __forceinline__ int v_st(int k, int c) { const int kk = (k & ~0xC) | ((k & 4) << 1) | ((k & 8) >> 1); return ((kk >> 3) * 4 + (c >> 5)) * 512 + ((kk & 7) * 32 + (c & 31)) * 2; }
__device__ __forceinline__ int v_rd_base(int lane) { return ((lane & 3) << 3) | (((lane >> 2) & 3) << 6) | (((lane >> 4) & 1) << 5) | (((lane >> 5) & 1) << 8); }
constexpr int v_rd_off(int d0, int ks, int half) { return d0 * 512 + ks * 4096 + half * 2048; }
template <int OFF> __device__ __forceinline__ s16x4 tr_read(int vb) {
    s16x4 r; asm volatile("ds_read_b64_tr_b16 %0, %1 offset:%2" : "=&v"(r) : "v"(vb), "i"(OFF) : "memory"); return r;
}
#define PKV(L, H) (bf16x8){L[0], L[1], L[2], L[3], H[0], H[1], H[2], H[3]}
template <int D0> __device__ __forceinline__ void pv_one(f32x16& od, int vb, bf16x8 pa0, bf16x8 pa1, bf16x8 pa2, bf16x8 pa3) {
    const s16x4 l0 = tr_read<v_rd_off(D0, 0, 0)>(vb), h0 = tr_read<v_rd_off(D0, 0, 1)>(vb), l1 = tr_read<v_rd_off(D0, 1, 0)>(vb), h1 = tr_read<v_rd_off(D0, 1, 1)>(vb);
    const s16x4 l2 = tr_read<v_rd_off(D0, 2, 0)>(vb), h2 = tr_read<v_rd_off(D0, 2, 1)>(vb), l3 = tr_read<v_rd_off(D0, 3, 0)>(vb), h3 = tr_read<v_rd_off(D0, 3, 1)>(vb);
    asm volatile("s_waitcnt lgkmcnt(0)" ::: "memory"); SBAR();
    od = __builtin_amdgcn_mfma_f32_32x32x16_bf16(pa0, PKV(l0, h0), od, 0, 0, 0);
    od = __builtin_amdgcn_mfma_f32_32x32x16_bf16(pa1, PKV(l1, h1), od, 0, 0, 0);
    od = __builtin_amdgcn_mfma_f32_32x32x16_bf16(pa2, PKV(l2, h2), od, 0, 0, 0);
    od = __builtin_amdgcn_mfma_f32_32x32x16_bf16(pa3, PKV(l3, h3), od, 0, 0, 0);
}
__device__ __forceinline__ void pv_d0(f32x16* o, int vb, bf16x8 pa0, bf16x8 pa1, bf16x8 pa2, bf16x8 pa3) {
    pv_one<0>(o[0], vb, pa0, pa1, pa2, pa3); pv_one<1>(o[1], vb, pa0, pa1, pa2, pa3); pv_one<2>(o[2], vb, pa0, pa1, pa2, pa3); pv_one<3>(o[3], vb, pa0, pa1, pa2, pa3);
}
template <int D0> __device__ __forceinline__ void pv_one32(f32x16& od, int vb, bf16x8 pa0, bf16x8 pa1) {
    const s16x4 l0 = tr_read<v_rd_off(D0, 0, 0)>(vb), h0 = tr_read<v_rd_off(D0, 0, 1)>(vb), l1 = tr_read<v_rd_off(D0, 1, 0)>(vb), h1 = tr_read<v_rd_off(D0, 1, 1)>(vb);
    asm volatile("s_waitcnt lgkmcnt(0)" ::: "memory"); SBAR();
    od = __builtin_amdgcn_mfma_f32_32x32x16_bf16(pa0, PKV(l0, h0), od, 0, 0, 0);
    od = __builtin_amdgcn_mfma_f32_32x32x16_bf16(pa1, PKV(l1, h1), od, 0, 0, 0);
}

typedef float f32x4c __attribute__((ext_vector_type(4)));
struct ConvJob {
    const float *w_gate, *w_up, *w_down, *w_out, *g_ffn; unsigned short *WGU, *WDN, *WOUT;
    int next, end, stride;
};
struct ConvItem { const float* W; unsigned short* dst; int N, K, k0, n0, drow; };
constexpr int CV_GU = 32 * 88, CV_OUT = 32 * 32, CV_TOTAL = 2 * CV_GU + CV_OUT;
__device__ __forceinline__ ConvItem conv_item(const float* Jw_gate, const float* Jw_up, const float* Jw_down, const float* Jw_out, unsigned short* JWGU, unsigned short* JWDN, unsigned short* JWOUT, int q) {
    ConvItem it;
    const bool gu = q < 2 * CV_GU; const int up = (q >= CV_GU) ? 1 : 0;
    const int rg = q - up * CV_GU, kbg = rg / 88, nbg = rg - kbg * 88;
    const int rd = gu ? 0 : q - 2 * CV_GU, kbd = rd >> 5, nbd = rd & 31;
    it.W = gu ? (up ? Jw_up : Jw_gate) : Jw_out;
    it.dst = gu ? JWGU : JWOUT;
    it.N = gu ? 5632 : 2048; it.K = 2048;
    it.k0 = 64 * (gu ? kbg : kbd); it.n0 = 64 * (gu ? nbg : nbd);
    it.drow = gu ? 256 * (it.n0 >> 7) + 128 * up + (it.n0 & 127) : it.n0;
    return it;
}
__device__ __forceinline__ void attn_dense_body(const bf16* __restrict__ Qb, const bf16* __restrict__ Kh, const bf16* __restrict__ Vh,
                                                unsigned short* __restrict__ Ob, int ldo, int dbase, int seq, char* lds, const int wave_in, ConvJob& cj,
                                                const bool second, unsigned short* __restrict__ Yb, const float lam, const float* __restrict__ subln) {
    using S8 = SM<125000>;
    const int wid = wave_in, lane = mk_lane(), tid = wid * 64 + lane, r32 = lane & 31, hi = lane >> 5;
    bf16* V_lds = (bf16*)lds; bf16* K_lds = (bf16*)(lds + 2 * SHM_V);
    float* ws = (float*)(lds + 2 * SHM_V + 2 * SHM_K) + wid * 64; float* li_l = ws; float* al_l = ws + 32;
    float m_reg = -1e30f, l_reg = 0; f32x16 o[4] = {}; bf16x8 qr[4];
    const bf16* Qw = Qb + (long)(wid * QBLK + r32) * LDR + dbase * 16 + hi * 8;
#pragma unroll
    for (int d0 = 0; d0 < 4; ++d0) qr[d0] = *reinterpret_cast<const bf16x8*>(Qw + d0 * 16);
    const int sr = tid >> 4, sc = (tid & 15) * 8, vst0 = v_st(sr, sc), vst1 = v_st(32 + sr, sc);
    const int vb0 = (int)(uintptr_t)V_lds + v_rd_base(lane);
    struct { bf16x8 vs0, vs1, ks0; } sr_[2];
    const int krow = tid >> 3, kcol = dbase * 16 + (tid & 7) * 8, kst0 = KSWZ(krow, kcol * 2);
#define SLOAD(i, k0) do { sr_[i].vs0 = *reinterpret_cast<const bf16x8*>(&Vh[(long)((k0) + sr) * LDR + sc]); sr_[i].vs1 = *reinterpret_cast<const bf16x8*>(&Vh[(long)((k0) + 32 + sr) * LDR + sc]); \
    sr_[i].ks0 = *reinterpret_cast<const bf16x8*>(&Kh[(long)((k0) + krow) * LDR + kcol]); } while (0)
#define SWRITE(b, i) do { *(bf16x8*)((char*)V_lds + (b) * SHM_V + vst0) = sr_[i].vs0;          \
    *(bf16x8*)((char*)V_lds + (b) * SHM_V + vst1) = sr_[i].vs1;                              \
    *(bf16x8*)((char*)K_lds + (b) * SHM_K + kst0) = sr_[i].ks0; } while (0)
#define SWAIT() do {} while (0)
#define RESC(a) do { if (__any((a) < 1.f)) { if (hi == 0) al_l[r32] = (a); asm volatile("s_waitcnt lgkmcnt(0)" ::: "memory"); \
    _Pragma("unroll") for (int d = 0; d < 4; ++d) _Pragma("unroll") for (int r = 0; r < 16; ++r) o[d][r] *= al_l[crow(r, hi)]; } } while (0)
    f32x16 pA0, pA1, pB0, pB1; float mnA, mnB, alA, alB; bf16x8 pa0, pa1, pa2, pa3; const int NT = seq / KVBLK;
    const float* const jwg = cj.w_gate; const float* const jwu = cj.w_up; const float* const jwd = cj.w_down; const float* const jwo = cj.w_out;
    unsigned short* const jGU = cj.WGU; unsigned short* const jDN = cj.WDN; unsigned short* const jOUT = cj.WOUT; const int jnext = cj.next, jend = cj.end, jstride = cj.stride;
    float* cscr = (float*)(lds + SHM_ATTN); f32x4c cv0, cv1; int slot = 0;
#define CV_Q(k) (min(jnext + (k) * jstride, jend))
#define CV_LOAD(q) do { const ConvItem it_ = conv_item(jwg, jwu, jwd, jwo, jGU, jDN, jOUT, (q)); const float* s_ = it_.W + (size_t)(it_.k0 + (tid >> 3)) * it_.N + it_.n0 + 8 * (tid & 7); \
    cv0 = __builtin_nontemporal_load((const f32x4c*)s_); cv1 = __builtin_nontemporal_load((const f32x4c*)(s_ + 4)); } while (0)
#define CV_WRITE() do { f32x4c* d_ = (f32x4c*)(cscr + (tid >> 3) * 64 + 8 * ((tid & 7) ^ ((tid >> 6) & 7))); d_[0] = cv0; d_[1] = cv1; } while (0)
#define CV_STORE(q) do { const ConvItem it_ = conv_item(jwg, jwu, jwd, jwo, jGU, jDN, jOUT, (q)); const int n_ = tid >> 3, c_ = tid & 7; const float* s_ = cscr + (8 * c_) * 64 + (n_ ^ (8 * c_)); \
    u32x4 o_; o_.x = cvtpk(s_[0], s_[64]); o_.y = cvtpk(s_[128], s_[192]); o_.z = cvtpk(s_[256], s_[320]); o_.w = cvtpk(s_[384], s_[448]); \
    *(u32x4*)(it_.dst + (size_t)(it_.drow + n_) * it_.K + it_.k0 + 8 * c_) = o_; } while (0)
#define CV_CONSUME() do { CV_WRITE(); const int qn_ = CV_Q(slot + 1); CV_LOAD(qn_); } while (0)
#define CV_FINISH() do { const int qc_ = CV_Q(slot); CV_STORE(qc_); ++slot; } while (0)
    const int owed = (jnext > jend) ? 0 : (jend - jnext) / jstride + 1;
    const int ctrips = min((owed + 1) >> 1, (NT - 2) >> 1);
    if (ctrips > 0) { const int q0_ = CV_Q(0); CV_LOAD(q0_); }
    constexpr int SE = 0, SO = 1;
    SLOAD(SE, 0); asm volatile("s_waitcnt vmcnt(0)" ::: "memory"); SWRITE(0, SE); __syncthreads();
    qkt<4>(pA0, pA1, K_lds, qr, dbase, r32, hi); S8::partialSM(pA0, pA1, m_reg, mnA, alA);
    SLOAD(SO, KVBLK); if (2 < NT) SLOAD(SE, 2 * KVBLK);
    SWAIT(); SWRITE(1, SO); __syncthreads();
#define B_TRIP(CONV) do { \
        SBAR(); qkt<4>(pB0, pB1, (bf16*)((char*)K_lds + SHM_K), qr, dbase, r32, hi); \
        finishSM(pA0, pA1, alA, l_reg, pa0, pa1, pa2, pa3); SBAR(); \
        SLOAD(SO, (j + 2) * KVBLK); SBAR(); \
        pv_d0(o, vb0, pa0, pa1, pa2, pa3); S8::partialSM(pB0, pB1, m_reg, mnB, alB); \
        __syncthreads(); SWAIT(); SWRITE(0, SE); \
        if (CONV) CV_CONSUME(); \
        RESC(alB); __syncthreads(); \
        if (CONV) CV_FINISH(); \
        SBAR(); qkt<4>(pA0, pA1, K_lds, qr, dbase, r32, hi); \
        finishSM(pB0, pB1, alB, l_reg, pa0, pa1, pa2, pa3); SBAR(); \
        SLOAD(SE, min(j + 3, NT - 1) * KVBLK); SBAR();     \
        pv_d0(o, vb0 + (int)SHM_V, pa0, pa1, pa2, pa3); S8::partialSM(pA0, pA1, m_reg, mnA, alA); \
        __syncthreads(); SWAIT(); SWRITE(1, SO); \
        if (CONV) CV_CONSUME(); \
        RESC(alA); __syncthreads(); \
        if (CONV) CV_FINISH(); } while (0)
    int j = 1;
    for (int tr = 0; tr < ctrips; ++tr, j += 2) B_TRIP(true);
    for (; j + 1 < NT; j += 2) B_TRIP(false);
#undef B_TRIP
    cj.next = min(jnext + slot * jstride, jend + jstride);
    SBAR(); qkt<4>(pB0, pB1, (bf16*)((char*)K_lds + SHM_K), qr, dbase, r32, hi);
    finishSM(pA0, pA1, alA, l_reg, pa0, pa1, pa2, pa3); SBAR();
    pv_d0(o, vb0, pa0, pa1, pa2, pa3); S8::partialSM(pB0, pB1, m_reg, mnB, alB);
    __syncthreads(); RESC(alB);
    finishSM(pB0, pB1, alB, l_reg, pa0, pa1, pa2, pa3); SBAR();
    pv_d0(o, vb0 + (int)SHM_V, pa0, pa1, pa2, pa3);
    if (hi == 0) li_l[r32] = l_reg; asm volatile("s_waitcnt lgkmcnt(0)" ::: "memory");
    float rli[16];
#pragma unroll
    for (int r = 0; r < 16; ++r) rli[r] = __builtin_amdgcn_rcpf(li_l[crow(r, hi)]);
    unsigned short* Ow = (unsigned short*)(lds + SHM_ATTN + 16384) + wid * 4096;
    if (!second) {
#pragma unroll
        for (int r = 0; r < 16; ++r) { int orow = crow(r, hi);
#pragma unroll
            for (int d0 = 0; d0 < 4; ++d0) Ow[orow * 128 + d0 * 32 + r32] = f2bf1(o[d0][r] * rli[r]); }
        asm volatile("s_waitcnt lgkmcnt(0)" ::: "memory");
    } else {
        float ssq[16];
#pragma unroll
        for (int r = 0; r < 16; ++r) { const int orow = crow(r, hi); ssq[r] = 0.f;
#pragma unroll
            for (int d0 = 0; d0 < 4; ++d0) { const float o0 = __uint_as_float((unsigned)Ow[orow * 128 + d0 * 32 + r32] << 16);
                const float d = o0 - lam * (o[d0][r] * rli[r]); o[d0][r] = d; ssq[r] += d * d; } }
#pragma unroll
        for (int r = 0; r < 16; ++r) { float v = ssq[r]; v += __shfl_xor(v, 1); v += __shfl_xor(v, 2); v += __shfl_xor(v, 4); v += __shfl_xor(v, 8); v += __shfl_xor(v, 16); ssq[r] = v; }
        float sl[4];
#pragma unroll
        for (int d0 = 0; d0 < 4; ++d0) sl[d0] = subln[d0 * 32 + r32] * 0.8f;
        unsigned short* Yw = Yb + (long)(wid * QBLK) * 2048;
#pragma unroll
        for (int r = 0; r < 16; ++r) { const int orow = crow(r, hi); const float rs = 1.0f / sqrtf(ssq[r] * (1.0f / 128.0f) + 1e-5f);
#pragma unroll
            for (int d0 = 0; d0 < 4; ++d0) Ow[orow * 128 + d0 * 32 + r32] = f2bf1(o[d0][r] * rs * sl[d0]); }
        asm volatile("s_waitcnt lgkmcnt(0)" ::: "memory");
#pragma unroll
        for (int i = 0; i < 8; ++i) { const int idx = i * 64 + lane, row = idx >> 4, ch = idx & 15;
            const u32x4 v = *(const u32x4*)(Ow + row * 128 + ch * 8);
            *(u32x4*)(Yw + (long)row * 2048 + ch * 8) = v; }
        asm volatile("s_waitcnt lgkmcnt(0)" ::: "memory");
    }
#undef CV_LOAD
#undef CV_Q
#undef CV_STORE
#undef CV_WRITE
#undef CV_CONSUME
#undef CV_FINISH
#undef SLOAD
#undef SWRITE
#undef SWAIT
#undef RESC
}

__device__ __forceinline__ void swa_wave_unit(const bf16* __restrict__ base, long rstride, int qc, int kc, int vc, int t0, int L,
                                              unsigned short* __restrict__ Ob, long ostride, float* __restrict__ Lb, long lstride, char* lds_w, float* scr) {
    constexpr float SCALE = 0.088388347648318440f, C = SCALE * 1.4426950408889634f;
    const int lane = mk_lane(), r32 = lane & 31, hi = lane >> 5;
    bf16* K_lds = (bf16*)lds_w; char* V_lds = lds_w + 8192;
    bf16x8 qr[8];
    { const bf16* Qw = base + (long)(t0 + r32) * rstride + qc + hi * 8;
#pragma unroll
      for (int d0 = 0; d0 < 8; ++d0) qr[d0] = *reinterpret_cast<const bf16x8*>(Qw + d0 * 16); }
    const int srow = lane >> 4, scol = (lane & 15) * 8;
    const bf16* kbase = base + (long)srow * rstride + kc + scol; const bf16* vbase = base + (long)srow * rstride + vc + scol;
    bf16x8 st[2][8];
#define TILE_K0(i) (t0 - 64 + 32 * (i))
#define TILE_OK(i) (TILE_K0(i) >= 0 && TILE_K0(i) < L)
#define TILE_KC(i) (min(max(TILE_K0(i), 0), L - 32))
#define LD_TILE(buf, pbase, i) do { const bf16* p_ = (pbase) + (long)TILE_KC(i) * rstride; _Pragma("unroll") for (int j = 0; j < 8; ++j) st[buf][j] = *reinterpret_cast<const bf16x8*>(p_ + (long)(4 * j) * rstride); } while (0)
    f32x16 s[5];
    LD_TILE(0, kbase, 0);
#pragma unroll
    for (int i = 0; i < 5; ++i) {
        if (i < 4) LD_TILE((i + 1) & 1, kbase, i + 1); else LD_TILE((i + 1) & 1, vbase, 0);
#pragma unroll
        for (int j = 0; j < 8; ++j) *(bf16x8*)((char*)K_lds + KSWZ(4 * j + srow, scol * 2)) = st[i & 1][j];
        f32x16 p = f32x16{};
#pragma unroll
        for (int d0 = 0; d0 < 8; ++d0) { const int cb = (d0 * 16 + hi * 8) * 2;
            const bf16x8 b0 = *reinterpret_cast<const bf16x8*>((const char*)K_lds + KSWZ(r32, cb));
            p = __builtin_amdgcn_mfma_f32_32x32x16_bf16(b0, qr[d0], p, 0, 0, 0); }
        const bool ok = TILE_OK(i);
#pragma unroll
        for (int r = 0; r < 16; ++r) {
            bool keep = ok;
            if (i == 0) keep = keep && (crow(r, hi) >= r32);
            if (i == 4) keep = keep && (crow(r, hi) <= r32);
            s[i][r] = keep ? p[r] : -1e30f;
        }
    }
    float m = -1e30f;
#pragma unroll
    for (int i = 0; i < 5; ++i)
#pragma unroll
        for (int r = 0; r < 16; ++r) m = fmaxf(m, s[i][r]);
    { auto rr = __builtin_amdgcn_permlane32_swap(__float_as_uint(m), __float_as_uint(m), false, false);
      m = fmaxf(__uint_as_float(rr[0]), __uint_as_float(rr[1])); }
    const float mC = -m * C; float l = 0.f;
#pragma unroll
    for (int i = 0; i < 5; ++i)
#pragma unroll
        for (int r = 0; r < 16; ++r) { s[i][r] = __builtin_amdgcn_exp2f(fmaf(s[i][r], C, mC)); l += s[i][r]; }
    { auto rr = __builtin_amdgcn_permlane32_swap(__float_as_uint(l), __float_as_uint(l), false, false);
      l = __uint_as_float(rr[0]) + __uint_as_float(rr[1]); }
    bf16x8 pa[5][2];
#pragma unroll
    for (int i = 0; i < 5; ++i) { PK4(s[i], 0, pa[i][0]); PK4(s[i], 8, pa[i][1]); }
    f32x16 o[4] = {};
    const int vb = (int)(uintptr_t)V_lds + v_rd_base(lane);
#pragma unroll
    for (int i = 0; i < 5; ++i) {
        if (i < 4) LD_TILE(i & 1, vbase, i + 1);
#pragma unroll
        for (int j = 0; j < 8; ++j) *(bf16x8*)(V_lds + v_st(4 * j + srow, scol)) = st[(i + 1) & 1][j];
        asm volatile("s_waitcnt lgkmcnt(0)" ::: "memory");
        pv_one32<0>(o[0], vb, pa[i][0], pa[i][1]); pv_one32<1>(o[1], vb, pa[i][0], pa[i][1]); pv_one32<2>(o[2], vb, pa[i][0], pa[i][1]); pv_one32<3>(o[3], vb, pa[i][0], pa[i][1]);
    }
#undef TILE_K0
#undef TILE_OK
#undef TILE_KC
#undef LD_TILE
    if (hi == 0) { scr[r32] = l; Lb[(long)(t0 + r32) * lstride] = m * SCALE + __logf(l); }
    asm volatile("s_waitcnt lgkmcnt(0)" ::: "memory");
    float rli[16];
#pragma unroll
    for (int r = 0; r < 16; ++r) rli[r] = __builtin_amdgcn_rcpf(scr[crow(r, hi)]);
#pragma unroll
    for (int r = 0; r < 16; ++r) { const long orow = (long)(t0 + crow(r, hi)) * ostride;
#pragma unroll
        for (int d0 = 0; d0 < 4; ++d0) Ob[orow + d0 * 32 + r32] = f2bf1(o[d0][r] * rli[r]); }
    asm volatile("s_waitcnt lgkmcnt(0)" ::: "memory");
}
__device__ __forceinline__ void swa_wg_unit(const bf16* __restrict__ QKVb, int gbr, int sub0, int qt0, int sstep, unsigned short* __restrict__ OAg, float* __restrict__ LSEg, char* lds, float* scr, const int wid) {
    constexpr float SCALE = 0.088388347648318440f, C = SCALE * 1.4426950408889634f;
    const int lane = mk_lane(), tid = wid * 64 + lane, r32 = lane & 31, hi = lane >> 5;
    const int dsh = 2 * gbr, dil = 1 << dsh, L = 2048 >> dsh, nblk = L >> 5; const bool big = nblk >= 8;
    const long rstride = (long)dil * LDR;
#define SUB_BASE(sub) (QKVb + ((size_t)((sub) >> (3 + dsh)) * 2048 + (((sub) >> 3) & (dil - 1))) * LDR + ((sub) & 7) * 128)
    const int srow = tid >> 4, scol = (tid & 15) * 8;
    bf16x8 kst[12], vst[12];
#pragma unroll
    for (int sl = 0; sl < 12; ++sl) {
        const int sub_s = big ? sub0 : sub0 + ((sl >> 2) & 1) * sstep; const int kt_s = big ? min(max(qt0 - 2 + sl, 0), nblk - 1) : (sl & 3);
        const bf16* p_ = SUB_BASE(sub_s) + (long)(kt_s * 32 + srow) * rstride + scol;
        kst[sl] = *reinterpret_cast<const bf16x8*>(p_ + 1024);
    }
    const int sub_w = big ? sub0 : sub0 + (wid >> 2) * sstep; const int qt = big ? qt0 + wid : (wid & 3); const int t0 = qt * 32;
    const bf16* base_w = SUB_BASE(sub_w);
    bf16x8 qr[8];
    { const bf16* Qw = base_w + (long)(t0 + r32) * rstride + hi * 8;
#pragma unroll
      for (int d0 = 0; d0 < 8; ++d0) qr[d0] = *reinterpret_cast<const bf16x8*>(Qw + d0 * 16); }
#pragma unroll
    for (int sl = 0; sl < 12; ++sl) *(bf16x8*)(lds + sl * 8192 + KSWZ(srow, scol * 2)) = kst[sl];
#pragma unroll
    for (int sl = 0; sl < 12; ++sl) {
        const int sub_s = big ? sub0 : sub0 + ((sl >> 2) & 1) * sstep; const int kt_s = big ? min(max(qt0 - 2 + sl, 0), nblk - 1) : (sl & 3);
        const bf16* p_ = SUB_BASE(sub_s) + (long)(kt_s * 32 + srow) * rstride + scol;
        vst[sl] = *reinterpret_cast<const bf16x8*>(p_ + 2048);
    }
    __syncthreads();
    f32x16 s[5];
#pragma unroll
    for (int i = 0; i < 5; ++i) {
        const int kt = qt - 2 + i; const bool ok = kt >= 0 && kt < nblk;
        const int slot = big ? wid + i : 4 * (wid >> 2) + min(max(kt, 0), 3);
        const char* Ks = lds + slot * 8192;
        f32x16 p = f32x16{};
#pragma unroll
        for (int d0 = 0; d0 < 8; ++d0) { const int cb = (d0 * 16 + hi * 8) * 2;
            const bf16x8 b0 = *reinterpret_cast<const bf16x8*>(Ks + KSWZ(r32, cb));
            p = __builtin_amdgcn_mfma_f32_32x32x16_bf16(b0, qr[d0], p, 0, 0, 0); }
#pragma unroll
        for (int r = 0; r < 16; ++r) {
            bool keep = ok;
            if (i == 0) keep = keep && (crow(r, hi) >= r32);
            if (i == 4) keep = keep && (crow(r, hi) <= r32);
            s[i][r] = keep ? p[r] : -1e30f;
        }
    }
    float m = -1e30f;
#pragma unroll
    for (int i = 0; i < 5; ++i)
#pragma unroll
        for (int r = 0; r < 16; ++r) m = fmaxf(m, s[i][r]);
    { auto rr = __builtin_amdgcn_permlane32_swap(__float_as_uint(m), __float_as_uint(m), false, false);
      m = fmaxf(__uint_as_float(rr[0]), __uint_as_float(rr[1])); }
    const float mC = -m * C; float l = 0.f;
#pragma unroll
    for (int i = 0; i < 5; ++i)
#pragma unroll
        for (int r = 0; r < 16; ++r) { s[i][r] = __builtin_amdgcn_exp2f(fmaf(s[i][r], C, mC)); l += s[i][r]; }
    { auto rr = __builtin_amdgcn_permlane32_swap(__float_as_uint(l), __float_as_uint(l), false, false);
      l = __uint_as_float(rr[0]) + __uint_as_float(rr[1]); }
    bf16x8 pa[5][2];
#pragma unroll
    for (int i = 0; i < 5; ++i) { PK4(s[i], 0, pa[i][0]); PK4(s[i], 8, pa[i][1]); }
    __syncthreads();
#pragma unroll
    for (int sl = 0; sl < 12; ++sl) *(bf16x8*)(lds + sl * 8192 + v_st(srow, scol)) = vst[sl];
    __syncthreads();
    f32x16 o[4] = {};
#pragma unroll
    for (int i = 0; i < 5; ++i) {
        const int kt = qt - 2 + i;
        const int slot = big ? wid + i : 4 * (wid >> 2) + min(max(kt, 0), 3);
        const int vb = (int)(uintptr_t)(lds + slot * 8192) + v_rd_base(lane);
        pv_one32<0>(o[0], vb, pa[i][0], pa[i][1]); pv_one32<1>(o[1], vb, pa[i][0], pa[i][1]); pv_one32<2>(o[2], vb, pa[i][0], pa[i][1]); pv_one32<3>(o[3], vb, pa[i][0], pa[i][1]);
    }
    const size_t tok0 = ((size_t)(sub_w >> (3 + dsh)) * 2048 + ((sub_w >> 3) & (dil - 1))); const int hh = sub_w & 7;
    if (hi == 0) { scr[r32] = l; LSEg[(tok0 + (size_t)(t0 + r32) * dil) * 8 + hh] = m * SCALE + __logf(l); }
    asm volatile("s_waitcnt lgkmcnt(0)" ::: "memory");
    float rli[16];
#pragma unroll
    for (int r = 0; r < 16; ++r) rli[r] = __builtin_amdgcn_rcpf(scr[crow(r, hi)]);
    { unsigned short* stg = (unsigned short*)(lds + 98304) + wid * 2048;
#pragma unroll
      for (int ps = 0; ps < 2; ++ps) {
#pragma unroll
        for (int r = 8 * ps; r < 8 * ps + 8; ++r) { const int sr_ = crow(r, hi) - 16 * ps;
#pragma unroll
            for (int d0 = 0; d0 < 4; ++d0) stg[sr_ * 128 + d0 * 32 + r32] = f2bf1(o[d0][r] * rli[r]); }
        asm volatile("s_waitcnt lgkmcnt(0)" ::: "memory");
#pragma unroll
        for (int i = 0; i < 4; ++i) { const int idx = i * 64 + lane, row = idx >> 4, ch = idx & 15;
            const u32x4 v = *(const u32x4*)(stg + row * 128 + ch * 8);
            *(u32x4*)(OAg + (tok0 + (size_t)(t0 + 16 * ps + row) * dil) * 1024 + hh * 128 + ch * 8) = v; }
        asm volatile("s_waitcnt lgkmcnt(0)" ::: "memory");
      } }
    asm volatile("s_waitcnt lgkmcnt(0)" ::: "memory");
    __syncthreads();
#undef SUB_BASE
}
#undef SBAR
}
#ifndef MK_DUP_PHASE
#define MK_DUP_PHASE -1
#endif
#define NREP(k) (1 + (MK_DUP_PHASE == (k) ? 1 : 0))
#ifndef WGM_P1
#define WGM_P1 4
#endif
#ifndef WGM_P4
#define WGM_P4 8
#endif
#ifndef WGM_P5
#define WGM_P5 2
#endif
#ifndef WGM_P6
#define WGM_P6 8
#endif
#ifndef MK_TIME_PHASE
#define MK_TIME_PHASE -1
#endif
#ifndef MK_ONE_LAUNCH
#define MK_ONE_LAUNCH 1
#endif
constexpr int NWAVES = 8;
constexpr int BATCH = 4, SEQ = 2048, DM = 2048, M = BATCH * SEQ, NIN = 6144, DFF = 5632, NGU = 2 * DFF, NHEAD = 8, HD = 128;
constexpr float RMS_EPS = 1e-6f, SUBLN_EPS = 1e-5f, LAM_INIT = 0.2f;
constexpr size_t MiB = 1u << 20;
constexpr size_t WS_SS1 = 0, WS_SS2 = 64 * 1024, WS_LSE = 1 * MiB;
constexpr size_t WS_QKV = 2 * MiB;
constexpr size_t WS_Y = 162 * MiB;
constexpr size_t WS_H = 34 * MiB;
constexpr size_t WS_WIN = 98 * MiB, WS_XN = 122 * MiB;
constexpr size_t WS_OA = 98 * MiB;
constexpr size_t WS_WOUT = 154 * MiB;
constexpr size_t WS_OB = 162 * MiB, WS_XG = 2 * MiB;
constexpr size_t WS_WGU = 194 * MiB, WS_WDN = 238 * MiB, WS_END = 260 * MiB;
static_assert(WS_H + (size_t)M * DFF * 2 <= WS_WOUT && WS_XG + (size_t)M * DM * 2 <= WS_H && WS_Y + (size_t)M * DM * 2 <= WS_WGU && WS_OA + (size_t)3 * M * 1024 * 2 <= WS_WOUT && WS_WDN + (size_t)DM * DFF * 2 <= WS_END && WS_WGU + (size_t)NGU * DM * 2 <= WS_WDN && WS_QKV + (size_t)M * NIN * 2 <= WS_WIN, "d_ws map");
constexpr int RING_BYTES = 131072, LDS_BYTES = 163840, MISC_OFF = 163584;
constexpr size_t WS_BAR = 128 * 1024, WS_CNT = 144 * 1024, WS_FLAG = 152 * 1024, WS_GRP = 160 * 1024, BAR_BYTES = 40 * 1024;

#define GAS __attribute__((address_space(1)))
#define LAS __attribute__((address_space(3)))
typedef unsigned short bf16;
typedef unsigned v4u __attribute__((ext_vector_type(4)));
typedef float f32x4 __attribute__((ext_vector_type(4)));
#define LDS_WAIT() asm volatile("s_waitcnt lgkmcnt(0)" ::: "memory")
__device__ __forceinline__ unsigned f2bf(float f) { unsigned u = __builtin_bit_cast(unsigned, f); return (u + 0x7fffu + ((u >> 16) & 1u)) >> 16; }
__device__ __forceinline__ unsigned pk2(float lo, float hi) { return f2bf(lo) | (f2bf(hi) << 16); }
__device__ __forceinline__ float bflo(unsigned w) { return __uint_as_float(w << 16); }
__device__ __forceinline__ float bfhi(unsigned w) { return __uint_as_float(w & 0xffff0000u); }
__device__ __forceinline__ float wave_sum(float v) {
#pragma unroll
    for (int o = 1; o < 64; o <<= 1) v += __shfl_xor(v, o);
    return v;
}
__device__ __forceinline__ void transpose_item(const float* W, int K, int N, bf16* WT, int k0, int n0, int dst_row0, LAS float* scr, int lane, const float* ks = nullptr) {
    float wv[32];
#pragma unroll
    for (int i = 0; i < 32; ++i) { const int kk = 2 * i + (lane >> 5); wv[i] = __builtin_nontemporal_load(W + (size_t)(k0 + kk) * N + n0 + (lane & 31)); }
#pragma unroll
    for (int i = 0; i < 32; ++i) { const int kk = 2 * i + (lane >> 5); scr[kk * 33 + (lane & 31)] = wv[i]; }
    LDS_WAIT(); asm volatile("" ::: "memory");
    const int c = lane & 7;
    f32x4 g0 = {1.f, 1.f, 1.f, 1.f}, g1 = {1.f, 1.f, 1.f, 1.f};
    if (ks) { g0 = *(const f32x4*)(ks + k0 + 8 * c); g1 = *(const f32x4*)(ks + k0 + 8 * c + 4); }
#pragma unroll
    for (int j = 0; j < 4; ++j) { const int n = (lane >> 3) + 8 * j; const LAS float* s = scr + (8 * c) * 33 + n;
        v4u o; o.x = pk2(s[0 * 33] * g0.x, s[1 * 33] * g0.y); o.y = pk2(s[2 * 33] * g0.z, s[3 * 33] * g0.w); o.z = pk2(s[4 * 33] * g1.x, s[5 * 33] * g1.y); o.w = pk2(s[6 * 33] * g1.z, s[7 * 33] * g1.w);
        *(GAS v4u*)(WT + (size_t)(dst_row0 + n) * K + k0 + 8 * c) = o; }
    LDS_WAIT(); asm volatile("" ::: "memory");
}

#define XB_TMO      128
#define XB_XCNT(j)  (256  + 64 * (j))
#define XB_XSUB(j)  (1280 + 64 * (j))
#define XB_XGEN(j)  (2304 + 64 * (j))
#define XB_TOP      3328
#define XB_TOPGEN   3392
#define XCD_BAR_WORDS 3456
#define XB_SPIN_CAP (1u << 18)

__device__ __forceinline__ unsigned xb_ld(unsigned* p)              { return __hip_atomic_load(p, __ATOMIC_RELAXED, __HIP_MEMORY_SCOPE_AGENT); }
__device__ __forceinline__ unsigned xb_add(unsigned* p, unsigned v) { return __hip_atomic_fetch_add(p, v, __ATOMIC_RELAXED, __HIP_MEMORY_SCOPE_AGENT); }
__device__ __forceinline__ unsigned xb_xcc_id() { return (unsigned)__builtin_amdgcn_s_getreg((3 << 11) | 20) & 0xFu; }
#define XB_SPIN(cond, bar) do { unsigned _sp = 0; while (cond) { __builtin_amdgcn_s_sleep(1); \
    if ((++_sp & 255u) == 0u) { if (xb_ld(&(bar)[XB_TMO])) break; if (_sp > XB_SPIN_CAP) { atomicAdd(&(bar)[XB_TMO], 1u); break; } } } } while (0)

struct XcdBarrier {
    unsigned* bar; unsigned x;
    volatile LAS unsigned* st;
};

__device__ __forceinline__ XcdBarrier xcd_barrier_post(unsigned* bar, volatile LAS unsigned* st, const int wave_in) {
    XcdBarrier b; b.bar = bar; b.x = xb_xcc_id(); b.st = st;
    if (wave_in == 0 && mk_lane() == 0) (void)xb_add(&bar[XB_XCNT(b.x)], 1u);
    return b;
}
__device__ __forceinline__ void xcd_barrier_complete(unsigned* bar, unsigned x, unsigned& nloc, unsigned& nx) {
    const unsigned G = gridDim.x * gridDim.y * gridDim.z;
    unsigned sum, cnt, mine, sp = 0u;
    for (;;) {
        sum = 0u; cnt = 0u; mine = 0u;
#pragma unroll
        for (unsigned j = 0; j < 16; ++j) { const unsigned c = xb_ld(&bar[XB_XCNT(j)]); sum += c; cnt += (c > 0u) ? 1u : 0u; mine = (j == x) ? c : mine; }
        if (sum == G) break;
        __builtin_amdgcn_s_sleep(1);
        if ((++sp & 255u) == 0u) { if (xb_ld(&bar[XB_TMO])) break; if (sp > XB_SPIN_CAP) { atomicAdd(&bar[XB_TMO], 1u); break; } }
    }
    nloc = mine > 0u ? mine : 1u; nx = cnt > 0u ? cnt : 1u;
}

__device__ __forceinline__ void xcd_barrier(const XcdBarrier& b, const int wave_in) {
    asm volatile("s_waitcnt vmcnt(0)" ::: "memory");
    __syncthreads();
    if (wave_in == 0 && mk_lane() == 0) {
        unsigned* bar = b.bar;
        __builtin_amdgcn_s_waitcnt(0);
        unsigned nloc = b.st[0], nx = b.st[1];
        if (nloc == 0u) { xcd_barrier_complete(bar, b.x, nloc, nx); b.st[0] = nloc; b.st[1] = nx; }
        const unsigned old = xb_add(&bar[XB_XSUB(b.x)], 1u);
        const unsigned gen = old / nloc;
        if (old + 1u == (gen + 1u) * nloc) {
            __builtin_amdgcn_fence(__ATOMIC_RELEASE, "agent");
            asm volatile("s_waitcnt vmcnt(0)" ::: "memory");
            const unsigned og = xb_add(&bar[XB_TOP], 1u);
            const unsigned tg = og / nx;
            if (og + 1u == (tg + 1u) * nx) xb_add(&bar[XB_TOPGEN], 1u);
            else XB_SPIN(xb_ld(&bar[XB_TOPGEN]) == tg, bar);
            __builtin_amdgcn_fence(__ATOMIC_ACQUIRE, "agent");
            xb_add(&bar[XB_XGEN(b.x)], 1u);
            asm volatile("s_waitcnt vmcnt(0)" ::: "memory");
        } else {
            XB_SPIN(xb_ld(&bar[XB_XGEN(b.x)]) == gen, bar);
            __builtin_amdgcn_fence(__ATOMIC_ACQUIRE, "agent");
            asm volatile("s_waitcnt vmcnt(0)" ::: "memory");
        }
    }
    __syncthreads();
}
struct Args { const float* in[11]; float* out; unsigned char* ws; int ph_lo, ph_hi; };
constexpr int NPHASE = 7;

__global__ void __launch_bounds__(NWAVES * 64, 2) mk_fwd(Args args) {
    extern __shared__ __attribute__((aligned(16))) unsigned char lds[];
    LAS unsigned char* ldsl = (LAS unsigned char*)lds;
    const int wave = __builtin_amdgcn_readfirstlane((int)threadIdx.x >> 6);
    const int G = gridDim.x, bx = blockIdx.x;
    const int vcu = (G % 8 == 0) ? (bx % 8) * (G / 8) + bx / 8 : bx;
    const int gw = vcu * NWAVES + wave, NGW = G * NWAVES;
    unsigned char* ws = args.ws;
    const float* x = args.in[0]; const float* g_attn = args.in[1]; const float* w_in = args.in[2]; const float* lambda_qk = args.in[3]; const float* subln = args.in[4];
    const float* w_out = args.in[5]; const float* g_ffn = args.in[6]; const float* w_gate = args.in[7]; const float* w_up = args.in[8]; const float* w_down = args.in[9];
    const float* g_final = args.in[10];
    float* out = args.out;
    float* SS1 = (float*)(ws + WS_SS1); float* SS2 = (float*)(ws + WS_SS2); float* LSE = (float*)(ws + WS_LSE);
    bf16* QKV = (bf16*)(ws + WS_QKV); bf16* WGU = (bf16*)(ws + WS_WGU); bf16* WDN = (bf16*)(ws + WS_WDN); bf16* HB = (bf16*)(ws + WS_H);
    bf16* WIN = (bf16*)(ws + WS_WIN); bf16* XN = (bf16*)(ws + WS_XN); bf16* OA = (bf16*)(ws + WS_OA); bf16* WOUT = (bf16*)(ws + WS_WOUT);
    bf16* OB = (bf16*)(ws + WS_OB); bf16* XG = (bf16*)(ws + WS_XG); bf16* Y = (bf16*)(ws + WS_Y);
    const int lo = args.ph_lo, hi_ph = args.ph_hi;
#define IN(k) (lo <= (k) && (k) < hi_ph)
    if (wave == 0) { const int l0 = mk_lane(); if (l0 < 32) ((LAS unsigned*)(ldsl + MISC_OFF))[l0] = 0u; }
    __syncthreads();
    XcdBarrier bar; bar.bar = (unsigned*)(ws + WS_BAR); bar.x = 0; bar.st = nullptr;
    if (hi_ph - lo > 1) bar = xcd_barrier_post((unsigned*)(ws + WS_BAR), (volatile LAS unsigned*)(ldsl + MISC_OFF), wave);
    if (lo < -1000) cg::this_grid().sync();
#define STAMP(k) do { if (MK_TIME_PHASE >= 0) { const unsigned long long t_ = __builtin_amdgcn_s_memrealtime(); if ((k) == MK_TIME_PHASE) tph0 = t_; if ((k) == MK_TIME_PHASE + 1) tph1 = t_; } } while (0)
    unsigned long long tph0 = 0, tph1 = 0; STAMP(0);
#define SEAM(k) do { if (IN(k) && IN((k) + 1)) { for (int rb = 0; rb < (MK_DUP_PHASE == 30 ? 3 : 1); ++rb) xcd_barrier(bar, wave); } } while (0)

    if (IN(0)) for (int rep = 0; rep < NREP(0); ++rep) { const int lane = mk_lane(), tid = wave * 64 + lane;
        LAS float* scr = (LAS float*)(ldsl + wave * 16384);
        constexpr int I_IN = (DM / 64) * (NIN / 32), I_OUT = (DM / 64) * (DM / 32);
        for (int it = gw; it < I_IN; it += NGW) {
            if (it < I_IN) { const int nblk = NIN / 32, kb = it / nblk, nb = it % nblk; transpose_item(w_in, DM, NIN, WIN, 64 * kb, 32 * nb, 32 * nb, scr, lane); }
            else { const int r = it - I_IN; const int nblk = DM / 32, kb = r / nblk, nb = r % nblk; transpose_item(w_out, DM, DM, WOUT, 64 * kb, 32 * nb, 32 * nb, scr, lane); }
        }
        for (int m = gw; m < M; m += NGW) {
            const GAS f32x4* xr = (const GAS f32x4*)(x + (size_t)m * DM) + lane;
            f32x4 v[8]; float s = 0.f;
#pragma unroll
            for (int j = 0; j < 8; ++j) { v[j] = __builtin_nontemporal_load(xr + 64 * j); s += (v[j].x * v[j].x + v[j].y * v[j].y) + (v[j].z * v[j].z + v[j].w * v[j].w); }
            const float rstd = 1.0f / sqrtf(wave_sum(s) * (1.f / DM) + RMS_EPS);
            GAS unsigned long long* o8 = (GAS unsigned long long*)(XN + (size_t)m * DM) + lane;
#pragma unroll
            for (int j = 0; j < 8; ++j) { const f32x4 gg = *((const GAS f32x4*)g_attn + lane + 64 * j);
                o8[64 * j] = (unsigned long long)pk2(v[j].x * rstd * gg.x, v[j].y * rstd * gg.y) | ((unsigned long long)pk2(v[j].z * rstd * gg.z, v[j].w * rstd * gg.w) << 32); }
        }
        for (int i = bx * (NWAVES * 64) + tid; i < M; i += G * NWAVES * 64) { SS1[i] = 0.f; SS2[i] = 0.f; }
    }
    SEAM(0); STAMP(1);
    if (IN(1)) {
        pg8::Gemm g{XN, WIN, M, NIN, DM}; pg8::StaticOrder S; S.init(M, NIN, G, bx); S.dup = NREP(1); S.wgm = WGM_P1;
        pg8::EpiQKV E{QKV, NIN};
        pg8::gemm_phase<pg8::EpiQKV, pg8::StaticOrder, true, true>(ldsl, g, S, E, wave);
    }
    SEAM(1); STAMP(2);
    if (IN(2)) { const int lane = mk_lane();
        float lam;
        { const float a = lambda_qk[lane] * lambda_qk[64 + lane], b2 = lambda_qk[128 + lane] * lambda_qk[192 + lane];
          lam = __expf(wave_sum(a)) - __expf(wave_sum(b2)) + LAM_INIT; }
        const int grp = vcu >> 3, k = vcu & 7, gb = grp >> 3, gh = grp & 7;
        const att::bf16* rowb = (const att::bf16*)QKV + (size_t)gb * SEQ * NIN;
        att::ConvJob cj{w_gate, w_up, w_down, w_out, g_ffn, WGU, WDN, WOUT, vcu, vcu + G * ((att::CV_TOTAL - 1 - vcu) / G), G};
        for (int i = 0; i < 2 * NREP(20); ++i) {
            const int c = i & 1;
            att::attn_dense_body(rowb + (size_t)k * 256 * NIN + 3072 + gh * HD, rowb + 4096 + gh * HD, rowb + 5120 + gh * HD, nullptr, 1024, 4 * c, SEQ, (char*)lds, wave, cj,
                                 c == 1, Y + ((size_t)gb * SEQ + k * 256) * DM + 1024 + gh * HD, lam, subln);
        }
        __syncthreads();
        { float* scr = (float*)((char*)lds + RING_BYTES) + wave * 64;
          for (int rep = 0; rep < NREP(21); ++rep) {
            att::swa_wg_unit((const att::bf16*)QKV, 0, gb * 8 + gh, 8 * k, 0, OA, LSE, (char*)lds, scr, wave);
            att::swa_wg_unit((const att::bf16*)QKV, 1, (gb * 4 + (k >> 1)) * 8 + gh, 8 * (k & 1), 0, OA + (size_t)M * 1024, LSE + (size_t)M * 8, (char*)lds, scr, wave);
            att::swa_wg_unit((const att::bf16*)QKV, 2, (gb * 16 + 2 * k) * 8 + gh, 0, 8, OA + (size_t)2 * M * 1024, LSE + (size_t)2 * M * 8, (char*)lds, scr, wave);
          } }
        asm volatile("s_waitcnt vmcnt(0)" ::: "memory"); __syncthreads();
        if (wave == 0 && lane == 0) {
            unsigned* gc = (unsigned*)(ws + WS_GRP) + 64 * grp;
            __builtin_amdgcn_fence(__ATOMIC_RELEASE, "agent"); asm volatile("s_waitcnt vmcnt(0)" ::: "memory");
            __hip_atomic_fetch_add(gc, 1u, __ATOMIC_RELAXED, __HIP_MEMORY_SCOPE_AGENT);
            unsigned sp = 0; while (__hip_atomic_load(gc, __ATOMIC_RELAXED, __HIP_MEMORY_SCOPE_AGENT) < 8u) { __builtin_amdgcn_s_sleep(2); if (++sp > (1u << 22)) break; }
            __builtin_amdgcn_fence(__ATOMIC_ACQUIRE, "agent"); asm volatile("s_waitcnt vmcnt(0)" ::: "memory");
        }
        __syncthreads();
        { const int col = (lane & 15) * 8;
#pragma unroll 2
          for (int it = 0; it < 8; ++it) {
            const size_t m = (size_t)gb * SEQ + k * 256 + wave * 32 + it * 4 + (lane >> 4);
            const float l0 = LSE[m * 8 + gh], l1 = LSE[((size_t)M + m) * 8 + gh], l2 = LSE[((size_t)2 * M + m) * 8 + gh];
            const float mx = fmaxf(l0, fmaxf(l1, l2)); float w0 = __expf(l0 - mx), w1 = __expf(l1 - mx), w2 = __expf(l2 - mx);
            const float inv = 1.0f / (w0 + w1 + w2); w0 *= inv; w1 *= inv; w2 *= inv;
            const v4u a0 = *(const GAS v4u*)(OA + m * 1024 + gh * HD + col), a1 = *(const GAS v4u*)(OA + ((size_t)M + m) * 1024 + gh * HD + col), a2 = *(const GAS v4u*)(OA + ((size_t)2 * M + m) * 1024 + gh * HD + col);
            v4u ya;
#pragma unroll
            for (int i = 0; i < 4; ++i) ya[i] = pk2(w0 * bflo(a0[i]) + w1 * bflo(a1[i]) + w2 * bflo(a2[i]), w0 * bfhi(a0[i]) + w1 * bfhi(a1[i]) + w2 * bfhi(a2[i]));
            *(GAS v4u*)(Y + m * DM + gh * HD + col) = ya;
          } }
        __syncthreads();
    }
    SEAM(2); STAMP(3);
    if (IN(4)) {
        pg8::Gemm g{Y, WOUT, M, DM, DM}; pg8::StaticOrder S; S.init(M, DM, G, bx); S.dup = NREP(4); S.wgm = WGM_P4;
        pg8::EpiOut E{x, XG, g_ffn, SS1, DM};
        pg8::gemm_phase<pg8::EpiOut, pg8::StaticOrder, true, true>(ldsl, g, S, E, wave);
    }
    SEAM(4); STAMP(4);
    if (IN(5)) {
        pg8::Gemm g{XG, WGU, M, NGU, DM}; pg8::StaticOrder S; S.init(M, NGU, G, bx); S.dup = NREP(5); S.wgm = WGM_P5;
        S.split_from = -1  ; S.kh_bytes = (DM / 2) * 2; S.kh_nt = DM / 128;
        pg8::EpiGateUp E{HB, DFF, SS1, 1.0f / DM, RMS_EPS, (pg8::f32x4*)(ws + WS_Y), (unsigned*)(ws + WS_FLAG)};
        pg8::gemm_phase<pg8::EpiGateUp, pg8::StaticOrder, true, true>(ldsl, g, S, E, wave);
        if (bx >= 128 && G == 256) {
            const int lane = mk_lane(); LAS float* scr = (LAS float*)(ldsl + wave * 16384);
            constexpr int I_D = (DFF / 64) * (DM / 32);
            for (int it = (bx - 128) * NWAVES + wave; it < I_D; it += 128 * NWAVES) { const int nblk = DM / 32, kb = it / nblk, nb = it % nblk; transpose_item(w_down, DFF, DM, WDN, 64 * kb, 32 * nb, 32 * nb, scr, lane); }
        }
    }
    SEAM(5); STAMP(5);
    if (IN(6)) {
        pg8::Gemm g{HB, WDN, M, DM, DFF}; pg8::StaticOrder S; S.init(M, DM, G, bx); S.wgm = WGM_P6;
        pg8::EpiDownNorm E{XG, g_ffn, out, g_final, SS2, (unsigned*)(ws + WS_CNT), DM, 1.0f / DM, RMS_EPS};
        pg8::gemm_phase<pg8::EpiDownNorm, pg8::StaticOrder, false, true>(ldsl, g, S, E, wave);
    }
    STAMP(6);
    if (MK_TIME_PHASE >= 0 && bx == 0 && wave == 0) { if (tph1 == 0) tph1 = __builtin_amdgcn_s_memrealtime(); const unsigned long long t0_ = __builtin_amdgcn_s_memrealtime(); while (__builtin_amdgcn_s_memrealtime() - t0_ < tph1 - tph0) __builtin_amdgcn_s_sleep(8); }
#undef IN
#undef SEAM
}

extern "C" void kernel_launch(void* const* d_in, const int* in_sizes, int n_in, void* d_out, int out_size, void* d_ws, size_t ws_size, hipStream_t stream) {
    static int grid = 0;
    if (grid == 0) {
        if (n_in != 11 || in_sizes[0] != M * DM || out_size != M * DM || ws_size < WS_END) { fprintf(stderr, "kernel_launch: shape/workspace mismatch (n_in %d, in0 %d, out %d, ws %zu)\n", n_in, n_in > 0 ? in_sizes[0] : -1, out_size, ws_size); grid = -1; return; }
        int dev = 0, cus = 0, per_cu = 0;
        if (hipGetDevice(&dev) != hipSuccess || hipDeviceGetAttribute(&cus, hipDeviceAttributeMultiprocessorCount, dev) != hipSuccess) { grid = -1; return; }
        if (hipFuncSetAttribute((const void*)mk_fwd, hipFuncAttributeMaxDynamicSharedMemorySize, LDS_BYTES) != hipSuccess) { fprintf(stderr, "kernel_launch: hipFuncSetAttribute failed\n"); grid = -1; return; }
        if (hipOccupancyMaxActiveBlocksPerMultiprocessor(&per_cu, (const void*)mk_fwd, NWAVES * 64, LDS_BYTES) != hipSuccess || per_cu < 1) { fprintf(stderr, "kernel_launch: occupancy query says %d\n", per_cu); per_cu = 1; }
        (void)hipGetLastError();
        grid = cus;
        if (grid != 256) { fprintf(stderr, "kernel_launch: this kernel needs a 256-CU device (got %d)\n", cus); grid = -1; return; }
    }
    if (grid < 0) return;
    Args a{};
    for (int i = 0; i < 11; ++i) a.in[i] = (const float*)d_in[i];
    a.out = (float*)d_out; a.ws = (unsigned char*)d_ws;
#if MK_ONE_LAUNCH
    if (hipMemsetAsync((char*)d_ws + WS_BAR, 0, BAR_BYTES, stream) != hipSuccess) { fprintf(stderr, "kernel_launch: memset failed\n"); return; }
#ifdef MK_PROBE_MEMSET2
    (void)hipMemsetAsync((char*)d_ws + WS_BAR, 0, BAR_BYTES, stream);
#endif
    a.ph_lo = 0; a.ph_hi = NPHASE;
    void* kargs[] = {&a};
    hipError_t e = hipLaunchCooperativeKernel((const void*)mk_fwd, dim3(grid), dim3(NWAVES * 64), kargs, LDS_BYTES, stream);
    if (e != hipSuccess) fprintf(stderr, "kernel_launch: cooperative launch failed: %s (grid %d)\n", hipGetErrorString(e), grid);
#else
    for (int p = 0; p < NPHASE; ++p) {
        a.ph_lo = p; a.ph_hi = p + 1;
        hipLaunchKernelGGL(mk_fwd, dim3(grid), dim3(NWAVES * 64), LDS_BYTES, stream, a);
    }
#endif
}
```

```cpp
#include <hip/hip_runtime.h>
#include <hip/hip_cooperative_groups.h>
#include <hip/hip_bf16.h>
#include <cstdio>
#include <cstdint>
#include <cmath>
namespace cg = cooperative_groups;
__device__ __forceinline__ int mk_lane() { int l; asm volatile("v_mbcnt_lo_u32_b32 %0, -1, 0\n\tv_mbcnt_hi_u32_b32 %0, -1, %0" : "=v"(l)); return l & 63; }
namespace pg8 {
#define PG8_LAS __attribute__((address_space(3)))
typedef unsigned short bf16_t;
typedef short bf16x8 __attribute__((ext_vector_type(8)));
typedef float f32x4 __attribute__((ext_vector_type(4)));
typedef unsigned u32x4 __attribute__((ext_vector_type(4)));
constexpr int BM = 256, BK = 64, HALF = 128, HTB = HALF * BK * 2  , STAGE_BYTES = 8 * HTB, NXCD = 8, WGM = 8;

__host__ __device__ __forceinline__ int lds_byte(int r, int c) { const int st = (r >> 4) * 2 + (c >> 5), rr = r & 15, cc = c & 31, ob = rr * 64 + cc * 2; return st * 1024 + (ob ^ (((ob >> 9) & 1) << 5)); }
__host__ __device__ __forceinline__ void stage_rc(int b, int& R, int& C) { const int st = b / 1024, sb = b % 1024, swz = sb ^ (((sb >> 9) & 1) << 5); R = (st >> 1) * 16 + swz / 64; C = (st & 1) * 32 + (swz % 64) / 2; }
__host__ __device__ __forceinline__ int perm32(int rho) { const int n = rho >> 4, i = rho & 15; return 8 * (i >> 2) + 4 * n + (i & 3); }

struct Unit { int pm, pn, first, khalf, koff, nt, ul; };
struct Gemm { const bf16_t* A; const bf16_t* Bt; int M, N, K; };

struct StaticOrder {
    int nM, nN, nwg, G, c, dup, split_from, kh_bytes, kh_nt, wgm;
    __host__ __device__ void init(int M, int N, int G_, int c_) { nM = M / BM; nN = N / BM; nwg = nM * nN; G = G_; c = c_; dup = 1; wgm = WGM; split_from = -1; kh_bytes = 0; kh_nt = 0; }
    __host__ __device__ bool next(int i, Unit& u) const {
        long L = (long)(i / dup) * G + c; u.khalf = 0; u.koff = 0; u.nt = 0; u.ul = 0;
        if (split_from >= 0 && (long)(i / dup) * G >= split_from) {
            if ((long)(i / dup) * G > split_from) return false;
            u.ul = c >> 1; L = split_from + u.ul; u.khalf = 1 + (c & 1); u.koff = (c & 1) ? kh_bytes : 0; u.nt = kh_nt; }
        if (L >= nwg) return false;
        int wgid = (int)L; { const int q = nwg / NXCD, r = nwg % NXCD, xcd = wgid % NXCD, off = wgid / NXCD; wgid = (xcd < r ? xcd * (q + 1) : r * (q + 1) + (xcd - r) * q) + off; }
        const int nig = wgm * nN, gid = wgid / nig, fm = gid * wgm, gsz = (nM - fm) < wgm ? (nM - fm) : wgm;
        u.pm = fm + ((wgid % nig) % gsz); u.pn = (wgid % nig) / gsz; u.first = (i % dup) == 0; return true;
    }
    __device__ __forceinline__ void a_ready(const Unit&) const {}
    __device__ __forceinline__ void done(const Unit&) const {}
};

__device__ __forceinline__ unsigned cvt_pk_bf16(float lo, float hi) { unsigned r; asm volatile("v_cvt_pk_bf16_f32 %0, %1, %2" : "=v"(r) : "v"(lo), "v"(hi)); return r; }
typedef float f32x2 __attribute__((ext_vector_type(2)));
__device__ __forceinline__ float invf_a(int f) {
    constexpr float T[16] = {1.0f, 0.4403666f, 0.19392274f, 0.0853971f, 0.03760603f, 0.01656044f, 0.0072926646f, 0.003211446f,
                             0.0014142136f, 0.00062277244f, 0.0002742482f, 0.000120769735f, 5.3182957e-05f, 2.342e-05f, 1.0313385e-05f, 4.5416705e-06f};
    return T[f];
}
__device__ __forceinline__ void sincos_rev(float ang, float& s, float& c) {
    const float rev = ang * 0.15915494309189535f; const float fr = rev - __builtin_floorf(rev);
    s = __builtin_amdgcn_sinf(fr); c = __builtin_amdgcn_cosf(fr);
}
struct EpiQKV {
    static constexpr bool PERM = true, AFTER_DRAIN = false;
    bf16_t* O; int ldc;
    __device__ __forceinline__ void operator()(const f32x4 (&acc)[2][2][4][2], const Unit& u, int wr, int wc, int fr, int fq) const {
        const int row0 = u.pm * BM + wr * 64 + fr;
        const int sec = u.pn >> 2;
        const int col0 = u.pn * BM + wc * 32 + 8 * fq;
        const bool ropeA = (sec <= 1) && (wc == 0);
        const bool ropeB = (sec == 3 || sec == 4) && ((wc & 1) == 0);
#pragma unroll
        for (int ai = 0; ai < 2; ++ai)
#pragma unroll
            for (int m = 0; m < 4; ++m) {
                const int row = row0 + ai * HALF + m * 16;
                const float pos = (float)(row & 2047);
                bf16_t* rowp = O + (size_t)row * ldc + col0;
                float cs[8], sn[8];
                if (ropeA) {
                    const int fb = 8 * (fq & 1);
#pragma unroll
                    for (int i = 0; i < 8; ++i) { float f0 = invf_a(i), f1 = invf_a(8 + i); sincos_rev(pos * (fb ? f1 : f0), sn[i], cs[i]); }
                    const float sg = (fq >= 2) ? 1.f : -1.f;
#pragma unroll
                    for (int i = 0; i < 8; ++i) sn[i] *= sg;
                } else if (ropeB) {
#pragma unroll
                    for (int i = 0; i < 8; ++i) sincos_rev(pos * invf_a(2 * i), sn[i], cs[i]);
                    const float sg = (fq == 1) ? 1.f : -1.f;
#pragma unroll
                    for (int i = 0; i < 8; ++i) sn[i] *= sg;
                }
#pragma unroll
                for (int bj = 0; bj < 2; ++bj) {
                    f32x4 v0 = acc[ai][bj][m][0], v1 = acc[ai][bj][m][1];
                    if (ropeA) {
                        f32x4 p0, p1;
#pragma unroll
                        for (int i = 0; i < 4; ++i) { p0[i] = __shfl_xor(v0[i], 32); p1[i] = __shfl_xor(v1[i], 32); }
#pragma unroll
                        for (int i = 0; i < 4; ++i) { v0[i] = v0[i] * cs[i] + p0[i] * sn[i]; v1[i] = v1[i] * cs[4 + i] + p1[i] * sn[4 + i]; }
                    } else if (ropeB) {
                        f32x4 p0, p1;
#pragma unroll
                        for (int i = 0; i < 4; ++i) { p0[i] = __shfl_xor(v0[i], 16); p1[i] = __shfl_xor(v1[i], 16); }
                        if (fq < 2) {
#pragma unroll
                            for (int i = 0; i < 4; ++i) { v0[i] = v0[i] * cs[i] + p0[i] * sn[i]; v1[i] = v1[i] * cs[4 + i] + p1[i] * sn[4 + i]; }
                        }
                    }
                    u32x4 w; w.x = cvt_pk_bf16(v0[0], v0[1]); w.y = cvt_pk_bf16(v0[2], v0[3]); w.z = cvt_pk_bf16(v1[0], v1[1]); w.w = cvt_pk_bf16(v1[2], v1[3]);
                    *(u32x4*)(rowp + bj * HALF) = w;
                }
            }
    }
};
struct EpiOut {
    static constexpr bool PERM = false, AFTER_DRAIN = false;
    const float* base; bf16_t* xg; const float* g; float* ss; int ldc;
    __device__ __forceinline__ void operator()(const f32x4 (&acc)[2][2][4][2], const Unit& u, int wr, int wc, int fr, int fq) const {
        typedef unsigned u32x2v __attribute__((ext_vector_type(2)));
        const int col0 = u.pn * BM + wc * 32 + 4 * fq;
        f32x4 gv[2][2];
#pragma unroll
        for (int bj = 0; bj < 2; ++bj)
#pragma unroll
            for (int n = 0; n < 2; ++n) gv[bj][n] = *(const f32x4*)(g + col0 + bj * HALF + n * 16);
#pragma unroll
        for (int ai = 0; ai < 2; ++ai)
#pragma unroll
            for (int m = 0; m < 4; ++m) {
                const int row = u.pm * BM + ai * HALF + wr * 64 + m * 16 + fr; const size_t off = (size_t)row * ldc + col0; float s = 0.f;
#pragma unroll
                for (int bj = 0; bj < 2; ++bj)
#pragma unroll
                    for (int n = 0; n < 2; ++n) {
                        const f32x4 x1 = *(const f32x4*)(base + off + bj * HALF + n * 16) + acc[ai][bj][m][n];
                        s += (x1[0] * x1[0] + x1[1] * x1[1]) + (x1[2] * x1[2] + x1[3] * x1[3]);
                        const f32x4 y = x1 * gv[bj][n]; u32x2v w; w.x = cvt_pk_bf16(y[0], y[1]); w.y = cvt_pk_bf16(y[2], y[3]);
                        *(u32x2v*)(xg + off + bj * HALF + n * 16) = w;
                    }
                s += __shfl_xor(s, 16); s += __shfl_xor(s, 32);
                if (fq == 0 && u.first) atomicAdd(ss + row, s);
            }
    }
};
struct EpiGateUp {
    static constexpr bool PERM = true, AFTER_DRAIN = false;
    bf16_t* H; int ldh; const float* ss; float inv_n, eps; f32x4* part; unsigned* flag;
    __device__ __forceinline__ void operator()(const f32x4 (&acc)[2][2][4][2], const Unit& u, int wr, int wc, int fr, int fq) const {
        const int tid = (wr * 4 + wc) * 64 + fq * 16 + fr;
        f32x4* pp = part + (size_t)u.ul * (32 * 512) + tid;
        if (u.khalf == 1) {
#pragma unroll
            for (int ai = 0; ai < 2; ++ai)
#pragma unroll
                for (int bj = 0; bj < 2; ++bj)
#pragma unroll
                    for (int m = 0; m < 4; ++m)
#pragma unroll
                        for (int n = 0; n < 2; ++n) pp[(size_t)(((ai * 2 + bj) * 4 + m) * 2 + n) * 512] = acc[ai][bj][m][n];
            asm volatile("s_waitcnt vmcnt(0)" ::: "memory"); __builtin_amdgcn_s_barrier(); asm volatile("" ::: "memory");
            if (tid == 0) { __builtin_amdgcn_fence(__ATOMIC_RELEASE, "agent"); asm volatile("s_waitcnt vmcnt(0)" ::: "memory");
                __hip_atomic_store(flag + 16 * u.ul, 1u, __ATOMIC_RELAXED, __HIP_MEMORY_SCOPE_AGENT); }
            return;
        }
        if (u.khalf == 2) {
            if (tid < 64) { unsigned sp = 0;
                while ((unsigned)__builtin_amdgcn_readfirstlane(__hip_atomic_load(flag + 16 * u.ul, __ATOMIC_RELAXED, __HIP_MEMORY_SCOPE_AGENT)) == 0u) { __builtin_amdgcn_s_sleep(2); if (++sp > (1u << 22)) break; }
                __builtin_amdgcn_fence(__ATOMIC_ACQUIRE, "agent"); asm volatile("s_waitcnt vmcnt(0)" ::: "memory"); }
            asm volatile("s_waitcnt vmcnt(0) lgkmcnt(0)" ::: "memory"); __builtin_amdgcn_s_barrier(); asm volatile("" ::: "memory");
        }
        const int col0 = u.pn * HALF + wc * 32 + 8 * fq;
#pragma unroll
        for (int ai = 0; ai < 2; ++ai)
#pragma unroll
            for (int m = 0; m < 4; ++m) {
                const int row = u.pm * BM + ai * HALF + wr * 64 + m * 16 + fr;
                const float rstd = 1.0f / sqrtf(ss[row] * inv_n + eps);
                f32x4 gq[2], uq[2];
#pragma unroll
                for (int n = 0; n < 2; ++n) { gq[n] = acc[ai][0][m][n]; uq[n] = acc[ai][1][m][n]; }
                if (u.khalf == 2) {
#pragma unroll
                    for (int n = 0; n < 2; ++n) { gq[n] += pp[(size_t)(((ai * 2 + 0) * 4 + m) * 2 + n) * 512]; uq[n] += pp[(size_t)(((ai * 2 + 1) * 4 + m) * 2 + n) * 512]; }
                }
                float hv[8];
#pragma unroll
                for (int n = 0; n < 2; ++n)
#pragma unroll
                    for (int i = 0; i < 4; ++i) { const float gg = gq[n][i] * rstd, uu = uq[n][i] * rstd;
                        hv[4 * n + i] = gg * __builtin_amdgcn_rcpf(1.0f + __builtin_amdgcn_exp2f(-1.4426950408889634f * gg)) * uu; }
                u32x4 w; w.x = cvt_pk_bf16(hv[0], hv[1]); w.y = cvt_pk_bf16(hv[2], hv[3]); w.z = cvt_pk_bf16(hv[4], hv[5]); w.w = cvt_pk_bf16(hv[6], hv[7]);
                *(u32x4*)(H + (size_t)row * ldh + col0) = w;
            }
    }
};
struct EpiDown {
    static constexpr bool PERM = false, AFTER_DRAIN = false;
    const bf16_t* base; float* out; float* ss; int ldc;
    __device__ __forceinline__ void operator()(const f32x4 (&acc)[2][2][4][2], const Unit& u, int wr, int wc, int fr, int fq) const {
        typedef unsigned u32x2v __attribute__((ext_vector_type(2)));
        const int col0 = u.pn * BM + wc * 32 + 4 * fq;
#pragma unroll
        for (int ai = 0; ai < 2; ++ai)
#pragma unroll
            for (int m = 0; m < 4; ++m) {
                const int row = u.pm * BM + ai * HALF + wr * 64 + m * 16 + fr; const size_t off = (size_t)row * ldc + col0; float s = 0.f;
#pragma unroll
                for (int bj = 0; bj < 2; ++bj)
#pragma unroll
                    for (int n = 0; n < 2; ++n) {
                        const u32x2v rb = *(const u32x2v*)(base + off + bj * HALF + n * 16);
                        f32x4 x2 = acc[ai][bj][m][n];
                        x2[0] += __uint_as_float(rb.x << 16); x2[1] += __uint_as_float(rb.x & 0xffff0000u); x2[2] += __uint_as_float(rb.y << 16); x2[3] += __uint_as_float(rb.y & 0xffff0000u);
                        *(f32x4*)(out + off + bj * HALF + n * 16) = x2;
                        s += (x2[0] * x2[0] + x2[1] * x2[1]) + (x2[2] * x2[2] + x2[3] * x2[3]);
                    }
                s += __shfl_xor(s, 16); s += __shfl_xor(s, 32);
                if (fq == 0 && u.first) atomicAdd(ss + row, s);
            }
    }
};
struct EpiDownNorm {
    static constexpr bool PERM = false, AFTER_DRAIN = true;
    const bf16_t* base; const float* gres; float* out; const float* g; float* ss; unsigned* cnt; int ldc; float inv_n, eps;
    __device__ __forceinline__ void fused(f32x4 (&acc)[2][2][4][2], const Unit& u, int wr, int wc, int fr, int fq, PG8_LAS unsigned char* lds, int wid, int lane) const {
        typedef unsigned u32x2v __attribute__((ext_vector_type(2)));
        const int col0 = u.pn * BM + wc * 32 + 4 * fq;
        f32x4 rg[2][2];
#pragma unroll
        for (int bj = 0; bj < 2; ++bj)
#pragma unroll
            for (int n = 0; n < 2; ++n) { const f32x4 t = *(const f32x4*)(gres + col0 + bj * HALF + n * 16); rg[bj][n] = (f32x4){1.0f / t[0], 1.0f / t[1], 1.0f / t[2], 1.0f / t[3]}; }
#pragma unroll
        for (int ai = 0; ai < 2; ++ai)
#pragma unroll
            for (int m = 0; m < 4; ++m) {
                const int row = u.pm * BM + ai * HALF + wr * 64 + m * 16 + fr; const size_t off = (size_t)row * ldc + col0; float s = 0.f;
#pragma unroll
                for (int bj = 0; bj < 2; ++bj)
#pragma unroll
                    for (int n = 0; n < 2; ++n) {
                        const u32x2v rb = *(const u32x2v*)(base + off + bj * HALF + n * 16);
                        f32x4 x2 = acc[ai][bj][m][n];
                        x2[0] += __uint_as_float(rb.x << 16) * rg[bj][n][0]; x2[1] += __uint_as_float(rb.x & 0xffff0000u) * rg[bj][n][1]; x2[2] += __uint_as_float(rb.y << 16) * rg[bj][n][2]; x2[3] += __uint_as_float(rb.y & 0xffff0000u) * rg[bj][n][3];
                        acc[ai][bj][m][n] = x2;
                        s += (x2[0] * x2[0] + x2[1] * x2[1]) + (x2[2] * x2[2] + x2[3] * x2[3]);
                    }
                s += __shfl_xor(s, 16); s += __shfl_xor(s, 32);
                if (fq == 0) atomicAdd(ss + row, s);
            }
        asm volatile("s_waitcnt vmcnt(0)" ::: "memory");
        __builtin_amdgcn_s_barrier(); asm volatile("" ::: "memory");
        if (wid == 0) {
            unsigned* c = cnt + 64 * u.pm;
            if (lane == 0) __hip_atomic_fetch_add(c, 1u, __ATOMIC_RELAXED, __HIP_MEMORY_SCOPE_AGENT);
            unsigned sp = 0;
            while ((unsigned)__builtin_amdgcn_readfirstlane(__hip_atomic_load(c, __ATOMIC_RELAXED, __HIP_MEMORY_SCOPE_AGENT)) < 8u) { __builtin_amdgcn_s_sleep(2); if (++sp > (1u << 22)) break; }
            __builtin_amdgcn_fence(__ATOMIC_ACQUIRE, "agent");
        }
        asm volatile("s_waitcnt vmcnt(0) lgkmcnt(0)" ::: "memory"); __builtin_amdgcn_s_barrier(); asm volatile("" ::: "memory");
        f32x4 gv[2][2];
#pragma unroll
        for (int bj = 0; bj < 2; ++bj)
#pragma unroll
            for (int n = 0; n < 2; ++n) gv[bj][n] = *(const f32x4*)(g + col0 + bj * HALF + n * 16);
#pragma unroll
        for (int ai = 0; ai < 2; ++ai)
#pragma unroll
            for (int m = 0; m < 4; ++m) {
                const int row = u.pm * BM + ai * HALF + wr * 64 + m * 16 + fr; const size_t off = (size_t)row * ldc + col0;
                const float rstd = 1.0f / sqrtf(__hip_atomic_load(ss + row, __ATOMIC_RELAXED, __HIP_MEMORY_SCOPE_AGENT) * inv_n + eps);
#pragma unroll
                for (int bj = 0; bj < 2; ++bj)
#pragma unroll
                    for (int n = 0; n < 2; ++n) *(f32x4*)(out + off + bj * HALF + n * 16) = acc[ai][bj][m][n] * rstd * gv[bj][n];
            }
    }
};
template <class Epi, class Sched, bool ALIGN_EPI = false, bool SP2 = false>
__device__ __forceinline__ void gemm_phase(PG8_LAS unsigned char* lds, const Gemm g, const Sched& S, const Epi& E, const int wave_in) {
    const int wid = wave_in, lane = mk_lane(), tid = wid * 64 + lane, wr = wid >> 2, wc = wid & 3, fr = lane & 15, fq = lane >> 4;
    const int K = g.K, nt = K / BK;
    unsigned voffA[2], voffB[2];
#pragma unroll
    for (int i = 0; i < 2; ++i) { int R, C; stage_rc(tid * 16 + i * 8192, R, C); const int Rb = Epi::PERM ? ((R & ~31) + perm32(R & 31)) : R;
        voffA[i] = (unsigned)(R * K + C) * 2u; voffB[i] = (unsigned)(Rb * K + C) * 2u; }
    const size_t kstep = (size_t)(BK * 2);
    const size_t hstep = (size_t)HALF * K * 2;
    const size_t tstep = 2 * hstep;
    const unsigned ldsw = (unsigned)wid * 1024u;
    const int aoff = lds_byte(wr * 64 + fr, fq * 8), boff = lds_byte(wc * 32 + fr, fq * 8);
#define PG8_SA(b, h) (((b) * 2 + (h)) * HTB)
#define PG8_SB(b, h) ((4 + (b) * 2 + (h)) * HTB)
#define PG8_STAGE(bufoff, gbase, voff) do { _Pragma("unroll") for (int _i = 0; _i < 2; ++_i) \
        __builtin_amdgcn_global_load_lds((const unsigned*)((const char*)(gbase) + (voff)[_i]), (PG8_LAS unsigned*)(lds + (bufoff) + ldsw + _i * 8192), 16, 0, 0); } while (0)
#define PG8_LDA(dst, b, h) do { _Pragma("unroll") for (int m = 0; m < 4; ++m) _Pragma("unroll") for (int k = 0; k < 2; ++k) dst[m][k] = *(const PG8_LAS bf16x8*)(lds + PG8_SA(b, h) + aoff + m * 2048 + k * 1024); } while (0)
#define PG8_LDB(dst, b, h) do { _Pragma("unroll") for (int n = 0; n < 2; ++n) _Pragma("unroll") for (int k = 0; k < 2; ++k) dst[n][k] = *(const PG8_LAS bf16x8*)(lds + PG8_SB(b, h) + boff + n * 2048 + k * 1024); } while (0)
#define PG8_MMA(ai, bj, At, Bt) do { __builtin_amdgcn_s_setprio(1); _Pragma("unroll") for (int m = 0; m < 4; ++m) _Pragma("unroll") for (int n = 0; n < 2; ++n) _Pragma("unroll") for (int k = 0; k < 2; ++k) \
        acc[ai][bj][m][n] = __builtin_amdgcn_mfma_f32_16x16x32_bf16(Bt[n][k], At[m][k], acc[ai][bj][m][n], 0, 0, 0); __builtin_amdgcn_s_setprio(0); } while (0)
#define PG8_WAIT_V(n) asm volatile("s_waitcnt vmcnt(" #n ")" ::: "memory")
#define PG8_WAIT_L(n) asm volatile("s_waitcnt lgkmcnt(" #n ")" ::: "memory")
#define PG8_BAR __builtin_amdgcn_s_barrier()
#define PG8_SCHED __builtin_amdgcn_sched_barrier(0)
    Unit cur, nxt; int ui = 0;
    if (!S.next(0, cur)) return;
    f32x4 acc[2][2][4][2];
#pragma unroll
    for (int a = 0; a < 2; ++a)
#pragma unroll
        for (int b = 0; b < 2; ++b)
#pragma unroll
            for (int m = 0; m < 4; ++m)
#pragma unroll
                for (int n = 0; n < 2; ++n) acc[a][b][m][n] = (f32x4){0.f, 0.f, 0.f, 0.f};
    bf16x8 At[4][2], B0[2][2], B1[2][2];
    const char* cA = (const char*)g.A + (size_t)cur.pm * tstep + cur.koff; const char* cB = (const char*)g.Bt + (size_t)cur.pn * tstep + cur.koff; int ntc = cur.nt ? cur.nt : nt;
    S.a_ready(cur);
    if constexpr (SP2) {
        PG8_STAGE(PG8_SB(0, 0), cB, voffB); PG8_STAGE(PG8_SB(0, 1), cB + hstep, voffB); PG8_STAGE(PG8_SA(0, 0), cA, voffA); PG8_STAGE(PG8_SA(0, 1), cA + hstep, voffA);
        if (wr == 1) PG8_BAR;
        PG8_WAIT_V(2); PG8_BAR;
        PG8_STAGE(PG8_SB(1, 0), cB + kstep, voffB); PG8_STAGE(PG8_SA(1, 0), cA + kstep, voffA); PG8_STAGE(PG8_SB(1, 1), cB + hstep + kstep, voffB);
        PG8_WAIT_V(6); PG8_BAR;
    } else {
        PG8_STAGE(PG8_SB(0, 0), cB, voffB); PG8_STAGE(PG8_SA(0, 0), cA, voffA); PG8_STAGE(PG8_SB(0, 1), cB + hstep, voffB); PG8_STAGE(PG8_SA(0, 1), cA + hstep, voffA);
        if (wr == 1) PG8_BAR;
        PG8_WAIT_V(4); PG8_BAR;
        PG8_STAGE(PG8_SB(1, 0), cB + kstep, voffB); PG8_STAGE(PG8_SA(1, 0), cA + kstep, voffA); PG8_STAGE(PG8_SB(1, 1), cB + hstep + kstep, voffB);
        PG8_WAIT_V(6); PG8_BAR;
    }
    for (;;) {
        const bool has_next = S.next(ui + 1, nxt);
        const char* nA = has_next ? (const char*)g.A + (size_t)nxt.pm * tstep + nxt.koff : cA; const char* nB = has_next ? (const char*)g.Bt + (size_t)nxt.pn * tstep + nxt.koff : cB;
        for (int t = 0; t < ntc; t += 2) {
            const bool last = (t == ntc - 2);
            const char* a1 = cA + (size_t)(t + 1) * kstep;
            const char* a2 = last ? nA : cA + (size_t)(t + 2) * kstep; const char* b2 = last ? nB : cB + (size_t)(t + 2) * kstep;
            const char* a3 = a2 + kstep; const char* b3 = b2 + kstep;
            if (last && has_next) S.a_ready(nxt);
            if constexpr (SP2) {
            PG8_LDB(B0, 0, 0); PG8_LDB(B1, 0, 1); PG8_SCHED; PG8_LDA(At, 0, 0); PG8_STAGE(PG8_SA(1, 1), a1 + hstep, voffA);
            PG8_WAIT_V(8); PG8_WAIT_L(0); PG8_BAR; PG8_MMA(0, 0, At, B0); PG8_MMA(0, 1, At, B1); PG8_BAR; PG8_SCHED;
            PG8_LDA(At, 0, 1); PG8_STAGE(PG8_SB(0, 0), b2, voffB); PG8_STAGE(PG8_SB(0, 1), b2 + hstep, voffB); PG8_STAGE(PG8_SA(0, 0), a2, voffA);
            PG8_WAIT_V(8); PG8_WAIT_L(0); PG8_BAR; PG8_MMA(1, 0, At, B0); PG8_MMA(1, 1, At, B1); PG8_BAR; PG8_SCHED;
            PG8_LDB(B0, 1, 0); PG8_LDB(B1, 1, 1); PG8_SCHED; PG8_LDA(At, 1, 0); PG8_STAGE(PG8_SA(0, 1), a2 + hstep, voffA);
            PG8_WAIT_V(8); PG8_WAIT_L(0); PG8_BAR; PG8_MMA(0, 0, At, B0); PG8_MMA(0, 1, At, B1); PG8_BAR; PG8_SCHED;
            PG8_LDA(At, 1, 1); PG8_STAGE(PG8_SB(1, 0), b3, voffB); PG8_STAGE(PG8_SB(1, 1), b3 + hstep, voffB); PG8_STAGE(PG8_SA(1, 0), a3, voffA);
            PG8_WAIT_V(8); PG8_WAIT_L(0); PG8_BAR; PG8_MMA(1, 0, At, B0); PG8_MMA(1, 1, At, B1); PG8_BAR; PG8_SCHED;
            } else {
            PG8_LDB(B0, 0, 0); PG8_SCHED; PG8_LDA(At, 0, 0); PG8_STAGE(PG8_SA(1, 1), a1 + hstep, voffA);
            PG8_WAIT_L(8); PG8_BAR; PG8_WAIT_L(0); PG8_MMA(0, 0, At, B0); PG8_BAR; PG8_SCHED;
            PG8_LDB(B1, 0, 1); PG8_STAGE(PG8_SB(0, 0), b2, voffB);
            PG8_BAR; PG8_WAIT_L(0); PG8_MMA(0, 1, At, B1); PG8_BAR;
            PG8_LDA(At, 0, 1); PG8_STAGE(PG8_SA(0, 0), a2, voffA);
            PG8_BAR; PG8_WAIT_L(0); PG8_MMA(1, 0, At, B0); PG8_BAR; PG8_SCHED;
            PG8_STAGE(PG8_SB(0, 1), b2 + hstep, voffB);
            PG8_WAIT_V(6); PG8_BAR; PG8_MMA(1, 1, At, B1); PG8_BAR;
            PG8_LDB(B0, 1, 0); PG8_SCHED; PG8_LDA(At, 1, 0); PG8_STAGE(PG8_SA(0, 1), a2 + hstep, voffA);
            PG8_WAIT_L(8); PG8_BAR; PG8_WAIT_L(0); PG8_MMA(0, 0, At, B0); PG8_BAR; PG8_SCHED;
            PG8_LDB(B1, 1, 1); PG8_STAGE(PG8_SB(1, 0), b3, voffB);
            PG8_BAR; PG8_WAIT_L(0); PG8_MMA(0, 1, At, B1); PG8_BAR;
            PG8_LDA(At, 1, 1); PG8_STAGE(PG8_SA(1, 0), a3, voffA);
            PG8_BAR; PG8_WAIT_L(0); PG8_MMA(1, 0, At, B0); PG8_BAR; PG8_SCHED;
            PG8_STAGE(PG8_SB(1, 1), b3 + hstep, voffB);
            PG8_WAIT_V(6); PG8_BAR; PG8_MMA(1, 1, At, B1); PG8_BAR;
            }
        }
        if constexpr (ALIGN_EPI) { if (wr == 0) PG8_BAR; }
        if constexpr (!Epi::AFTER_DRAIN) { E(acc, cur, wr, wc, fr, fq); S.done(cur); }
        if (!has_next) break;
#pragma unroll
        for (int a = 0; a < 2; ++a)
#pragma unroll
            for (int b = 0; b < 2; ++b)
#pragma unroll
                for (int m = 0; m < 4; ++m)
#pragma unroll
                    for (int n = 0; n < 2; ++n) acc[a][b][m][n] = (f32x4){0.f, 0.f, 0.f, 0.f};
        cur = nxt; cA = nA; cB = nB; ++ui; ntc = cur.nt ? cur.nt : nt;
        if constexpr (ALIGN_EPI) { if (wr == 1) PG8_BAR; }
    }
    PG8_WAIT_V(0);
    if constexpr (!ALIGN_EPI) { if (wr == 0) PG8_BAR; }
    PG8_BAR;
    if constexpr (Epi::AFTER_DRAIN) { E.fused(acc, cur, wr, wc, fr, fq, lds, wid, lane); S.done(cur); }
#undef PG8_SA
#undef PG8_SB
#undef PG8_STAGE
#undef PG8_LDA
#undef PG8_LDB
#undef PG8_MMA
#undef PG8_WAIT_V
#undef PG8_WAIT_L
#undef PG8_BAR
#undef PG8_SCHED
}
}
namespace att {
using bf16 = __hip_bfloat16;
using bf16x8 = __attribute__((ext_vector_type(8))) short;
using s16x4  = __attribute__((ext_vector_type(4))) short;
using f32x16 = __attribute__((ext_vector_type(16))) float;
using u32x4  = __attribute__((ext_vector_type(4))) unsigned;
constexpr int D = 128, NW = 8, QBLK = 32, KVBLK = 64;
constexpr int LDR = 6144;
constexpr size_t SHM_V = KVBLK * D * 2, SHM_K = KVBLK * D * 2, SHM_ATTN = 2 * SHM_V + 2 * SHM_K + NW * 64 * 4;
#define KSWZ(row, colB) ((row) * 256 + ((colB) ^ (((row) & 7) << 4)))
#define SBAR() __builtin_amdgcn_sched_barrier(0)
__device__ __forceinline__ int crow(int r, int hi) { return (r & 3) + 8 * (r >> 2) + 4 * hi; }
__device__ __forceinline__ unsigned cvtpk(float lo, float hi) { unsigned r; asm volatile("v_cvt_pk_bf16_f32 %0, %1, %2" : "=v"(r) : "v"(lo), "v"(hi)); return r; }
__device__ __forceinline__ unsigned short f2bf1(float x) { return (unsigned short)(cvtpk(x, x) & 0xffffu); }
#define PK4(P, BASE, OUT) do { unsigned a0 = cvtpk(P[BASE + 0], P[BASE + 1]), a1 = cvtpk(P[BASE + 2], P[BASE + 3]);   \
    unsigned b0 = cvtpk(P[BASE + 4], P[BASE + 5]), b1 = cvtpk(P[BASE + 6], P[BASE + 7]);                              \
    auto r0 = __builtin_amdgcn_permlane32_swap(a0, b0, false, false); auto r1 = __builtin_amdgcn_permlane32_swap(a1, b1, false, false); \
    u32x4 w = {r0[0], r1[0], r0[1], r1[1]}; OUT = *reinterpret_cast<bf16x8*>(&w); } while (0)

template <int SCALE_E6>
struct SM {
    static constexpr float SCALE = SCALE_E6 == 125000 ? 0.125f : 0.088388347648318440f;
    static constexpr float THR = 8.f;
    static __device__ __forceinline__ void partialSM(f32x16& p0, f32x16& p1, float& m_reg, float& mn, float& alpha) {
        constexpr float C = SCALE * 1.4426950408889634f;
        float pmax = p0[0];
#pragma unroll
        for (int r = 1; r < 16; ++r) pmax = fmaxf(pmax, p0[r]);
#pragma unroll
        for (int r = 0; r < 16; ++r) pmax = fmaxf(pmax, p1[r]);
        { auto rr = __builtin_amdgcn_permlane32_swap(__float_as_uint(pmax), __float_as_uint(pmax), false, false);
          pmax = fmaxf(__uint_as_float(rr[0]), __uint_as_float(rr[1])); }
        if (__builtin_expect(__all(pmax - m_reg <= THR / SCALE), 1)) { mn = m_reg; alpha = 1.f; }
        else { mn = fmaxf(m_reg, pmax); alpha = __builtin_amdgcn_exp2f((m_reg - mn) * C); m_reg = mn; }
        float mnC = -mn * C;
#pragma unroll
        for (int r = 0; r < 16; ++r) p0[r] = fmaf(p0[r], C, mnC);
#pragma unroll
        for (int r = 0; r < 16; ++r) p1[r] = fmaf(p1[r], C, mnC);
#pragma unroll
        for (int r = 0; r < 16; ++r) p0[r] = __builtin_amdgcn_exp2f(p0[r]);
    }
};
__device__ __forceinline__ void finishSM(f32x16& p0, f32x16& p1, float alpha, float& l_reg, bf16x8& pa0, bf16x8& pa1, bf16x8& pa2, bf16x8& pa3) {
#pragma unroll
    for (int r = 0; r < 16; ++r) p1[r] = __builtin_amdgcn_exp2f(p1[r]);
    float ps = 0;
#pragma unroll
    for (int r = 0; r < 16; ++r) ps += p0[r];
#pragma unroll
    for (int r = 0; r < 16; ++r) ps += p1[r];
    { auto rr = __builtin_amdgcn_permlane32_swap(__float_as_uint(ps), __float_as_uint(ps), false, false);
      ps = __uint_as_float(rr[0]) + __uint_as_float(rr[1]); }
    l_reg = l_reg * alpha + ps;
    PK4(p0, 0, pa0); PK4(p0, 8, pa1); PK4(p1, 0, pa2); PK4(p1, 8, pa3);
}
template <int ND0>
__device__ __forceinline__ void qkt(f32x16& p0, f32x16& p1, const bf16* Ks, const bf16x8* qr, int dbase, int r32, int hi) {
    p0 = f32x16{}; p1 = f32x16{};
#pragma unroll
    for (int d0 = 0; d0 < ND0; ++d0) { int cb = ((dbase + d0) * 16 + hi * 8) * 2;
        bf16x8 b0 = *reinterpret_cast<const bf16x8*>((const char*)Ks + KSWZ(r32, cb));
        bf16x8 b1 = *reinterpret_cast<const bf16x8*>((const char*)Ks + KSWZ(32 + r32, cb));
        p0 = __builtin_amdgcn_mfma_f32_32x32x16_bf16(b0, qr[d0], p0, 0, 0, 0);
        p1 = __builtin_amdgcn_mfma_f32_32x32x16_bf16(b1, qr[d0], p1, 0, 0, 0); }
}
__device__ __forceinline__ int v_st(int k, int c) { const int kk = (k & ~0xC) | ((k & 4) << 1) | ((k & 8) >> 1); return ((kk >> 3) * 4 + (c >> 5)) * 512 + ((kk & 7) * 32 + (c & 31)) * 2; }
__device__ __forceinline__ int v_rd_base(int lane) { return ((lane & 3) << 3) | (((lane >> 2) & 3) << 6) | (((lane >> 4) & 1) << 5) | (((lane >> 5) & 1) << 8); }
constexpr int v_rd_off(int d0, int ks, int half) { return d0 * 512 + ks * 4096 + half * 2048; }
template <int OFF> __device__ __forceinline__ s16x4 tr_read(int vb) {
    s16x4 r; asm volatile("ds_read_b64_tr_b16 %0, %1 offset:%2" : "=&v"(r) : "v"(vb), "i"(OFF) : "memory"); return r;
}
#define PKV(L, H) (bf16x8){L[0], L[1], L[2], L[3], H[0], H[1], H[2], H[3]}
template <int D0> __device__ __forceinline__ void pv_one(f32x16& od, int vb, bf16x8 pa0, bf16x8 pa1, bf16x8 pa2, bf16x8 pa3) {
    const s16x4 l0 = tr_read<v_rd_off(D0, 0, 0)>(vb), h0 = tr_read<v_rd_off(D0, 0, 1)>(vb), l1 = tr_read<v_rd_off(D0, 1, 0)>(vb), h1 = tr_read<v_rd_off(D0, 1, 1)>(vb);
    const s16x4 l2 = tr_read<v_rd_off(D0, 2, 0)>(vb), h2 = tr_read<v_rd_off(D0, 2, 1)>(vb), l3 = tr_read<v_rd_off(D0, 3, 0)>(vb), h3 = tr_read<v_rd_off(D0, 3, 1)>(vb);
    asm volatile("s_waitcnt lgkmcnt(0)" ::: "memory"); SBAR();
    od = __builtin_amdgcn_mfma_f32_32x32x16_bf16(pa0, PKV(l0, h0), od, 0, 0, 0);
    od = __builtin_amdgcn_mfma_f32_32x32x16_bf16(pa1, PKV(l1, h1), od, 0, 0, 0);
    od = __builtin_amdgcn_mfma_f32_32x32x16_bf16(pa2, PKV(l2, h2), od, 0, 0, 0);
    od = __builtin_amdgcn_mfma_f32_32x32x16_bf16(pa3, PKV(l3, h3), od, 0, 0, 0);
}
__device__ __forceinline__ void pv_d0(f32x16* o, int vb, bf16x8 pa0, bf16x8 pa1, bf16x8 pa2, bf16x8 pa3) {
    pv_one<0>(o[0], vb, pa0, pa1, pa2, pa3); pv_one<1>(o[1], vb, pa0, pa1, pa2, pa3); pv_one<2>(o[2], vb, pa0, pa1, pa2, pa3); pv_one<3>(o[3], vb, pa0, pa1, pa2, pa3);
}
template <int D0> __device__ __forceinline__ void pv_one32(f32x16& od, int vb, bf16x8 pa0, bf16x8 pa1) {
    const s16x4 l0 = tr_read<v_rd_off(D0, 0, 0)>(vb), h0 = tr_read<v_rd_off(D0, 0, 1)>(vb), l1 = tr_read<v_rd_off(D0, 1, 0)>(vb), h1 = tr_read<v_rd_off(D0, 1, 1)>(vb);
    asm volatile("s_waitcnt lgkmcnt(0)" ::: "memory"); SBAR();
    od = __builtin_amdgcn_mfma_f32_32x32x16_bf16(pa0, PKV(l0, h0), od, 0, 0, 0);
    od = __builtin_amdgcn_mfma_f32_32x32x16_bf16(pa1, PKV(l1, h1), od, 0, 0, 0);
}

typedef float f32x4c __attribute__((ext_vector_type(4)));
struct ConvJob {
    const float *w_gate, *w_up, *w_down, *w_out, *g_ffn; unsigned short *WGU, *WDN, *WOUT;
    int next, end, stride;
};
struct ConvItem { const float* W; unsigned short* dst; int N, K, k0, n0, drow; };
constexpr int CV_GU = 32 * 88, CV_OUT = 32 * 32, CV_TOTAL = 2 * CV_GU + CV_OUT;
__device__ __forceinline__ ConvItem conv_item(const float* Jw_gate, const float* Jw_up, const float* Jw_down, const float* Jw_out, unsigned short* JWGU, unsigned short* JWDN, unsigned short* JWOUT, int q) {
    ConvItem it;
    const bool gu = q < 2 * CV_GU; const int up = (q >= CV_GU) ? 1 : 0;
    const int rg = q - up * CV_GU, kbg = rg / 88, nbg = rg - kbg * 88;
    const int rd = gu ? 0 : q - 2 * CV_GU, kbd = rd >> 5, nbd = rd & 31;
    it.W = gu ? (up ? Jw_up : Jw_gate) : Jw_out;
    it.dst = gu ? JWGU : JWOUT;
    it.N = gu ? 5632 : 2048; it.K = 2048;
    it.k0 = 64 * (gu ? kbg : kbd); it.n0 = 64 * (gu ? nbg : nbd);
    it.drow = gu ? 256 * (it.n0 >> 7) + 128 * up + (it.n0 & 127) : it.n0;
    return it;
}
__device__ __forceinline__ void attn_dense_body(const bf16* __restrict__ Qb, const bf16* __restrict__ Kh, const bf16* __restrict__ Vh,
                                                unsigned short* __restrict__ Ob, int ldo, int dbase, int seq, char* lds, const int wave_in, ConvJob& cj,
                                                const bool second, unsigned short* __restrict__ Yb, const float lam, const float* __restrict__ subln) {
    using S8 = SM<125000>;
    const int wid = wave_in, lane = mk_lane(), tid = wid * 64 + lane, r32 = lane & 31, hi = lane >> 5;
    bf16* V_lds = (bf16*)lds; bf16* K_lds = (bf16*)(lds + 2 * SHM_V);
    float* ws = (float*)(lds + 2 * SHM_V + 2 * SHM_K) + wid * 64; float* li_l = ws; float* al_l = ws + 32;
    float m_reg = -1e30f, l_reg = 0; f32x16 o[4] = {}; bf16x8 qr[4];
    const bf16* Qw = Qb + (long)(wid * QBLK + r32) * LDR + dbase * 16 + hi * 8;
#pragma unroll
    for (int d0 = 0; d0 < 4; ++d0) qr[d0] = *reinterpret_cast<const bf16x8*>(Qw + d0 * 16);
    const int sr = tid >> 4, sc = (tid & 15) * 8, vst0 = v_st(sr, sc), vst1 = v_st(32 + sr, sc);
    const int vb0 = (int)(uintptr_t)V_lds + v_rd_base(lane);
    struct { bf16x8 vs0, vs1, ks0; } sr_[2];
    const int krow = tid >> 3, kcol = dbase * 16 + (tid & 7) * 8, kst0 = KSWZ(krow, kcol * 2);
#define SLOAD(i, k0) do { sr_[i].vs0 = *reinterpret_cast<const bf16x8*>(&Vh[(long)((k0) + sr) * LDR + sc]); sr_[i].vs1 = *reinterpret_cast<const bf16x8*>(&Vh[(long)((k0) + 32 + sr) * LDR + sc]); \
    sr_[i].ks0 = *reinterpret_cast<const bf16x8*>(&Kh[(long)((k0) + krow) * LDR + kcol]); } while (0)
#define SWRITE(b, i) do { *(bf16x8*)((char*)V_lds + (b) * SHM_V + vst0) = sr_[i].vs0;          \
    *(bf16x8*)((char*)V_lds + (b) * SHM_V + vst1) = sr_[i].vs1;                              \
    *(bf16x8*)((char*)K_lds + (b) * SHM_K + kst0) = sr_[i].ks0; } while (0)
#define SWAIT() do {} while (0)
#define RESC(a) do { if (__any((a) < 1.f)) { if (hi == 0) al_l[r32] = (a); asm volatile("s_waitcnt lgkmcnt(0)" ::: "memory"); \
    _Pragma("unroll") for (int d = 0; d < 4; ++d) _Pragma("unroll") for (int r = 0; r < 16; ++r) o[d][r] *= al_l[crow(r, hi)]; } } while (0)
    f32x16 pA0, pA1, pB0, pB1; float mnA, mnB, alA, alB; bf16x8 pa0, pa1, pa2, pa3; const int NT = seq / KVBLK;
    const float* const jwg = cj.w_gate; const float* const jwu = cj.w_up; const float* const jwd = cj.w_down; const float* const jwo = cj.w_out;
    unsigned short* const jGU = cj.WGU; unsigned short* const jDN = cj.WDN; unsigned short* const jOUT = cj.WOUT; const int jnext = cj.next, jend = cj.end, jstride = cj.stride;
    float* cscr = (float*)(lds + SHM_ATTN); f32x4c cv0, cv1; int slot = 0;
#define CV_Q(k) (min(jnext + (k) * jstride, jend))
#define CV_LOAD(q) do { const ConvItem it_ = conv_item(jwg, jwu, jwd, jwo, jGU, jDN, jOUT, (q)); const float* s_ = it_.W + (size_t)(it_.k0 + (tid >> 3)) * it_.N + it_.n0 + 8 * (tid & 7); \
    cv0 = __builtin_nontemporal_load((const f32x4c*)s_); cv1 = __builtin_nontemporal_load((const f32x4c*)(s_ + 4)); } while (0)
#define CV_WRITE() do { f32x4c* d_ = (f32x4c*)(cscr + (tid >> 3) * 64 + 8 * ((tid & 7) ^ ((tid >> 6) & 7))); d_[0] = cv0; d_[1] = cv1; } while (0)
#define CV_STORE(q) do { const ConvItem it_ = conv_item(jwg, jwu, jwd, jwo, jGU, jDN, jOUT, (q)); const int n_ = tid >> 3, c_ = tid & 7; const float* s_ = cscr + (8 * c_) * 64 + (n_ ^ (8 * c_)); \
    u32x4 o_; o_.x = cvtpk(s_[0], s_[64]); o_.y = cvtpk(s_[128], s_[192]); o_.z = cvtpk(s_[256], s_[320]); o_.w = cvtpk(s_[384], s_[448]); \
    *(u32x4*)(it_.dst + (size_t)(it_.drow + n_) * it_.K + it_.k0 + 8 * c_) = o_; } while (0)
#define CV_CONSUME() do { CV_WRITE(); const int qn_ = CV_Q(slot + 1); CV_LOAD(qn_); } while (0)
#define CV_FINISH() do { const int qc_ = CV_Q(slot); CV_STORE(qc_); ++slot; } while (0)
    const int owed = (jnext > jend) ? 0 : (jend - jnext) / jstride + 1;
    const int ctrips = min((owed + 1) >> 1, (NT - 2) >> 1);
    if (ctrips > 0) { const int q0_ = CV_Q(0); CV_LOAD(q0_); }
    constexpr int SE = 0, SO = 1;
    SLOAD(SE, 0); asm volatile("s_waitcnt vmcnt(0)" ::: "memory"); SWRITE(0, SE); __syncthreads();
    qkt<4>(pA0, pA1, K_lds, qr, dbase, r32, hi); S8::partialSM(pA0, pA1, m_reg, mnA, alA);
    SLOAD(SO, KVBLK); if (2 < NT) SLOAD(SE, 2 * KVBLK);
    SWAIT(); SWRITE(1, SO); __syncthreads();
#define B_TRIP(CONV) do { \
        SBAR(); qkt<4>(pB0, pB1, (bf16*)((char*)K_lds + SHM_K), qr, dbase, r32, hi); \
        finishSM(pA0, pA1, alA, l_reg, pa0, pa1, pa2, pa3); SBAR(); \
        SLOAD(SO, (j + 2) * KVBLK); SBAR(); \
        pv_d0(o, vb0, pa0, pa1, pa2, pa3); S8::partialSM(pB0, pB1, m_reg, mnB, alB); \
        __syncthreads(); SWAIT(); SWRITE(0, SE); \
        if (CONV) CV_CONSUME(); \
        RESC(alB); __syncthreads(); \
        if (CONV) CV_FINISH(); \
        SBAR(); qkt<4>(pA0, pA1, K_lds, qr, dbase, r32, hi); \
        finishSM(pB0, pB1, alB, l_reg, pa0, pa1, pa2, pa3); SBAR(); \
        SLOAD(SE, min(j + 3, NT - 1) * KVBLK); SBAR();     \
        pv_d0(o, vb0 + (int)SHM_V, pa0, pa1, pa2, pa3); S8::partialSM(pA0, pA1, m_reg, mnA, alA); \
        __syncthreads(); SWAIT(); SWRITE(1, SO); \
        if (CONV) CV_CONSUME(); \
        RESC(alA); __syncthreads(); \
        if (CONV) CV_FINISH(); } while (0)
    int j = 1;
    for (int tr = 0; tr < ctrips; ++tr, j += 2) B_TRIP(true);
    for (; j + 1 < NT; j += 2) B_TRIP(false);
#undef B_TRIP
    cj.next = min(jnext + slot * jstride, jend + jstride);
    SBAR(); qkt<4>(pB0, pB1, (bf16*)((char*)K_lds + SHM_K), qr, dbase, r32, hi);
    finishSM(pA0, pA1, alA, l_reg, pa0, pa1, pa2, pa3); SBAR();
    pv_d0(o, vb0, pa0, pa1, pa2, pa3); S8::partialSM(pB0, pB1, m_reg, mnB, alB);
    __syncthreads(); RESC(alB);
    finishSM(pB0, pB1, alB, l_reg, pa0, pa1, pa2, pa3); SBAR();
    pv_d0(o, vb0 + (int)SHM_V, pa0, pa1, pa2, pa3);
    if (hi == 0) li_l[r32] = l_reg; asm volatile("s_waitcnt lgkmcnt(0)" ::: "memory");
    float rli[16];
#pragma unroll
    for (int r = 0; r < 16; ++r) rli[r] = __builtin_amdgcn_rcpf(li_l[crow(r, hi)]);
    unsigned short* Ow = (unsigned short*)(lds + SHM_ATTN + 16384) + wid * 4096;
    if (!second) {
#pragma unroll
        for (int r = 0; r < 16; ++r) { int orow = crow(r, hi);
#pragma unroll
            for (int d0 = 0; d0 < 4; ++d0) Ow[orow * 128 + d0 * 32 + r32] = f2bf1(o[d0][r] * rli[r]); }
        asm volatile("s_waitcnt lgkmcnt(0)" ::: "memory");
    } else {
        float ssq[16];
#pragma unroll
        for (int r = 0; r < 16; ++r) { const int orow = crow(r, hi); ssq[r] = 0.f;
#pragma unroll
            for (int d0 = 0; d0 < 4; ++d0) { const float o0 = __uint_as_float((unsigned)Ow[orow * 128 + d0 * 32 + r32] << 16);
                const float d = o0 - lam * (o[d0][r] * rli[r]); o[d0][r] = d; ssq[r] += d * d; } }
#pragma unroll
        for (int r = 0; r < 16; ++r) { float v = ssq[r]; v += __shfl_xor(v, 1); v += __shfl_xor(v, 2); v += __shfl_xor(v, 4); v += __shfl_xor(v, 8); v += __shfl_xor(v, 16); ssq[r] = v; }
        float sl[4];
#pragma unroll
        for (int d0 = 0; d0 < 4; ++d0) sl[d0] = subln[d0 * 32 + r32] * 0.8f;
        unsigned short* Yw = Yb + (long)(wid * QBLK) * 2048;
#pragma unroll
        for (int r = 0; r < 16; ++r) { const int orow = crow(r, hi); const float rs = 1.0f / sqrtf(ssq[r] * (1.0f / 128.0f) + 1e-5f);
#pragma unroll
            for (int d0 = 0; d0 < 4; ++d0) Ow[orow * 128 + d0 * 32 + r32] = f2bf1(o[d0][r] * rs * sl[d0]); }
        asm volatile("s_waitcnt lgkmcnt(0)" ::: "memory");
#pragma unroll
        for (int i = 0; i < 8; ++i) { const int idx = i * 64 + lane, row = idx >> 4, ch = idx & 15;
            const u32x4 v = *(const u32x4*)(Ow + row * 128 + ch * 8);
            *(u32x4*)(Yw + (long)row * 2048 + ch * 8) = v; }
        asm volatile("s_waitcnt lgkmcnt(0)" ::: "memory");
    }
#undef CV_LOAD
#undef CV_Q
#undef CV_STORE
#undef CV_WRITE
#undef CV_CONSUME
#undef CV_FINISH
#undef SLOAD
#undef SWRITE
#undef SWAIT
#undef RESC
}

__device__ __forceinline__ void swa_wave_unit(const bf16* __restrict__ base, long rstride, int qc, int kc, int vc, int t0, int L,
                                              unsigned short* __restrict__ Ob, long ostride, float* __restrict__ Lb, long lstride, char* lds_w, float* scr) {
    constexpr float SCALE = 0.088388347648318440f, C = SCALE * 1.4426950408889634f;
    const int lane = mk_lane(), r32 = lane & 31, hi = lane >> 5;
    bf16* K_lds = (bf16*)lds_w; char* V_lds = lds_w + 8192;
    bf16x8 qr[8];
    { const bf16* Qw = base + (long)(t0 + r32) * rstride + qc + hi * 8;
#pragma unroll
      for (int d0 = 0; d0 < 8; ++d0) qr[d0] = *reinterpret_cast<const bf16x8*>(Qw + d0 * 16); }
    const int srow = lane >> 4, scol = (lane & 15) * 8;
    const bf16* kbase = base + (long)srow * rstride + kc + scol; const bf16* vbase = base + (long)srow * rstride + vc + scol;
    bf16x8 st[2][8];
#define TILE_K0(i) (t0 - 64 + 32 * (i))
#define TILE_OK(i) (TILE_K0(i) >= 0 && TILE_K0(i) < L)
#define TILE_KC(i) (min(max(TILE_K0(i), 0), L - 32))
#define LD_TILE(buf, pbase, i) do { const bf16* p_ = (pbase) + (long)TILE_KC(i) * rstride; _Pragma("unroll") for (int j = 0; j < 8; ++j) st[buf][j] = *reinterpret_cast<const bf16x8*>(p_ + (long)(4 * j) * rstride); } while (0)
    f32x16 s[5];
    LD_TILE(0, kbase, 0);
#pragma unroll
    for (int i = 0; i < 5; ++i) {
        if (i < 4) LD_TILE((i + 1) & 1, kbase, i + 1); else LD_TILE((i + 1) & 1, vbase, 0);
#pragma unroll
        for (int j = 0; j < 8; ++j) *(bf16x8*)((char*)K_lds + KSWZ(4 * j + srow, scol * 2)) = st[i & 1][j];
        f32x16 p = f32x16{};
#pragma unroll
        for (int d0 = 0; d0 < 8; ++d0) { const int cb = (d0 * 16 + hi * 8) * 2;
            const bf16x8 b0 = *reinterpret_cast<const bf16x8*>((const char*)K_lds + KSWZ(r32, cb));
            p = __builtin_amdgcn_mfma_f32_32x32x16_bf16(b0, qr[d0], p, 0, 0, 0); }
        const bool ok = TILE_OK(i);
#pragma unroll
        for (int r = 0; r < 16; ++r) {
            bool keep = ok;
            if (i == 0) keep = keep && (crow(r, hi) >= r32);
            if (i == 4) keep = keep && (crow(r, hi) <= r32);
            s[i][r] = keep ? p[r] : -1e30f;
        }
    }
    float m = -1e30f;
#pragma unroll
    for (int i = 0; i < 5; ++i)
#pragma unroll
        for (int r = 0; r < 16; ++r) m = fmaxf(m, s[i][r]);
    { auto rr = __builtin_amdgcn_permlane32_swap(__float_as_uint(m), __float_as_uint(m), false, false);
      m = fmaxf(__uint_as_float(rr[0]), __uint_as_float(rr[1])); }
    const float mC = -m * C; float l = 0.f;
#pragma unroll
    for (int i = 0; i < 5; ++i)
#pragma unroll
        for (int r = 0; r < 16; ++r) { s[i][r] = __builtin_amdgcn_exp2f(fmaf(s[i][r], C, mC)); l += s[i][r]; }
    { auto rr = __builtin_amdgcn_permlane32_swap(__float_as_uint(l), __float_as_uint(l), false, false);
      l = __uint_as_float(rr[0]) + __uint_as_float(rr[1]); }
    bf16x8 pa[5][2];
#pragma unroll
    for (int i = 0; i < 5; ++i) { PK4(s[i], 0, pa[i][0]); PK4(s[i], 8, pa[i][1]); }
    f32x16 o[4] = {};
    const int vb = (int)(uintptr_t)V_lds + v_rd_base(lane);
#pragma unroll
    for (int i = 0; i < 5; ++i) {
        if (i < 4) LD_TILE(i & 1, vbase, i + 1);
#pragma unroll
        for (int j = 0; j < 8; ++j) *(bf16x8*)(V_lds + v_st(4 * j + srow, scol)) = st[(i + 1) & 1][j];
        asm volatile("s_waitcnt lgkmcnt(0)" ::: "memory");
        pv_one32<0>(o[0], vb, pa[i][0], pa[i][1]); pv_one32<1>(o[1], vb, pa[i][0], pa[i][1]); pv_one32<2>(o[2], vb, pa[i][0], pa[i][1]); pv_one32<3>(o[3], vb, pa[i][0], pa[i][1]);
    }
#undef TILE_K0
#undef TILE_OK
#undef TILE_KC
#undef LD_TILE
    if (hi == 0) { scr[r32] = l; Lb[(long)(t0 + r32) * lstride] = m * SCALE + __logf(l); }
    asm volatile("s_waitcnt lgkmcnt(0)" ::: "memory");
    float rli[16];
#pragma unroll
    for (int r = 0; r < 16; ++r) rli[r] = __builtin_amdgcn_rcpf(scr[crow(r, hi)]);
#pragma unroll
    for (int r = 0; r < 16; ++r) { const long orow = (long)(t0 + crow(r, hi)) * ostride;
#pragma unroll
        for (int d0 = 0; d0 < 4; ++d0) Ob[orow + d0 * 32 + r32] = f2bf1(o[d0][r] * rli[r]); }
    asm volatile("s_waitcnt lgkmcnt(0)" ::: "memory");
}
__device__ __forceinline__ void swa_wg_unit(const bf16* __restrict__ QKVb, int gbr, int sub0, int qt0, int sstep, unsigned short* __restrict__ OAg, float* __restrict__ LSEg, char* lds, float* scr, const int wid) {
    constexpr float SCALE = 0.088388347648318440f, C = SCALE * 1.4426950408889634f;
    const int lane = mk_lane(), tid = wid * 64 + lane, r32 = lane & 31, hi = lane >> 5;
    const int dsh = 2 * gbr, dil = 1 << dsh, L = 2048 >> dsh, nblk = L >> 5; const bool big = nblk >= 8;
    const long rstride = (long)dil * LDR;
#define SUB_BASE(sub) (QKVb + ((size_t)((sub) >> (3 + dsh)) * 2048 + (((sub) >> 3) & (dil - 1))) * LDR + ((sub) & 7) * 128)
    const int srow = tid >> 4, scol = (tid & 15) * 8;
    bf16x8 kst[12], vst[12];
#pragma unroll
    for (int sl = 0; sl < 12; ++sl) {
        const int sub_s = big ? sub0 : sub0 + ((sl >> 2) & 1) * sstep; const int kt_s = big ? min(max(qt0 - 2 + sl, 0), nblk - 1) : (sl & 3);
        const bf16* p_ = SUB_BASE(sub_s) + (long)(kt_s * 32 + srow) * rstride + scol;
        kst[sl] = *reinterpret_cast<const bf16x8*>(p_ + 1024);
    }
    const int sub_w = big ? sub0 : sub0 + (wid >> 2) * sstep; const int qt = big ? qt0 + wid : (wid & 3); const int t0 = qt * 32;
    const bf16* base_w = SUB_BASE(sub_w);
    bf16x8 qr[8];
    { const bf16* Qw = base_w + (long)(t0 + r32) * rstride + hi * 8;
#pragma unroll
      for (int d0 = 0; d0 < 8; ++d0) qr[d0] = *reinterpret_cast<const bf16x8*>(Qw + d0 * 16); }
#pragma unroll
    for (int sl = 0; sl < 12; ++sl) *(bf16x8*)(lds + sl * 8192 + KSWZ(srow, scol * 2)) = kst[sl];
#pragma unroll
    for (int sl = 0; sl < 12; ++sl) {
        const int sub_s = big ? sub0 : sub0 + ((sl >> 2) & 1) * sstep; const int kt_s = big ? min(max(qt0 - 2 + sl, 0), nblk - 1) : (sl & 3);
        const bf16* p_ = SUB_BASE(sub_s) + (long)(kt_s * 32 + srow) * rstride + scol;
        vst[sl] = *reinterpret_cast<const bf16x8*>(p_ + 2048);
    }
    __syncthreads();
    f32x16 s[5];
#pragma unroll
    for (int i = 0; i < 5; ++i) {
        const int kt = qt - 2 + i; const bool ok = kt >= 0 && kt < nblk;
        const int slot = big ? wid + i : 4 * (wid >> 2) + min(max(kt, 0), 3);
        const char* Ks = lds + slot * 8192;
        f32x16 p = f32x16{};
#pragma unroll
        for (int d0 = 0; d0 < 8; ++d0) { const int cb = (d0 * 16 + hi * 8) * 2;
            const bf16x8 b0 = *reinterpret_cast<const bf16x8*>(Ks + KSWZ(r32, cb));
            p = __builtin_amdgcn_mfma_f32_32x32x16_bf16(b0, qr[d0], p, 0, 0, 0); }
#pragma unroll
        for (int r = 0; r < 16; ++r) {
            bool keep = ok;
            if (i == 0) keep = keep && (crow(r, hi) >= r32);
            if (i == 4) keep = keep && (crow(r, hi) <= r32);
            s[i][r] = keep ? p[r] : -1e30f;
        }
    }
    float m = -1e30f;
#pragma unroll
    for (int i = 0; i < 5; ++i)
#pragma unroll
        for (int r = 0; r < 16; ++r) m = fmaxf(m, s[i][r]);
    { auto rr = __builtin_amdgcn_permlane32_swap(__float_as_uint(m), __float_as_uint(m), false, false);
      m = fmaxf(__uint_as_float(rr[0]), __uint_as_float(rr[1])); }
    const float mC = -m * C; float l = 0.f;
#pragma unroll
    for (int i = 0; i < 5; ++i)
#pragma unroll
        for (int r = 0; r < 16; ++r) { s[i][r] = __builtin_amdgcn_exp2f(fmaf(s[i][r], C, mC)); l += s[i][r]; }
    { auto rr = __builtin_amdgcn_permlane32_swap(__float_as_uint(l), __float_as_uint(l), false, false);
      l = __uint_as_float(rr[0]) + __uint_as_float(rr[1]); }
    bf16x8 pa[5][2];
#pragma unroll
    for (int i = 0; i < 5; ++i) { PK4(s[i], 0, pa[i][0]); PK4(s[i], 8, pa[i][1]); }
    __syncthreads();
#pragma unroll
    for (int sl = 0; sl < 12; ++sl) *(bf16x8*)(lds + sl * 8192 + v_st(srow, scol)) = vst[sl];
    __syncthreads();
    f32x16 o[4] = {};
#pragma unroll
    for (int i = 0; i < 5; ++i) {
        const int kt = qt - 2 + i;
        const int slot = big ? wid + i : 4 * (wid >> 2) + min(max(kt, 0), 3);
        const int vb = (int)(uintptr_t)(lds + slot * 8192) + v_rd_base(lane);
        pv_one32<0>(o[0], vb, pa[i][0], pa[i][1]); pv_one32<1>(o[1], vb, pa[i][0], pa[i][1]); pv_one32<2>(o[2], vb, pa[i][0], pa[i][1]); pv_one32<3>(o[3], vb, pa[i][0], pa[i][1]);
    }
    const size_t tok0 = ((size_t)(sub_w >> (3 + dsh)) * 2048 + ((sub_w >> 3) & (dil - 1))); const int hh = sub_w & 7;
    if (hi == 0) { scr[r32] = l; LSEg[(tok0 + (size_t)(t0 + r32) * dil) * 8 + hh] = m * SCALE + __logf(l); }
    asm volatile("s_waitcnt lgkmcnt(0)" ::: "memory");
    float rli[16];
#pragma unroll
    for (int r = 0; r < 16; ++r) rli[r] = __builtin_amdgcn_rcpf(scr[crow(r, hi)]);
    { unsigned short* stg = (unsigned short*)(lds + 98304) + wid * 2048;
#pragma unroll
      for (int ps = 0; ps < 2; ++ps) {
#pragma unroll
        for (int r = 8 * ps; r < 8 * ps + 8; ++r) { const int sr_ = crow(r, hi) - 16 * ps;
#pragma unroll
            for (int d0 = 0; d0 < 4; ++d0) stg[sr_ * 128 + d0 * 32 + r32] = f2bf1(o[d0][r] * rli[r]); }
        asm volatile("s_waitcnt lgkmcnt(0)" ::: "memory");
#pragma unroll
        for (int i = 0; i < 4; ++i) { const int idx = i * 64 + lane, row = idx >> 4, ch = idx & 15;
            const u32x4 v = *(const u32x4*)(stg + row * 128 + ch * 8);
            *(u32x4*)(OAg + (tok0 + (size_t)(t0 + 16 * ps + row) * dil) * 1024 + hh * 128 + ch * 8) = v; }
        asm volatile("s_waitcnt lgkmcnt(0)" ::: "memory");
      } }
    asm volatile("s_waitcnt lgkmcnt(0)" ::: "memory");
    __syncthreads();
#undef SUB_BASE
}
#undef SBAR
}
#ifndef MK_DUP_PHASE
#define MK_DUP_PHASE -1
#endif
#define NREP(k) (1 + (MK_DUP_PHASE == (k) ? 1 : 0))
#ifndef WGM_P1
#define WGM_P1 4
#endif
#ifndef WGM_P4
#define WGM_P4 8
#endif
#ifndef WGM_P5
#define WGM_P5 2
#endif
#ifndef WGM_P6
#define WGM_P6 8
#endif
#ifndef MK_TIME_PHASE
#define MK_TIME_PHASE -1
#endif
#ifndef MK_ONE_LAUNCH
#define MK_ONE_LAUNCH 1
#endif
constexpr int NWAVES = 8;
constexpr int BATCH = 4, SEQ = 2048, DM = 2048, M = BATCH * SEQ, NIN = 6144, DFF = 5632, NGU = 2 * DFF, NHEAD = 8, HD = 128;
constexpr float RMS_EPS = 1e-6f, SUBLN_EPS = 1e-5f, LAM_INIT = 0.2f;
constexpr size_t MiB = 1u << 20;
constexpr size_t WS_SS1 = 0, WS_SS2 = 64 * 1024, WS_LSE = 1 * MiB;
constexpr size_t WS_QKV = 2 * MiB;
constexpr size_t WS_Y = 162 * MiB;
constexpr size_t WS_H = 34 * MiB;
constexpr size_t WS_WIN = 98 * MiB, WS_XN = 122 * MiB;
constexpr size_t WS_OA = 98 * MiB;
constexpr size_t WS_WOUT = 154 * MiB;
constexpr size_t WS_OB = 162 * MiB, WS_XG = 2 * MiB;
constexpr size_t WS_WGU = 194 * MiB, WS_WDN = 238 * MiB, WS_END = 260 * MiB;
static_assert(WS_H + (size_t)M * DFF * 2 <= WS_WOUT && WS_XG + (size_t)M * DM * 2 <= WS_H && WS_Y + (size_t)M * DM * 2 <= WS_WGU && WS_OA + (size_t)3 * M * 1024 * 2 <= WS_WOUT && WS_WDN + (size_t)DM * DFF * 2 <= WS_END && WS_WGU + (size_t)NGU * DM * 2 <= WS_WDN && WS_QKV + (size_t)M * NIN * 2 <= WS_WIN, "d_ws map");
constexpr int RING_BYTES = 131072, LDS_BYTES = 163840, MISC_OFF = 163584;
constexpr size_t WS_BAR = 128 * 1024, WS_CNT = 144 * 1024, WS_FLAG = 152 * 1024, WS_GRP = 160 * 1024, BAR_BYTES = 40 * 1024;

#define GAS __attribute__((address_space(1)))
#define LAS __attribute__((address_space(3)))
typedef unsigned short bf16;
typedef unsigned v4u __attribute__((ext_vector_type(4)));
typedef float f32x4 __attribute__((ext_vector_type(4)));
#define LDS_WAIT() asm volatile("s_waitcnt lgkmcnt(0)" ::: "memory")
__device__ __forceinline__ unsigned f2bf(float f) { unsigned u = __builtin_bit_cast(unsigned, f); return (u + 0x7fffu + ((u >> 16) & 1u)) >> 16; }
__device__ __forceinline__ unsigned pk2(float lo, float hi) { return f2bf(lo) | (f2bf(hi) << 16); }
__device__ __forceinline__ float bflo(unsigned w) { return __uint_as_float(w << 16); }
__device__ __forceinline__ float bfhi(unsigned w) { return __uint_as_float(w & 0xffff0000u); }
__device__ __forceinline__ float wave_sum(float v) {
#pragma unroll
    for (int o = 1; o < 64; o <<= 1) v += __shfl_xor(v, o);
    return v;
}
__device__ __forceinline__ void transpose_item(const float* W, int K, int N, bf16* WT, int k0, int n0, int dst_row0, LAS float* scr, int lane, const float* ks = nullptr) {
    float wv[32];
#pragma unroll
    for (int i = 0; i < 32; ++i) { const int kk = 2 * i + (lane >> 5); wv[i] = __builtin_nontemporal_load(W + (size_t)(k0 + kk) * N + n0 + (lane & 31)); }
#pragma unroll
    for (int i = 0; i < 32; ++i) { const int kk = 2 * i + (lane >> 5); scr[kk * 33 + (lane & 31)] = wv[i]; }
    LDS_WAIT(); asm volatile("" ::: "memory");
    const int c = lane & 7;
    f32x4 g0 = {1.f, 1.f, 1.f, 1.f}, g1 = {1.f, 1.f, 1.f, 1.f};
    if (ks) { g0 = *(const f32x4*)(ks + k0 + 8 * c); g1 = *(const f32x4*)(ks + k0 + 8 * c + 4); }
#pragma unroll
    for (int j = 0; j < 4; ++j) { const int n = (lane >> 3) + 8 * j; const LAS float* s = scr + (8 * c) * 33 + n;
        v4u o; o.x = pk2(s[0 * 33] * g0.x, s[1 * 33] * g0.y); o.y = pk2(s[2 * 33] * g0.z, s[3 * 33] * g0.w); o.z = pk2(s[4 * 33] * g1.x, s[5 * 33] * g1.y); o.w = pk2(s[6 * 33] * g1.z, s[7 * 33] * g1.w);
        *(GAS v4u*)(WT + (size_t)(dst_row0 + n) * K + k0 + 8 * c) = o; }
    LDS_WAIT(); asm volatile("" ::: "memory");
}

#define XB_TMO      128
#define XB_XCNT(j)  (256  + 64 * (j))
#define XB_XSUB(j)  (1280 + 64 * (j))
#define XB_XGEN(j)  (2304 + 64 * (j))
#define XB_TOP      3328
#define XB_TOPGEN   3392
#define XCD_BAR_WORDS 3456
#define XB_SPIN_CAP (1u << 18)

__device__ __forceinline__ unsigned xb_ld(unsigned* p)              { return __hip_atomic_load(p, __ATOMIC_RELAXED, __HIP_MEMORY_SCOPE_AGENT); }
__device__ __forceinline__ unsigned xb_add(unsigned* p, unsigned v) { return __hip_atomic_fetch_add(p, v, __ATOMIC_RELAXED, __HIP_MEMORY_SCOPE_AGENT); }
__device__ __forceinline__ unsigned xb_xcc_id() { return (unsigned)__builtin_amdgcn_s_getreg((3 << 11) | 20) & 0xFu; }
#define XB_SPIN(cond, bar) do { unsigned _sp = 0; while (cond) { __builtin_amdgcn_s_sleep(1); \
    if ((++_sp & 255u) == 0u) { if (xb_ld(&(bar)[XB_TMO])) break; if (_sp > XB_SPIN_CAP) { atomicAdd(&(bar)[XB_TMO], 1u); break; } } } } while (0)

struct XcdBarrier {
    unsigned* bar; unsigned x;
    volatile LAS unsigned* st;
};

__device__ __forceinline__ XcdBarrier xcd_barrier_post(unsigned* bar, volatile LAS unsigned* st, const int wave_in) {
    XcdBarrier b; b.bar = bar; b.x = xb_xcc_id(); b.st = st;
    if (wave_in == 0 && mk_lane() == 0) (void)xb_add(&bar[XB_XCNT(b.x)], 1u);
    return b;
}
__device__ __forceinline__ void xcd_barrier_complete(unsigned* bar, unsigned x, unsigned& nloc, unsigned& nx) {
    const unsigned G = gridDim.x * gridDim.y * gridDim.z;
    unsigned sum, cnt, mine, sp = 0u;
    for (;;) {
        sum = 0u; cnt = 0u; mine = 0u;
#pragma unroll
        for (unsigned j = 0; j < 16; ++j) { const unsigned c = xb_ld(&bar[XB_XCNT(j)]); sum += c; cnt += (c > 0u) ? 1u : 0u; mine = (j == x) ? c : mine; }
        if (sum == G) break;
        __builtin_amdgcn_s_sleep(1);
        if ((++sp & 255u) == 0u) { if (xb_ld(&bar[XB_TMO])) break; if (sp > XB_SPIN_CAP) { atomicAdd(&bar[XB_TMO], 1u); break; } }
    }
    nloc = mine > 0u ? mine : 1u; nx = cnt > 0u ? cnt : 1u;
}

__device__ __forceinline__ void xcd_barrier(const XcdBarrier& b, const int wave_in) {
    asm volatile("s_waitcnt vmcnt(0)" ::: "memory");
    __syncthreads();
    if (wave_in == 0 && mk_lane() == 0) {
        unsigned* bar = b.bar;
        __builtin_amdgcn_s_waitcnt(0);
        unsigned nloc = b.st[0], nx = b.st[1];
        if (nloc == 0u) { xcd_barrier_complete(bar, b.x, nloc, nx); b.st[0] = nloc; b.st[1] = nx; }
        const unsigned old = xb_add(&bar[XB_XSUB(b.x)], 1u);
        const unsigned gen = old / nloc;
        if (old + 1u == (gen + 1u) * nloc) {
            __builtin_amdgcn_fence(__ATOMIC_RELEASE, "agent");
            asm volatile("s_waitcnt vmcnt(0)" ::: "memory");
            const unsigned og = xb_add(&bar[XB_TOP], 1u);
            const unsigned tg = og / nx;
            if (og + 1u == (tg + 1u) * nx) xb_add(&bar[XB_TOPGEN], 1u);
            else XB_SPIN(xb_ld(&bar[XB_TOPGEN]) == tg, bar);
            __builtin_amdgcn_fence(__ATOMIC_ACQUIRE, "agent");
            xb_add(&bar[XB_XGEN(b.x)], 1u);
            asm volatile("s_waitcnt vmcnt(0)" ::: "memory");
        } else {
            XB_SPIN(xb_ld(&bar[XB_XGEN(b.x)]) == gen, bar);
            __builtin_amdgcn_fence(__ATOMIC_ACQUIRE, "agent");
            asm volatile("s_waitcnt vmcnt(0)" ::: "memory");
        }
    }
    __syncthreads();
}
struct Args { const float* in[11]; float* out; unsigned char* ws; int ph_lo, ph_hi; };
constexpr int NPHASE = 7;

__global__ void __launch_bounds__(NWAVES * 64, 2) mk_fwd(Args args) {
    extern __shared__ __attribute__((aligned(16))) unsigned char lds[];
    LAS unsigned char* ldsl = (LAS unsigned char*)lds;
    const int wave = __builtin_amdgcn_readfirstlane((int)threadIdx.x >> 6);
    const int G = gridDim.x, bx = blockIdx.x;
    const int vcu = (G % 8 == 0) ? (bx % 8) * (G / 8) + bx / 8 : bx;
    const int gw = vcu * NWAVES + wave, NGW = G * NWAVES;
    unsigned char* ws = args.ws;
    const float* x = args.in[0]; const float* g_attn = args.in[1]; const float* w_in = args.in[2]; const float* lambda_qk = args.in[3]; const float* subln = args.in[4];
    const float* w_out = args.in[5]; const float* g_ffn = args.in[6]; const float* w_gate = args.in[7]; const float* w_up = args.in[8]; const float* w_down = args.in[9];
    const float* g_final = args.in[10];
    float* out = args.out;
    float* SS1 = (float*)(ws + WS_SS1); float* SS2 = (float*)(ws + WS_SS2); float* LSE = (float*)(ws + WS_LSE);
    bf16* QKV = (bf16*)(ws + WS_QKV); bf16* WGU = (bf16*)(ws + WS_WGU); bf16* WDN = (bf16*)(ws + WS_WDN); bf16* HB = (bf16*)(ws + WS_H);
    bf16* WIN = (bf16*)(ws + WS_WIN); bf16* XN = (bf16*)(ws + WS_XN); bf16* OA = (bf16*)(ws + WS_OA); bf16* WOUT = (bf16*)(ws + WS_WOUT);
    bf16* OB = (bf16*)(ws + WS_OB); bf16* XG = (bf16*)(ws + WS_XG); bf16* Y = (bf16*)(ws + WS_Y);
    const int lo = args.ph_lo, hi_ph = args.ph_hi;
#define IN(k) (lo <= (k) && (k) < hi_ph)
    if (wave == 0) { const int l0 = mk_lane(); if (l0 < 32) ((LAS unsigned*)(ldsl + MISC_OFF))[l0] = 0u; }
    __syncthreads();
    XcdBarrier bar; bar.bar = (unsigned*)(ws + WS_BAR); bar.x = 0; bar.st = nullptr;
    if (hi_ph - lo > 1) bar = xcd_barrier_post((unsigned*)(ws + WS_BAR), (volatile LAS unsigned*)(ldsl + MISC_OFF), wave);
    if (lo < -1000) cg::this_grid().sync();
#define STAMP(k) do { if (MK_TIME_PHASE >= 0) { const unsigned long long t_ = __builtin_amdgcn_s_memrealtime(); if ((k) == MK_TIME_PHASE) tph0 = t_; if ((k) == MK_TIME_PHASE + 1) tph1 = t_; } } while (0)
    unsigned long long tph0 = 0, tph1 = 0; STAMP(0);
#define SEAM(k) do { if (IN(k) && IN((k) + 1)) { for (int rb = 0; rb < (MK_DUP_PHASE == 30 ? 3 : 1); ++rb) xcd_barrier(bar, wave); } } while (0)

    if (IN(0)) for (int rep = 0; rep < NREP(0); ++rep) { const int lane = mk_lane(), tid = wave * 64 + lane;
        LAS float* scr = (LAS float*)(ldsl + wave * 16384);
        constexpr int I_IN = (DM / 64) * (NIN / 32), I_OUT = (DM / 64) * (DM / 32);
        for (int it = gw; it < I_IN; it += NGW) {
            if (it < I_IN) { const int nblk = NIN / 32, kb = it / nblk, nb = it % nblk; transpose_item(w_in, DM, NIN, WIN, 64 * kb, 32 * nb, 32 * nb, scr, lane); }
            else { const int r = it - I_IN; const int nblk = DM / 32, kb = r / nblk, nb = r % nblk; transpose_item(w_out, DM, DM, WOUT, 64 * kb, 32 * nb, 32 * nb, scr, lane); }
        }
        for (int m = gw; m < M; m += 2 * NGW) {
            const GAS f32x4* xr0 = (const GAS f32x4*)(x + (size_t)m * DM) + lane; const GAS f32x4* xr1 = (const GAS f32x4*)(x + (size_t)(m + NGW) * DM) + lane;
            f32x4 v0[8], v1[8]; float s0 = 0.f, s1 = 0.f;
#pragma unroll
            for (int j = 0; j < 8; ++j) v0[j] = __builtin_nontemporal_load(xr0 + 64 * j);
#pragma unroll
            for (int j = 0; j < 8; ++j) v1[j] = __builtin_nontemporal_load(xr1 + 64 * j);
#pragma unroll
            for (int j = 0; j < 8; ++j) { s0 += (v0[j].x * v0[j].x + v0[j].y * v0[j].y) + (v0[j].z * v0[j].z + v0[j].w * v0[j].w); s1 += (v1[j].x * v1[j].x + v1[j].y * v1[j].y) + (v1[j].z * v1[j].z + v1[j].w * v1[j].w); }
            const float rstd0 = 1.0f / sqrtf(wave_sum(s0) * (1.f / DM) + RMS_EPS), rstd1 = 1.0f / sqrtf(wave_sum(s1) * (1.f / DM) + RMS_EPS);
            GAS unsigned long long* o80 = (GAS unsigned long long*)(XN + (size_t)m * DM) + lane; GAS unsigned long long* o81 = (GAS unsigned long long*)(XN + (size_t)(m + NGW) * DM) + lane;
#pragma unroll
            for (int j = 0; j < 8; ++j) { const f32x4 gg = *((const GAS f32x4*)g_attn + lane + 64 * j);
                o80[64 * j] = (unsigned long long)pk2(v0[j].x * rstd0 * gg.x, v0[j].y * rstd0 * gg.y) | ((unsigned long long)pk2(v0[j].z * rstd0 * gg.z, v0[j].w * rstd0 * gg.w) << 32);
                o81[64 * j] = (unsigned long long)pk2(v1[j].x * rstd1 * gg.x, v1[j].y * rstd1 * gg.y) | ((unsigned long long)pk2(v1[j].z * rstd1 * gg.z, v1[j].w * rstd1 * gg.w) << 32); }
        }
        for (int i = bx * (NWAVES * 64) + tid; i < M; i += G * NWAVES * 64) { SS1[i] = 0.f; SS2[i] = 0.f; }
    }
    SEAM(0); STAMP(1);
    if (IN(1)) {
        pg8::Gemm g{XN, WIN, M, NIN, DM}; pg8::StaticOrder S; S.init(M, NIN, G, bx); S.dup = NREP(1); S.wgm = WGM_P1;
        pg8::EpiQKV E{QKV, NIN};
        pg8::gemm_phase<pg8::EpiQKV, pg8::StaticOrder, true, true>(ldsl, g, S, E, wave);
    }
    SEAM(1); STAMP(2);
    if (IN(2)) { const int lane = mk_lane();
        float lam;
        { const float a = lambda_qk[lane] * lambda_qk[64 + lane], b2 = lambda_qk[128 + lane] * lambda_qk[192 + lane];
          lam = __expf(wave_sum(a)) - __expf(wave_sum(b2)) + LAM_INIT; }
        const int grp = vcu >> 3, k = vcu & 7, gb = grp >> 3, gh = grp & 7;
        const att::bf16* rowb = (const att::bf16*)QKV + (size_t)gb * SEQ * NIN;
        att::ConvJob cj{w_gate, w_up, w_down, w_out, g_ffn, WGU, WDN, WOUT, vcu, vcu + G * ((att::CV_TOTAL - 1 - vcu) / G), G};
        for (int i = 0; i < 2 * NREP(20); ++i) {
            const int c = i & 1;
            att::attn_dense_body(rowb + (size_t)k * 256 * NIN + 3072 + gh * HD, rowb + 4096 + gh * HD, rowb + 5120 + gh * HD, nullptr, 1024, 4 * c, SEQ, (char*)lds, wave, cj,
                                 c == 1, Y + ((size_t)gb * SEQ + k * 256) * DM + 1024 + gh * HD, lam, subln);
        }
        __syncthreads();
        { float* scr = (float*)((char*)lds + RING_BYTES) + wave * 64;
          for (int rep = 0; rep < NREP(21); ++rep) {
            att::swa_wg_unit((const att::bf16*)QKV, 0, gb * 8 + gh, 8 * k, 0, OA, LSE, (char*)lds, scr, wave);
            att::swa_wg_unit((const att::bf16*)QKV, 1, (gb * 4 + (k >> 1)) * 8 + gh, 8 * (k & 1), 0, OA + (size_t)M * 1024, LSE + (size_t)M * 8, (char*)lds, scr, wave);
            att::swa_wg_unit((const att::bf16*)QKV, 2, (gb * 16 + 2 * k) * 8 + gh, 0, 8, OA + (size_t)2 * M * 1024, LSE + (size_t)2 * M * 8, (char*)lds, scr, wave);
          } }
        asm volatile("s_waitcnt vmcnt(0)" ::: "memory"); __syncthreads();
        if (wave == 0 && lane == 0) {
            unsigned* gc = (unsigned*)(ws + WS_GRP) + 64 * grp;
            __builtin_amdgcn_fence(__ATOMIC_RELEASE, "agent"); asm volatile("s_waitcnt vmcnt(0)" ::: "memory");
            __hip_atomic_fetch_add(gc, 1u, __ATOMIC_RELAXED, __HIP_MEMORY_SCOPE_AGENT);
            unsigned sp = 0; while (__hip_atomic_load(gc, __ATOMIC_RELAXED, __HIP_MEMORY_SCOPE_AGENT) < 8u) { __builtin_amdgcn_s_sleep(2); if (++sp > (1u << 22)) break; }
            __builtin_amdgcn_fence(__ATOMIC_ACQUIRE, "agent"); asm volatile("s_waitcnt vmcnt(0)" ::: "memory");
        }
        __syncthreads();
        { const int col = (lane & 15) * 8;
#pragma unroll 2
          for (int it = 0; it < 8; ++it) {
            const size_t m = (size_t)gb * SEQ + k * 256 + wave * 32 + it * 4 + (lane >> 4);
            const float l0 = LSE[m * 8 + gh], l1 = LSE[((size_t)M + m) * 8 + gh], l2 = LSE[((size_t)2 * M + m) * 8 + gh];
            const float mx = fmaxf(l0, fmaxf(l1, l2)); float w0 = __expf(l0 - mx), w1 = __expf(l1 - mx), w2 = __expf(l2 - mx);
            const float inv = 1.0f / (w0 + w1 + w2); w0 *= inv; w1 *= inv; w2 *= inv;
            const v4u a0 = *(const GAS v4u*)(OA + m * 1024 + gh * HD + col), a1 = *(const GAS v4u*)(OA + ((size_t)M + m) * 1024 + gh * HD + col), a2 = *(const GAS v4u*)(OA + ((size_t)2 * M + m) * 1024 + gh * HD + col);
            v4u ya;
#pragma unroll
            for (int i = 0; i < 4; ++i) ya[i] = pk2(w0 * bflo(a0[i]) + w1 * bflo(a1[i]) + w2 * bflo(a2[i]), w0 * bfhi(a0[i]) + w1 * bfhi(a1[i]) + w2 * bfhi(a2[i]));
            *(GAS v4u*)(Y + m * DM + gh * HD + col) = ya;
          } }
        __syncthreads();
    }
    SEAM(2); STAMP(3);
    if (IN(4)) {
        pg8::Gemm g{Y, WOUT, M, DM, DM}; pg8::StaticOrder S; S.init(M, DM, G, bx); S.dup = NREP(4); S.wgm = WGM_P4;
        pg8::EpiOut E{x, XG, g_ffn, SS1, DM};
        pg8::gemm_phase<pg8::EpiOut, pg8::StaticOrder, true, true>(ldsl, g, S, E, wave);
    }
    SEAM(4); STAMP(4);
    if (IN(5)) {
        pg8::Gemm g{XG, WGU, M, NGU, DM}; pg8::StaticOrder S; S.init(M, NGU, G, bx); S.dup = NREP(5); S.wgm = WGM_P5;
        S.split_from = -1  ; S.kh_bytes = (DM / 2) * 2; S.kh_nt = DM / 128;
        pg8::EpiGateUp E{HB, DFF, SS1, 1.0f / DM, RMS_EPS, (pg8::f32x4*)(ws + WS_Y), (unsigned*)(ws + WS_FLAG)};
        pg8::gemm_phase<pg8::EpiGateUp, pg8::StaticOrder, true, true>(ldsl, g, S, E, wave);
        if (bx >= 128 && G == 256) {
            const int lane = mk_lane(); LAS float* scr = (LAS float*)(ldsl + wave * 16384);
            constexpr int I_D = (DFF / 64) * (DM / 32);
            for (int it = (bx - 128) * NWAVES + wave; it < I_D; it += 128 * NWAVES) { const int nblk = DM / 32, kb = it / nblk, nb = it % nblk; transpose_item(w_down, DFF, DM, WDN, 64 * kb, 32 * nb, 32 * nb, scr, lane); }
        }
    }
    SEAM(5); STAMP(5);
    if (IN(6)) {
        pg8::Gemm g{HB, WDN, M, DM, DFF}; pg8::StaticOrder S; S.init(M, DM, G, bx); S.wgm = WGM_P6;
        pg8::EpiDownNorm E{XG, g_ffn, out, g_final, SS2, (unsigned*)(ws + WS_CNT), DM, 1.0f / DM, RMS_EPS};
        pg8::gemm_phase<pg8::EpiDownNorm, pg8::StaticOrder, false, true>(ldsl, g, S, E, wave);
    }
    STAMP(6);
    if (MK_TIME_PHASE >= 0 && bx == 0 && wave == 0) { if (tph1 == 0) tph1 = __builtin_amdgcn_s_memrealtime(); const unsigned long long t0_ = __builtin_amdgcn_s_memrealtime(); while (__builtin_amdgcn_s_memrealtime() - t0_ < tph1 - tph0) __builtin_amdgcn_s_sleep(8); }
#undef IN
#undef SEAM
}

extern "C" void kernel_launch(void* const* d_in, const int* in_sizes, int n_in, void* d_out, int out_size, void* d_ws, size_t ws_size, hipStream_t stream) {
    static int grid = 0;
    if (grid == 0) {
        if (n_in != 11 || in_sizes[0] != M * DM || out_size != M * DM || ws_size < WS_END) { fprintf(stderr, "kernel_launch: shape/workspace mismatch (n_in %d, in0 %d, out %d, ws %zu)\n", n_in, n_in > 0 ? in_sizes[0] : -1, out_size, ws_size); grid = -1; return; }
        int dev = 0, cus = 0, per_cu = 0;
        if (hipGetDevice(&dev) != hipSuccess || hipDeviceGetAttribute(&cus, hipDeviceAttributeMultiprocessorCount, dev) != hipSuccess) { grid = -1; return; }
        if (hipFuncSetAttribute((const void*)mk_fwd, hipFuncAttributeMaxDynamicSharedMemorySize, LDS_BYTES) != hipSuccess) { fprintf(stderr, "kernel_launch: hipFuncSetAttribute failed\n"); grid = -1; return; }
        if (hipOccupancyMaxActiveBlocksPerMultiprocessor(&per_cu, (const void*)mk_fwd, NWAVES * 64, LDS_BYTES) != hipSuccess || per_cu < 1) { fprintf(stderr, "kernel_launch: occupancy query says %d\n", per_cu); per_cu = 1; }
        (void)hipGetLastError();
        grid = cus;
        if (grid != 256) { fprintf(stderr, "kernel_launch: this kernel needs a 256-CU device (got %d)\n", cus); grid = -1; return; }
    }
    if (grid < 0) return;
    Args a{};
    for (int i = 0; i < 11; ++i) a.in[i] = (const float*)d_in[i];
    a.out = (float*)d_out; a.ws = (unsigned char*)d_ws;
#if MK_ONE_LAUNCH
    if (hipMemsetAsync((char*)d_ws + WS_BAR, 0, BAR_BYTES, stream) != hipSuccess) { fprintf(stderr, "kernel_launch: memset failed\n"); return; }
#ifdef MK_PROBE_MEMSET2
    (void)hipMemsetAsync((char*)d_ws + WS_BAR, 0, BAR_BYTES, stream);
#endif
    a.ph_lo = 0; a.ph_hi = NPHASE;
    void* kargs[] = {&a};
    hipError_t e = hipLaunchCooperativeKernel((const void*)mk_fwd, dim3(grid), dim3(NWAVES * 64), kargs, LDS_BYTES, stream);
    if (e != hipSuccess) fprintf(stderr, "kernel_launch: cooperative launch failed: %s (grid %d)\n", hipGetErrorString(e), grid);
#else
    for (int p = 0; p < NPHASE; ++p) {
        a.ph_lo = p; a.ph_hi = p + 1;
        hipLaunchKernelGGL(mk_fwd, dim3(grid), dim3(NWAVES * 64), LDS_BYTES, stream, a);
    }
#endif
}
```
